# Optimizing an MI355X kernel written in HIP

```python
import jax, jax.numpy as jnp
from jax import lax
import numpy as np

D_MODEL = 2048
BATCH = 4
SEQ = 4096
DEPTH = 2

CHUNK = 64
N_MIXERS = 2
EPS = 1e-6

SSM_EXPAND = 2
D_INNER = SSM_EXPAND * D_MODEL
SSM_HEADDIM = 64
SSM_HEADS = D_INNER // SSM_HEADDIM
SSM_GROUPS = 8
SSM_HEADS_PER_GROUP = SSM_HEADS // SSM_GROUPS
SSM_STATE = 128
SSM_CONV = 4
SSD_CHUNK = CHUNK
CONV_DIM = D_INNER + 2 * SSM_GROUPS * SSM_STATE
SSM_IN = D_INNER + CONV_DIM + SSM_HEADS
DT_MIN = 1e-3
DT_MAX = 1e-1

POOL_EXPAND = 2
D_POOL = POOL_EXPAND * D_MODEL
POOL_WINDOWS = (2, 4, 8, 16)
POOL_GROUPS = len(POOL_WINDOWS)
POOL_GROUP_DIM = D_POOL // POOL_GROUPS

kernel_name = "hybrid_ssd_multiscale_pool_trunk"


def rmsnorm(x, g):
    xf = x.astype(jnp.float32)
    y = xf * lax.rsqrt(jnp.mean(xf * xf, axis=-1, keepdims=True) + EPS)
    return (y * g.astype(jnp.float32)).astype(x.dtype)


def causal_depthwise_conv(x, w, b):
    k_taps = w.shape[0]
    length = x.shape[1]
    xp = jnp.pad(x, ((0, 0), (k_taps - 1, 0), (0, 0)))
    y = b
    for k in range(k_taps):
        y = y + xp[:, k:k + length] * w[k]
    return y


def ssd_chunked_scan(xdt, a_dt, bm, cm):
    bsz, length, g, r, p = xdt.shape
    n = bm.shape[-1]
    n_chunks = length // SSD_CHUNK

    def to_chunks(t):
        t = t.reshape((bsz, n_chunks, SSD_CHUNK) + t.shape[2:])
        return jnp.moveaxis(t, 1, 0)

    mask = jnp.tril(jnp.ones((SSD_CHUNK, SSD_CHUNK), dtype=bool))[None, :, :, None, None]

    def step(state, inp):
        xc, ac, bc, cc = inp
        cs = jnp.cumsum(ac, axis=1)
        seg = cs[:, :, None] - cs[:, None, :]
        decay = jnp.exp(jnp.where(mask, seg, -jnp.inf))
        cb = jnp.einsum("blgn,bsgn->blsg", cc, bc)
        y_diag = jnp.einsum("blsg,blsgr,bsgrp->blgrp", cb, decay, xc)
        y_off = jnp.einsum("blgn,bgrpn,blgr->blgrp", cc, state, jnp.exp(cs))
        last = cs[:, -1]
        w_in = jnp.exp(last[:, None] - cs)
        new_state = state * jnp.exp(last)[..., None, None] + jnp.einsum(
            "bsgn,bsgr,bsgrp->bgrpn", bc, w_in, xc)
        return new_state, y_diag + y_off

    state0 = jnp.zeros((bsz, g, r, p, n), jnp.float32)
    _, ys = lax.scan(step, state0, (to_chunks(xdt), to_chunks(a_dt), to_chunks(bm), to_chunks(cm)))
    return jnp.moveaxis(ys, 0, 1).reshape(bsz, length, g, r, p)


def ssm_mixer(h, w_in, conv_w, conv_b, dt_bias, a_log, d_skip, norm_g, w_out):
    bsz, length, _ = h.shape
    g, r, p, n = SSM_GROUPS, SSM_HEADS_PER_GROUP, SSM_HEADDIM, SSM_STATE
    proj = h @ w_in
    z = proj[..., :D_INNER]
    xbc = proj[..., D_INNER:D_INNER + CONV_DIM]
    dt = proj[..., D_INNER + CONV_DIM:]
    xbc = jax.nn.silu(causal_depthwise_conv(xbc, conv_w, conv_b)).astype(jnp.float32)
    xs = xbc[..., :D_INNER].reshape(bsz, length, g, r, p)
    bm = xbc[..., D_INNER:D_INNER + g * n].reshape(bsz, length, g, n)
    cm = xbc[..., D_INNER + g * n:].reshape(bsz, length, g, n)
    dt = jax.nn.softplus(dt.astype(jnp.float32) + dt_bias.astype(jnp.float32))
    dt = dt.reshape(bsz, length, g, r)
    a = -jnp.exp(a_log.astype(jnp.float32)).reshape(g, r)
    y = ssd_chunked_scan(xs * dt[..., None], dt * a, bm, cm)
    y = y + d_skip.astype(jnp.float32).reshape(g, r, 1) * xs
    y = y.reshape(bsz, length, D_INNER) * jax.nn.silu(z.astype(jnp.float32))
    y = rmsnorm(y, norm_g)
    return y.astype(h.dtype) @ w_out


def pool_mixer(h, w_in, w_group, scale, w_out):
    bsz, length, _ = h.shape
    proj = h @ w_in
    u = proj[..., :D_POOL].astype(jnp.float32).reshape(bsz, length, POOL_GROUPS, POOL_GROUP_DIM)
    gate = proj[..., D_POOL:].astype(jnp.float32)
    cs = jnp.cumsum(u, axis=1)
    pos = jnp.arange(1, length + 1, dtype=jnp.int32)
    means = []
    for gi, win in enumerate(POOL_WINDOWS):
        c = cs[:, :, gi]
        shifted = jnp.pad(c, ((0, 0), (win, 0), (0, 0)))[:, :length]
        cnt = jnp.minimum(pos, win).astype(jnp.float32)[None, :, None]
        means.append((c - shifted) / cnt)
    mixed = jnp.stack(means, axis=2) - u
    mixed = jnp.einsum("blgc,gcd->blgd", mixed, w_group.astype(jnp.float32))
    mixed = mixed.reshape(bsz, length, D_POOL) * scale.astype(jnp.float32)
    y = mixed * jax.nn.silu(gate)
    return y.astype(h.dtype) @ w_out


def setup_inputs(seed: int = 0) -> dict:
    key = jax.random.key(seed)
    ks = jax.random.split(key, 20)
    n_a = (DEPTH + N_MIXERS - 1) // N_MIXERS
    n_b = DEPTH // N_MIXERS
    f32 = jnp.float32
    x = jax.random.normal(ks[0], (BATCH, SEQ, D_MODEL), f32)
    ln_g = 1.0 + 0.05 * jax.random.normal(ks[1], (DEPTH, D_MODEL), f32)
    final_g = 1.0 + 0.05 * jax.random.normal(ks[2], (D_MODEL,), f32)
    ssm_w_in = jax.random.normal(ks[3], (n_a, D_MODEL, SSM_IN), f32) * D_MODEL ** -0.5
    ssm_conv_w = jax.random.normal(ks[4], (n_a, SSM_CONV, CONV_DIM), f32) * SSM_CONV ** -0.5
    ssm_conv_b = 0.01 * jax.random.normal(ks[5], (n_a, CONV_DIM), f32)
    u_dt = jax.random.uniform(ks[6], (n_a, SSM_HEADS), f32)
    dt0 = jnp.exp(u_dt * (np.log(DT_MAX) - np.log(DT_MIN)) + np.log(DT_MIN))
    ssm_dt_bias = dt0 + jnp.log(-jnp.expm1(-dt0))
    ssm_a_log = jnp.log(jax.random.uniform(ks[7], (n_a, SSM_HEADS), f32, 1.0, 16.0))
    ssm_d = 1.0 + 0.1 * jax.random.normal(ks[8], (n_a, SSM_HEADS), f32)
    ssm_norm_g = 1.0 + 0.05 * jax.random.normal(ks[9], (n_a, D_INNER), f32)
    ssm_w_out = jax.random.normal(ks[10], (n_a, D_INNER, D_MODEL), f32) * D_INNER ** -0.5
    pool_w_in = jax.random.normal(ks[11], (n_b, D_MODEL, 2 * D_POOL), f32) * D_MODEL ** -0.5
    pool_w_group = jax.random.normal(ks[12], (n_b, POOL_GROUPS, POOL_GROUP_DIM, POOL_GROUP_DIM), f32) * POOL_GROUP_DIM ** -0.5
    pool_scale = 1.0 + 0.1 * jax.random.normal(ks[13], (n_b, D_POOL), f32)
    pool_w_out = jax.random.normal(ks[14], (n_b, D_POOL, D_MODEL), f32) * D_POOL ** -0.5
    return {"x": x, "ln_g": ln_g, "final_g": final_g,
            "ssm_w_in": ssm_w_in, "ssm_conv_w": ssm_conv_w, "ssm_conv_b": ssm_conv_b,
            "ssm_dt_bias": ssm_dt_bias, "ssm_a_log": ssm_a_log, "ssm_d": ssm_d,
            "ssm_norm_g": ssm_norm_g, "ssm_w_out": ssm_w_out,
            "pool_w_in": pool_w_in, "pool_w_group": pool_w_group,
            "pool_scale": pool_scale, "pool_w_out": pool_w_out}


def reference(x, ln_g, final_g, ssm_w_in, ssm_conv_w, ssm_conv_b, ssm_dt_bias, ssm_a_log,
              ssm_d, ssm_norm_g, ssm_w_out, pool_w_in, pool_w_group, pool_scale, pool_w_out):
    for i in range(DEPTH):
        j = i // N_MIXERS
        hn = rmsnorm(x, ln_g[i])
        if i % N_MIXERS == 0:
            x = x + ssm_mixer(hn, ssm_w_in[j], ssm_conv_w[j], ssm_conv_b[j], ssm_dt_bias[j],
                              ssm_a_log[j], ssm_d[j], ssm_norm_g[j], ssm_w_out[j])
        else:
            x = x + pool_mixer(hn, pool_w_in[j], pool_w_group[j], pool_scale[j], pool_w_out[j])
    return rmsnorm(x, final_g)
```

```cpp
#include <hip/hip_runtime.h>
#include <cstdio>
#include <cstdint>

#ifndef MK_ONE_LAUNCH
#define MK_ONE_LAUNCH 0
#endif

namespace pg8 {
#define PG8_LAS __attribute__((address_space(3)))
typedef unsigned short bf16_t;
typedef short bf16x8 __attribute__((ext_vector_type(8)));
typedef float f32x4 __attribute__((ext_vector_type(4)));
typedef unsigned u32x4 __attribute__((ext_vector_type(4)));
typedef unsigned u32x2 __attribute__((ext_vector_type(2)));
constexpr int BM = 256, BK = 64, HALF = 128, HTB = HALF * BK * 2  , STAGE_BYTES = 8 * HTB, NXCD = 8, WGM = 8;
constexpr float RMS_EPS = 1e-6f;

__host__ __device__ __forceinline__ int lds_byte(int r, int c) { const int st = (r >> 4) * 2 + (c >> 5), rr = r & 15, cc = c & 31, ob = rr * 64 + cc * 2; return st * 1024 + (ob ^ (((ob >> 9) & 1) << 5)); }
__host__ __device__ __forceinline__ void stage_rc(int b, int& R, int& C) { const int st = b / 1024, sb = b % 1024, swz = sb ^ (((sb >> 9) & 1) << 5); R = (st >> 1) * 16 + swz / 64; C = (st & 1) * 32 + (swz % 64) / 2; }
__host__ __device__ __forceinline__ int perm32(int rho) { const int n = rho >> 4, i = rho & 15; return 8 * (i >> 2) + 4 * n + (i & 3); }

struct Unit { int pm, pn; };
struct Gemm { const bf16_t* A; const bf16_t* Bt; int M, N, K, lda, ldb, gsh; };

struct StaticOrder {
    int nM, nN, nwg, G, c;
    __host__ __device__ void init(int M, int N, int G_, int c_) { nM = M / BM; nN = N / BM; nwg = nM * nN; G = G_; c = c_; }
    __host__ __device__ bool next(int i, Unit& u) const {
        const long L = (long)i * G + c; if (L >= nwg) return false;
        int wgid = (int)L; { const int q = nwg / NXCD, r = nwg % NXCD, xcd = wgid % NXCD, off = wgid / NXCD; wgid = (xcd < r ? xcd * (q + 1) : r * (q + 1) + (xcd - r) * q) + off; }
        const int nig = WGM * nN, gid = wgid / nig, fm = gid * WGM, gsz = (nM - fm) < WGM ? (nM - fm) : WGM;
        u.pm = fm + ((wgid % nig) % gsz); u.pn = (wgid % nig) / gsz; return true;
    }
    __device__ __forceinline__ void a_ready(const Unit&) const {}
    __device__ __forceinline__ void done(const Unit&) const {}
};

__device__ __forceinline__ unsigned cvt_pk_bf16(float lo, float hi) { unsigned r; asm volatile("v_cvt_pk_bf16_f32 %0, %1, %2" : "=v"(r) : "v"(lo), "v"(hi)); return r; }
__device__ __forceinline__ float bf_lo(unsigned w) { return __uint_as_float(w << 16); }
__device__ __forceinline__ float bf_hi(unsigned w) { return __uint_as_float(w & 0xffff0000u); }
__device__ __forceinline__ float sigmoid_f(float v) { return __builtin_amdgcn_rcpf(1.0f + __builtin_amdgcn_exp2f(-1.4426950408889634f * v)); }

struct EpiProj {
    static constexpr bool PERM = true, AFTER_DRAIN = false;
    bf16_t* O0; int ld0; bf16_t* O1; int ld1; int split_pn; const float* ssq; float inv_n;
    __device__ __forceinline__ void operator()(const f32x4 (&acc)[2][2][4][2], const Unit& u, int wr, int wc, int fr, int fq) const {
        const int row0 = u.pm * BM + wr * 64 + fr;
        bf16_t* base; int ld, colt;
        if (u.pn < split_pn) { base = O0; ld = ld0; colt = u.pn * BM; } else { base = O1; ld = ld1; colt = (u.pn - split_pn) * BM; }
        const int col0 = colt + wc * 32 + 8 * fq;
#pragma unroll
        for (int ai = 0; ai < 2; ++ai)
#pragma unroll
            for (int m = 0; m < 4; ++m) { const int row = row0 + ai * HALF + m * 16; const float s = rsqrtf(ssq[row] * inv_n + RMS_EPS);
                bf16_t* rowp = base + (size_t)row * ld + col0;
#pragma unroll
                for (int bj = 0; bj < 2; ++bj) { const f32x4 v0 = acc[ai][bj][m][0] * s, v1 = acc[ai][bj][m][1] * s;
                    u32x4 w; w.x = cvt_pk_bf16(v0[0], v0[1]); w.y = cvt_pk_bf16(v0[2], v0[3]); w.z = cvt_pk_bf16(v1[0], v1[1]); w.w = cvt_pk_bf16(v1[2], v1[3]);
                    *(u32x4*)(rowp + bj * HALF) = w; } }
    }
};
struct EpiRes {
    static constexpr bool PERM = false, AFTER_DRAIN = false;
    const float* base; float* out; bf16_t* ob; const float* ssq_in; float inv_n; float* ssq_out; int ldc;
    __device__ __forceinline__ void operator()(const f32x4 (&acc)[2][2][4][2], const Unit& u, int wr, int wc, int fr, int fq) const {
        const int row0 = u.pm * BM + wr * 64 + fr, col0 = u.pn * BM + wc * 32 + 4 * fq;
#pragma unroll
        for (int ai = 0; ai < 2; ++ai)
#pragma unroll
            for (int m = 0; m < 4; ++m) { const int row = row0 + ai * HALF + m * 16; const float s = ssq_in ? rsqrtf(ssq_in[row] * inv_n + RMS_EPS) : 1.0f;
                const size_t off = (size_t)row * ldc + col0; float q = 0.f;
#pragma unroll
                for (int bj = 0; bj < 2; ++bj)
#pragma unroll
                    for (int n = 0; n < 2; ++n) { const size_t o2 = off + bj * HALF + n * 16; const f32x4 b = *(const f32x4*)(base + o2); const f32x4 o = b + acc[ai][bj][m][n] * s;
                        *(f32x4*)(out + o2) = o; q += (o[0] * o[0] + o[1] * o[1]) + (o[2] * o[2] + o[3] * o[3]);
                        if (ob) { u32x2 w; w.x = cvt_pk_bf16(o[0], o[1]); w.y = cvt_pk_bf16(o[2], o[3]); *(u32x2*)(ob + o2) = w; } }
                if (ssq_out) { q += __shfl_xor(q, 16); q += __shfl_xor(q, 32); if (fq == 0) atomicAdd(ssq_out + row, q); }
                asm volatile("" ::: "memory"); }
    }
};
struct EpiGate {
    static constexpr bool PERM = true, AFTER_DRAIN = false;
    bf16_t* O; const bf16_t* gate; const float* scale; int ldc;
    __device__ __forceinline__ void operator()(const f32x4 (&acc)[2][2][4][2], const Unit& u, int wr, int wc, int fr, int fq) const {
        const int row0 = u.pm * BM + wr * 64 + fr, col0 = u.pn * BM + wc * 32 + 8 * fq;
        f32x4 sc[2][2];
#pragma unroll
        for (int bj = 0; bj < 2; ++bj)
#pragma unroll
            for (int n = 0; n < 2; ++n) sc[bj][n] = *(const f32x4*)(scale + col0 + bj * HALF + 4 * n);
#pragma unroll
        for (int ai = 0; ai < 2; ++ai)
#pragma unroll
            for (int m = 0; m < 4; ++m) { const size_t off = (size_t)(row0 + ai * HALF + m * 16) * ldc + col0;
#pragma unroll
                for (int bj = 0; bj < 2; ++bj) { const u32x4 gw = *(const u32x4*)(gate + off + bj * HALF);
                    const float g0 = bf_lo(gw.x), g1 = bf_hi(gw.x), g2 = bf_lo(gw.y), g3 = bf_hi(gw.y), g4 = bf_lo(gw.z), g5 = bf_hi(gw.z), g6 = bf_lo(gw.w), g7 = bf_hi(gw.w);
                    const f32x4 v0 = acc[ai][bj][m][0] * sc[bj][0], v1 = acc[ai][bj][m][1] * sc[bj][1];
                    u32x4 w; w.x = cvt_pk_bf16(v0[0] * g0 * sigmoid_f(g0), v0[1] * g1 * sigmoid_f(g1)); w.y = cvt_pk_bf16(v0[2] * g2 * sigmoid_f(g2), v0[3] * g3 * sigmoid_f(g3));
                    w.z = cvt_pk_bf16(v1[0] * g4 * sigmoid_f(g4), v1[1] * g5 * sigmoid_f(g5)); w.w = cvt_pk_bf16(v1[2] * g6 * sigmoid_f(g6), v1[3] * g7 * sigmoid_f(g7));
                    *(u32x4*)(O + off + bj * HALF) = w; } }
    }
};

template <class Epi, class Sched, bool ALIGN_EPI = false, bool SP2 = false>
__device__ __forceinline__ void gemm_phase(PG8_LAS unsigned char* lds, const Gemm g, const Sched& S, const Epi& E) {
    const int tid = threadIdx.x, wid = __builtin_amdgcn_readfirstlane(tid >> 6), lane = tid & 63, wr = wid >> 2, wc = wid & 3, fr = lane & 15, fq = lane >> 4;
    const int K = g.K, nt = K / BK;
    unsigned voffA[2], voffB[2];
#pragma unroll
    for (int i = 0; i < 2; ++i) { int R, C; stage_rc(tid * 16 + i * 8192, R, C); const int Rb = Epi::PERM ? ((R & ~31) + perm32(R & 31)) : R;
        voffA[i] = (unsigned)(R * g.lda + C) * 2u; voffB[i] = (unsigned)(Rb * g.ldb + C) * 2u; }
    const size_t kstep = (size_t)(BK * 2);
    const size_t hstepA = (size_t)HALF * g.lda * 2, hstepB = (size_t)HALF * g.ldb * 2;
    const size_t tstepA = 2 * hstepA, tstepB = 2 * hstepB, gstepA = (size_t)K * 2;
    const unsigned ldsw = (unsigned)wid * 1024u;
    const int aoff = lds_byte(wr * 64 + fr, fq * 8), boff = lds_byte(wc * 32 + fr, fq * 8);
#define PG8_SA(b, h) (((b) * 2 + (h)) * HTB)
#define PG8_SB(b, h) ((4 + (b) * 2 + (h)) * HTB)
#define PG8_STAGE(bufoff, gbase, voff) do { _Pragma("unroll") for (int _i = 0; _i < 2; ++_i) \
        __builtin_amdgcn_global_load_lds((const unsigned*)((const char*)(gbase) + (voff)[_i]), (PG8_LAS unsigned*)(lds + (bufoff) + ldsw + _i * 8192), 16, 0, 0); } while (0)
#define PG8_LDA(dst, b, h) do { _Pragma("unroll") for (int m = 0; m < 4; ++m) _Pragma("unroll") for (int k = 0; k < 2; ++k) dst[m][k] = *(const PG8_LAS bf16x8*)(lds + PG8_SA(b, h) + aoff + m * 2048 + k * 1024); } while (0)
#define PG8_LDB(dst, b, h) do { _Pragma("unroll") for (int n = 0; n < 2; ++n) _Pragma("unroll") for (int k = 0; k < 2; ++k) dst[n][k] = *(const PG8_LAS bf16x8*)(lds + PG8_SB(b, h) + boff + n * 2048 + k * 1024); } while (0)
#define PG8_MMA(ai, bj, At, Bt) do { __builtin_amdgcn_s_setprio(1); _Pragma("unroll") for (int m = 0; m < 4; ++m) _Pragma("unroll") for (int n = 0; n < 2; ++n) _Pragma("unroll") for (int k = 0; k < 2; ++k) \
        acc[ai][bj][m][n] = __builtin_amdgcn_mfma_f32_16x16x32_bf16(Bt[n][k], At[m][k], acc[ai][bj][m][n], 0, 0, 0); __builtin_amdgcn_s_setprio(0); } while (0)
#define PG8_WAIT_V(n) asm volatile("s_waitcnt vmcnt(" #n ")" ::: "memory")
#define PG8_WAIT_L(n) asm volatile("s_waitcnt lgkmcnt(" #n ")" ::: "memory")
#define PG8_BAR __builtin_amdgcn_s_barrier()
#define PG8_SCHED __builtin_amdgcn_sched_barrier(0)
    Unit cur, nxt; int ui = 0;
    if (!S.next(0, cur)) return;
    f32x4 acc[2][2][4][2];
#pragma unroll
    for (int a = 0; a < 2; ++a)
#pragma unroll
        for (int b = 0; b < 2; ++b)
#pragma unroll
            for (int m = 0; m < 4; ++m)
#pragma unroll
                for (int n = 0; n < 2; ++n) acc[a][b][m][n] = (f32x4){0.f, 0.f, 0.f, 0.f};
    bf16x8 At[4][2], B0[2][2], B1[2][2];
    const char* cA = (const char*)g.A + (size_t)cur.pm * tstepA + (size_t)(cur.pn >> g.gsh) * gstepA; const char* cB = (const char*)g.Bt + (size_t)cur.pn * tstepB;
    S.a_ready(cur);
    if constexpr (SP2) {
        PG8_STAGE(PG8_SB(0, 0), cB, voffB); PG8_STAGE(PG8_SB(0, 1), cB + hstepB, voffB); PG8_STAGE(PG8_SA(0, 0), cA, voffA); PG8_STAGE(PG8_SA(0, 1), cA + hstepA, voffA);
        if (wr == 1) PG8_BAR;
        PG8_WAIT_V(2); PG8_BAR;
        PG8_STAGE(PG8_SB(1, 0), cB + kstep, voffB); PG8_STAGE(PG8_SA(1, 0), cA + kstep, voffA); PG8_STAGE(PG8_SB(1, 1), cB + hstepB + kstep, voffB);
        PG8_WAIT_V(6); PG8_BAR;
    } else {
        PG8_STAGE(PG8_SB(0, 0), cB, voffB); PG8_STAGE(PG8_SA(0, 0), cA, voffA); PG8_STAGE(PG8_SB(0, 1), cB + hstepB, voffB); PG8_STAGE(PG8_SA(0, 1), cA + hstepA, voffA);
        if (wr == 1) PG8_BAR;
        PG8_WAIT_V(4); PG8_BAR;
        PG8_STAGE(PG8_SB(1, 0), cB + kstep, voffB); PG8_STAGE(PG8_SA(1, 0), cA + kstep, voffA); PG8_STAGE(PG8_SB(1, 1), cB + hstepB + kstep, voffB);
        PG8_WAIT_V(6); PG8_BAR;
    }
    for (;;) {
        const bool has_next = S.next(ui + 1, nxt);
        const char* nA = has_next ? (const char*)g.A + (size_t)nxt.pm * tstepA + (size_t)(nxt.pn >> g.gsh) * gstepA : cA; const char* nB = has_next ? (const char*)g.Bt + (size_t)nxt.pn * tstepB : cB;
        for (int t = 0; t < nt; t += 2) {
            const bool last = (t == nt - 2);
            const char* a1 = cA + (size_t)(t + 1) * kstep;
            const char* a2 = last ? nA : cA + (size_t)(t + 2) * kstep; const char* b2 = last ? nB : cB + (size_t)(t + 2) * kstep;
            const char* a3 = a2 + kstep; const char* b3 = b2 + kstep;
            if (last && has_next) S.a_ready(nxt);
            if constexpr (SP2) {
            PG8_LDB(B0, 0, 0); PG8_LDB(B1, 0, 1); PG8_SCHED; PG8_LDA(At, 0, 0); PG8_STAGE(PG8_SA(1, 1), a1 + hstepA, voffA);
            PG8_WAIT_V(8); PG8_WAIT_L(0); PG8_BAR; PG8_MMA(0, 0, At, B0); PG8_MMA(0, 1, At, B1); PG8_BAR; PG8_SCHED;
            PG8_LDA(At, 0, 1); PG8_STAGE(PG8_SB(0, 0), b2, voffB); PG8_STAGE(PG8_SB(0, 1), b2 + hstepB, voffB); PG8_STAGE(PG8_SA(0, 0), a2, voffA);
            PG8_WAIT_V(8); PG8_WAIT_L(0); PG8_BAR; PG8_MMA(1, 0, At, B0); PG8_MMA(1, 1, At, B1); PG8_BAR; PG8_SCHED;
            PG8_LDB(B0, 1, 0); PG8_LDB(B1, 1, 1); PG8_SCHED; PG8_LDA(At, 1, 0); PG8_STAGE(PG8_SA(0, 1), a2 + hstepA, voffA);
            PG8_WAIT_V(8); PG8_WAIT_L(0); PG8_BAR; PG8_MMA(0, 0, At, B0); PG8_MMA(0, 1, At, B1); PG8_BAR; PG8_SCHED;
            PG8_LDA(At, 1, 1); PG8_STAGE(PG8_SB(1, 0), b3, voffB); PG8_STAGE(PG8_SB(1, 1), b3 + hstepB, voffB); PG8_STAGE(PG8_SA(1, 0), a3, voffA);
            PG8_WAIT_V(8); PG8_WAIT_L(0); PG8_BAR; PG8_MMA(1, 0, At, B0); PG8_MMA(1, 1, At, B1); PG8_BAR; PG8_SCHED;
            } else {
            PG8_LDB(B0, 0, 0); PG8_SCHED; PG8_LDA(At, 0, 0); PG8_STAGE(PG8_SA(1, 1), a1 + hstepA, voffA);
            PG8_WAIT_L(8); PG8_BAR; PG8_WAIT_L(0); PG8_MMA(0, 0, At, B0); PG8_BAR; PG8_SCHED;
            PG8_LDB(B1, 0, 1); PG8_STAGE(PG8_SB(0, 0), b2, voffB);
            PG8_BAR; PG8_WAIT_L(0); PG8_MMA(0, 1, At, B1); PG8_BAR;
            PG8_LDA(At, 0, 1); PG8_STAGE(PG8_SA(0, 0), a2, voffA);
            PG8_BAR; PG8_WAIT_L(0); PG8_MMA(1, 0, At, B0); PG8_BAR; PG8_SCHED;
            PG8_STAGE(PG8_SB(0, 1), b2 + hstepB, voffB);
            PG8_WAIT_V(6); PG8_BAR; PG8_MMA(1, 1, At, B1); PG8_BAR;
            PG8_LDB(B0, 1, 0); PG8_SCHED; PG8_LDA(At, 1, 0); PG8_STAGE(PG8_SA(0, 1), a2 + hstepA, voffA);
            PG8_WAIT_L(8); PG8_BAR; PG8_WAIT_L(0); PG8_MMA(0, 0, At, B0); PG8_BAR; PG8_SCHED;
            PG8_LDB(B1, 1, 1); PG8_STAGE(PG8_SB(1, 0), b3, voffB);
            PG8_BAR; PG8_WAIT_L(0); PG8_MMA(0, 1, At, B1); PG8_BAR;
            PG8_LDA(At, 1, 1); PG8_STAGE(PG8_SA(1, 0), a3, voffA);
            PG8_BAR; PG8_WAIT_L(0); PG8_MMA(1, 0, At, B0); PG8_BAR; PG8_SCHED;
            PG8_STAGE(PG8_SB(1, 1), b3 + hstepB, voffB);
            PG8_WAIT_V(6); PG8_BAR; PG8_MMA(1, 1, At, B1); PG8_BAR;
            }
        }
        if constexpr (ALIGN_EPI) { if (wr == 0) PG8_BAR; }
        if constexpr (!Epi::AFTER_DRAIN) { E(acc, cur, wr, wc, fr, fq); S.done(cur); }
        if (!has_next) break;
#pragma unroll
        for (int a = 0; a < 2; ++a)
#pragma unroll
            for (int b = 0; b < 2; ++b)
#pragma unroll
                for (int m = 0; m < 4; ++m)
#pragma unroll
                    for (int n = 0; n < 2; ++n) acc[a][b][m][n] = (f32x4){0.f, 0.f, 0.f, 0.f};
        cur = nxt; cA = nA; cB = nB; ++ui;
        if constexpr (ALIGN_EPI) { if (wr == 1) PG8_BAR; }
    }
    PG8_WAIT_V(0);
    if constexpr (!ALIGN_EPI) { if (wr == 0) PG8_BAR; }
    PG8_BAR;
    if constexpr (Epi::AFTER_DRAIN) { E.fused(acc, cur, wr, wc, fr, fq, lds, wid, lane); S.done(cur); }
#undef PG8_SA
#undef PG8_SB
#undef PG8_STAGE
#undef PG8_LDA
#undef PG8_LDB
#undef PG8_MMA
#undef PG8_WAIT_V
#undef PG8_WAIT_L
#undef PG8_BAR
#undef PG8_SCHED
}

}

constexpr int NWAVES = 8;
constexpr int BATCH = 4, SEQ = 4096, DM = 2048, M = BATCH * SEQ;
constexpr int DI = 4096, HD = 64, NH = 64, NG = 8, HPG = 8, NS = 128, CONVK = 4;
constexpr int CONV_DIM = DI + 2 * NG * NS;
constexpr int SSM_IN = DI + CONV_DIM + NH;
constexpr int N1 = DI + CONV_DIM;
constexpr int BCW = 2 * NG * NS;
constexpr int DP = 4096, PG = 4, PGD = 1024;
constexpr float EPS = 1e-6f;

constexpr size_t MiB = 1u << 20;
constexpr size_t WS_CTL = 0, CTL_ZERO_BYTES = 1 * MiB;
constexpr size_t WS_DT  = 1 * MiB;
constexpr size_t WS_W1T = 5 * MiB;
constexpr size_t WS_W2T = 46 * MiB;
constexpr size_t WS_W3T = 62 * MiB;
constexpr size_t WS_W4T = 94 * MiB;
constexpr size_t WS_W5T = 102 * MiB;
constexpr size_t WS_RA  = 120 * MiB;
constexpr size_t WS_RB  = 248 * MiB;
constexpr size_t WS_RC  = 440 * MiB;
constexpr size_t WS_END = 512 * MiB;
static_assert(WS_W1T + (size_t)SSM_IN * DM * 2 <= WS_W2T && WS_W2T + (size_t)DM * DI * 2 <= WS_W3T && WS_W3T + (size_t)2 * DP * DM * 2 <= WS_W4T && WS_W4T + (size_t)DP * PGD * 2 <= WS_W5T && WS_W5T + (size_t)DM * DP * 2 <= WS_RA, "weights map");
static_assert(WS_RA + (size_t)M * DI * 2 <= WS_RB && WS_RB + (size_t)M * CONV_DIM * 2 <= WS_RC && WS_RC + (size_t)M * DM * 2 <= WS_END && WS_RB + 128 * MiB + (size_t)M * DP * 2 <= WS_END, "activation map");
constexpr int CW_BAR = 4096;
constexpr int CW_SSQ1 = 16384, CW_SSQ2 = CW_SSQ1 + M, CW_SSQ3 = CW_SSQ2 + M;
static_assert((CW_SSQ3 + M) * 4 <= (int)CTL_ZERO_BYTES, "CTL words inside the memset region");

constexpr int RING_OFF = 0, RING_BYTES = 131072;
constexpr int LDSCTL_OFF = RING_BYTES, MISC_OFF = LDSCTL_OFF + 320;
constexpr int LDS_BYTES = 147456;
static_assert(MISC_OFF + 128 <= LDS_BYTES, "LDS map");

#define LAS __attribute__((address_space(3)))
typedef unsigned short bf16;
typedef unsigned v4u __attribute__((ext_vector_type(4)));
typedef unsigned v2u __attribute__((ext_vector_type(2)));
typedef float f32x4 __attribute__((ext_vector_type(4)));
typedef short bf16x8 __attribute__((ext_vector_type(8)));
#define LDS_WAIT() asm volatile("s_waitcnt lgkmcnt(0)" ::: "memory")
#define VM_WAIT() asm volatile("s_waitcnt vmcnt(0)" ::: "memory")
__device__ __forceinline__ unsigned f2bf(float f) { unsigned u = __builtin_bit_cast(unsigned, f); return (u + 0x7fffu + ((u >> 16) & 1u)) >> 16; }
__device__ __forceinline__ unsigned pk2(float lo, float hi) { return f2bf(lo) | (f2bf(hi) << 16); }
__device__ __forceinline__ float bflo(unsigned w) { return __uint_as_float(w << 16); }
__device__ __forceinline__ float bfhi(unsigned w) { return __uint_as_float(w & 0xffff0000u); }
__device__ __forceinline__ float bf1(bf16 v) { return __uint_as_float(((unsigned)v) << 16); }
__device__ __forceinline__ float sigm(float v) { return 1.0f / (1.0f + __expf(-v)); }
__device__ __forceinline__ float wave_sum(float v) {
#pragma unroll
    for (int o = 1; o < 64; o <<= 1) v += __shfl_xor(v, o);
    return v;
}

#define XB_TMO      128
#define XB_XCNT(j)  (256  + 64 * (j))
#define XB_XSUB(j)  (1280 + 64 * (j))
#define XB_XGEN(j)  (2304 + 64 * (j))
#define XB_TOP      3328
#define XB_TOPGEN   3392
#define XCD_BAR_WORDS 3456
#define XB_SPIN_CAP (1u << 18)

__device__ __forceinline__ unsigned xb_ld(unsigned* p)              { return __hip_atomic_load(p, __ATOMIC_RELAXED, __HIP_MEMORY_SCOPE_AGENT); }
__device__ __forceinline__ unsigned xb_add(unsigned* p, unsigned v) { return __hip_atomic_fetch_add(p, v, __ATOMIC_RELAXED, __HIP_MEMORY_SCOPE_AGENT); }
__device__ __forceinline__ unsigned xb_xcc_id() { return (unsigned)__builtin_amdgcn_s_getreg((3 << 11) | 20) & 0xFu; }
#define XB_SPIN(cond, bar) do { unsigned _sp = 0; while (cond) { __builtin_amdgcn_s_sleep(1); \
    if ((++_sp & 255u) == 0u) { if (xb_ld(&(bar)[XB_TMO])) break; if (_sp > XB_SPIN_CAP) { atomicAdd(&(bar)[XB_TMO], 1u); break; } } } } while (0)

struct XcdBarrier {
    unsigned* bar; unsigned x;
    volatile LAS unsigned* st;
};

__device__ __forceinline__ XcdBarrier xcd_barrier_post(unsigned* bar, volatile LAS unsigned* st) {
    XcdBarrier b; b.bar = bar; b.x = xb_xcc_id(); b.st = st;
    if (threadIdx.x == 0) (void)xb_add(&bar[XB_XCNT(b.x)], 1u);
    return b;
}
__device__ __forceinline__ void xcd_barrier_complete(unsigned* bar, unsigned x, unsigned& nloc, unsigned& nx) {
    const unsigned G = gridDim.x * gridDim.y * gridDim.z;
    unsigned sum, cnt, mine, sp = 0u;
    for (;;) {
        sum = 0u; cnt = 0u; mine = 0u;
#pragma unroll
        for (unsigned j = 0; j < 16; ++j) { const unsigned c = xb_ld(&bar[XB_XCNT(j)]); sum += c; cnt += (c > 0u) ? 1u : 0u; mine = (j == x) ? c : mine; }
        if (sum == G) break;
        __builtin_amdgcn_s_sleep(1);
        if ((++sp & 255u) == 0u) { if (xb_ld(&bar[XB_TMO])) break; if (sp > XB_SPIN_CAP) { atomicAdd(&bar[XB_TMO], 1u); break; } }
    }
    nloc = mine > 0u ? mine : 1u; nx = cnt > 0u ? cnt : 1u;
}

__device__ __forceinline__ void xcd_barrier(const XcdBarrier& b) {
    asm volatile("s_waitcnt vmcnt(0)" ::: "memory");
    __syncthreads();
    if (threadIdx.x == 0) {
        unsigned* bar = b.bar;
        __builtin_amdgcn_s_waitcnt(0);
        unsigned nloc = b.st[0], nx = b.st[1];
        if (nloc == 0u) { xcd_barrier_complete(bar, b.x, nloc, nx); b.st[0] = nloc; b.st[1] = nx; }
        const unsigned old = xb_add(&bar[XB_XSUB(b.x)], 1u);
        const unsigned gen = old / nloc;
        if (old + 1u == (gen + 1u) * nloc) {
            __builtin_amdgcn_fence(__ATOMIC_RELEASE, "agent");
            asm volatile("s_waitcnt vmcnt(0)" ::: "memory");
            const unsigned og = xb_add(&bar[XB_TOP], 1u);
            const unsigned tg = og / nx;
            if (og + 1u == (tg + 1u) * nx) xb_add(&bar[XB_TOPGEN], 1u);
            else XB_SPIN(xb_ld(&bar[XB_TOPGEN]) == tg, bar);
            __builtin_amdgcn_fence(__ATOMIC_ACQUIRE, "agent");
            xb_add(&bar[XB_XGEN(b.x)], 1u);
            asm volatile("s_waitcnt vmcnt(0)" ::: "memory");
        } else {
            XB_SPIN(xb_ld(&bar[XB_XGEN(b.x)]) == gen, bar);
            __builtin_amdgcn_fence(__ATOMIC_ACQUIRE, "agent");
            asm volatile("s_waitcnt vmcnt(0)" ::: "memory");
        }
    }
    __syncthreads();
}


struct Ctx { LAS unsigned char* lds; int tid, lane, wave, G, vcu; };

__device__ __forceinline__ void transpose_item(const float* W, const float* gain, int K, int N, bf16* WT, int row_off, LAS float* scr, int item, int lane) {
    const int nblk = N / 32, kb = item / nblk, nb = item % nblk, k0 = 64 * kb, n0 = 32 * nb;
#pragma unroll 8
    for (int i = 0; i < 32; ++i) { const int kk = 2 * i + (lane >> 5); const float gk = gain ? gain[k0 + kk] : 1.0f; scr[kk * 33 + (lane & 31)] = W[(size_t)(k0 + kk) * N + n0 + (lane & 31)] * gk; }
    LDS_WAIT(); asm volatile("" ::: "memory");
    const int c = lane & 7;
#pragma unroll
    for (int j = 0; j < 4; ++j) { const int n = (lane >> 3) + 8 * j; const LAS float* s = scr + (8 * c) * 33 + n;
        v4u o; o.x = pk2(s[0 * 33], s[1 * 33]); o.y = pk2(s[2 * 33], s[3 * 33]); o.z = pk2(s[4 * 33], s[5 * 33]); o.w = pk2(s[6 * 33], s[7 * 33]);
        *(v4u*)(WT + (size_t)(row_off + n0 + n) * K + k0 + 8 * c) = o; }
    LDS_WAIT(); asm volatile("" ::: "memory");
}

struct Ptrs {
    const float *x, *ln_g, *final_g, *ssm_w_in, *conv_w, *conv_b, *dt_bias, *a_log, *ssm_d, *norm_g, *ssm_w_out, *pool_w_in, *pool_w_group, *pool_scale, *pool_w_out;
    float* out; unsigned char* ws;
};

__device__ __forceinline__ void phase_prep(const Ctx& F, const Ptrs& P) {
    LAS float* scr = (LAS float*)(F.lds + RING_OFF + F.wave * 16384);
    const int gw = F.vcu * NWAVES + F.wave, NGW = F.G * NWAVES;
    bf16* W1T = (bf16*)(P.ws + WS_W1T); bf16* W2T = (bf16*)(P.ws + WS_W2T); bf16* W3T = (bf16*)(P.ws + WS_W3T); bf16* W4T = (bf16*)(P.ws + WS_W4T); bf16* W5T = (bf16*)(P.ws + WS_W5T);
    constexpr int I1 = (DM / 64) * (SSM_IN / 32), I2 = (DI / 64) * (DM / 32), I3 = (DM / 64) * (2 * DP / 32), I4G = (PGD / 64) * (PGD / 32), I4 = PG * I4G, I5 = (DP / 64) * (DM / 32);
    constexpr int NITEMS = I1 + I2 + I3 + I4 + I5;
    for (int it = gw; it < NITEMS; it += NGW) {
        int r = it;
        if (r < I1) { transpose_item(P.ssm_w_in, P.ln_g, DM, SSM_IN, W1T, 0, scr, r, F.lane); continue; } r -= I1;
        if (r < I2) { transpose_item(P.ssm_w_out, P.norm_g, DI, DM, W2T, 0, scr, r, F.lane); continue; } r -= I2;
        if (r < I3) { transpose_item(P.pool_w_in, P.ln_g + DM, DM, 2 * DP, W3T, 0, scr, r, F.lane); continue; } r -= I3;
        if (r < I4) { const int g = r / I4G; transpose_item(P.pool_w_group + (size_t)g * PGD * PGD, nullptr, PGD, PGD, W4T, g * PGD, scr, r % I4G, F.lane); continue; } r -= I4;
        transpose_item(P.pool_w_out, nullptr, DP, DM, W5T, 0, scr, r, F.lane);
    }
    bf16* XB = (bf16*)(P.ws + WS_RC); float* ssq1 = (float*)(P.ws + WS_CTL) + CW_SSQ1;
    for (int m = gw; m < M; m += NGW) {
        const f32x4* xr = (const f32x4*)(P.x + (size_t)m * DM) + F.lane;
        f32x4 v[8]; float s = 0.f;
#pragma unroll
        for (int j = 0; j < 8; ++j) { v[j] = xr[64 * j]; s += (v[j].x * v[j].x + v[j].y * v[j].y) + (v[j].z * v[j].z + v[j].w * v[j].w); }
        s = wave_sum(s);
        if (F.lane == 0) ssq1[m] = s;
        v2u* o8 = (v2u*)(XB + (size_t)m * DM) + F.lane;
#pragma unroll
        for (int j = 0; j < 8; ++j) { v2u w; w.x = pk2(v[j].x, v[j].y); w.y = pk2(v[j].z, v[j].w); o8[64 * j] = w; }
    }
}

__device__ __forceinline__ float softplus_f(float v) { return fmaxf(v, 0.f) + log1pf(expf(-fabsf(v))); }

__device__ __forceinline__ void phase_dt(const Ctx& F, const Ptrs& P) {
    const bf16* XB = (const bf16*)(P.ws + WS_RC); const bf16* WDT = (const bf16*)(P.ws + WS_W1T) + (size_t)N1 * DM;
    const float* ssq1 = (const float*)(P.ws + WS_CTL) + CW_SSQ1; float* DT = (float*)(P.ws + WS_DT);
    const int rt = F.wave >> 1, ct0 = (F.wave & 1) * 2, fr = F.lane & 15, fq = F.lane >> 4;
    for (int item = F.vcu; item < M / 64; item += F.G) {
        const int r0 = item * 64 + rt * 16;
        const bf16* ap = XB + (size_t)(r0 + fr) * DM + 8 * fq;
        const bf16* bp0 = WDT + (size_t)(16 * ct0 + fr) * DM + 8 * fq; const bf16* bp1 = bp0 + (size_t)16 * DM;
        f32x4 acc0 = {0.f, 0.f, 0.f, 0.f}, acc1 = {0.f, 0.f, 0.f, 0.f};
#pragma unroll 4
        for (int ks = 0; ks < DM / 32; ++ks) {
            const bf16x8 a = *(const bf16x8*)(ap + 32 * ks), b0 = *(const bf16x8*)(bp0 + 32 * ks), b1 = *(const bf16x8*)(bp1 + 32 * ks);
            acc0 = __builtin_amdgcn_mfma_f32_16x16x32_bf16(a, b0, acc0, 0, 0, 0);
            acc1 = __builtin_amdgcn_mfma_f32_16x16x32_bf16(a, b1, acc1, 0, 0, 0);
        }
        const int h0 = 16 * ct0 + fr, h1 = h0 + 16; const float bias0 = P.dt_bias[h0], bias1 = P.dt_bias[h1];
#pragma unroll
        for (int r = 0; r < 4; ++r) { const int row = r0 + 4 * fq + r; const float s = rsqrtf(ssq1[row] * (1.0f / DM) + EPS);
            DT[(size_t)row * NH + h0] = softplus_f(acc0[r] * s + bias0); DT[(size_t)row * NH + h1] = softplus_f(acc1[r] * s + bias1); }
    }
}

__device__ __forceinline__ void phase_bcconv(const Ctx& F, const Ptrs& P) {
    const bf16* XBC = (const bf16*)(P.ws + WS_RB); bf16* BC = (bf16*)(P.ws + WS_RC);
    const int NCG = BCW / 8;
    const int nitems = (M / 32) * NCG;
    for (int it = F.vcu * 512 + F.tid; it < nitems; it += F.G * 512) {
        const int cg = it % NCG, tb = it / NCG, c0 = cg * 8, t0 = tb * 32, ch = DI + c0;
        float w[4][8], bias[8];
#pragma unroll
        for (int k = 0; k < 4; ++k) { const f32x4 a = *(const f32x4*)(P.conv_w + (size_t)k * CONV_DIM + ch), b = *(const f32x4*)(P.conv_w + (size_t)k * CONV_DIM + ch + 4);
            w[k][0] = a.x; w[k][1] = a.y; w[k][2] = a.z; w[k][3] = a.w; w[k][4] = b.x; w[k][5] = b.y; w[k][6] = b.z; w[k][7] = b.w; }
        { const f32x4 a = *(const f32x4*)(P.conv_b + ch), b = *(const f32x4*)(P.conv_b + ch + 4); bias[0] = a.x; bias[1] = a.y; bias[2] = a.z; bias[3] = a.w; bias[4] = b.x; bias[5] = b.y; bias[6] = b.z; bias[7] = b.w; }
        float h3[8], h2[8], h1[8];
        const bool seq_start = (t0 % SEQ) == 0;
#pragma unroll
        for (int j = 0; j < 8; ++j) { h3[j] = 0.f; h2[j] = 0.f; h1[j] = 0.f; }
        if (!seq_start) {
            const v4u r3 = *(const v4u*)(XBC + (size_t)(t0 - 3) * CONV_DIM + ch), r2 = *(const v4u*)(XBC + (size_t)(t0 - 2) * CONV_DIM + ch), r1 = *(const v4u*)(XBC + (size_t)(t0 - 1) * CONV_DIM + ch);
            h3[0] = bflo(r3.x); h3[1] = bfhi(r3.x); h3[2] = bflo(r3.y); h3[3] = bfhi(r3.y); h3[4] = bflo(r3.z); h3[5] = bfhi(r3.z); h3[6] = bflo(r3.w); h3[7] = bfhi(r3.w);
            h2[0] = bflo(r2.x); h2[1] = bfhi(r2.x); h2[2] = bflo(r2.y); h2[3] = bfhi(r2.y); h2[4] = bflo(r2.z); h2[5] = bfhi(r2.z); h2[6] = bflo(r2.w); h2[7] = bfhi(r2.w);
            h1[0] = bflo(r1.x); h1[1] = bfhi(r1.x); h1[2] = bflo(r1.y); h1[3] = bfhi(r1.y); h1[4] = bflo(r1.z); h1[5] = bfhi(r1.z); h1[6] = bflo(r1.w); h1[7] = bfhi(r1.w);
        }
#pragma unroll 4
        for (int t = 0; t < 32; ++t) {
            const v4u rr = *(const v4u*)(XBC + (size_t)(t0 + t) * CONV_DIM + ch);
            float cur[8] = {bflo(rr.x), bfhi(rr.x), bflo(rr.y), bfhi(rr.y), bflo(rr.z), bfhi(rr.z), bflo(rr.w), bfhi(rr.w)};
            float o[8];
#pragma unroll
            for (int j = 0; j < 8; ++j) { const float v = bias[j] + w[0][j] * h3[j] + w[1][j] * h2[j] + w[2][j] * h1[j] + w[3][j] * cur[j]; o[j] = v * sigm(v); h3[j] = h2[j]; h2[j] = h1[j]; h1[j] = cur[j]; }
            v4u ow; ow.x = pk2(o[0], o[1]); ow.y = pk2(o[2], o[3]); ow.z = pk2(o[4], o[5]); ow.w = pk2(o[6], o[7]);
            *(v4u*)(BC + (size_t)(t0 + t) * BCW + c0) = ow;
        }
    }
}

__device__ __forceinline__ void ssd_tok_load(const bf16* XBC, const bf16* BC, const bf16* Z, const float* DT, size_t tok, int ch, int h, int g, int ng,
                                             float& xr, float& dtv, float& zv, v4u& B0, v4u& B1, v4u& C0, v4u& C1) {
    xr = bf1(XBC[tok * CONV_DIM + ch]); dtv = DT[tok * NH + h]; zv = bf1(Z[tok * DI + ch]);
    B0 = *(const v4u*)(BC + tok * BCW + g * NS + ng * 16); B1 = *(const v4u*)(BC + tok * BCW + g * NS + ng * 16 + 8);
    C0 = *(const v4u*)(BC + tok * BCW + NG * NS + g * NS + ng * 16); C1 = *(const v4u*)(BC + tok * BCW + NG * NS + g * NS + ng * 16 + 8);
}
__device__ __forceinline__ void phase_ssd_naive(const Ctx& F, const Ptrs& P) {
    const bf16* XBC = (const bf16*)(P.ws + WS_RB); const bf16* BC = (const bf16*)(P.ws + WS_RC); bf16* Z = (bf16*)(P.ws + WS_RA);
    const float* DT = (const float*)(P.ws + WS_DT); float* ssq2 = (float*)(P.ws + WS_CTL) + CW_SSQ2;
    const int p = F.tid >> 3, ng = F.tid & 7;
    for (int unit = F.vcu; unit < BATCH * NH; unit += F.G) {
        const int b = unit / NH, h = unit % NH, g = h / HPG, ch = h * HD + p;
        const float a = -expf(P.a_log[h]), Dh = P.ssm_d[h];
        const float w0 = P.conv_w[ch], w1 = P.conv_w[CONV_DIM + ch], w2 = P.conv_w[2 * CONV_DIM + ch], w3 = P.conv_w[3 * CONV_DIM + ch], cb = P.conv_b[ch];
        float st[16];
#pragma unroll
        for (int j = 0; j < 16; ++j) st[j] = 0.f;
        float xm3 = 0.f, xm2 = 0.f, xm1 = 0.f;
        float xr, dtv, zv; v4u B0, B1, C0, C1;
        ssd_tok_load(XBC, BC, Z, DT, (size_t)b * SEQ, ch, h, g, ng, xr, dtv, zv, B0, B1, C0, C1);
        for (int t = 0; t < SEQ; ++t) {
            const size_t tok = (size_t)b * SEQ + t;
            float nxr, ndtv, nzv; v4u nB0, nB1, nC0, nC1;
            ssd_tok_load(XBC, BC, Z, DT, (t + 1 < SEQ) ? tok + 1 : tok, ch, h, g, ng, nxr, ndtv, nzv, nB0, nB1, nC0, nC1);
            const float xc = cb + w0 * xm3 + w1 * xm2 + w2 * xm1 + w3 * xr; xm3 = xm2; xm2 = xm1; xm1 = xr;
            const float xv = xc * sigm(xc);
            const float dA = expf(dtv * a), dx = dtv * xv;
            const float Bv[16] = {bflo(B0.x), bfhi(B0.x), bflo(B0.y), bfhi(B0.y), bflo(B0.z), bfhi(B0.z), bflo(B0.w), bfhi(B0.w), bflo(B1.x), bfhi(B1.x), bflo(B1.y), bfhi(B1.y), bflo(B1.z), bfhi(B1.z), bflo(B1.w), bfhi(B1.w)};
            const float Cv[16] = {bflo(C0.x), bfhi(C0.x), bflo(C0.y), bfhi(C0.y), bflo(C0.z), bfhi(C0.z), bflo(C0.w), bfhi(C0.w), bflo(C1.x), bfhi(C1.x), bflo(C1.y), bfhi(C1.y), bflo(C1.z), bfhi(C1.z), bflo(C1.w), bfhi(C1.w)};
            float y = 0.f;
#pragma unroll
            for (int j = 0; j < 16; ++j) { st[j] = st[j] * dA + dx * Bv[j]; y += Cv[j] * st[j]; }
            y += __shfl_xor(y, 1); y += __shfl_xor(y, 2); y += __shfl_xor(y, 4);
            y += Dh * xv;
            const float gated = y * (zv * sigm(zv));
            float q = gated * gated; q += __shfl_xor(q, 8); q += __shfl_xor(q, 16); q += __shfl_xor(q, 32);
            if (ng == 0) Z[tok * DI + ch] = (bf16)f2bf(gated);
            if (F.lane == 0) atomicAdd(ssq2 + tok, q);
            xr = nxr; dtv = ndtv; zv = nzv; B0 = nB0; B1 = nB1; C0 = nC0; C1 = nC1;
        }
    }
}

__device__ __forceinline__ void phase_pool(const Ctx& F, const Ptrs& P) {
    const bf16* U = (const bf16*)(P.ws + WS_RA); bf16* MX = (bf16*)(P.ws + WS_RB + 128 * MiB);
    const int NCG = DP / 8;
    const int nitems = (M / 32) * NCG;
    for (int it = F.vcu * 512 + F.tid; it < nitems; it += F.G * 512) {
        const int cg = it % NCG, tb = it / NCG, c0 = cg * 8, t0 = tb * 32, win = 2 << (c0 / PGD);
        const int pos0 = t0 % SEQ;
        float s[8];
#pragma unroll
        for (int j = 0; j < 8; ++j) s[j] = 0.f;
        for (int d = 1; d < win; ++d) if (pos0 - d >= 0) { const v4u r = *(const v4u*)(U + (size_t)(t0 - d) * DP + c0);
            s[0] += bflo(r.x); s[1] += bfhi(r.x); s[2] += bflo(r.y); s[3] += bfhi(r.y); s[4] += bflo(r.z); s[5] += bfhi(r.z); s[6] += bflo(r.w); s[7] += bfhi(r.w); }
        for (int t = 0; t < 32; ++t) {
            const int pos = pos0 + t;
            const v4u r = *(const v4u*)(U + (size_t)(t0 + t) * DP + c0);
            const float cur[8] = {bflo(r.x), bfhi(r.x), bflo(r.y), bfhi(r.y), bflo(r.z), bfhi(r.z), bflo(r.w), bfhi(r.w)};
#pragma unroll
            for (int j = 0; j < 8; ++j) s[j] += cur[j];
            const int cnt = (pos + 1 < win) ? (pos + 1) : win; const float inv = 1.0f / (float)cnt;
            v4u ow; ow.x = pk2(s[0] * inv - cur[0], s[1] * inv - cur[1]); ow.y = pk2(s[2] * inv - cur[2], s[3] * inv - cur[3]); ow.z = pk2(s[4] * inv - cur[4], s[5] * inv - cur[5]); ow.w = pk2(s[6] * inv - cur[6], s[7] * inv - cur[7]);
            *(v4u*)(MX + (size_t)(t0 + t) * DP + c0) = ow;
            if (pos - (win - 1) >= 0) { const v4u q = *(const v4u*)(U + (size_t)(t0 + t - (win - 1)) * DP + c0);
                s[0] -= bflo(q.x); s[1] -= bfhi(q.x); s[2] -= bflo(q.y); s[3] -= bfhi(q.y); s[4] -= bflo(q.z); s[5] -= bfhi(q.z); s[6] -= bflo(q.w); s[7] -= bfhi(q.w); }
        }
    }
}

__device__ __forceinline__ void phase_final(const Ctx& F, const Ptrs& P) {
    const int gw = F.vcu * NWAVES + F.wave, NGW = F.G * NWAVES;
    f32x4 gv[8];
#pragma unroll
    for (int j = 0; j < 8; ++j) gv[j] = ((const f32x4*)P.final_g)[F.lane + 64 * j];
    for (int m = gw; m < M; m += NGW) {
        f32x4* xr = (f32x4*)(P.out + (size_t)m * DM) + F.lane;
        f32x4 v[8]; float s = 0.f;
#pragma unroll
        for (int j = 0; j < 8; ++j) { v[j] = xr[64 * j]; s += (v[j].x * v[j].x + v[j].y * v[j].y) + (v[j].z * v[j].z + v[j].w * v[j].w); }
        s = wave_sum(s);
        const float rs = rsqrtf(s * (1.0f / DM) + EPS);
#pragma unroll
        for (int j = 0; j < 8; ++j) xr[64 * j] = v[j] * rs * gv[j];
    }
}

constexpr int N_PHASES = 10;
struct Args { Ptrs p; int ph_lo, ph_hi, li, pad; };
__global__ void __launch_bounds__(NWAVES * 64, 2) trunk_fwd(Args args) {
    extern __shared__ __attribute__((aligned(16))) unsigned char lds[];
    Ctx F;
    F.lds = (LAS unsigned char*)lds;
    F.tid = threadIdx.x; F.lane = F.tid & 63; F.wave = __builtin_amdgcn_readfirstlane(F.tid >> 6);
    F.G = gridDim.x; { const int bx = blockIdx.x; F.vcu = (F.G % 8 == 0) ? (bx % 8) * (F.G / 8) + bx / 8 : bx; }
    const Ptrs& P = args.p;
    unsigned* ctl = (unsigned*)(P.ws + WS_CTL);
    for (int u = F.tid; u < (LDS_BYTES - LDSCTL_OFF) / 4; u += NWAVES * 64) ((LAS unsigned*)(F.lds + LDSCTL_OFF))[u] = 0u;
    __syncthreads();
#if MK_ONE_LAUNCH
    XcdBarrier bar = xcd_barrier_post(ctl + CW_BAR, (volatile LAS unsigned*)(F.lds + MISC_OFF) + 8);
#define GRID_BAR() xcd_barrier(bar)
#else
#define GRID_BAR() do {} while (0)
#endif
    const int lo = args.ph_lo, hi = args.ph_hi;
#define IN(k) (lo <= (k) && (k) < hi)
#define BOTH(k) (IN(k) && IN((k) + 1))
    float* ssq1 = (float*)ctl + CW_SSQ1; float* ssq2 = (float*)ctl + CW_SSQ2; float* ssq3 = (float*)ctl + CW_SSQ3;
    bf16* W1T = (bf16*)(P.ws + WS_W1T); bf16* W2T = (bf16*)(P.ws + WS_W2T); bf16* W3T = (bf16*)(P.ws + WS_W3T); bf16* W4T = (bf16*)(P.ws + WS_W4T); bf16* W5T = (bf16*)(P.ws + WS_W5T);
    bf16* RA = (bf16*)(P.ws + WS_RA); bf16* RB = (bf16*)(P.ws + WS_RB); bf16* RC = (bf16*)(P.ws + WS_RC); bf16* MX = (bf16*)(P.ws + WS_RB + 128 * MiB);

    if (IN(0)) { phase_prep(F, P); if (BOTH(0)) GRID_BAR(); }
    if (IN(1)) {
        phase_dt(F, P);
        pg8::Gemm g{RC, W1T, M, N1, DM, DM, DM, 30}; pg8::StaticOrder S; S.init(M, N1, F.G, (int)blockIdx.x);
        pg8::EpiProj E{RA, DI, RB, CONV_DIM, DI / 256, ssq1, 1.0f / DM};
        pg8::gemm_phase<pg8::EpiProj, pg8::StaticOrder, true, true>(F.lds + RING_OFF, g, S, E);
        if (BOTH(1)) GRID_BAR();
    }
    if (IN(2)) { phase_bcconv(F, P); if (BOTH(2)) GRID_BAR(); }
    if (IN(3)) { phase_ssd_naive(F, P); if (BOTH(3)) GRID_BAR(); }
    if (IN(4)) {
        pg8::Gemm g{RA, W2T, M, DM, DI, DI, DI, 30}; pg8::StaticOrder S; S.init(M, DM, F.G, (int)blockIdx.x);
        pg8::EpiRes E{P.x, P.out, RC, ssq2, 1.0f / DI, ssq3, DM};
        pg8::gemm_phase<pg8::EpiRes, pg8::StaticOrder, true, true>(F.lds + RING_OFF, g, S, E);
        if (BOTH(4)) GRID_BAR();
    }
    if (IN(5)) {
        pg8::Gemm g{RC, W3T, M, 2 * DP, DM, DM, DM, 30}; pg8::StaticOrder S; S.init(M, 2 * DP, F.G, (int)blockIdx.x);
        pg8::EpiProj E{RA, DP, RB, DP, DP / 256, ssq3, 1.0f / DM};
        pg8::gemm_phase<pg8::EpiProj, pg8::StaticOrder, true, true>(F.lds + RING_OFF, g, S, E);
        if (BOTH(5)) GRID_BAR();
    }
    if (IN(6)) { phase_pool(F, P); if (BOTH(6)) GRID_BAR(); }
    if (IN(7)) {
        pg8::Gemm g{MX, W4T, M, DP, PGD, DP, PGD, 2}; pg8::StaticOrder S; S.init(M, DP, F.G, (int)blockIdx.x);
        pg8::EpiGate E{RA, RB, P.pool_scale, DP};
        pg8::gemm_phase<pg8::EpiGate, pg8::StaticOrder, true, true>(F.lds + RING_OFF, g, S, E);
        if (BOTH(7)) GRID_BAR();
    }
    if (IN(8)) {
        pg8::Gemm g{RA, W5T, M, DM, DP, DP, DP, 30}; pg8::StaticOrder S; S.init(M, DM, F.G, (int)blockIdx.x);
        pg8::EpiRes E{P.out, P.out, nullptr, nullptr, 0.f, nullptr, DM};
        pg8::gemm_phase<pg8::EpiRes, pg8::StaticOrder, true, true>(F.lds + RING_OFF, g, S, E);
        if (BOTH(8)) GRID_BAR();
    }
    if (IN(9)) { phase_final(F, P); }
#undef IN
#undef BOTH
}

extern "C" void kernel_launch(void* const* d_in, const int* in_sizes, int n_in, void* d_out, int out_size, void* d_ws, size_t ws_size, hipStream_t stream) {
    static int grid = 0;
    if (grid == 0) {
        if (n_in != 15 || in_sizes[0] != M * DM || out_size != M * DM || ws_size < WS_END) { fprintf(stderr, "kernel_launch: unexpected shapes: n_in %d in0 %d out %d ws %zu (need %zu); nothing launched\n", n_in, n_in > 0 ? in_sizes[0] : -1, out_size, ws_size, (size_t)WS_END); grid = -1; return; }
        int dev = 0, cus = 0, per_cu = 0;
        if (hipGetDevice(&dev) != hipSuccess || hipDeviceGetAttribute(&cus, hipDeviceAttributeMultiprocessorCount, dev) != hipSuccess) { fprintf(stderr, "kernel_launch: device query failed\n"); grid = -1; return; }
        if (hipFuncSetAttribute((const void*)trunk_fwd, hipFuncAttributeMaxDynamicSharedMemorySize, LDS_BYTES) != hipSuccess) { fprintf(stderr, "kernel_launch: hipFuncSetAttribute failed\n"); grid = -1; return; }
        if (hipOccupancyMaxActiveBlocksPerMultiprocessor(&per_cu, (const void*)trunk_fwd, NWAVES * 64, LDS_BYTES) != hipSuccess || per_cu < 1) { fprintf(stderr, "kernel_launch: occupancy query says %d blocks per CU\n", per_cu); }
        (void)hipGetLastError();
        grid = cus;
    }
    if (grid < 0) return;
    if (hipMemsetAsync((char*)d_ws + WS_CTL, 0, CTL_ZERO_BYTES, stream) != hipSuccess) { fprintf(stderr, "kernel_launch: memset failed\n"); return; }
    Args a{};
    a.p.x = (const float*)d_in[0]; a.p.ln_g = (const float*)d_in[1]; a.p.final_g = (const float*)d_in[2]; a.p.ssm_w_in = (const float*)d_in[3]; a.p.conv_w = (const float*)d_in[4];
    a.p.conv_b = (const float*)d_in[5]; a.p.dt_bias = (const float*)d_in[6]; a.p.a_log = (const float*)d_in[7]; a.p.ssm_d = (const float*)d_in[8]; a.p.norm_g = (const float*)d_in[9];
    a.p.ssm_w_out = (const float*)d_in[10]; a.p.pool_w_in = (const float*)d_in[11]; a.p.pool_w_group = (const float*)d_in[12]; a.p.pool_scale = (const float*)d_in[13]; a.p.pool_w_out = (const float*)d_in[14];
    a.p.out = (float*)d_out; a.p.ws = (unsigned char*)d_ws;
#if MK_ONE_LAUNCH
    a.ph_lo = 0; a.ph_hi = N_PHASES; a.li = 0;
    hipLaunchKernelGGL(trunk_fwd, dim3(grid), dim3(NWAVES * 64), LDS_BYTES, stream, a);
#else
    for (int li = 0; li < N_PHASES; ++li) { a.ph_lo = li; a.ph_hi = li + 1; a.li = li;
        hipLaunchKernelGGL(trunk_fwd, dim3(grid), dim3(NWAVES * 64), LDS_BYTES, stream, a); }
#endif
    const hipError_t le = hipPeekAtLastError();
    if (le != hipSuccess) fprintf(stderr, "kernel_launch: launch failed: %s\n", hipGetErrorName(le));
}
```

```cpp
#include <hip/hip_runtime.h>
#include <cstdio>
#include <cstdint>

#ifndef MK_ONE_LAUNCH
#define MK_ONE_LAUNCH 1
#endif

namespace pg8 {
#define PG8_LAS __attribute__((address_space(3)))
typedef unsigned short bf16_t;
typedef short bf16x8 __attribute__((ext_vector_type(8)));
typedef float f32x4 __attribute__((ext_vector_type(4)));
typedef unsigned u32x4 __attribute__((ext_vector_type(4)));
typedef unsigned u32x2 __attribute__((ext_vector_type(2)));
constexpr int BM = 256, BK = 64, HALF = 128, HTB = HALF * BK * 2  , STAGE_BYTES = 8 * HTB, NXCD = 8, WGM = 8;
constexpr float RMS_EPS = 1e-6f;

__host__ __device__ __forceinline__ int lds_byte(int r, int c) { const int st = (r >> 4) * 2 + (c >> 5), rr = r & 15, cc = c & 31, ob = rr * 64 + cc * 2; return st * 1024 + (ob ^ (((ob >> 9) & 1) << 5)); }
__host__ __device__ __forceinline__ void stage_rc(int b, int& R, int& C) { const int st = b / 1024, sb = b % 1024, swz = sb ^ (((sb >> 9) & 1) << 5); R = (st >> 1) * 16 + swz / 64; C = (st & 1) * 32 + (swz % 64) / 2; }
__host__ __device__ __forceinline__ int perm32(int rho) { const int n = rho >> 4, i = rho & 15; return 8 * (i >> 2) + 4 * n + (i & 3); }

struct Unit { int pm, pn; };
struct Gemm { const bf16_t* A; const bf16_t* Bt; int M, N, K, lda, ldb, gsh; };

struct StaticOrder {
    int nM, nN, nwg, G, c;
    __host__ __device__ void init(int M, int N, int G_, int c_) { nM = M / BM; nN = N / BM; nwg = nM * nN; G = G_; c = c_; }
    __host__ __device__ bool next(int i, Unit& u) const {
        const long L = (long)i * G + c; if (L >= nwg) return false;
        int wgid = (int)L; { const int q = nwg / NXCD, r = nwg % NXCD, xcd = wgid % NXCD, off = wgid / NXCD; wgid = (xcd < r ? xcd * (q + 1) : r * (q + 1) + (xcd - r) * q) + off; }
        const int nig = WGM * nN, gid = wgid / nig, fm = gid * WGM, gsz = (nM - fm) < WGM ? (nM - fm) : WGM;
        u.pm = fm + ((wgid % nig) % gsz); u.pn = (wgid % nig) / gsz; return true;
    }
    __device__ __forceinline__ void a_ready(const Unit&) const {}
    __device__ __forceinline__ void done(const Unit&) const {}
};

__device__ __forceinline__ unsigned cvt_pk_bf16(float lo, float hi) { unsigned r; asm volatile("v_cvt_pk_bf16_f32 %0, %1, %2" : "=v"(r) : "v"(lo), "v"(hi)); return r; }
__device__ __forceinline__ float bf_lo(unsigned w) { return __uint_as_float(w << 16); }
__device__ __forceinline__ float bf_hi(unsigned w) { return __uint_as_float(w & 0xffff0000u); }
__device__ __forceinline__ float sigmoid_f(float v) { return __builtin_amdgcn_rcpf(1.0f + __builtin_amdgcn_exp2f(-1.4426950408889634f * v)); }

struct EpiProj {
    static constexpr bool PERM = true, AFTER_DRAIN = false;
    bf16_t* O0; int ld0; bf16_t* O1; int ld1; int split_pn; const float* ssq; float inv_n;
    __device__ __forceinline__ void operator()(const f32x4 (&acc)[2][2][4][2], const Unit& u, int wr, int wc, int fr, int fq) const {
        const int row0 = u.pm * BM + wr * 64 + fr;
        bf16_t* base; int ld, colt;
        if (u.pn < split_pn) { base = O0; ld = ld0; colt = u.pn * BM; } else { base = O1; ld = ld1; colt = (u.pn - split_pn) * BM; }
        const int col0 = colt + wc * 32 + 8 * fq;
#pragma unroll
        for (int ai = 0; ai < 2; ++ai)
#pragma unroll
            for (int m = 0; m < 4; ++m) { const int row = row0 + ai * HALF + m * 16; const float s = rsqrtf(ssq[row] * inv_n + RMS_EPS);
                bf16_t* rowp = base + (size_t)row * ld + col0;
#pragma unroll
                for (int bj = 0; bj < 2; ++bj) { const f32x4 v0 = acc[ai][bj][m][0] * s, v1 = acc[ai][bj][m][1] * s;
                    u32x4 w; w.x = cvt_pk_bf16(v0[0], v0[1]); w.y = cvt_pk_bf16(v0[2], v0[3]); w.z = cvt_pk_bf16(v1[0], v1[1]); w.w = cvt_pk_bf16(v1[2], v1[3]);
                    *(u32x4*)(rowp + bj * HALF) = w; } }
    }
};
struct EpiRes {
    static constexpr bool PERM = false, AFTER_DRAIN = false;
    const float* base; float* out; bf16_t* ob; const float* ssq_in; float inv_n; float* ssq_out; int ldc;
    __device__ __forceinline__ void operator()(const f32x4 (&acc)[2][2][4][2], const Unit& u, int wr, int wc, int fr, int fq) const {
        const int row0 = u.pm * BM + wr * 64 + fr, col0 = u.pn * BM + wc * 32 + 4 * fq;
#pragma unroll
        for (int ai = 0; ai < 2; ++ai)
#pragma unroll
            for (int m = 0; m < 4; ++m) { const int row = row0 + ai * HALF + m * 16; const float s = ssq_in ? rsqrtf(ssq_in[row] * inv_n + RMS_EPS) : 1.0f;
                const size_t off = (size_t)row * ldc + col0; float q = 0.f;
#pragma unroll
                for (int bj = 0; bj < 2; ++bj)
#pragma unroll
                    for (int n = 0; n < 2; ++n) { const size_t o2 = off + bj * HALF + n * 16; const f32x4 b = *(const f32x4*)(base + o2); const f32x4 o = b + acc[ai][bj][m][n] * s;
                        *(f32x4*)(out + o2) = o; q += (o[0] * o[0] + o[1] * o[1]) + (o[2] * o[2] + o[3] * o[3]);
                        if (ob) { u32x2 w; w.x = cvt_pk_bf16(o[0], o[1]); w.y = cvt_pk_bf16(o[2], o[3]); *(u32x2*)(ob + o2) = w; } }
                if (ssq_out) { q += __shfl_xor(q, 16); q += __shfl_xor(q, 32); if (fq == 0) atomicAdd(ssq_out + row, q); }
                asm volatile("" ::: "memory"); }
    }
};
struct EpiGate {
    static constexpr bool PERM = true, AFTER_DRAIN = false;
    bf16_t* O; const bf16_t* gate; const float* scale; int ldc;
    __device__ __forceinline__ void operator()(const f32x4 (&acc)[2][2][4][2], const Unit& u, int wr, int wc, int fr, int fq) const {
        const int row0 = u.pm * BM + wr * 64 + fr, col0 = u.pn * BM + wc * 32 + 8 * fq;
        f32x4 sc[2][2];
#pragma unroll
        for (int bj = 0; bj < 2; ++bj)
#pragma unroll
            for (int n = 0; n < 2; ++n) sc[bj][n] = *(const f32x4*)(scale + col0 + bj * HALF + 4 * n);
#pragma unroll
        for (int ai = 0; ai < 2; ++ai)
#pragma unroll
            for (int m = 0; m < 4; ++m) { const size_t off = (size_t)(row0 + ai * HALF + m * 16) * ldc + col0;
#pragma unroll
                for (int bj = 0; bj < 2; ++bj) { const u32x4 gw = *(const u32x4*)(gate + off + bj * HALF);
                    const float g0 = bf_lo(gw.x), g1 = bf_hi(gw.x), g2 = bf_lo(gw.y), g3 = bf_hi(gw.y), g4 = bf_lo(gw.z), g5 = bf_hi(gw.z), g6 = bf_lo(gw.w), g7 = bf_hi(gw.w);
                    const f32x4 v0 = acc[ai][bj][m][0] * sc[bj][0], v1 = acc[ai][bj][m][1] * sc[bj][1];
                    u32x4 w; w.x = cvt_pk_bf16(v0[0] * g0 * sigmoid_f(g0), v0[1] * g1 * sigmoid_f(g1)); w.y = cvt_pk_bf16(v0[2] * g2 * sigmoid_f(g2), v0[3] * g3 * sigmoid_f(g3));
                    w.z = cvt_pk_bf16(v1[0] * g4 * sigmoid_f(g4), v1[1] * g5 * sigmoid_f(g5)); w.w = cvt_pk_bf16(v1[2] * g6 * sigmoid_f(g6), v1[3] * g7 * sigmoid_f(g7));
                    *(u32x4*)(O + off + bj * HALF) = w; } }
    }
};

template <class Epi, class Sched, bool ALIGN_EPI = false, bool SP2 = false>
__device__ __forceinline__ void gemm_phase(PG8_LAS unsigned char* lds, const Gemm g, const Sched& S, const Epi& E) {
    const int tid = threadIdx.x, wid = __builtin_amdgcn_readfirstlane(tid >> 6), lane = tid & 63, wr = wid >> 2, wc = wid & 3, fr = lane & 15, fq = lane >> 4;
    const int K = g.K, nt = K / BK;
    unsigned voffA[2], voffB[2];
#pragma unroll
    for (int i = 0; i < 2; ++i) { int R, C; stage_rc(tid * 16 + i * 8192, R, C); const int Rb = Epi::PERM ? ((R & ~31) + perm32(R & 31)) : R;
        voffA[i] = (unsigned)(R * g.lda + C) * 2u; voffB[i] = (unsigned)(Rb * g.ldb + C) * 2u; }
    const size_t kstep = (size_t)(BK * 2);
    const size_t hstepA = (size_t)HALF * g.lda * 2, hstepB = (size_t)HALF * g.ldb * 2;
    const size_t tstepA = 2 * hstepA, tstepB = 2 * hstepB, gstepA = (size_t)K * 2;
    const unsigned ldsw = (unsigned)wid * 1024u;
    const int aoff = lds_byte(wr * 64 + fr, fq * 8), boff = lds_byte(wc * 32 + fr, fq * 8);
#define PG8_SA(b, h) (((b) * 2 + (h)) * HTB)
#define PG8_SB(b, h) ((4 + (b) * 2 + (h)) * HTB)
#define PG8_STAGE(bufoff, gbase, voff) do { _Pragma("unroll") for (int _i = 0; _i < 2; ++_i) \
        __builtin_amdgcn_global_load_lds((const unsigned*)((const char*)(gbase) + (voff)[_i]), (PG8_LAS unsigned*)(lds + (bufoff) + ldsw + _i * 8192), 16, 0, 0); } while (0)
#define PG8_LDA(dst, b, h) do { _Pragma("unroll") for (int m = 0; m < 4; ++m) _Pragma("unroll") for (int k = 0; k < 2; ++k) dst[m][k] = *(const PG8_LAS bf16x8*)(lds + PG8_SA(b, h) + aoff + m * 2048 + k * 1024); } while (0)
#define PG8_LDB(dst, b, h) do { _Pragma("unroll") for (int n = 0; n < 2; ++n) _Pragma("unroll") for (int k = 0; k < 2; ++k) dst[n][k] = *(const PG8_LAS bf16x8*)(lds + PG8_SB(b, h) + boff + n * 2048 + k * 1024); } while (0)
#define PG8_MMA(ai, bj, At, Bt) do { __builtin_amdgcn_s_setprio(1); _Pragma("unroll") for (int m = 0; m < 4; ++m) _Pragma("unroll") for (int n = 0; n < 2; ++n) _Pragma("unroll") for (int k = 0; k < 2; ++k) \
        acc[ai][bj][m][n] = __builtin_amdgcn_mfma_f32_16x16x32_bf16(Bt[n][k], At[m][k], acc[ai][bj][m][n], 0, 0, 0); __builtin_amdgcn_s_setprio(0); } while (0)
#define PG8_WAIT_V(n) asm volatile("s_waitcnt vmcnt(" #n ")" ::: "memory")
#define PG8_WAIT_L(n) asm volatile("s_waitcnt lgkmcnt(" #n ")" ::: "memory")
#define PG8_BAR __builtin_amdgcn_s_barrier()
#define PG8_SCHED __builtin_amdgcn_sched_barrier(0)
    Unit cur, nxt; int ui = 0;
    if (!S.next(0, cur)) return;
    f32x4 acc[2][2][4][2];
#pragma unroll
    for (int a = 0; a < 2; ++a)
#pragma unroll
        for (int b = 0; b < 2; ++b)
#pragma unroll
            for (int m = 0; m < 4; ++m)
#pragma unroll
                for (int n = 0; n < 2; ++n) acc[a][b][m][n] = (f32x4){0.f, 0.f, 0.f, 0.f};
    bf16x8 At[4][2], B0[2][2], B1[2][2];
    const char* cA = (const char*)g.A + (size_t)cur.pm * tstepA + (size_t)(cur.pn >> g.gsh) * gstepA; const char* cB = (const char*)g.Bt + (size_t)cur.pn * tstepB;
    S.a_ready(cur);
    if constexpr (SP2) {
        PG8_STAGE(PG8_SB(0, 0), cB, voffB); PG8_STAGE(PG8_SB(0, 1), cB + hstepB, voffB); PG8_STAGE(PG8_SA(0, 0), cA, voffA); PG8_STAGE(PG8_SA(0, 1), cA + hstepA, voffA);
        if (wr == 1) PG8_BAR;
        PG8_WAIT_V(2); PG8_BAR;
        PG8_STAGE(PG8_SB(1, 0), cB + kstep, voffB); PG8_STAGE(PG8_SA(1, 0), cA + kstep, voffA); PG8_STAGE(PG8_SB(1, 1), cB + hstepB + kstep, voffB);
        PG8_WAIT_V(6); PG8_BAR;
    } else {
        PG8_STAGE(PG8_SB(0, 0), cB, voffB); PG8_STAGE(PG8_SA(0, 0), cA, voffA); PG8_STAGE(PG8_SB(0, 1), cB + hstepB, voffB); PG8_STAGE(PG8_SA(0, 1), cA + hstepA, voffA);
        if (wr == 1) PG8_BAR;
        PG8_WAIT_V(4); PG8_BAR;
        PG8_STAGE(PG8_SB(1, 0), cB + kstep, voffB); PG8_STAGE(PG8_SA(1, 0), cA + kstep, voffA); PG8_STAGE(PG8_SB(1, 1), cB + hstepB + kstep, voffB);
        PG8_WAIT_V(6); PG8_BAR;
    }
    for (;;) {
        const bool has_next = S.next(ui + 1, nxt);
        const char* nA = has_next ? (const char*)g.A + (size_t)nxt.pm * tstepA + (size_t)(nxt.pn >> g.gsh) * gstepA : cA; const char* nB = has_next ? (const char*)g.Bt + (size_t)nxt.pn * tstepB : cB;
        for (int t = 0; t < nt; t += 2) {
            const bool last = (t == nt - 2);
            const char* a1 = cA + (size_t)(t + 1) * kstep;
            const char* a2 = last ? nA : cA + (size_t)(t + 2) * kstep; const char* b2 = last ? nB : cB + (size_t)(t + 2) * kstep;
            const char* a3 = a2 + kstep; const char* b3 = b2 + kstep;
            if (last && has_next) S.a_ready(nxt);
            if constexpr (SP2) {
            PG8_LDB(B0, 0, 0); PG8_LDB(B1, 0, 1); PG8_SCHED; PG8_LDA(At, 0, 0); PG8_STAGE(PG8_SA(1, 1), a1 + hstepA, voffA);
            PG8_WAIT_V(8); PG8_WAIT_L(0); PG8_BAR; PG8_MMA(0, 0, At, B0); PG8_MMA(0, 1, At, B1); PG8_BAR; PG8_SCHED;
            PG8_LDA(At, 0, 1); PG8_STAGE(PG8_SB(0, 0), b2, voffB); PG8_STAGE(PG8_SB(0, 1), b2 + hstepB, voffB); PG8_STAGE(PG8_SA(0, 0), a2, voffA);
            PG8_WAIT_V(8); PG8_WAIT_L(0); PG8_BAR; PG8_MMA(1, 0, At, B0); PG8_MMA(1, 1, At, B1); PG8_BAR; PG8_SCHED;
            PG8_LDB(B0, 1, 0); PG8_LDB(B1, 1, 1); PG8_SCHED; PG8_LDA(At, 1, 0); PG8_STAGE(PG8_SA(0, 1), a2 + hstepA, voffA);
            PG8_WAIT_V(8); PG8_WAIT_L(0); PG8_BAR; PG8_MMA(0, 0, At, B0); PG8_MMA(0, 1, At, B1); PG8_BAR; PG8_SCHED;
            PG8_LDA(At, 1, 1); PG8_STAGE(PG8_SB(1, 0), b3, voffB); PG8_STAGE(PG8_SB(1, 1), b3 + hstepB, voffB); PG8_STAGE(PG8_SA(1, 0), a3, voffA);
            PG8_WAIT_V(8); PG8_WAIT_L(0); PG8_BAR; PG8_MMA(1, 0, At, B0); PG8_MMA(1, 1, At, B1); PG8_BAR; PG8_SCHED;
            } else {
            PG8_LDB(B0, 0, 0); PG8_SCHED; PG8_LDA(At, 0, 0); PG8_STAGE(PG8_SA(1, 1), a1 + hstepA, voffA);
            PG8_WAIT_L(8); PG8_BAR; PG8_WAIT_L(0); PG8_MMA(0, 0, At, B0); PG8_BAR; PG8_SCHED;
            PG8_LDB(B1, 0, 1); PG8_STAGE(PG8_SB(0, 0), b2, voffB);
            PG8_BAR; PG8_WAIT_L(0); PG8_MMA(0, 1, At, B1); PG8_BAR;
            PG8_LDA(At, 0, 1); PG8_STAGE(PG8_SA(0, 0), a2, voffA);
            PG8_BAR; PG8_WAIT_L(0); PG8_MMA(1, 0, At, B0); PG8_BAR; PG8_SCHED;
            PG8_STAGE(PG8_SB(0, 1), b2 + hstepB, voffB);
            PG8_WAIT_V(6); PG8_BAR; PG8_MMA(1, 1, At, B1); PG8_BAR;
            PG8_LDB(B0, 1, 0); PG8_SCHED; PG8_LDA(At, 1, 0); PG8_STAGE(PG8_SA(0, 1), a2 + hstepA, voffA);
            PG8_WAIT_L(8); PG8_BAR; PG8_WAIT_L(0); PG8_MMA(0, 0, At, B0); PG8_BAR; PG8_SCHED;
            PG8_LDB(B1, 1, 1); PG8_STAGE(PG8_SB(1, 0), b3, voffB);
            PG8_BAR; PG8_WAIT_L(0); PG8_MMA(0, 1, At, B1); PG8_BAR;
            PG8_LDA(At, 1, 1); PG8_STAGE(PG8_SA(1, 0), a3, voffA);
            PG8_BAR; PG8_WAIT_L(0); PG8_MMA(1, 0, At, B0); PG8_BAR; PG8_SCHED;
            PG8_STAGE(PG8_SB(1, 1), b3 + hstepB, voffB);
            PG8_WAIT_V(6); PG8_BAR; PG8_MMA(1, 1, At, B1); PG8_BAR;
            }
        }
        if constexpr (ALIGN_EPI) { if (wr == 0) PG8_BAR; }
        if constexpr (!Epi::AFTER_DRAIN) { E(acc, cur, wr, wc, fr, fq); S.done(cur); }
        if (!has_next) break;
#pragma unroll
        for (int a = 0; a < 2; ++a)
#pragma unroll
            for (int b = 0; b < 2; ++b)
#pragma unroll
                for (int m = 0; m < 4; ++m)
#pragma unroll
                    for (int n = 0; n < 2; ++n) acc[a][b][m][n] = (f32x4){0.f, 0.f, 0.f, 0.f};
        cur = nxt; cA = nA; cB = nB; ++ui;
        if constexpr (ALIGN_EPI) { if (wr == 1) PG8_BAR; }
    }
    PG8_WAIT_V(0);
    if constexpr (!ALIGN_EPI) { if (wr == 0) PG8_BAR; }
    PG8_BAR;
    if constexpr (Epi::AFTER_DRAIN) { E.fused(acc, cur, wr, wc, fr, fq, lds, wid, lane); S.done(cur); }
#undef PG8_SA
#undef PG8_SB
#undef PG8_STAGE
#undef PG8_LDA
#undef PG8_LDB
#undef PG8_MMA
#undef PG8_WAIT_V
#undef PG8_WAIT_L
#undef PG8_BAR
#undef PG8_SCHED
}

}

constexpr int NWAVES = 8;
constexpr int BATCH = 4, SEQ = 4096, DM = 2048, M = BATCH * SEQ;
constexpr int DI = 4096, HD = 64, NH = 64, NG = 8, HPG = 8, NS = 128, CONVK = 4;
constexpr int CONV_DIM = DI + 2 * NG * NS;
constexpr int SSM_IN = DI + CONV_DIM + NH;
constexpr int N1 = DI + CONV_DIM;
constexpr int BCW = 2 * NG * NS;
constexpr int DP = 4096, PG = 4, PGD = 1024;
constexpr float EPS = 1e-6f;

constexpr size_t MiB = 1u << 20;
constexpr size_t WS_CTL = 0, CTL_ZERO_BYTES = 1 * MiB;
constexpr size_t WS_DT  = 1 * MiB;
constexpr size_t WS_W1T = 5 * MiB;
constexpr size_t WS_W2T = 46 * MiB;
constexpr size_t WS_W3T = 62 * MiB;
constexpr size_t WS_W4T = 94 * MiB;
constexpr size_t WS_W5T = 102 * MiB;
constexpr size_t WS_RA  = 120 * MiB;
constexpr size_t WS_RB  = 248 * MiB;
constexpr size_t WS_RC  = 440 * MiB;
constexpr size_t WS_END = 512 * MiB;
static_assert(WS_W1T + (size_t)SSM_IN * DM * 2 <= WS_W2T && WS_W2T + (size_t)DM * DI * 2 <= WS_W3T && WS_W3T + (size_t)2 * DP * DM * 2 <= WS_W4T && WS_W4T + (size_t)DP * PGD * 2 <= WS_W5T && WS_W5T + (size_t)DM * DP * 2 <= WS_RA, "weights map");
static_assert(WS_RA + (size_t)M * DI * 2 <= WS_RB && WS_RB + (size_t)M * CONV_DIM * 2 <= WS_RC && WS_RC + (size_t)M * DM * 2 <= WS_END && WS_RB + 128 * MiB + (size_t)M * DP * 2 <= WS_END, "activation map");
constexpr int CW_BAR = 4096;
constexpr int CW_SSQ1 = 16384, CW_SSQ2 = CW_SSQ1 + M, CW_SSQ3 = CW_SSQ2 + M;
static_assert((CW_SSQ3 + M) * 4 <= (int)CTL_ZERO_BYTES, "CTL words inside the memset region");

constexpr int RING_OFF = 0, RING_BYTES = 143360;
constexpr int LDSCTL_OFF = RING_BYTES, MISC_OFF = LDSCTL_OFF + 320;
constexpr int LDS_BYTES = 147456;
static_assert(MISC_OFF + 128 <= LDS_BYTES, "LDS map");

#define LAS __attribute__((address_space(3)))
typedef unsigned short bf16;
typedef unsigned v4u __attribute__((ext_vector_type(4)));
typedef unsigned v2u __attribute__((ext_vector_type(2)));
typedef float f32x4 __attribute__((ext_vector_type(4)));
typedef short bf16x8 __attribute__((ext_vector_type(8)));
#define LDS_WAIT() asm volatile("s_waitcnt lgkmcnt(0)" ::: "memory")
#define VM_WAIT() asm volatile("s_waitcnt vmcnt(0)" ::: "memory")
__device__ __forceinline__ unsigned f2bf(float f) { unsigned u = __builtin_bit_cast(unsigned, f); return (u + 0x7fffu + ((u >> 16) & 1u)) >> 16; }
__device__ __forceinline__ unsigned pk2(float lo, float hi) { return f2bf(lo) | (f2bf(hi) << 16); }
__device__ __forceinline__ float bflo(unsigned w) { return __uint_as_float(w << 16); }
__device__ __forceinline__ float bfhi(unsigned w) { return __uint_as_float(w & 0xffff0000u); }
__device__ __forceinline__ float bf1(bf16 v) { return __uint_as_float(((unsigned)v) << 16); }
__device__ __forceinline__ float sigm(float v) { return 1.0f / (1.0f + __expf(-v)); }
__device__ __forceinline__ float wave_sum(float v) {
#pragma unroll
    for (int o = 1; o < 64; o <<= 1) v += __shfl_xor(v, o);
    return v;
}

#define XB_TMO      128
#define XB_XCNT(j)  (256  + 64 * (j))
#define XB_XSUB(j)  (1280 + 64 * (j))
#define XB_XGEN(j)  (2304 + 64 * (j))
#define XB_TOP      3328
#define XB_TOPGEN   3392
#define XCD_BAR_WORDS 3456
#define XB_SPIN_CAP (1u << 18)

__device__ __forceinline__ unsigned xb_ld(unsigned* p)              { return __hip_atomic_load(p, __ATOMIC_RELAXED, __HIP_MEMORY_SCOPE_AGENT); }
__device__ __forceinline__ unsigned xb_add(unsigned* p, unsigned v) { return __hip_atomic_fetch_add(p, v, __ATOMIC_RELAXED, __HIP_MEMORY_SCOPE_AGENT); }
__device__ __forceinline__ unsigned xb_xcc_id() { return (unsigned)__builtin_amdgcn_s_getreg((3 << 11) | 20) & 0xFu; }
#define XB_SPIN(cond, bar) do { unsigned _sp = 0; while (cond) { __builtin_amdgcn_s_sleep(1); \
    if ((++_sp & 255u) == 0u) { if (xb_ld(&(bar)[XB_TMO])) break; if (_sp > XB_SPIN_CAP) { atomicAdd(&(bar)[XB_TMO], 1u); break; } } } } while (0)

struct XcdBarrier {
    unsigned* bar; unsigned x;
    volatile LAS unsigned* st;
};

__device__ __forceinline__ XcdBarrier xcd_barrier_post(unsigned* bar, volatile LAS unsigned* st) {
    XcdBarrier b; b.bar = bar; b.x = xb_xcc_id(); b.st = st;
    if (threadIdx.x == 0) (void)xb_add(&bar[XB_XCNT(b.x)], 1u);
    return b;
}
__device__ __forceinline__ void xcd_barrier_complete(unsigned* bar, unsigned x, unsigned& nloc, unsigned& nx) {
    const unsigned G = gridDim.x * gridDim.y * gridDim.z;
    unsigned sum, cnt, mine, sp = 0u;
    for (;;) {
        sum = 0u; cnt = 0u; mine = 0u;
#pragma unroll
        for (unsigned j = 0; j < 16; ++j) { const unsigned c = xb_ld(&bar[XB_XCNT(j)]); sum += c; cnt += (c > 0u) ? 1u : 0u; mine = (j == x) ? c : mine; }
        if (sum == G) break;
        __builtin_amdgcn_s_sleep(1);
        if ((++sp & 255u) == 0u) { if (xb_ld(&bar[XB_TMO])) break; if (sp > XB_SPIN_CAP) { atomicAdd(&bar[XB_TMO], 1u); break; } }
    }
    nloc = mine > 0u ? mine : 1u; nx = cnt > 0u ? cnt : 1u;
}

__device__ __forceinline__ void xcd_barrier(const XcdBarrier& b) {
    asm volatile("s_waitcnt vmcnt(0)" ::: "memory");
    __syncthreads();
    if (threadIdx.x == 0) {
        unsigned* bar = b.bar;
        __builtin_amdgcn_s_waitcnt(0);
        unsigned nloc = b.st[0], nx = b.st[1];
        if (nloc == 0u) { xcd_barrier_complete(bar, b.x, nloc, nx); b.st[0] = nloc; b.st[1] = nx; }
        const unsigned old = xb_add(&bar[XB_XSUB(b.x)], 1u);
        const unsigned gen = old / nloc;
        if (old + 1u == (gen + 1u) * nloc) {
            __builtin_amdgcn_fence(__ATOMIC_RELEASE, "agent");
            asm volatile("s_waitcnt vmcnt(0)" ::: "memory");
            const unsigned og = xb_add(&bar[XB_TOP], 1u);
            const unsigned tg = og / nx;
            if (og + 1u == (tg + 1u) * nx) xb_add(&bar[XB_TOPGEN], 1u);
            else XB_SPIN(xb_ld(&bar[XB_TOPGEN]) == tg, bar);
            __builtin_amdgcn_fence(__ATOMIC_ACQUIRE, "agent");
            xb_add(&bar[XB_XGEN(b.x)], 1u);
            asm volatile("s_waitcnt vmcnt(0)" ::: "memory");
        } else {
            XB_SPIN(xb_ld(&bar[XB_XGEN(b.x)]) == gen, bar);
            __builtin_amdgcn_fence(__ATOMIC_ACQUIRE, "agent");
            asm volatile("s_waitcnt vmcnt(0)" ::: "memory");
        }
    }
    __syncthreads();
}

struct Ctx { LAS unsigned char* lds; int tid, lane, wave, G, vcu; };

__device__ __forceinline__ void transpose_item(const float* W, const float* gain, int K, int N, bf16* WT, int row_off, LAS float* scr, int item, int lane) {
    const int nblk = N / 32, kb = item / nblk, nb = item % nblk, k0 = 64 * kb, n0 = 32 * nb;
#pragma unroll 8
    for (int i = 0; i < 32; ++i) { const int kk = 2 * i + (lane >> 5); const float gk = gain ? gain[k0 + kk] : 1.0f; scr[kk * 33 + (lane & 31)] = W[(size_t)(k0 + kk) * N + n0 + (lane & 31)] * gk; }
    LDS_WAIT(); asm volatile("" ::: "memory");
    const int c = lane & 7;
#pragma unroll
    for (int j = 0; j < 4; ++j) { const int n = (lane >> 3) + 8 * j; const LAS float* s = scr + (8 * c) * 33 + n;
        v4u o; o.x = pk2(s[0 * 33], s[1 * 33]); o.y = pk2(s[2 * 33], s[3 * 33]); o.z = pk2(s[4 * 33], s[5 * 33]); o.w = pk2(s[6 * 33], s[7 * 33]);
        *(v4u*)(WT + (size_t)(row_off + n0 + n) * K + k0 + 8 * c) = o; }
    LDS_WAIT(); asm volatile("" ::: "memory");
}

struct Ptrs {
    const float *x, *ln_g, *final_g, *ssm_w_in, *conv_w, *conv_b, *dt_bias, *a_log, *ssm_d, *norm_g, *ssm_w_out, *pool_w_in, *pool_w_group, *pool_scale, *pool_w_out;
    float* out; unsigned char* ws;
};

__device__ __forceinline__ void phase_prep(const Ctx& F, const Ptrs& P) {
    LAS float* scr = (LAS float*)(F.lds + RING_OFF + F.wave * 16384);
    const int gw = F.vcu * NWAVES + F.wave, NGW = F.G * NWAVES;
    bf16* W1T = (bf16*)(P.ws + WS_W1T); bf16* W2T = (bf16*)(P.ws + WS_W2T); bf16* W3T = (bf16*)(P.ws + WS_W3T); bf16* W4T = (bf16*)(P.ws + WS_W4T); bf16* W5T = (bf16*)(P.ws + WS_W5T);
    constexpr int I1 = (DM / 64) * (SSM_IN / 32), I2 = (DI / 64) * (DM / 32), I3 = (DM / 64) * (2 * DP / 32), I4G = (PGD / 64) * (PGD / 32), I4 = PG * I4G, I5 = (DP / 64) * (DM / 32);
    constexpr int NITEMS = I1 + I2 + I3 + I4 + I5;
    for (int it = gw; it < NITEMS; it += NGW) {
        int r = it;
        if (r < I1) { transpose_item(P.ssm_w_in, P.ln_g, DM, SSM_IN, W1T, 0, scr, r, F.lane); continue; } r -= I1;
        if (r < I2) { transpose_item(P.ssm_w_out, P.norm_g, DI, DM, W2T, 0, scr, r, F.lane); continue; } r -= I2;
        if (r < I3) { transpose_item(P.pool_w_in, P.ln_g + DM, DM, 2 * DP, W3T, 0, scr, r, F.lane); continue; } r -= I3;
        if (r < I4) { const int g = r / I4G; transpose_item(P.pool_w_group + (size_t)g * PGD * PGD, nullptr, PGD, PGD, W4T, g * PGD, scr, r % I4G, F.lane); continue; } r -= I4;
        transpose_item(P.pool_w_out, nullptr, DP, DM, W5T, 0, scr, r, F.lane);
    }
    bf16* XB = (bf16*)(P.ws + WS_RC); float* ssq1 = (float*)(P.ws + WS_CTL) + CW_SSQ1;
    for (int m = gw; m < M; m += NGW) {
        const f32x4* xr = (const f32x4*)(P.x + (size_t)m * DM) + F.lane;
        f32x4 v[8]; float s = 0.f;
#pragma unroll
        for (int j = 0; j < 8; ++j) { v[j] = xr[64 * j]; s += (v[j].x * v[j].x + v[j].y * v[j].y) + (v[j].z * v[j].z + v[j].w * v[j].w); }
        s = wave_sum(s);
        if (F.lane == 0) ssq1[m] = s;
        v2u* o8 = (v2u*)(XB + (size_t)m * DM) + F.lane;
#pragma unroll
        for (int j = 0; j < 8; ++j) { v2u w; w.x = pk2(v[j].x, v[j].y); w.y = pk2(v[j].z, v[j].w); o8[64 * j] = w; }
    }
}

__device__ __forceinline__ float softplus_f(float v) { return fmaxf(v, 0.f) + log1pf(expf(-fabsf(v))); }

__device__ __forceinline__ void phase_dt(const Ctx& F, const Ptrs& P) {
    const bf16* XB = (const bf16*)(P.ws + WS_RC); const bf16* WDT = (const bf16*)(P.ws + WS_W1T) + (size_t)N1 * DM;
    const float* ssq1 = (const float*)(P.ws + WS_CTL) + CW_SSQ1; float* DT = (float*)(P.ws + WS_DT);
    const int rt = F.wave >> 1, ct0 = (F.wave & 1) * 2, fr = F.lane & 15, fq = F.lane >> 4;
    for (int item = F.vcu; item < M / 64; item += F.G) {
        const int r0 = item * 64 + rt * 16;
        const bf16* ap = XB + (size_t)(r0 + fr) * DM + 8 * fq;
        const bf16* bp0 = WDT + (size_t)(16 * ct0 + fr) * DM + 8 * fq; const bf16* bp1 = bp0 + (size_t)16 * DM;
        f32x4 acc0 = {0.f, 0.f, 0.f, 0.f}, acc1 = {0.f, 0.f, 0.f, 0.f};
#pragma unroll 4
        for (int ks = 0; ks < DM / 32; ++ks) {
            const bf16x8 a = *(const bf16x8*)(ap + 32 * ks), b0 = *(const bf16x8*)(bp0 + 32 * ks), b1 = *(const bf16x8*)(bp1 + 32 * ks);
            acc0 = __builtin_amdgcn_mfma_f32_16x16x32_bf16(a, b0, acc0, 0, 0, 0);
            acc1 = __builtin_amdgcn_mfma_f32_16x16x32_bf16(a, b1, acc1, 0, 0, 0);
        }
        const int h0 = 16 * ct0 + fr, h1 = h0 + 16; const float bias0 = P.dt_bias[h0], bias1 = P.dt_bias[h1];
#pragma unroll
        for (int r = 0; r < 4; ++r) { const int row = r0 + 4 * fq + r; const float s = rsqrtf(ssq1[row] * (1.0f / DM) + EPS);
            DT[(size_t)row * NH + h0] = softplus_f(acc0[r] * s + bias0); DT[(size_t)row * NH + h1] = softplus_f(acc1[r] * s + bias1); }
    }
}

__device__ __forceinline__ void phase_bcconv(const Ctx& F, const Ptrs& P) {
    const bf16* XBC = (const bf16*)(P.ws + WS_RB); bf16* BC = (bf16*)(P.ws + WS_RC);
    const int NCG = BCW / 8;
    const int nitems = (M / 32) * NCG;
    for (int it = F.vcu * 512 + F.tid; it < nitems; it += F.G * 512) {
        const int cg = it % NCG, tb = it / NCG, c0 = cg * 8, t0 = tb * 32, ch = DI + c0;
        float w[4][8], bias[8];
#pragma unroll
        for (int k = 0; k < 4; ++k) { const f32x4 a = *(const f32x4*)(P.conv_w + (size_t)k * CONV_DIM + ch), b = *(const f32x4*)(P.conv_w + (size_t)k * CONV_DIM + ch + 4);
            w[k][0] = a.x; w[k][1] = a.y; w[k][2] = a.z; w[k][3] = a.w; w[k][4] = b.x; w[k][5] = b.y; w[k][6] = b.z; w[k][7] = b.w; }
        { const f32x4 a = *(const f32x4*)(P.conv_b + ch), b = *(const f32x4*)(P.conv_b + ch + 4); bias[0] = a.x; bias[1] = a.y; bias[2] = a.z; bias[3] = a.w; bias[4] = b.x; bias[5] = b.y; bias[6] = b.z; bias[7] = b.w; }
        float h3[8], h2[8], h1[8];
        const bool seq_start = (t0 % SEQ) == 0;
#pragma unroll
        for (int j = 0; j < 8; ++j) { h3[j] = 0.f; h2[j] = 0.f; h1[j] = 0.f; }
        if (!seq_start) {
            const v4u r3 = *(const v4u*)(XBC + (size_t)(t0 - 3) * CONV_DIM + ch), r2 = *(const v4u*)(XBC + (size_t)(t0 - 2) * CONV_DIM + ch), r1 = *(const v4u*)(XBC + (size_t)(t0 - 1) * CONV_DIM + ch);
            h3[0] = bflo(r3.x); h3[1] = bfhi(r3.x); h3[2] = bflo(r3.y); h3[3] = bfhi(r3.y); h3[4] = bflo(r3.z); h3[5] = bfhi(r3.z); h3[6] = bflo(r3.w); h3[7] = bfhi(r3.w);
            h2[0] = bflo(r2.x); h2[1] = bfhi(r2.x); h2[2] = bflo(r2.y); h2[3] = bfhi(r2.y); h2[4] = bflo(r2.z); h2[5] = bfhi(r2.z); h2[6] = bflo(r2.w); h2[7] = bfhi(r2.w);
            h1[0] = bflo(r1.x); h1[1] = bfhi(r1.x); h1[2] = bflo(r1.y); h1[3] = bfhi(r1.y); h1[4] = bflo(r1.z); h1[5] = bfhi(r1.z); h1[6] = bflo(r1.w); h1[7] = bfhi(r1.w);
        }
#pragma unroll 4
        for (int t = 0; t < 32; ++t) {
            const v4u rr = *(const v4u*)(XBC + (size_t)(t0 + t) * CONV_DIM + ch);
            float cur[8] = {bflo(rr.x), bfhi(rr.x), bflo(rr.y), bfhi(rr.y), bflo(rr.z), bfhi(rr.z), bflo(rr.w), bfhi(rr.w)};
            float o[8];
#pragma unroll
            for (int j = 0; j < 8; ++j) { const float v = bias[j] + w[0][j] * h3[j] + w[1][j] * h2[j] + w[2][j] * h1[j] + w[3][j] * cur[j]; o[j] = v * sigm(v); h3[j] = h2[j]; h2[j] = h1[j]; h1[j] = cur[j]; }
            v4u ow; ow.x = pk2(o[0], o[1]); ow.y = pk2(o[2], o[3]); ow.z = pk2(o[4], o[5]); ow.w = pk2(o[6], o[7]);
            *(v4u*)(BC + (size_t)(t0 + t) * BCW + c0) = ow;
        }
    }
}

__device__ __forceinline__ void ssd_tok_load(const bf16* XBC, const bf16* BC, const bf16* Z, const float* DT, size_t tok, int ch, int h, int g, int ng,
                                             float& xr, float& dtv, float& zv, v4u& B0, v4u& B1, v4u& C0, v4u& C1) {
    xr = bf1(XBC[tok * CONV_DIM + ch]); dtv = DT[tok * NH + h]; zv = bf1(Z[tok * DI + ch]);
    B0 = *(const v4u*)(BC + tok * BCW + g * NS + ng * 16); B1 = *(const v4u*)(BC + tok * BCW + g * NS + ng * 16 + 8);
    C0 = *(const v4u*)(BC + tok * BCW + NG * NS + g * NS + ng * 16); C1 = *(const v4u*)(BC + tok * BCW + NG * NS + g * NS + ng * 16 + 8);
}
__device__ __forceinline__ void phase_ssd_naive(const Ctx& F, const Ptrs& P) {
    const bf16* XBC = (const bf16*)(P.ws + WS_RB); const bf16* BC = (const bf16*)(P.ws + WS_RC); bf16* Z = (bf16*)(P.ws + WS_RA);
    const float* DT = (const float*)(P.ws + WS_DT); float* ssq2 = (float*)(P.ws + WS_CTL) + CW_SSQ2;
    const int p = F.tid >> 3, ng = F.tid & 7;
    for (int unit = F.vcu; unit < BATCH * NH; unit += F.G) {
        const int b = unit / NH, h = unit % NH, g = h / HPG, ch = h * HD + p;
        const float a = -expf(P.a_log[h]), Dh = P.ssm_d[h];
        const float w0 = P.conv_w[ch], w1 = P.conv_w[CONV_DIM + ch], w2 = P.conv_w[2 * CONV_DIM + ch], w3 = P.conv_w[3 * CONV_DIM + ch], cb = P.conv_b[ch];
        float st[16];
#pragma unroll
        for (int j = 0; j < 16; ++j) st[j] = 0.f;
        float xm3 = 0.f, xm2 = 0.f, xm1 = 0.f;
        float xr, dtv, zv; v4u B0, B1, C0, C1;
        ssd_tok_load(XBC, BC, Z, DT, (size_t)b * SEQ, ch, h, g, ng, xr, dtv, zv, B0, B1, C0, C1);
        for (int t = 0; t < SEQ; ++t) {
            const size_t tok = (size_t)b * SEQ + t;
            float nxr, ndtv, nzv; v4u nB0, nB1, nC0, nC1;
            ssd_tok_load(XBC, BC, Z, DT, (t + 1 < SEQ) ? tok + 1 : tok, ch, h, g, ng, nxr, ndtv, nzv, nB0, nB1, nC0, nC1);
            const float xc = cb + w0 * xm3 + w1 * xm2 + w2 * xm1 + w3 * xr; xm3 = xm2; xm2 = xm1; xm1 = xr;
            const float xv = xc * sigm(xc);
            const float dA = expf(dtv * a), dx = dtv * xv;
            const float Bv[16] = {bflo(B0.x), bfhi(B0.x), bflo(B0.y), bfhi(B0.y), bflo(B0.z), bfhi(B0.z), bflo(B0.w), bfhi(B0.w), bflo(B1.x), bfhi(B1.x), bflo(B1.y), bfhi(B1.y), bflo(B1.z), bfhi(B1.z), bflo(B1.w), bfhi(B1.w)};
            const float Cv[16] = {bflo(C0.x), bfhi(C0.x), bflo(C0.y), bfhi(C0.y), bflo(C0.z), bfhi(C0.z), bflo(C0.w), bfhi(C0.w), bflo(C1.x), bfhi(C1.x), bflo(C1.y), bfhi(C1.y), bflo(C1.z), bfhi(C1.z), bflo(C1.w), bfhi(C1.w)};
            float y = 0.f;
#pragma unroll
            for (int j = 0; j < 16; ++j) { st[j] = st[j] * dA + dx * Bv[j]; y += Cv[j] * st[j]; }
            y += __shfl_xor(y, 1); y += __shfl_xor(y, 2); y += __shfl_xor(y, 4);
            y += Dh * xv;
            const float gated = y * (zv * sigm(zv));
            float q = gated * gated; q += __shfl_xor(q, 8); q += __shfl_xor(q, 16); q += __shfl_xor(q, 32);
            if (ng == 0) Z[tok * DI + ch] = (bf16)f2bf(gated);
            if (F.lane == 0) atomicAdd(ssq2 + tok, q);
            xr = nxr; dtv = ndtv; zv = nzv; B0 = nB0; B1 = nB1; C0 = nC0; C1 = nC1;
        }
    }
}

constexpr int IMG_C = 0, IMG_B = 16384, IMG_BT = 32768, IMG_BYTES = 49152;
constexpr int SL_IMG0 = 0, SL_IMG1 = IMG_BYTES, SL_XT = 2 * IMG_BYTES, SL_XWT = SL_XT + 8192, SL_P = SL_XWT + 8192, SL_YT = SL_P + 8192, SL_END = SL_YT + 16384;
static_assert(SL_END <= RING_BYTES, "SSD LDS map");
__device__ __forceinline__ int img256(int r, int c) { return r * 256 + ((c ^ (r & 15)) << 4); }
__device__ __forceinline__ int img128(int r, int c) { return r * 128 + ((c ^ ((r >> 1) & 7)) << 4); }
typedef __bf16 bf16x2_t __attribute__((ext_vector_type(2)));
typedef float f32x2_t __attribute__((ext_vector_type(2)));
__device__ __forceinline__ unsigned cvtpk(float lo, float hi) { f32x2_t v = {lo, hi}; bf16x2_t b = __builtin_convertvector(v, bf16x2_t); return __builtin_bit_cast(unsigned, b); }
#define RAW_BARRIER() do { asm volatile("s_waitcnt lgkmcnt(0)" ::: "memory"); __builtin_amdgcn_s_barrier(); asm volatile("" ::: "memory"); } while (0)

__device__ __forceinline__ void phase_bcprep(const Ctx& F, const Ptrs& P) {
    const bf16* XBC = (const bf16*)(P.ws + WS_RB); unsigned char* IMGS = (unsigned char*)P.out;
    LAS unsigned char* L = F.lds;
    const int cg = F.tid & 31, tg = F.tid >> 5, isC = cg >> 4, n0 = 8 * (cg & 15);
    for (int unit = F.vcu; unit < BATCH * (SEQ / 64) * NG; unit += F.G) {
        const int g = unit % NG, bc = unit / NG, c = bc % (SEQ / 64);
        const int ch = DI + isC * (NG * NS) + g * NS + n0;
        const size_t T0 = (size_t)bc * 64 + 4 * tg;
        float w[4][8], bias[8];
#pragma unroll
        for (int k = 0; k < 4; ++k) { const f32x4 a = *(const f32x4*)(P.conv_w + (size_t)k * CONV_DIM + ch), b = *(const f32x4*)(P.conv_w + (size_t)k * CONV_DIM + ch + 4);
            w[k][0] = a.x; w[k][1] = a.y; w[k][2] = a.z; w[k][3] = a.w; w[k][4] = b.x; w[k][5] = b.y; w[k][6] = b.z; w[k][7] = b.w; }
        { const f32x4 a = *(const f32x4*)(P.conv_b + ch), b = *(const f32x4*)(P.conv_b + ch + 4); bias[0] = a.x; bias[1] = a.y; bias[2] = a.z; bias[3] = a.w; bias[4] = b.x; bias[5] = b.y; bias[6] = b.z; bias[7] = b.w; }
        float raw[7][8];
        const bool nohalo = (c == 0 && tg == 0);
#pragma unroll
        for (int k = 0; k < 7; ++k) {
            const size_t row = (k < 3 && nohalo) ? T0 : (T0 + k - 3);
            v4u rr = *(const v4u*)(XBC + row * CONV_DIM + ch);
            if (k < 3 && nohalo) { rr.x = 0u; rr.y = 0u; rr.z = 0u; rr.w = 0u; }
            raw[k][0] = bflo(rr.x); raw[k][1] = bfhi(rr.x); raw[k][2] = bflo(rr.y); raw[k][3] = bfhi(rr.y); raw[k][4] = bflo(rr.z); raw[k][5] = bfhi(rr.z); raw[k][6] = bflo(rr.w); raw[k][7] = bfhi(rr.w);
        }
        float o[4][8];
#pragma unroll
        for (int i = 0; i < 4; ++i)
#pragma unroll
            for (int j = 0; j < 8; ++j) { const float v = bias[j] + w[0][j] * raw[i][j] + w[1][j] * raw[i + 1][j] + w[2][j] * raw[i + 2][j] + w[3][j] * raw[i + 3][j]; o[i][j] = v * sigm(v); }
        const int ks = n0 >> 5, hi = (n0 >> 4) & 1, q0 = 2 * ((n0 >> 3) & 1);
        const int ibase = isC ? IMG_C : IMG_B;
#pragma unroll
        for (int i = 0; i < 4; ++i) { const int l = 4 * tg + i;
            v2u lo, hi2; lo.x = cvtpk(o[i][0], o[i][1]); lo.y = cvtpk(o[i][2], o[i][3]); hi2.x = cvtpk(o[i][4], o[i][5]); hi2.y = cvtpk(o[i][6], o[i][7]);
            *(LAS v2u*)(L + ibase + img256(l, 4 * ks + q0) + 8 * hi) = lo;
            *(LAS v2u*)(L + ibase + img256(l, 4 * ks + q0 + 1) + 8 * hi) = hi2; }
        if (!isC) {
#pragma unroll
            for (int e = 0; e < 8; ++e) { v2u t; t.x = cvtpk(o[0][e], o[1][e]); t.y = cvtpk(o[2][e], o[3][e]);
                *(LAS v2u*)(L + IMG_BT + img128(n0 + e, tg >> 1) + 8 * (tg & 1)) = t; }
        }
        RAW_BARRIER();
        unsigned char* blob = IMGS + (size_t)unit * IMG_BYTES;
#pragma unroll
        for (int k = 0; k < 6; ++k) { const v4u v = *(const LAS v4u*)(L + F.tid * 16 + k * 8192); *(v4u*)(blob + F.tid * 16 + k * 8192) = v; }
        RAW_BARRIER();
    }
}

__device__ __forceinline__ void ssd_issue(const Ctx& F, const unsigned char* IMGS, const bf16* XBC, const bf16* Z, const float* DT, int b, int c, int g, int h, int w, int lane,
                                          unsigned short (&xr)[11], unsigned short (&zr)[8], float& dtv) {
    const unsigned char* blob = IMGS + ((size_t)(b * (SEQ / 64) + c) * NG + g) * IMG_BYTES;
    LAS unsigned char* dst = F.lds + ((c & 1) ? SL_IMG1 : SL_IMG0);
#pragma unroll
    for (int k = 0; k < 6; ++k) { const int piece = k * 8 + w;
        __builtin_amdgcn_global_load_lds((const unsigned*)(blob + piece * 1024 + lane * 16), (LAS unsigned*)(dst + piece * 1024), 16, 0, 0); }
    const long T0 = (long)b * SEQ + c * 64;
#pragma unroll
    for (int k = 0; k < 11; ++k) { long row = T0 + 8 * w - 3 + k; row = row < 0 ? 0 : row; xr[k] = XBC[(size_t)row * CONV_DIM + h * HD + lane]; }
#pragma unroll
    for (int i = 0; i < 8; ++i) zr[i] = Z[(size_t)(T0 + 8 * w + i) * DI + h * HD + lane];
    dtv = DT[(size_t)(T0 + lane) * NH + h];
}
__device__ __forceinline__ void phase_ssd(const Ctx& F, const Ptrs& P) {
    const bf16* XBC = (const bf16*)(P.ws + WS_RB); bf16* Z = (bf16*)(P.ws + WS_RA);
    const float* DT = (const float*)(P.ws + WS_DT); float* ssq2 = (float*)(P.ws + WS_CTL) + CW_SSQ2; const unsigned char* IMGS = (const unsigned char*)P.out;
    LAS unsigned char* L = F.lds;
    const int w = F.wave, lane = F.lane, r = lane & 15, q = lane >> 4, pt = w & 3, lh = w >> 2;
    for (int unit = F.vcu; unit < BATCH * NH; unit += F.G) {
        const int b = unit / NH, h = unit % NH, g = h / HPG, ch = h * HD + lane;
        const float a = -expf(P.a_log[h]), Dh = P.ssm_d[h];
        const float w0 = P.conv_w[ch], w1 = P.conv_w[CONV_DIM + ch], w2 = P.conv_w[2 * CONV_DIM + ch], w3 = P.conv_w[3 * CONV_DIM + ch], cbias = P.conv_b[ch];
        f32x4 st[8];
#pragma unroll
        for (int j = 0; j < 8; ++j) st[j] = (f32x4){0.f, 0.f, 0.f, 0.f};
        unsigned short nxr[11], nzr[8]; float ndt;
        ssd_issue(F, IMGS, XBC, Z, DT, b, 0, g, h, w, lane, nxr, nzr, ndt);
        asm volatile("s_waitcnt vmcnt(0)" ::: "memory"); RAW_BARRIER();
        for (int c = 0; c < SEQ / 64; ++c) {
            unsigned short xr[11], zr[8]; float dts = ndt;
#pragma unroll
            for (int k = 0; k < 11; ++k) xr[k] = nxr[k];
#pragma unroll
            for (int i = 0; i < 8; ++i) zr[i] = nzr[i];
            if (c + 1 < SEQ / 64) ssd_issue(F, IMGS, XBC, Z, DT, b, c + 1, g, h, w, lane, nxr, nzr, ndt);
            const LAS unsigned char* IC = L + ((c & 1) ? SL_IMG1 : SL_IMG0) + IMG_C; const LAS unsigned char* IB = IC + (IMG_B - IMG_C); const LAS unsigned char* IBT = IC + (IMG_BT - IMG_C);
            float cs = a * dts;
#pragma unroll
            for (int o = 1; o < 64; o <<= 1) { const float t = __shfl_up(cs, o); if (lane >= o) cs += t; }
            const float last = __shfl(cs, 63);
            const float wv = dts * __expf(last - cs), ev = __expf(cs), elast = __expf(last);
            {
                float xin[11];
#pragma unroll
                for (int k = 0; k < 11; ++k) xin[k] = (c == 0 && w == 0 && k < 3) ? 0.f : bf1(xr[k]);
                float xo[8], xw[8];
#pragma unroll
                for (int i = 0; i < 8; ++i) { const float v = cbias + w0 * xin[i] + w1 * xin[i + 1] + w2 * xin[i + 2] + w3 * xin[i + 3]; xo[i] = v * sigm(v); xw[i] = xo[i] * __shfl(wv, 8 * w + i); }
                v4u a4, b4; a4.x = cvtpk(xo[0], xo[1]); a4.y = cvtpk(xo[2], xo[3]); a4.z = cvtpk(xo[4], xo[5]); a4.w = cvtpk(xo[6], xo[7]);
                b4.x = cvtpk(xw[0], xw[1]); b4.y = cvtpk(xw[2], xw[3]); b4.z = cvtpk(xw[4], xw[5]); b4.w = cvtpk(xw[6], xw[7]);
                *(LAS v4u*)(L + SL_XT + img128(lane, w)) = a4; *(LAS v4u*)(L + SL_XWT + img128(lane, w)) = b4;
            }
            {
                const int lt = w >> 1, st0 = 2 * (w & 1);
                f32x4 cbt[2] = {(f32x4){0.f, 0.f, 0.f, 0.f}, (f32x4){0.f, 0.f, 0.f, 0.f}};
#pragma unroll
                for (int ks = 0; ks < 4; ++ks) { const bf16x8 av = *(const LAS bf16x8*)(IC + img256(16 * lt + r, 4 * ks + q));
                    const bf16x8 b0 = *(const LAS bf16x8*)(IB + img256(16 * st0 + r, 4 * ks + q)), b1 = *(const LAS bf16x8*)(IB + img256(16 * st0 + 16 + r, 4 * ks + q));
                    cbt[0] = __builtin_amdgcn_mfma_f32_16x16x32_bf16(av, b0, cbt[0], 0, 0, 0); cbt[1] = __builtin_amdgcn_mfma_f32_16x16x32_bf16(av, b1, cbt[1], 0, 0, 0); }
#pragma unroll
                for (int t = 0; t < 2; ++t) { const int s = 16 * (st0 + t) + r; const float cs_s = __shfl(cs, s), dt_s = __shfl(dts, s);
#pragma unroll
                    for (int rg = 0; rg < 4; ++rg) { const int l = 16 * lt + 4 * q + rg; const float cs_l = __shfl(cs, l);
                        float v = cbt[t][rg] * __expf(fminf(cs_l - cs_s, 0.f)) * dt_s; v = (s <= l) ? v : 0.f; if (s == l) v += Dh;
                        *(LAS unsigned short*)(L + SL_P + img128(l, s >> 3) + (s & 7) * 2) = (unsigned short)(cvtpk(v, 0.f) & 0xffffu); } }
            }
            f32x4 acc[2] = {(f32x4){0.f, 0.f, 0.f, 0.f}, (f32x4){0.f, 0.f, 0.f, 0.f}};
#pragma unroll
            for (int ks = 0; ks < 4; ++ks) {
                v4u sbw; sbw.x = cvtpk(st[2 * ks][0], st[2 * ks][1]); sbw.y = cvtpk(st[2 * ks][2], st[2 * ks][3]); sbw.z = cvtpk(st[2 * ks + 1][0], st[2 * ks + 1][1]); sbw.w = cvtpk(st[2 * ks + 1][2], st[2 * ks + 1][3]);
                const bf16x8 sb = __builtin_bit_cast(bf16x8, sbw);
#pragma unroll
                for (int t = 0; t < 2; ++t) { const bf16x8 av = *(const LAS bf16x8*)(IC + img256(16 * (2 * lh + t) + r, 4 * ks + q)); acc[t] = __builtin_amdgcn_mfma_f32_16x16x32_bf16(av, sb, acc[t], 0, 0, 0); }
            }
#pragma unroll
            for (int t = 0; t < 2; ++t)
#pragma unroll
                for (int rg = 0; rg < 4; ++rg) acc[t][rg] *= __shfl(ev, 16 * (2 * lh + t) + 4 * q + rg);
#pragma unroll
            for (int j = 0; j < 8; ++j) st[j] = st[j] * elast;
            RAW_BARRIER();
#pragma unroll
            for (int ks = 0; ks < 2; ++ks) { const bf16x8 xb = *(const LAS bf16x8*)(L + SL_XT + img128(16 * pt + r, 4 * ks + q));
#pragma unroll
                for (int t = 0; t < 2; ++t) { const bf16x8 av = *(const LAS bf16x8*)(L + SL_P + img128(16 * (2 * lh + t) + r, 4 * ks + q)); acc[t] = __builtin_amdgcn_mfma_f32_16x16x32_bf16(av, xb, acc[t], 0, 0, 0); } }
#pragma unroll
            for (int ks = 0; ks < 2; ++ks) { const bf16x8 xwb = *(const LAS bf16x8*)(L + SL_XWT + img128(16 * pt + r, 4 * ks + q));
#pragma unroll
                for (int j = 0; j < 8; ++j) { const bf16x8 av = *(const LAS bf16x8*)(IBT + img128(16 * j + r, 4 * ks + q)); st[j] = __builtin_amdgcn_mfma_f32_16x16x32_bf16(av, xwb, st[j], 0, 0, 0); } }
#pragma unroll
            for (int t = 0; t < 2; ++t) { const int p = 16 * pt + r; *(LAS f32x4*)(L + SL_YT + p * 256 + (((4 * (2 * lh + t) + q) ^ (p & 15)) << 4)) = acc[t]; }
            RAW_BARRIER();
            {
                const f32x4 y0 = *(const LAS f32x4*)(L + SL_YT + lane * 256 + (((2 * w) ^ (lane & 15)) << 4)), y1 = *(const LAS f32x4*)(L + SL_YT + lane * 256 + (((2 * w + 1) ^ (lane & 15)) << 4));
                const size_t T0 = (size_t)b * SEQ + c * 64 + 8 * w;
#pragma unroll
                for (int i = 0; i < 8; ++i) { const float y = i < 4 ? y0[i & 3] : y1[i & 3]; const float zv = bf1(zr[i]); const float gated = y * (zv * sigm(zv));
                    Z[(T0 + i) * DI + ch] = (bf16)(cvtpk(gated, 0.f) & 0xffffu);
                    const float q2 = wave_sum(gated * gated); if (lane == 0) atomicAdd(ssq2 + T0 + i, q2); }
            }
            asm volatile("s_waitcnt vmcnt(0)" ::: "memory"); RAW_BARRIER();
        }
    }
}

__device__ __forceinline__ void phase_pool(const Ctx& F, const Ptrs& P) {
    const bf16* U = (const bf16*)(P.ws + WS_RA); bf16* MX = (bf16*)(P.ws + WS_RB + 128 * MiB);
    const int NCG = DP / 8;
    const int nitems = (M / 32) * NCG;
    for (int it = F.vcu * 512 + F.tid; it < nitems; it += F.G * 512) {
        const int cg = it % NCG, tb = it / NCG, c0 = cg * 8, t0 = tb * 32, win = 2 << (c0 / PGD);
        const int pos0 = t0 % SEQ;
        float s[8];
#pragma unroll
        for (int j = 0; j < 8; ++j) s[j] = 0.f;
        for (int d = 1; d < win; ++d) if (pos0 - d >= 0) { const v4u r = *(const v4u*)(U + (size_t)(t0 - d) * DP + c0);
            s[0] += bflo(r.x); s[1] += bfhi(r.x); s[2] += bflo(r.y); s[3] += bfhi(r.y); s[4] += bflo(r.z); s[5] += bfhi(r.z); s[6] += bflo(r.w); s[7] += bfhi(r.w); }
        for (int t = 0; t < 32; ++t) {
            const int pos = pos0 + t;
            const v4u r = *(const v4u*)(U + (size_t)(t0 + t) * DP + c0);
            const float cur[8] = {bflo(r.x), bfhi(r.x), bflo(r.y), bfhi(r.y), bflo(r.z), bfhi(r.z), bflo(r.w), bfhi(r.w)};
#pragma unroll
            for (int j = 0; j < 8; ++j) s[j] += cur[j];
            const int cnt = (pos + 1 < win) ? (pos + 1) : win; const float inv = 1.0f / (float)cnt;
            v4u ow; ow.x = pk2(s[0] * inv - cur[0], s[1] * inv - cur[1]); ow.y = pk2(s[2] * inv - cur[2], s[3] * inv - cur[3]); ow.z = pk2(s[4] * inv - cur[4], s[5] * inv - cur[5]); ow.w = pk2(s[6] * inv - cur[6], s[7] * inv - cur[7]);
            *(v4u*)(MX + (size_t)(t0 + t) * DP + c0) = ow;
            if (pos - (win - 1) >= 0) { const v4u q = *(const v4u*)(U + (size_t)(t0 + t - (win - 1)) * DP + c0);
                s[0] -= bflo(q.x); s[1] -= bfhi(q.x); s[2] -= bflo(q.y); s[3] -= bfhi(q.y); s[4] -= bflo(q.z); s[5] -= bfhi(q.z); s[6] -= bflo(q.w); s[7] -= bfhi(q.w); }
        }
    }
}

__device__ __forceinline__ void phase_final(const Ctx& F, const Ptrs& P) {
    const int gw = F.vcu * NWAVES + F.wave, NGW = F.G * NWAVES;
    f32x4 gv[8];
#pragma unroll
    for (int j = 0; j < 8; ++j) gv[j] = ((const f32x4*)P.final_g)[F.lane + 64 * j];
    for (int m = gw; m < M; m += NGW) {
        f32x4* xr = (f32x4*)(P.out + (size_t)m * DM) + F.lane;
        f32x4 v[8]; float s = 0.f;
#pragma unroll
        for (int j = 0; j < 8; ++j) { v[j] = xr[64 * j]; s += (v[j].x * v[j].x + v[j].y * v[j].y) + (v[j].z * v[j].z + v[j].w * v[j].w); }
        s = wave_sum(s);
        const float rs = rsqrtf(s * (1.0f / DM) + EPS);
#pragma unroll
        for (int j = 0; j < 8; ++j) xr[64 * j] = v[j] * rs * gv[j];
    }
}

constexpr int N_PHASES = 10;
struct Args { Ptrs p; int ph_lo, ph_hi, li, pad; };
__global__ void __launch_bounds__(NWAVES * 64, 2) trunk_fwd(Args args) {
    extern __shared__ __attribute__((aligned(16))) unsigned char lds[];
    Ctx F;
    F.lds = (LAS unsigned char*)lds;
    F.tid = threadIdx.x; F.lane = F.tid & 63; F.wave = __builtin_amdgcn_readfirstlane(F.tid >> 6);
    F.G = gridDim.x; { const int bx = blockIdx.x; F.vcu = (F.G % 8 == 0) ? (bx % 8) * (F.G / 8) + bx / 8 : bx; }
    const Ptrs& P = args.p;
    unsigned* ctl = (unsigned*)(P.ws + WS_CTL);
    for (int u = F.tid; u < (LDS_BYTES - LDSCTL_OFF) / 4; u += NWAVES * 64) ((LAS unsigned*)(F.lds + LDSCTL_OFF))[u] = 0u;
    __syncthreads();
#if MK_ONE_LAUNCH
    XcdBarrier bar = xcd_barrier_post(ctl + CW_BAR, (volatile LAS unsigned*)(F.lds + MISC_OFF) + 8);
#define GRID_BAR() xcd_barrier(bar)
#else
#define GRID_BAR() do {} while (0)
#endif
    const int lo = args.ph_lo, hi = args.ph_hi;
#define IN(k) (lo <= (k) && (k) < hi)
#define BOTH(k) (IN(k) && IN((k) + 1))
    float* ssq1 = (float*)ctl + CW_SSQ1; float* ssq2 = (float*)ctl + CW_SSQ2; float* ssq3 = (float*)ctl + CW_SSQ3;
    bf16* W1T = (bf16*)(P.ws + WS_W1T); bf16* W2T = (bf16*)(P.ws + WS_W2T); bf16* W3T = (bf16*)(P.ws + WS_W3T); bf16* W4T = (bf16*)(P.ws + WS_W4T); bf16* W5T = (bf16*)(P.ws + WS_W5T);
    bf16* RA = (bf16*)(P.ws + WS_RA); bf16* RB = (bf16*)(P.ws + WS_RB); bf16* RC = (bf16*)(P.ws + WS_RC); bf16* MX = (bf16*)(P.ws + WS_RB + 128 * MiB);

    if (IN(0)) { phase_prep(F, P); if (BOTH(0)) GRID_BAR(); }
    if (IN(1)) {
        phase_dt(F, P);
        pg8::Gemm g{RC, W1T, M, N1, DM, DM, DM, 30}; pg8::StaticOrder S; S.init(M, N1, F.G, (int)blockIdx.x);
        pg8::EpiProj E{RA, DI, RB, CONV_DIM, DI / 256, ssq1, 1.0f / DM};
        pg8::gemm_phase<pg8::EpiProj, pg8::StaticOrder, true, true>(F.lds + RING_OFF, g, S, E);
        if (BOTH(1)) GRID_BAR();
    }
    if (IN(2)) { phase_bcprep(F, P); if (BOTH(2)) GRID_BAR(); }
    if (IN(3)) { phase_ssd(F, P); if (BOTH(3)) GRID_BAR(); }
    if (IN(4)) {
        pg8::Gemm g{RA, W2T, M, DM, DI, DI, DI, 30}; pg8::StaticOrder S; S.init(M, DM, F.G, (int)blockIdx.x);
        pg8::EpiRes E{P.x, P.out, RC, ssq2, 1.0f / DI, ssq3, DM};
        pg8::gemm_phase<pg8::EpiRes, pg8::StaticOrder, true, true>(F.lds + RING_OFF, g, S, E);
        if (BOTH(4)) GRID_BAR();
    }
    if (IN(5)) {
        pg8::Gemm g{RC, W3T, M, 2 * DP, DM, DM, DM, 30}; pg8::StaticOrder S; S.init(M, 2 * DP, F.G, (int)blockIdx.x);
        pg8::EpiProj E{RA, DP, RB, DP, DP / 256, ssq3, 1.0f / DM};
        pg8::gemm_phase<pg8::EpiProj, pg8::StaticOrder, true, true>(F.lds + RING_OFF, g, S, E);
        if (BOTH(5)) GRID_BAR();
    }
    if (IN(6)) { phase_pool(F, P); if (BOTH(6)) GRID_BAR(); }
    if (IN(7)) {
        pg8::Gemm g{MX, W4T, M, DP, PGD, DP, PGD, 2}; pg8::StaticOrder S; S.init(M, DP, F.G, (int)blockIdx.x);
        pg8::EpiGate E{RA, RB, P.pool_scale, DP};
        pg8::gemm_phase<pg8::EpiGate, pg8::StaticOrder, true, true>(F.lds + RING_OFF, g, S, E);
        if (BOTH(7)) GRID_BAR();
    }
    if (IN(8)) {
        pg8::Gemm g{RA, W5T, M, DM, DP, DP, DP, 30}; pg8::StaticOrder S; S.init(M, DM, F.G, (int)blockIdx.x);
        pg8::EpiRes E{P.out, P.out, nullptr, nullptr, 0.f, nullptr, DM};
        pg8::gemm_phase<pg8::EpiRes, pg8::StaticOrder, true, true>(F.lds + RING_OFF, g, S, E);
        if (BOTH(8)) GRID_BAR();
    }
    if (IN(9)) { phase_final(F, P); }
#undef IN
#undef BOTH
}

extern "C" void kernel_launch(void* const* d_in, const int* in_sizes, int n_in, void* d_out, int out_size, void* d_ws, size_t ws_size, hipStream_t stream) {
    static int grid = 0;
    if (grid == 0) {
        if (n_in != 15 || in_sizes[0] != M * DM || out_size != M * DM || ws_size < WS_END) { fprintf(stderr, "kernel_launch: unexpected shapes: n_in %d in0 %d out %d ws %zu (need %zu); nothing launched\n", n_in, n_in > 0 ? in_sizes[0] : -1, out_size, ws_size, (size_t)WS_END); grid = -1; return; }
        int dev = 0, cus = 0, per_cu = 0;
        if (hipGetDevice(&dev) != hipSuccess || hipDeviceGetAttribute(&cus, hipDeviceAttributeMultiprocessorCount, dev) != hipSuccess) { fprintf(stderr, "kernel_launch: device query failed\n"); grid = -1; return; }
        if (hipFuncSetAttribute((const void*)trunk_fwd, hipFuncAttributeMaxDynamicSharedMemorySize, LDS_BYTES) != hipSuccess) { fprintf(stderr, "kernel_launch: hipFuncSetAttribute failed\n"); grid = -1; return; }
        if (hipOccupancyMaxActiveBlocksPerMultiprocessor(&per_cu, (const void*)trunk_fwd, NWAVES * 64, LDS_BYTES) != hipSuccess || per_cu < 1) { fprintf(stderr, "kernel_launch: occupancy query says %d blocks per CU\n", per_cu); }
        (void)hipGetLastError();
        grid = cus;
    }
    if (grid < 0) return;
    if (hipMemsetAsync((char*)d_ws + WS_CTL, 0, CTL_ZERO_BYTES, stream) != hipSuccess) { fprintf(stderr, "kernel_launch: memset failed\n"); return; }
    Args a{};
    a.p.x = (const float*)d_in[0]; a.p.ln_g = (const float*)d_in[1]; a.p.final_g = (const float*)d_in[2]; a.p.ssm_w_in = (const float*)d_in[3]; a.p.conv_w = (const float*)d_in[4];
    a.p.conv_b = (const float*)d_in[5]; a.p.dt_bias = (const float*)d_in[6]; a.p.a_log = (const float*)d_in[7]; a.p.ssm_d = (const float*)d_in[8]; a.p.norm_g = (const float*)d_in[9];
    a.p.ssm_w_out = (const float*)d_in[10]; a.p.pool_w_in = (const float*)d_in[11]; a.p.pool_w_group = (const float*)d_in[12]; a.p.pool_scale = (const float*)d_in[13]; a.p.pool_w_out = (const float*)d_in[14];
    a.p.out = (float*)d_out; a.p.ws = (unsigned char*)d_ws;
#if MK_ONE_LAUNCH
    a.ph_lo = 0; a.ph_hi = N_PHASES; a.li = 0;
    hipLaunchKernelGGL(trunk_fwd, dim3(grid), dim3(NWAVES * 64), LDS_BYTES, stream, a);
#else
    for (int li = 0; li < N_PHASES; ++li) { a.ph_lo = li; a.ph_hi = li + 1; a.li = li;
        hipLaunchKernelGGL(trunk_fwd, dim3(grid), dim3(NWAVES * 64), LDS_BYTES, stream, a); }
#endif
    const hipError_t le = hipPeekAtLastError();
    if (le != hipSuccess) fprintf(stderr, "kernel_launch: launch failed: %s\n", hipGetErrorName(le));
}
```

```cpp
#include <hip/hip_runtime.h>
#include <cstdio>
#include <cstdint>

#ifndef REPEAT_MASK
#define REPEAT_MASK 0
#endif
#ifndef STAMP_PHASE
#define STAMP_PHASE -1
#endif
#ifndef MK_ONE_LAUNCH
#define MK_ONE_LAUNCH 1
#endif

namespace pg8 {
#define PG8_LAS __attribute__((address_space(3)))
typedef unsigned short bf16_t;
typedef short bf16x8 __attribute__((ext_vector_type(8)));
typedef float f32x4 __attribute__((ext_vector_type(4)));
typedef unsigned u32x4 __attribute__((ext_vector_type(4)));
typedef unsigned u32x2 __attribute__((ext_vector_type(2)));
constexpr int BM = 256, BK = 64, HALF = 128, HTB = HALF * BK * 2  , STAGE_BYTES = 8 * HTB, NXCD = 8, WGM = 8;
constexpr float RMS_EPS = 1e-6f;

__host__ __device__ __forceinline__ int lds_byte(int r, int c) { const int st = (r >> 4) * 2 + (c >> 5), rr = r & 15, cc = c & 31, ob = rr * 64 + cc * 2; return st * 1024 + (ob ^ (((ob >> 9) & 1) << 5)); }
__host__ __device__ __forceinline__ void stage_rc(int b, int& R, int& C) { const int st = b / 1024, sb = b % 1024, swz = sb ^ (((sb >> 9) & 1) << 5); R = (st >> 1) * 16 + swz / 64; C = (st & 1) * 32 + (swz % 64) / 2; }
__host__ __device__ __forceinline__ int perm32(int rho) { const int n = rho >> 4, i = rho & 15; return 8 * (i >> 2) + 4 * n + (i & 3); }

struct Unit { int pm, pn, ord; };
struct Gemm { const bf16_t* A; const bf16_t* Bt; int M, N, K, lda, ldb, gsh, bgsh; };

struct StaticOrder {
    int nM, nN, nwg, G, c;
    __host__ __device__ void init(int M, int N, int G_, int c_) { nM = M / BM; nN = N / BM; nwg = nM * nN; G = G_; c = c_; }
    __host__ __device__ bool next(int i, Unit& u) const {
        const long L = (long)i * G + c; if (L >= nwg) return false;
        int wgid = (int)L; { const int q = nwg / NXCD, r = nwg % NXCD, xcd = wgid % NXCD, off = wgid / NXCD; wgid = (xcd < r ? xcd * (q + 1) : r * (q + 1) + (xcd - r) * q) + off; }
        const int nig = WGM * nN, gid = wgid / nig, fm = gid * WGM, gsz = (nM - fm) < WGM ? (nM - fm) : WGM;
        u.pm = fm + ((wgid % nig) % gsz); u.pn = (wgid % nig) / gsz; return true;
    }
    __device__ __forceinline__ void a_ready(const Unit&) const {}
    __device__ __forceinline__ void done(const Unit&) const {}
};

__device__ __forceinline__ unsigned cvt_pk_bf16(float lo, float hi) { unsigned r; asm volatile("v_cvt_pk_bf16_f32 %0, %1, %2" : "=v"(r) : "v"(lo), "v"(hi)); return r; }
__device__ __forceinline__ float bf_lo(unsigned w) { return __uint_as_float(w << 16); }
__device__ __forceinline__ float bf_hi(unsigned w) { return __uint_as_float(w & 0xffff0000u); }
__device__ __forceinline__ float sigmoid_f(float v) { return __builtin_amdgcn_rcpf(1.0f + __builtin_amdgcn_exp2f(-1.4426950408889634f * v)); }

struct EpiProj {
    static constexpr bool PERM = true, AFTER_DRAIN = false;
    bf16_t* O0; int ld0; bf16_t* O1; int ld1; int split_pn; const float* ssq; float inv_n; const PG8_LAS float* rs_lds;
    __device__ __forceinline__ void operator()(const f32x4 (&acc)[2][2][4][2], const Unit& u, int wr, int wc, int fr, int fq) const {
        const int row0 = u.pm * BM + wr * 64 + fr;
        bf16_t* base; int ld, colt;
        if (u.pn < split_pn) { base = O0; ld = ld0; colt = u.pn * BM; } else { base = O1; ld = ld1; colt = (u.pn - split_pn) * BM; }
        const int col0 = colt + wc * 32 + 8 * fq;
#pragma unroll
        for (int ai = 0; ai < 2; ++ai)
#pragma unroll
            for (int m = 0; m < 4; ++m) { const int row = row0 + ai * HALF + m * 16; const float s = rs_lds ? rs_lds[u.ord * BM + wr * 64 + fr + ai * HALF + m * 16] : rsqrtf(ssq[row] * inv_n + RMS_EPS);
                bf16_t* rowp = base + (size_t)row * ld + col0;
#pragma unroll
                for (int bj = 0; bj < 2; ++bj) { const f32x4 v0 = acc[ai][bj][m][0] * s, v1 = acc[ai][bj][m][1] * s;
                    u32x4 w; w.x = cvt_pk_bf16(v0[0], v0[1]); w.y = cvt_pk_bf16(v0[2], v0[3]); w.z = cvt_pk_bf16(v1[0], v1[1]); w.w = cvt_pk_bf16(v1[2], v1[3]);
                    *(u32x4*)(rowp + bj * HALF) = w; } }
    }
};
struct EpiPlain {
    static constexpr bool PERM = true, AFTER_DRAIN = false;
    bf16_t* O; int ld;
    __device__ __forceinline__ void operator()(const f32x4 (&acc)[2][2][4][2], const Unit& u, int wr, int wc, int fr, int fq) const {
        const int row0 = u.pm * BM + wr * 64 + fr, col0 = u.pn * BM + wc * 32 + 8 * fq;
#pragma unroll
        for (int ai = 0; ai < 2; ++ai)
#pragma unroll
            for (int m = 0; m < 4; ++m) { bf16_t* rowp = O + (size_t)(row0 + ai * HALF + m * 16) * ld + col0;
#pragma unroll
                for (int bj = 0; bj < 2; ++bj) { const f32x4 v0 = acc[ai][bj][m][0], v1 = acc[ai][bj][m][1];
                    u32x4 w; w.x = cvt_pk_bf16(v0[0], v0[1]); w.y = cvt_pk_bf16(v0[2], v0[3]); w.z = cvt_pk_bf16(v1[0], v1[1]); w.w = cvt_pk_bf16(v1[2], v1[3]);
                    *(u32x4*)(rowp + bj * HALF) = w; } }
    }
};
struct EpiRes {
    static constexpr bool PERM = false, AFTER_DRAIN = false;
    const float* base; float* out; bf16_t* ob; const PG8_LAS float* rs_lds; float* ssq_out; int ldc;
    __device__ __forceinline__ void operator()(const f32x4 (&acc)[2][2][4][2], const Unit& u, int wr, int wc, int fr, int fq) const {
        const int rl0 = wr * 64 + fr, row0 = u.pm * BM + rl0, col0 = u.pn * BM + wc * 32 + 4 * fq;
#pragma unroll
        for (int ai = 0; ai < 2; ++ai)
#pragma unroll
            for (int m = 0; m < 4; ++m) { const int row = row0 + ai * HALF + m * 16; const float s = rs_lds ? rs_lds[u.ord * BM + rl0 + ai * HALF + m * 16] : 1.0f;
                const size_t off = (size_t)row * ldc + col0; float q = 0.f;
#pragma unroll
                for (int bj = 0; bj < 2; ++bj)
#pragma unroll
                    for (int n = 0; n < 2; ++n) { const size_t o2 = off + bj * HALF + n * 16; const f32x4 b = *(const f32x4*)(base + o2); const f32x4 o = b + acc[ai][bj][m][n] * s;
                        *(f32x4*)(out + o2) = o; q += (o[0] * o[0] + o[1] * o[1]) + (o[2] * o[2] + o[3] * o[3]);
                        if (ob) { u32x2 w; w.x = cvt_pk_bf16(o[0], o[1]); w.y = cvt_pk_bf16(o[2], o[3]); *(u32x2*)(ob + o2) = w; } }
                if (ssq_out) { q += __shfl_xor(q, 16); q += __shfl_xor(q, 32); if (fq == 0) ssq_out[(size_t)row * 32 + u.pn * 4 + wc] = q; }
                if (m & 1) asm volatile("" ::: "memory"); }
    }
};
struct EpiResB {
    static constexpr bool PERM = false, AFTER_DRAIN = false;
    bf16_t* xio; const PG8_LAS float* rs_lds; float* ssq_out; int ldc;
    __device__ __forceinline__ void operator()(const f32x4 (&acc)[2][2][4][2], const Unit& u, int wr, int wc, int fr, int fq) const {
        const int rl0 = wr * 64 + fr, row0 = u.pm * BM + rl0, col0 = u.pn * BM + wc * 32 + 4 * fq;
#pragma unroll
        for (int ai = 0; ai < 2; ++ai)
#pragma unroll
            for (int m = 0; m < 4; ++m) { const int row = row0 + ai * HALF + m * 16; const float s = rs_lds[u.ord * BM + rl0 + ai * HALF + m * 16];
                const size_t off = (size_t)row * ldc + col0; float q = 0.f;
#pragma unroll
                for (int bj = 0; bj < 2; ++bj)
#pragma unroll
                    for (int n = 0; n < 2; ++n) { const size_t o2 = off + bj * HALF + n * 16; const u32x2 bw = *(const u32x2*)(xio + o2);
                        f32x4 o = acc[ai][bj][m][n] * s; o[0] += bf_lo(bw.x); o[1] += bf_hi(bw.x); o[2] += bf_lo(bw.y); o[3] += bf_hi(bw.y);
                        q += (o[0] * o[0] + o[1] * o[1]) + (o[2] * o[2] + o[3] * o[3]);
                        u32x2 w; w.x = cvt_pk_bf16(o[0], o[1]); w.y = cvt_pk_bf16(o[2], o[3]); *(u32x2*)(xio + o2) = w; }
                q += __shfl_xor(q, 16); q += __shfl_xor(q, 32); if (fq == 0) ssq_out[(size_t)row * 32 + u.pn * 4 + wc] = q;
                if (m & 1) asm volatile("" ::: "memory"); }
    }
};
struct PanelOrder {
    int G, c;
    __host__ __device__ void init(int G_, int c_) { G = G_; c = c_; }
    __host__ __device__ bool next(int i, Unit& u) const { if (i >= 2) return false; const int xcd = c & 7, idx = c >> 3; u.pm = 32 * i + 4 * xcd + (idx >> 3); u.pn = idx & 7; return true; }
    __device__ __forceinline__ void a_ready(const Unit&) const {}
    __device__ __forceinline__ void done(const Unit&) const {}
};
struct EpiFinal {
    static constexpr bool PERM = false, AFTER_DRAIN = false;
    const bf16_t* base; float* out; const float* gain; float* xslots; unsigned* cnt; unsigned* tmo; PG8_LAS unsigned char* lds; int ldc;
    __device__ __forceinline__ void operator()(f32x4 (&acc)[2][2][4][2], const Unit& u, int wr, int wc, int fr, int fq) const {
        PG8_LAS float* Pt = (PG8_LAS float*)lds;
        PG8_LAS float* St = (PG8_LAS float*)(lds + 4096);
        const int tid = threadIdx.x, wid = __builtin_amdgcn_readfirstlane(tid >> 6), lane = tid & 63;
        const int rl0 = wr * 64 + fr, row0 = u.pm * BM + rl0, col0 = u.pn * BM + wc * 32 + 4 * fq;
#pragma unroll
        for (int ai = 0; ai < 2; ++ai)
#pragma unroll
            for (int m = 0; m < 4; ++m) { const size_t off = (size_t)(row0 + ai * HALF + m * 16) * ldc + col0; float q = 0.f;
#pragma unroll
                for (int bj = 0; bj < 2; ++bj)
#pragma unroll
                    for (int n = 0; n < 2; ++n) { const u32x2 bw = *(const u32x2*)(base + off + bj * HALF + n * 16);
                        f32x4 o = acc[ai][bj][m][n]; o[0] += bf_lo(bw.x); o[1] += bf_hi(bw.x); o[2] += bf_lo(bw.y); o[3] += bf_hi(bw.y); acc[ai][bj][m][n] = o;
                        q += (o[0] * o[0] + o[1] * o[1]) + (o[2] * o[2] + o[3] * o[3]); }
                q += __shfl_xor(q, 16); q += __shfl_xor(q, 32);
                if (fq == 0) Pt[(rl0 + ai * HALF + m * 16) * 4 + wc] = q; }
        asm volatile("s_waitcnt lgkmcnt(0)" ::: "memory"); __builtin_amdgcn_s_barrier(); asm volatile("" ::: "memory");
        if (tid < BM) { const f32x4 p4 = *(const PG8_LAS f32x4*)(Pt + tid * 4);
            __hip_atomic_store(xslots + (size_t)(u.pm * BM + tid) * 8 + u.pn, (p4[0] + p4[1]) + (p4[2] + p4[3]), __ATOMIC_RELAXED, __HIP_MEMORY_SCOPE_AGENT); }
        asm volatile("s_waitcnt vmcnt(0)" ::: "memory");
        if (tid < BM && lane == 0) __hip_atomic_fetch_add(cnt + 64 * u.pm, 1u, __ATOMIC_RELAXED, __HIP_MEMORY_SCOPE_AGENT);
        if (wid == 0) {
            unsigned sp = 0;
            while ((unsigned)__builtin_amdgcn_readfirstlane(__hip_atomic_load(cnt + 64 * u.pm, __ATOMIC_RELAXED, __HIP_MEMORY_SCOPE_AGENT)) < 32u) {
                __builtin_amdgcn_s_sleep(2);
                if (++sp > (1u << 22)) { if (lane == 0) __hip_atomic_store(tmo, 1u, __ATOMIC_RELAXED, __HIP_MEMORY_SCOPE_AGENT); break; } }
            __builtin_amdgcn_fence(__ATOMIC_ACQUIRE, "agent");
        }
        asm volatile("s_waitcnt vmcnt(0) lgkmcnt(0)" ::: "memory"); __builtin_amdgcn_s_barrier(); asm volatile("" ::: "memory");
        if (tid < BM) { const float* sl = xslots + (size_t)(u.pm * BM + tid) * 8; float t = 0.f;
#pragma unroll
            for (int j = 0; j < 8; ++j) t += __hip_atomic_load(sl + j, __ATOMIC_RELAXED, __HIP_MEMORY_SCOPE_AGENT);
            St[tid] = rsqrtf(t * (1.0f / 2048.0f) + RMS_EPS); }
        asm volatile("s_waitcnt vmcnt(0) lgkmcnt(0)" ::: "memory"); __builtin_amdgcn_s_barrier(); asm volatile("" ::: "memory");
        f32x4 gv[2][2];
#pragma unroll
        for (int bj = 0; bj < 2; ++bj)
#pragma unroll
            for (int n = 0; n < 2; ++n) gv[bj][n] = *(const f32x4*)(gain + col0 + bj * HALF + n * 16);
#pragma unroll
        for (int ai = 0; ai < 2; ++ai)
#pragma unroll
            for (int m = 0; m < 4; ++m) { const int rl = rl0 + ai * HALF + m * 16; const float s = St[rl]; float* rowp = out + (size_t)(u.pm * BM + rl) * ldc + col0;
#pragma unroll
                for (int bj = 0; bj < 2; ++bj)
#pragma unroll
                    for (int n = 0; n < 2; ++n) *(f32x4*)(rowp + bj * HALF + n * 16) = acc[ai][bj][m][n] * s * gv[bj][n]; }
        asm volatile("s_waitcnt lgkmcnt(0)" ::: "memory"); __builtin_amdgcn_s_barrier(); asm volatile("" ::: "memory");
    }
};
struct EpiGate {
    static constexpr bool PERM = true, AFTER_DRAIN = false;
    bf16_t* O; const bf16_t* gate; const float* scale; int ldc;
    __device__ __forceinline__ void operator()(const f32x4 (&acc)[2][2][4][2], const Unit& u, int wr, int wc, int fr, int fq) const {
        const int row0 = u.pm * BM + wr * 64 + fr, col0 = u.pn * BM + wc * 32 + 8 * fq;
        f32x4 sc[2][2];
#pragma unroll
        for (int bj = 0; bj < 2; ++bj)
#pragma unroll
            for (int n = 0; n < 2; ++n) sc[bj][n] = *(const f32x4*)(scale + col0 + bj * HALF + 4 * n);
#pragma unroll
        for (int ai = 0; ai < 2; ++ai)
#pragma unroll
            for (int m = 0; m < 4; ++m) { const size_t off = (size_t)(row0 + ai * HALF + m * 16) * ldc + col0;
#pragma unroll
                for (int bj = 0; bj < 2; ++bj) { const u32x4 gw = *(const u32x4*)(gate + off + bj * HALF);
                    const float g0 = bf_lo(gw.x), g1 = bf_hi(gw.x), g2 = bf_lo(gw.y), g3 = bf_hi(gw.y), g4 = bf_lo(gw.z), g5 = bf_hi(gw.z), g6 = bf_lo(gw.w), g7 = bf_hi(gw.w);
                    const f32x4 v0 = acc[ai][bj][m][0] * sc[bj][0], v1 = acc[ai][bj][m][1] * sc[bj][1];
                    u32x4 w; w.x = cvt_pk_bf16(v0[0] * g0 * sigmoid_f(g0), v0[1] * g1 * sigmoid_f(g1)); w.y = cvt_pk_bf16(v0[2] * g2 * sigmoid_f(g2), v0[3] * g3 * sigmoid_f(g3));
                    w.z = cvt_pk_bf16(v1[0] * g4 * sigmoid_f(g4), v1[1] * g5 * sigmoid_f(g5)); w.w = cvt_pk_bf16(v1[2] * g6 * sigmoid_f(g6), v1[3] * g7 * sigmoid_f(g7));
                    *(u32x4*)(O + off + bj * HALF) = w; } }
    }
};

template <class Epi, class Sched, bool ALIGN_EPI = false, bool SP2 = false>
__device__ __forceinline__ void gemm_phase(PG8_LAS unsigned char* lds, const Gemm g, const Sched& S, const Epi& E) {
    const int tid = threadIdx.x, wid = __builtin_amdgcn_readfirstlane(tid >> 6), lane = tid & 63, wr = wid >> 2, wc = wid & 3, fr = lane & 15, fq = lane >> 4;
    const int K = g.K, nt = K / BK;
    unsigned voffA[2], voffB[2];
#pragma unroll
    for (int i = 0; i < 2; ++i) { int R, C; stage_rc(tid * 16 + i * 8192, R, C); const int Rb = Epi::PERM ? ((R & ~31) + perm32(R & 31)) : R;
        voffA[i] = (unsigned)(R * g.lda + C) * 2u; voffB[i] = (unsigned)(Rb * g.ldb + C) * 2u; }
    const size_t kstep = (size_t)(BK * 2);
    const size_t hstepA = (size_t)HALF * g.lda * 2, hstepB = (size_t)HALF * g.ldb * 2;
    const size_t tstepA = 2 * hstepA, tstepB = 2 * hstepB, gstepA = (size_t)K * 2;
    const unsigned ldsw = (unsigned)wid * 1024u;
    const int aoff = lds_byte(wr * 64 + fr, fq * 8), boff = lds_byte(wc * 32 + fr, fq * 8);
#define PG8_SA(b, h) (((b) * 2 + (h)) * HTB)
#define PG8_SB(b, h) ((4 + (b) * 2 + (h)) * HTB)
#define PG8_STAGE(bufoff, gbase, voff) do { _Pragma("unroll") for (int _i = 0; _i < 2; ++_i) \
        __builtin_amdgcn_global_load_lds((const unsigned*)((const char*)(gbase) + (voff)[_i]), (PG8_LAS unsigned*)(lds + (bufoff) + ldsw + _i * 8192), 16, 0, 0); } while (0)
#define PG8_LDA(dst, b, h) do { _Pragma("unroll") for (int m = 0; m < 4; ++m) _Pragma("unroll") for (int k = 0; k < 2; ++k) dst[m][k] = *(const PG8_LAS bf16x8*)(lds + PG8_SA(b, h) + aoff + m * 2048 + k * 1024); } while (0)
#define PG8_LDB(dst, b, h) do { _Pragma("unroll") for (int n = 0; n < 2; ++n) _Pragma("unroll") for (int k = 0; k < 2; ++k) dst[n][k] = *(const PG8_LAS bf16x8*)(lds + PG8_SB(b, h) + boff + n * 2048 + k * 1024); } while (0)
#define PG8_MMA(ai, bj, At, Bt) do { __builtin_amdgcn_s_setprio(1); _Pragma("unroll") for (int m = 0; m < 4; ++m) _Pragma("unroll") for (int n = 0; n < 2; ++n) _Pragma("unroll") for (int k = 0; k < 2; ++k) \
        acc[ai][bj][m][n] = __builtin_amdgcn_mfma_f32_16x16x32_bf16(Bt[n][k], At[m][k], acc[ai][bj][m][n], 0, 0, 0); __builtin_amdgcn_s_setprio(0); } while (0)
#define PG8_WAIT_V(n) asm volatile("s_waitcnt vmcnt(" #n ")" ::: "memory")
#define PG8_WAIT_L(n) asm volatile("s_waitcnt lgkmcnt(" #n ")" ::: "memory")
#define PG8_BAR __builtin_amdgcn_s_barrier()
#define PG8_SCHED __builtin_amdgcn_sched_barrier(0)
    Unit cur, nxt; int ui = 0;
    if (!S.next(0, cur)) return;
    cur.ord = 0;
    f32x4 acc[2][2][4][2];
#pragma unroll
    for (int a = 0; a < 2; ++a)
#pragma unroll
        for (int b = 0; b < 2; ++b)
#pragma unroll
            for (int m = 0; m < 4; ++m)
#pragma unroll
                for (int n = 0; n < 2; ++n) acc[a][b][m][n] = (f32x4){0.f, 0.f, 0.f, 0.f};
    bf16x8 At[4][2], B0[2][2], B1[2][2];
    const char* cA = (const char*)g.A + (size_t)cur.pm * tstepA + (size_t)(cur.pn >> g.gsh) * gstepA; const char* cB = (const char*)g.Bt + (size_t)cur.pn * tstepB + (size_t)(cur.pm >> g.bgsh) * gstepA;
    S.a_ready(cur);
    if constexpr (SP2) {
        PG8_STAGE(PG8_SB(0, 0), cB, voffB); PG8_STAGE(PG8_SB(0, 1), cB + hstepB, voffB); PG8_STAGE(PG8_SA(0, 0), cA, voffA); PG8_STAGE(PG8_SA(0, 1), cA + hstepA, voffA);
        if (wr == 1) PG8_BAR;
        PG8_WAIT_V(2); PG8_BAR;
        PG8_STAGE(PG8_SB(1, 0), cB + kstep, voffB); PG8_STAGE(PG8_SA(1, 0), cA + kstep, voffA); PG8_STAGE(PG8_SB(1, 1), cB + hstepB + kstep, voffB);
        PG8_WAIT_V(6); PG8_BAR;
    } else {
        PG8_STAGE(PG8_SB(0, 0), cB, voffB); PG8_STAGE(PG8_SA(0, 0), cA, voffA); PG8_STAGE(PG8_SB(0, 1), cB + hstepB, voffB); PG8_STAGE(PG8_SA(0, 1), cA + hstepA, voffA);
        if (wr == 1) PG8_BAR;
        PG8_WAIT_V(4); PG8_BAR;
        PG8_STAGE(PG8_SB(1, 0), cB + kstep, voffB); PG8_STAGE(PG8_SA(1, 0), cA + kstep, voffA); PG8_STAGE(PG8_SB(1, 1), cB + hstepB + kstep, voffB);
        PG8_WAIT_V(6); PG8_BAR;
    }
    for (;;) {
        const bool has_next = S.next(ui + 1, nxt); nxt.ord = ui + 1;
        const char* nA = has_next ? (const char*)g.A + (size_t)nxt.pm * tstepA + (size_t)(nxt.pn >> g.gsh) * gstepA : cA; const char* nB = has_next ? (const char*)g.Bt + (size_t)nxt.pn * tstepB + (size_t)(nxt.pm >> g.bgsh) * gstepA : cB;
        for (int t = 0; t < nt; t += 2) {
            const bool last = (t == nt - 2);
            const char* a1 = cA + (size_t)(t + 1) * kstep;
            const char* a2 = last ? nA : cA + (size_t)(t + 2) * kstep; const char* b2 = last ? nB : cB + (size_t)(t + 2) * kstep;
            const char* a3 = a2 + kstep; const char* b3 = b2 + kstep;
            if (last && has_next) S.a_ready(nxt);
            if constexpr (SP2) {
            PG8_LDB(B0, 0, 0); PG8_LDB(B1, 0, 1); PG8_SCHED; PG8_LDA(At, 0, 0); PG8_STAGE(PG8_SA(1, 1), a1 + hstepA, voffA);
            PG8_WAIT_V(8); PG8_WAIT_L(0); PG8_BAR; PG8_MMA(0, 0, At, B0); PG8_MMA(0, 1, At, B1); PG8_BAR; PG8_SCHED;
            PG8_LDA(At, 0, 1); PG8_STAGE(PG8_SB(0, 0), b2, voffB); PG8_STAGE(PG8_SB(0, 1), b2 + hstepB, voffB); PG8_STAGE(PG8_SA(0, 0), a2, voffA);
            PG8_WAIT_V(8); PG8_WAIT_L(0); PG8_BAR; PG8_MMA(1, 0, At, B0); PG8_MMA(1, 1, At, B1); PG8_BAR; PG8_SCHED;
            PG8_LDB(B0, 1, 0); PG8_LDB(B1, 1, 1); PG8_SCHED; PG8_LDA(At, 1, 0); PG8_STAGE(PG8_SA(0, 1), a2 + hstepA, voffA);
            PG8_WAIT_V(8); PG8_WAIT_L(0); PG8_BAR; PG8_MMA(0, 0, At, B0); PG8_MMA(0, 1, At, B1); PG8_BAR; PG8_SCHED;
            PG8_LDA(At, 1, 1); PG8_STAGE(PG8_SB(1, 0), b3, voffB); PG8_STAGE(PG8_SB(1, 1), b3 + hstepB, voffB); PG8_STAGE(PG8_SA(1, 0), a3, voffA);
            PG8_WAIT_V(8); PG8_WAIT_L(0); PG8_BAR; PG8_MMA(1, 0, At, B0); PG8_MMA(1, 1, At, B1); PG8_BAR; PG8_SCHED;
            } else {
            PG8_LDB(B0, 0, 0); PG8_SCHED; PG8_LDA(At, 0, 0); PG8_STAGE(PG8_SA(1, 1), a1 + hstepA, voffA);
            PG8_WAIT_L(8); PG8_BAR; PG8_WAIT_L(0); PG8_MMA(0, 0, At, B0); PG8_BAR; PG8_SCHED;
            PG8_LDB(B1, 0, 1); PG8_STAGE(PG8_SB(0, 0), b2, voffB);
            PG8_BAR; PG8_WAIT_L(0); PG8_MMA(0, 1, At, B1); PG8_BAR;
            PG8_LDA(At, 0, 1); PG8_STAGE(PG8_SA(0, 0), a2, voffA);
            PG8_BAR; PG8_WAIT_L(0); PG8_MMA(1, 0, At, B0); PG8_BAR; PG8_SCHED;
            PG8_STAGE(PG8_SB(0, 1), b2 + hstepB, voffB);
            PG8_WAIT_V(6); PG8_BAR; PG8_MMA(1, 1, At, B1); PG8_BAR;
            PG8_LDB(B0, 1, 0); PG8_SCHED; PG8_LDA(At, 1, 0); PG8_STAGE(PG8_SA(0, 1), a2 + hstepA, voffA);
            PG8_WAIT_L(8); PG8_BAR; PG8_WAIT_L(0); PG8_MMA(0, 0, At, B0); PG8_BAR; PG8_SCHED;
            PG8_LDB(B1, 1, 1); PG8_STAGE(PG8_SB(1, 0), b3, voffB);
            PG8_BAR; PG8_WAIT_L(0); PG8_MMA(0, 1, At, B1); PG8_BAR;
            PG8_LDA(At, 1, 1); PG8_STAGE(PG8_SA(1, 0), a3, voffA);
            PG8_BAR; PG8_WAIT_L(0); PG8_MMA(1, 0, At, B0); PG8_BAR; PG8_SCHED;
            PG8_STAGE(PG8_SB(1, 1), b3 + hstepB, voffB);
            PG8_WAIT_V(6); PG8_BAR; PG8_MMA(1, 1, At, B1); PG8_BAR;
            }
        }
        if constexpr (ALIGN_EPI) { if (wr == 0) PG8_BAR; }
        if constexpr (!Epi::AFTER_DRAIN) { E(acc, cur, wr, wc, fr, fq); S.done(cur); }
        if (!has_next) break;
#pragma unroll
        for (int a = 0; a < 2; ++a)
#pragma unroll
            for (int b = 0; b < 2; ++b)
#pragma unroll
                for (int m = 0; m < 4; ++m)
#pragma unroll
                    for (int n = 0; n < 2; ++n) acc[a][b][m][n] = (f32x4){0.f, 0.f, 0.f, 0.f};
        cur = nxt; cA = nA; cB = nB; ++ui;
        if constexpr (ALIGN_EPI) { if (wr == 1) PG8_BAR; }
    }
    PG8_WAIT_V(0);
    if constexpr (!ALIGN_EPI) { if (wr == 0) PG8_BAR; }
    PG8_BAR;
    if constexpr (Epi::AFTER_DRAIN) { E.fused(acc, cur, wr, wc, fr, fq, lds, wid, lane); S.done(cur); }
#undef PG8_SA
#undef PG8_SB
#undef PG8_STAGE
#undef PG8_LDA
#undef PG8_LDB
#undef PG8_MMA
#undef PG8_WAIT_V
#undef PG8_WAIT_L
#undef PG8_BAR
#undef PG8_SCHED
}

}

constexpr int NWAVES = 8;
constexpr int BATCH = 4, SEQ = 4096, DM = 2048, M = BATCH * SEQ;
constexpr int DI = 4096, HD = 64, NH = 64, NG = 8, HPG = 8, NS = 128, CONVK = 4;
constexpr int CONV_DIM = DI + 2 * NG * NS;
constexpr int SSM_IN = DI + CONV_DIM + NH;
constexpr int N1 = DI + CONV_DIM;
constexpr int BCW = 2 * NG * NS;
constexpr int DP = 4096, PG = 4, PGD = 1024;
constexpr float EPS = 1e-6f;

constexpr size_t MiB = 1u << 20;
constexpr size_t WS_CTL = 0, CTL_ZERO_BYTES = 1 * MiB;
constexpr size_t WS_DT  = 1 * MiB;
constexpr size_t WS_W1T = 5 * MiB;
constexpr size_t WS_W2T = 46 * MiB;
constexpr size_t WS_W3T = 62 * MiB;
constexpr size_t WS_W4T = 94 * MiB;
constexpr size_t WS_W5T = 102 * MiB;
constexpr size_t WS_RA  = 120 * MiB;
constexpr size_t WS_RB  = 248 * MiB;
constexpr size_t WS_RC  = 440 * MiB;
constexpr size_t WS_SSQP = 504 * MiB;
constexpr size_t WS_END = 512 * MiB;
static_assert(WS_W1T + (size_t)SSM_IN * DM * 2 <= WS_W2T && WS_W2T + (size_t)DM * DI * 2 <= WS_W3T && WS_W3T + (size_t)2 * DP * DM * 2 <= WS_W4T && WS_W4T + (size_t)DP * PGD * 2 <= WS_W5T && WS_W5T + (size_t)DM * DP * 2 <= WS_RA, "weights map");
static_assert(WS_RA + (size_t)M * DI * 2 <= WS_RB && WS_RB + (size_t)M * CONV_DIM * 2 <= WS_RC && WS_RC + (size_t)M * DM * 2 <= WS_END && WS_RB + 128 * MiB + (size_t)M * DP * 2 <= WS_END, "activation map");
constexpr int CW_TMO = 64, CW_FIN = 8192;
constexpr int CW_BAR = 4096;
constexpr int CW_SSQ1 = 16384, CW_SSQ2 = CW_SSQ1 + M, CW_SSQ3 = CW_SSQ2 + M;
static_assert((CW_SSQ3 + M) * 4 <= (int)CTL_ZERO_BYTES, "CTL words inside the memset region");

constexpr int RING_OFF = 0, RING_BYTES = 159744;
constexpr int LDSCTL_OFF = RING_BYTES, MISC_OFF = LDSCTL_OFF + 320;
constexpr int LDS_BYTES = 163840;
static_assert(MISC_OFF + 128 <= LDS_BYTES, "LDS map");

#define LAS __attribute__((address_space(3)))
typedef unsigned short bf16;
typedef unsigned v4u __attribute__((ext_vector_type(4)));
typedef unsigned v2u __attribute__((ext_vector_type(2)));
typedef float f32x4 __attribute__((ext_vector_type(4)));
typedef short bf16x8 __attribute__((ext_vector_type(8)));
#define LDS_WAIT() asm volatile("s_waitcnt lgkmcnt(0)" ::: "memory")
#define VM_WAIT() asm volatile("s_waitcnt vmcnt(0)" ::: "memory")
__device__ __forceinline__ unsigned f2bf(float f) { unsigned u = __builtin_bit_cast(unsigned, f); return (u + 0x7fffu + ((u >> 16) & 1u)) >> 16; }
__device__ __forceinline__ unsigned pk2(float lo, float hi) { return f2bf(lo) | (f2bf(hi) << 16); }
__device__ __forceinline__ float bflo(unsigned w) { return __uint_as_float(w << 16); }
__device__ __forceinline__ float bfhi(unsigned w) { return __uint_as_float(w & 0xffff0000u); }
__device__ __forceinline__ float bf1(bf16 v) { return __uint_as_float(((unsigned)v) << 16); }
__device__ __forceinline__ float sigm(float v) { return __builtin_amdgcn_rcpf(1.0f + __builtin_amdgcn_exp2f(-1.4426950408889634f * v)); }
__device__ __forceinline__ float wave_sum(float v) {
#pragma unroll
    for (int o = 1; o < 64; o <<= 1) v += __shfl_xor(v, o);
    return v;
}

#define XB_TMO      128
#define XB_XCNT(j)  (256  + 64 * (j))
#define XB_XSUB(j)  (1280 + 64 * (j))
#define XB_XGEN(j)  (2304 + 64 * (j))
#define XB_TOP      3328
#define XB_TOPGEN   3392
#define XCD_BAR_WORDS 3456
#define XB_SPIN_CAP (1u << 18)

__device__ __forceinline__ unsigned xb_ld(unsigned* p)              { return __hip_atomic_load(p, __ATOMIC_RELAXED, __HIP_MEMORY_SCOPE_AGENT); }
__device__ __forceinline__ unsigned xb_add(unsigned* p, unsigned v) { return __hip_atomic_fetch_add(p, v, __ATOMIC_RELAXED, __HIP_MEMORY_SCOPE_AGENT); }
__device__ __forceinline__ unsigned xb_xcc_id() { return (unsigned)__builtin_amdgcn_s_getreg((3 << 11) | 20) & 0xFu; }
#define XB_SPIN(cond, bar) do { unsigned _sp = 0; while (cond) { __builtin_amdgcn_s_sleep(1); \
    if ((++_sp & 255u) == 0u) { if (xb_ld(&(bar)[XB_TMO])) break; if (_sp > XB_SPIN_CAP) { atomicAdd(&(bar)[XB_TMO], 1u); break; } } } } while (0)

struct XcdBarrier {
    unsigned* bar; unsigned x;
    volatile LAS unsigned* st;
};

__device__ __forceinline__ XcdBarrier xcd_barrier_post(unsigned* bar, volatile LAS unsigned* st) {
    XcdBarrier b; b.bar = bar; b.x = xb_xcc_id(); b.st = st;
    if (threadIdx.x == 0) (void)xb_add(&bar[XB_XCNT(b.x)], 1u);
    return b;
}
__device__ __forceinline__ void xcd_barrier_complete(unsigned* bar, unsigned x, unsigned& nloc, unsigned& nx) {
    const unsigned G = gridDim.x * gridDim.y * gridDim.z;
    unsigned sum, cnt, mine, sp = 0u;
    for (;;) {
        sum = 0u; cnt = 0u; mine = 0u;
#pragma unroll
        for (unsigned j = 0; j < 16; ++j) { const unsigned c = xb_ld(&bar[XB_XCNT(j)]); sum += c; cnt += (c > 0u) ? 1u : 0u; mine = (j == x) ? c : mine; }
        if (sum == G) break;
        __builtin_amdgcn_s_sleep(1);
        if ((++sp & 255u) == 0u) { if (xb_ld(&bar[XB_TMO])) break; if (sp > XB_SPIN_CAP) { atomicAdd(&bar[XB_TMO], 1u); break; } }
    }
    nloc = mine > 0u ? mine : 1u; nx = cnt > 0u ? cnt : 1u;
}

__device__ __forceinline__ void xcd_barrier(const XcdBarrier& b) {
    asm volatile("s_waitcnt vmcnt(0)" ::: "memory");
    __syncthreads();
    if (threadIdx.x == 0) {
        unsigned* bar = b.bar;
        __builtin_amdgcn_s_waitcnt(0);
        unsigned nloc = b.st[0], nx = b.st[1];
        if (nloc == 0u) { xcd_barrier_complete(bar, b.x, nloc, nx); b.st[0] = nloc; b.st[1] = nx; }
        const unsigned old = xb_add(&bar[XB_XSUB(b.x)], 1u);
        const unsigned gen = old / nloc;
        if (old + 1u == (gen + 1u) * nloc) {
            __builtin_amdgcn_fence(__ATOMIC_RELEASE, "agent");
            asm volatile("s_waitcnt vmcnt(0)" ::: "memory");
            const unsigned og = xb_add(&bar[XB_TOP], 1u);
            const unsigned tg = og / nx;
            if (og + 1u == (tg + 1u) * nx) xb_add(&bar[XB_TOPGEN], 1u);
            else XB_SPIN(xb_ld(&bar[XB_TOPGEN]) == tg, bar);
            __builtin_amdgcn_fence(__ATOMIC_ACQUIRE, "agent");
            xb_add(&bar[XB_XGEN(b.x)], 1u);
            asm volatile("s_waitcnt vmcnt(0)" ::: "memory");
        } else {
            XB_SPIN(xb_ld(&bar[XB_XGEN(b.x)]) == gen, bar);
            __builtin_amdgcn_fence(__ATOMIC_ACQUIRE, "agent");
            asm volatile("s_waitcnt vmcnt(0)" ::: "memory");
        }
    }
    __syncthreads();
}

struct Ctx { LAS unsigned char* lds; int tid, lane, wave, G, vcu; };

struct Ptrs {
    const float *x, *ln_g, *final_g, *ssm_w_in, *conv_w, *conv_b, *dt_bias, *a_log, *ssm_d, *norm_g, *ssm_w_out, *pool_w_in, *pool_w_group, *pool_scale, *pool_w_out;
    float* out; unsigned char* ws;
};

__device__ __forceinline__ void t_decode(const Ptrs& P, int it, const float*& src, const float*& gain, bf16*& dst, int& ldw, int& K) {
    constexpr int I1 = (DM / 64) * (SSM_IN / 32), I2 = (DI / 64) * (DM / 32), I3 = (DM / 64) * (DP / 32), I4G = (PGD / 64) * (PGD / 32), I4 = PG * I4G;
    const float* W; const float* g; bf16* WT; int N, row_off = 0, r = it;
    if (r < I1) { W = P.ssm_w_in; g = P.ln_g; K = DM; N = SSM_IN; ldw = SSM_IN; WT = (bf16*)(P.ws + WS_W1T); }
    else if ((r -= I1) < I2) { W = P.ssm_w_out; g = P.norm_g; K = DI; N = DM; ldw = DM; WT = (bf16*)(P.ws + WS_W2T); }
    else if ((r -= I2) < I3) { W = P.pool_w_in + DP; g = P.ln_g + DM; K = DM; N = DP; ldw = 2 * DP; WT = (bf16*)(P.ws + WS_W3T); row_off = DP; }
    else if ((r -= I3) < I4) { const int gi = r / I4G; r -= gi * I4G; W = P.pool_w_group + (size_t)gi * PGD * PGD; g = nullptr; K = PGD; N = PGD; ldw = PGD; WT = (bf16*)(P.ws + WS_W4T); row_off = gi * PGD; }
    else { r -= I4; W = P.pool_w_out; g = nullptr; K = DP; N = DM; ldw = DM; WT = (bf16*)(P.ws + WS_W5T); }
    const int nblk = N / 32, kb = r / nblk, nb = r - kb * nblk, k0 = 64 * kb, n0 = 32 * nb;
    src = W + (size_t)k0 * ldw + n0; gain = g ? g + k0 : nullptr; dst = WT + (size_t)(row_off + n0) * K + k0;
}
__device__ __forceinline__ void t_load(const float* src, const float* gain, int ldw, int lane, f32x4 (&v)[8], float (&gv)[8]) {
#pragma unroll
    for (int i = 0; i < 8; ++i) { const int kk = 8 * i + (lane >> 3); v[i] = *(const f32x4*)(src + (size_t)kk * ldw + 4 * (lane & 7)); gv[i] = gain ? gain[kk] : 1.0f; }
}
__device__ __forceinline__ void t_process(bf16* dst, int K, int lane, LAS float* scr, const f32x4 (&v)[8], const float (&gv)[8]) {
#pragma unroll
    for (int i = 0; i < 8; ++i) *(LAS f32x4*)(scr + (8 * i + (lane >> 3)) * 32 + (((lane & 7) ^ i) << 2)) = v[i] * gv[i];
    LDS_WAIT(); asm volatile("" ::: "memory");
    const int c = lane & 7, nn = lane >> 3;
#pragma unroll
    for (int j = 0; j < 4; ++j) { const int n = nn + 8 * j; const LAS float* s = scr + (8 * c) * 32 + (((n >> 2) ^ c) << 2) + (n & 3);
        v4u o; o.x = pk2(s[0 * 32], s[1 * 32]); o.y = pk2(s[2 * 32], s[3 * 32]); o.z = pk2(s[4 * 32], s[5 * 32]); o.w = pk2(s[6 * 32], s[7 * 32]);
        *(v4u*)(dst + (size_t)n * K + 8 * c) = o; }
    LDS_WAIT(); asm volatile("" ::: "memory");
}
__device__ __forceinline__ void r_decode(const Ptrs& P, int r, const float*& src, bf16*& dst, float& scale, float*& ssq) {
    if (r < M) { src = P.x + (size_t)r * DM; dst = (bf16*)(P.ws + WS_RC) + (size_t)r * DM; scale = 1.0f; ssq = (float*)(P.ws + WS_CTL) + CW_SSQ1 + r; }
    else { const int rr = r - M, m = rr >> 1, hf = rr & 1; src = P.pool_w_in + (size_t)m * 2 * DP + hf * DM; dst = (bf16*)P.out + (size_t)m * DP + hf * DM; scale = P.ln_g[DM + m]; ssq = nullptr; }
}
__device__ __forceinline__ void r_load(const float* src, int lane, f32x4 (&v)[8]) {
#pragma unroll
    for (int j = 0; j < 8; ++j) v[j] = ((const f32x4*)src)[lane + 64 * j];
}
__device__ __forceinline__ void r_process(bf16* dst, float scale, float* ssq, int lane, const f32x4 (&v)[8]) {
    if (ssq) { float s = 0.f;
#pragma unroll
        for (int j = 0; j < 8; ++j) s += (v[j].x * v[j].x + v[j].y * v[j].y) + (v[j].z * v[j].z + v[j].w * v[j].w);
        s = wave_sum(s); if (lane == 0) *ssq = s; }
#pragma unroll
    for (int j = 0; j < 8; ++j) { v2u w; w.x = pk2(v[j].x * scale, v[j].y * scale); w.y = pk2(v[j].z * scale, v[j].w * scale); ((v2u*)dst)[lane + 64 * j] = w; }
}
__device__ __forceinline__ int t_map(int li, int mode) {
    constexpr int I1 = (DM / 64) * (SSM_IN / 32), I2 = (DI / 64) * (DM / 32), I3 = (DM / 64) * (DP / 32), I4 = PG * (PGD / 64) * (PGD / 32);
    return mode == 0 ? (li < I1 ? li : li + I2) : (li < I2 ? I1 + li : I1 + I3 + I4 + li);
}
__device__ __forceinline__ void prep_transposes(const Ctx& F, const Ptrs& P, int mode, int gw, int NGW) {
    LAS float* scr = (LAS float*)(F.lds + RING_OFF + F.wave * 16384);
    const int lane = F.lane;
    constexpr int I1 = (DM / 64) * (SSM_IN / 32), I2 = (DI / 64) * (DM / 32), I3 = (DM / 64) * (DP / 32), I4 = PG * (PGD / 64) * (PGD / 32), I5 = (DP / 64) * (DM / 32);
    const int NT = mode == 0 ? I1 + I3 + I4 : I2 + I5;
    if (gw >= NT) return;
    const int cnt = (NT - gw + NGW - 1) / NGW;
    const float *sA, *gA, *sB, *gB; bf16 *dA, *dB; int lA, kA, lB, kB; f32x4 vA[8], vB[8]; float fA[8], fB[8];
    t_decode(P, t_map(gw, mode), sA, gA, dA, lA, kA); t_load(sA, gA, lA, lane, vA, fA);
    for (int j = 0; j < cnt; j += 2) {
        { const int jn = (j + 1 < cnt) ? j + 1 : cnt - 1; t_decode(P, t_map(gw + jn * NGW, mode), sB, gB, dB, lB, kB); t_load(sB, gB, lB, lane, vB, fB); }
        t_process(dA, kA, lane, scr, vA, fA);
        { const int jn = (j + 2 < cnt) ? j + 2 : cnt - 1; t_decode(P, t_map(gw + jn * NGW, mode), sA, gA, dA, lA, kA); t_load(sA, gA, lA, lane, vA, fA); }
        if (j + 1 < cnt) t_process(dB, kB, lane, scr, vB, fB);
    }
}
__device__ __forceinline__ void phase_prep(const Ctx& F, const Ptrs& P) {
    const int gw = F.vcu * NWAVES + F.wave, NGW = F.G * NWAVES, lane = F.lane;
    prep_transposes(F, P, 0, gw, NGW);
    {
        constexpr int NR = M + 2 * DM;
        const int cnt = (NR - gw + NGW - 1) / NGW;
        const float *sA, *sB; bf16 *dA, *dB; float cA, cB; float *qA, *qB; f32x4 vA[8], vB[8];
        r_decode(P, gw, sA, dA, cA, qA); r_load(sA, lane, vA);
        for (int j = 0; j < cnt; j += 2) {
            { const int jn = (j + 1 < cnt) ? j + 1 : cnt - 1; r_decode(P, gw + jn * NGW, sB, dB, cB, qB); r_load(sB, lane, vB); }
            r_process(dA, cA, qA, lane, vA);
            { const int jn = (j + 2 < cnt) ? j + 2 : cnt - 1; r_decode(P, gw + jn * NGW, sA, dA, cA, qA); r_load(sA, lane, vA); }
            if (j + 1 < cnt) r_process(dB, cB, qB, lane, vB);
        }
    }
}

__device__ __forceinline__ float softplus_f(float v) { return fmaxf(v, 0.f) + log1pf(expf(-fabsf(v))); }

__device__ __forceinline__ void phase_dt(const Ctx& F, const Ptrs& P) {
    const bf16* XB = (const bf16*)(P.ws + WS_RC); const bf16* WDT = (const bf16*)(P.ws + WS_W1T) + (size_t)N1 * DM;
    const float* ssq1 = (const float*)(P.ws + WS_CTL) + CW_SSQ1; float* DT = (float*)(P.ws + WS_DT);
    LAS float* part = (LAS float*)F.lds;
    const int w = F.wave, lane = F.lane, fr = lane & 15, fq = lane >> 4;
    for (int item = F.vcu; item < M / 64; item += F.G) {
        const int r0 = item * 64;
        f32x4 acc[4][4];
#pragma unroll
        for (int i = 0; i < 4; ++i)
#pragma unroll
            for (int j = 0; j < 4; ++j) acc[i][j] = (f32x4){0.f, 0.f, 0.f, 0.f};
        const bf16* ap = XB + (size_t)(r0 + fr) * DM + w * 256 + 8 * fq;
        const bf16* bp = WDT + (size_t)fr * DM + w * 256 + 8 * fq;
#pragma unroll
        for (int hf = 0; hf < 2; ++hf) {
            bf16x8 a[4][4], b[4][4];
#pragma unroll
            for (int ks = 0; ks < 4; ++ks)
#pragma unroll
                for (int t = 0; t < 4; ++t) { a[ks][t] = *(const bf16x8*)(ap + (size_t)(16 * t) * DM + 32 * (4 * hf + ks)); b[ks][t] = *(const bf16x8*)(bp + (size_t)(16 * t) * DM + 32 * (4 * hf + ks)); }
#pragma unroll
            for (int ks = 0; ks < 4; ++ks)
#pragma unroll
                for (int rt = 0; rt < 4; ++rt)
#pragma unroll
                    for (int ct = 0; ct < 4; ++ct) acc[rt][ct] = __builtin_amdgcn_mfma_f32_16x16x32_bf16(a[ks][rt], b[ks][ct], acc[rt][ct], 0, 0, 0);
        }
#pragma unroll
        for (int rt = 0; rt < 4; ++rt)
#pragma unroll
            for (int ct = 0; ct < 4; ++ct) *(LAS f32x4*)(part + (size_t)w * 4096 + (16 * ct + fr) * 64 + 16 * rt + 4 * fq) = acc[rt][ct];
        __syncthreads();
        {
            const int hd = F.tid & 63, rb = 8 * (F.tid >> 6);
            f32x4 s0 = (f32x4){0.f, 0.f, 0.f, 0.f}, s1 = s0;
#pragma unroll
            for (int pw = 0; pw < 8; ++pw) { s0 = s0 + *(const LAS f32x4*)(part + (size_t)pw * 4096 + hd * 64 + rb); s1 = s1 + *(const LAS f32x4*)(part + (size_t)pw * 4096 + hd * 64 + rb + 4); }
            const float bias = P.dt_bias[hd];
#pragma unroll
            for (int i = 0; i < 8; ++i) { const int row = r0 + rb + i; const float sc = rsqrtf(ssq1[row] * (1.0f / DM) + EPS); const float v = (i < 4 ? s0[i & 3] : s1[i & 3]) * sc + bias;
                DT[(size_t)row * NH + hd] = softplus_f(v); }
        }
        __syncthreads();
    }
}

constexpr int IMG_C = 0, IMG_B = 16384, IMG_BT = 32768, IMG_BYTES = 49152;
constexpr int SC_BYTES = 1024, BL_C = 0, BL_BT = 16384, BL_CBT = 32768, BL_SC = BL_CBT + 10 * 1024, BLOB_BYTES = BL_SC + 8 * SC_BYTES;
constexpr int MAIN_BYTES = 32768 + SC_BYTES, HEAD_BYTES = 10 * 1024 + SC_BYTES;
constexpr int SL_MAIN = 0, SL_HEAD = 2 * MAIN_BYTES, SL_XT = SL_HEAD + 2 * HEAD_BYTES, SL_XWT = SL_XT + 2 * 8192, SL_P = SL_XWT + 2 * 8192, SL_YT = SL_P + 2 * 8192, SL_END = SL_YT + 2 * 8192;
static_assert(SL_END <= RING_BYTES, "SSD LDS map");
__device__ __forceinline__ int img256(int r, int c) { return r * 256 + ((c ^ (r & 15)) << 4); }
__device__ __forceinline__ int img128(int r, int c) { return r * 128 + ((c ^ ((r >> 1) & 7)) << 4); }
typedef __bf16 bf16x2_t __attribute__((ext_vector_type(2)));
typedef float f32x2_t __attribute__((ext_vector_type(2)));
__device__ __forceinline__ unsigned cvtpk(float lo, float hi) { f32x2_t v = {lo, hi}; bf16x2_t b = __builtin_convertvector(v, bf16x2_t); return __builtin_bit_cast(unsigned, b); }
#define RAW_BARRIER() do { asm volatile("s_waitcnt lgkmcnt(0)" ::: "memory"); __builtin_amdgcn_s_barrier(); asm volatile("" ::: "memory"); } while (0)

__device__ __forceinline__ void bc_load(const bf16* XBC, const float* DT, int unit, int isC, int n0, int tg, int wave, int lane, v4u (&raw)[7], float& dtv) {
    const int g = unit % NG, bc = unit / NG, c = bc % (SEQ / 64);
    const int ch = DI + isC * (NG * NS) + g * NS + n0;
    const size_t T0 = (size_t)bc * 64 + 4 * tg;
    const bool nohalo = (c == 0 && tg == 0);
#pragma unroll
    for (int k = 0; k < 7; ++k) { const size_t row = (k < 3 && nohalo) ? T0 : (T0 + k - 3); raw[k] = *(const v4u*)(XBC + row * CONV_DIM + ch); }
    dtv = DT[((size_t)bc * 64 + lane) * NH + g * HPG + wave];
}
__device__ __forceinline__ void bc_process(const Ctx& F, const Ptrs& P, unsigned char* IMGS, int unit, int isC, int n0, int tg, const float (&w)[4][8], const float (&bias)[8], const v4u (&rawv)[7], float dtv) {
    LAS unsigned char* L = F.lds;
    const int g = unit % NG, bc = unit / NG, c = bc % (SEQ / 64);
    const bool nohalo = (c == 0 && tg == 0);
    float raw[7][8];
#pragma unroll
    for (int k = 0; k < 7; ++k) { v4u rr = rawv[k];
        if (k < 3 && nohalo) { rr.x = 0u; rr.y = 0u; rr.z = 0u; rr.w = 0u; }
        raw[k][0] = bflo(rr.x); raw[k][1] = bfhi(rr.x); raw[k][2] = bflo(rr.y); raw[k][3] = bfhi(rr.y); raw[k][4] = bflo(rr.z); raw[k][5] = bfhi(rr.z); raw[k][6] = bflo(rr.w); raw[k][7] = bfhi(rr.w); }
    float o[4][8];
#pragma unroll
    for (int i = 0; i < 4; ++i)
#pragma unroll
        for (int j = 0; j < 8; ++j) { const float v = bias[j] + w[0][j] * raw[i][j] + w[1][j] * raw[i + 1][j] + w[2][j] * raw[i + 2][j] + w[3][j] * raw[i + 3][j]; o[i][j] = v * sigm(v); }
    const int ks = n0 >> 5, hi = (n0 >> 4) & 1, q0 = 2 * ((n0 >> 3) & 1);
    const int ibase = isC ? IMG_C : IMG_B;
#pragma unroll
    for (int i = 0; i < 4; ++i) { const int l = 4 * tg + i;
        v2u lo, hi2; lo.x = cvtpk(o[i][0], o[i][1]); lo.y = cvtpk(o[i][2], o[i][3]); hi2.x = cvtpk(o[i][4], o[i][5]); hi2.y = cvtpk(o[i][6], o[i][7]);
        *(LAS v2u*)(L + ibase + img256(l, 4 * ks + q0) + 8 * hi) = lo;
        *(LAS v2u*)(L + ibase + img256(l, 4 * ks + q0 + 1) + 8 * hi) = hi2; }
    if (!isC) {
#pragma unroll
        for (int e = 0; e < 8; ++e) { v2u t; t.x = cvtpk(o[0][e], o[1][e]); t.y = cvtpk(o[2][e], o[3][e]);
            *(LAS v2u*)(L + IMG_BT + img128(n0 + e, tg >> 1) + 8 * (tg & 1)) = t; }
    }
    RAW_BARRIER();
    unsigned char* blob = IMGS + (size_t)unit * BLOB_BYTES;
#pragma unroll
    for (int k = 0; k < 2; ++k) { const v4u vc = *(const LAS v4u*)(L + IMG_C + F.tid * 16 + k * 8192), vt = *(const LAS v4u*)(L + IMG_BT + F.tid * 16 + k * 8192);
        *(v4u*)(blob + BL_C + F.tid * 16 + k * 8192) = vc; *(v4u*)(blob + BL_BT + F.tid * 16 + k * 8192) = vt; }
    {
        const int w = F.wave, r = F.lane & 15, q = F.lane >> 4;
        const int lt0 = (w < 4) ? w : (w == 4) ? 1 : (w == 5) ? 2 : 3, st0 = (w < 4) ? w : (w == 4) ? 0 : (w == 7) ? 2 : 1;
#pragma unroll
        for (int tt = 0; tt < 2; ++tt) { if (tt == 1 && (w < 4 || w > 5)) break;
            const int lt = tt ? lt0 + 1 : lt0, st = tt ? 0 : st0;
            f32x4 cb = {0.f, 0.f, 0.f, 0.f};
#pragma unroll
            for (int ks = 0; ks < 4; ++ks) { const bf16x8 av = *(const LAS bf16x8*)(L + IMG_C + img256(16 * lt + r, 4 * ks + q)), bv = *(const LAS bf16x8*)(L + IMG_B + img256(16 * st + r, 4 * ks + q));
                cb = __builtin_amdgcn_mfma_f32_16x16x32_bf16(av, bv, cb, 0, 0, 0); }
            *(f32x4*)(blob + BL_CBT + (tt ? 8 + (w - 4) : w) * 1024 + F.lane * 16) = cb; }
    }
    {
        const int hh = g * HPG + F.wave; const float a = -expf(P.a_log[hh]);
        float cs = a * dtv;
#pragma unroll
        for (int o2 = 1; o2 < 64; o2 <<= 1) { const float t = __shfl_up(cs, o2); if (F.lane >= o2) cs += t; }
        const float last = __shfl(cs, 63);
        float* sc = (float*)(blob + BL_SC + F.wave * SC_BYTES);
        sc[F.lane] = dtv; sc[64 + F.lane] = cs; sc[128 + F.lane] = __expf(cs); sc[192 + F.lane] = dtv * __expf(last - cs);
    }
    RAW_BARRIER();
}
__device__ __forceinline__ void phase_bcprep(const Ctx& F, const Ptrs& P) {
    const bf16* XBC = (const bf16*)(P.ws + WS_RB); unsigned char* IMGS = (unsigned char*)P.out; const float* DT = (const float*)(P.ws + WS_DT);
    const int cg = F.tid & 31, tg = F.tid >> 5, isC = cg >> 4, n0 = 8 * (cg & 15);
    constexpr int NU = BATCH * (SEQ / 64) * NG;
    if (F.G % NG != 0 || F.vcu >= NU) return;
    const int g = F.vcu % NG, ch = DI + isC * (NG * NS) + g * NS + n0, cnt = (NU - F.vcu + F.G - 1) / F.G;
    float w[4][8], bias[8];
#pragma unroll
    for (int k = 0; k < 4; ++k) { const f32x4 a = *(const f32x4*)(P.conv_w + (size_t)k * CONV_DIM + ch), b = *(const f32x4*)(P.conv_w + (size_t)k * CONV_DIM + ch + 4);
        w[k][0] = a.x; w[k][1] = a.y; w[k][2] = a.z; w[k][3] = a.w; w[k][4] = b.x; w[k][5] = b.y; w[k][6] = b.z; w[k][7] = b.w; }
    { const f32x4 a = *(const f32x4*)(P.conv_b + ch), b = *(const f32x4*)(P.conv_b + ch + 4); bias[0] = a.x; bias[1] = a.y; bias[2] = a.z; bias[3] = a.w; bias[4] = b.x; bias[5] = b.y; bias[6] = b.z; bias[7] = b.w; }
    v4u rA[7], rB[7]; float dA, dB;
    bc_load(XBC, DT, F.vcu, isC, n0, tg, F.wave, F.lane, rA, dA);
    for (int j = 0; j < cnt; j += 2) {
        { const int jn = (j + 1 < cnt) ? j + 1 : j; bc_load(XBC, DT, F.vcu + jn * F.G, isC, n0, tg, F.wave, F.lane, rB, dB); }
        bc_process(F, P, IMGS, F.vcu + j * F.G, isC, n0, tg, w, bias, rA, dA);
        if (j + 1 < cnt) {
            { const int jn = (j + 2 < cnt) ? j + 2 : j + 1; bc_load(XBC, DT, F.vcu + jn * F.G, isC, n0, tg, F.wave, F.lane, rA, dA); }
            bc_process(F, P, IMGS, F.vcu + (j + 1) * F.G, isC, n0, tg, w, bias, rB, dB);
        }
    }
}

__device__ __forceinline__ int dpp_i(int v, const int ctrl_sel) { return ctrl_sel == 0 ? __builtin_amdgcn_update_dpp(0, v, 0xB1, 0xF, 0xF, false) : ctrl_sel == 1 ? __builtin_amdgcn_update_dpp(0, v, 0x4E, 0xF, 0xF, false) : __builtin_amdgcn_update_dpp(0, v, 0x141, 0xF, 0xF, false); }
__device__ __forceinline__ float dpp_add(float v, const int sel) { return v + __int_as_float(dpp_i(__float_as_int(v), sel)); }
template <bool DIAG> __device__ __forceinline__ void ssd_p_tile(LAS unsigned char* Pbuf, const LAS unsigned char* CBT, const LAS float* SC, int slot, int lane, int lt, int st, int r, int q, float Dh) {
    const f32x4 cb = *(const LAS f32x4*)(CBT + slot * 1024 + lane * 16);
    const f32x4 csl = *(const LAS f32x4*)(SC + 64 + 16 * lt + 4 * q);
    const int s = 16 * st + r; const float cs_s = SC[64 + s], dt_s = SC[s];
#pragma unroll
    for (int rg = 0; rg < 4; ++rg) { const int l = 16 * lt + 4 * q + rg; float v;
        if (DIAG) { v = cb[rg] * __expf(fminf(csl[rg] - cs_s, 0.f)) * dt_s; v = (s <= l) ? v : 0.f; if (s == l) v += Dh; }
        else v = cb[rg] * __expf(csl[rg] - cs_s) * dt_s;
        *(LAS unsigned short*)(Pbuf + img128(l, s >> 3) + (s & 7) * 2) = (unsigned short)(cvtpk(v, 0.f) & 0xffffu); }
}
struct ConvW { float a[4], b[4], ba, bb; };
__device__ __forceinline__ void ssd_head(LAS unsigned char* L, int par, int hpar, bool first_chunk, const unsigned (&xr)[7], int w, int lane, int r, int q, const ConvW& cw, float Dh) {
    const LAS unsigned char* HD = L + SL_HEAD + hpar * HEAD_BYTES; const LAS float* SC = (const LAS float*)(HD + 10 * 1024);
    {
        const int cp = lane & 31, hf = lane >> 5;
        const f32x4 wv4 = *(const LAS f32x4*)(SC + 192 + 8 * w + 4 * hf);
        float xa[7], xc[7];
#pragma unroll
        for (int k = 0; k < 7; ++k) { const bool zpad = first_chunk && w == 0 && hf == 0 && k < 3; xa[k] = zpad ? 0.f : bflo(xr[k]); xc[k] = zpad ? 0.f : bfhi(xr[k]); }
        float oa[4], oc[4], wa[4], wc[4];
#pragma unroll
        for (int i = 0; i < 4; ++i) { const float va = cw.ba + cw.a[0] * xa[i] + cw.a[1] * xa[i + 1] + cw.a[2] * xa[i + 2] + cw.a[3] * xa[i + 3], vc = cw.bb + cw.b[0] * xc[i] + cw.b[1] * xc[i + 1] + cw.b[2] * xc[i + 2] + cw.b[3] * xc[i + 3];
            oa[i] = va * sigm(va); oc[i] = vc * sigm(vc); wa[i] = oa[i] * wv4[i]; wc[i] = oc[i] * wv4[i]; }
        v2u t; LAS unsigned char* XTb = L + SL_XT + par * 8192; LAS unsigned char* XWb = L + SL_XWT + par * 8192;
        const int o0 = img128(2 * cp, w) + 8 * hf, o1 = img128(2 * cp + 1, w) + 8 * hf;
        t.x = cvtpk(oa[0], oa[1]); t.y = cvtpk(oa[2], oa[3]); *(LAS v2u*)(XTb + o0) = t;
        t.x = cvtpk(oc[0], oc[1]); t.y = cvtpk(oc[2], oc[3]); *(LAS v2u*)(XTb + o1) = t;
        t.x = cvtpk(wa[0], wa[1]); t.y = cvtpk(wa[2], wa[3]); *(LAS v2u*)(XWb + o0) = t;
        t.x = cvtpk(wc[0], wc[1]); t.y = cvtpk(wc[2], wc[3]); *(LAS v2u*)(XWb + o1) = t;
    }
    LAS unsigned char* Pb = L + SL_P + par * 8192;
    if (w < 4) ssd_p_tile<true>(Pb, HD, SC, w, lane, w, w, r, q, Dh);
    else { const int lt1 = (w == 4) ? 1 : (w == 5) ? 2 : 3, st1 = (w == 4) ? 0 : (w == 7) ? 2 : 1;
        ssd_p_tile<false>(Pb, HD, SC, w, lane, lt1, st1, r, q, Dh);
        if (w < 6) ssd_p_tile<false>(Pb, HD, SC, 8 + (w - 4), lane, lt1 + 1, 0, r, q, Dh); }
}
__device__ __forceinline__ void ssd_mfma(LAS unsigned char* L, int par, f32x4 (&st)[8], int lane, int r, int q, int pt, int lh, const int (&a256)[4], const int (&a128)[2]) {
    const LAS unsigned char* IC = L + SL_MAIN + par * MAIN_BYTES; const LAS unsigned char* IBT = IC + 16384; const LAS float* SC = (const LAS float*)(IC + 32768);
    f32x4 acc[2] = {(f32x4){0.f, 0.f, 0.f, 0.f}, (f32x4){0.f, 0.f, 0.f, 0.f}};
    {
        bf16x8 yav[4][2], sb[4];
#pragma unroll
        for (int ks = 0; ks < 4; ++ks) {
#pragma unroll
            for (int t = 0; t < 2; ++t) yav[ks][t] = *(const LAS bf16x8*)(IC + 4096 * (2 * lh + t) + a256[ks]);
            v4u sbw; sbw.x = cvtpk(st[2 * ks][0], st[2 * ks][1]); sbw.y = cvtpk(st[2 * ks][2], st[2 * ks][3]); sbw.z = cvtpk(st[2 * ks + 1][0], st[2 * ks + 1][1]); sbw.w = cvtpk(st[2 * ks + 1][2], st[2 * ks + 1][3]);
            sb[ks] = __builtin_bit_cast(bf16x8, sbw); }
#pragma unroll
        for (int ks = 0; ks < 4; ++ks)
#pragma unroll
            for (int t = 0; t < 2; ++t) acc[t] = __builtin_amdgcn_mfma_f32_16x16x32_bf16(yav[ks][t], sb[ks], acc[t], 0, 0, 0);
    }
    { const float elast = SC[128 + 63];
#pragma unroll
      for (int t = 0; t < 2; ++t) { const f32x4 ev4 = *(const LAS f32x4*)(SC + 128 + 16 * (2 * lh + t) + 4 * q); acc[t] = acc[t] * ev4; }
#pragma unroll
      for (int j = 0; j < 8; ++j) st[j] = st[j] * elast; }
    {
        const LAS unsigned char* XTb = L + SL_XT + par * 8192; const LAS unsigned char* XWb = L + SL_XWT + par * 8192; const LAS unsigned char* Pb = L + SL_P + par * 8192;
        bf16x8 xb[2], pav[2][2], xwb[2], bav[2][8];
#pragma unroll
        for (int ks = 0; ks < 2; ++ks) { xb[ks] = *(const LAS bf16x8*)(XTb + 2048 * pt + a128[ks]); xwb[ks] = *(const LAS bf16x8*)(XWb + 2048 * pt + a128[ks]);
#pragma unroll
            for (int t = 0; t < 2; ++t) pav[ks][t] = *(const LAS bf16x8*)(Pb + 2048 * (2 * lh + t) + a128[ks]);
#pragma unroll
            for (int j = 0; j < 8; ++j) bav[ks][j] = *(const LAS bf16x8*)(IBT + 2048 * j + a128[ks]); }
#pragma unroll
        for (int t = 0; t < 2; ++t) acc[t] = __builtin_amdgcn_mfma_f32_16x16x32_bf16(pav[0][t], xb[0], acc[t], 0, 0, 0);
        if (lh == 1) {
#pragma unroll
            for (int t = 0; t < 2; ++t) acc[t] = __builtin_amdgcn_mfma_f32_16x16x32_bf16(pav[1][t], xb[1], acc[t], 0, 0, 0); }
#pragma unroll
        for (int ks = 0; ks < 2; ++ks)
#pragma unroll
            for (int j = 0; j < 8; ++j) st[j] = __builtin_amdgcn_mfma_f32_16x16x32_bf16(bav[ks][j], xwb[ks], st[j], 0, 0, 0);
    }
#pragma unroll
    for (int t = 0; t < 2; ++t) { const int p = 16 * pt + r; v2u yw; yw.x = cvtpk(acc[t][0], acc[t][1]); yw.y = cvtpk(acc[t][2], acc[t][3]);
        *(LAS v2u*)(L + SL_YT + par * 8192 + img128(p, 2 * (2 * lh + t) + (q >> 1)) + 8 * (q & 1)) = yw; }
}
__device__ __forceinline__ void ssd_epi(const LAS unsigned char* L, int par, const unsigned (&zr)[4], int w, int lane, unsigned (&ob)[4], float& s1) {
    const int cp = lane & 31, hf = lane >> 5;
    const v2u ya = *(const LAS v2u*)(L + SL_YT + par * 8192 + img128(2 * cp, w) + 8 * hf), yc = *(const LAS v2u*)(L + SL_YT + par * 8192 + img128(2 * cp + 1, w) + 8 * hf);
    const float y0[4] = {bflo(ya.x), bfhi(ya.x), bflo(ya.y), bfhi(ya.y)}, y1[4] = {bflo(yc.x), bfhi(yc.x), bflo(yc.y), bfhi(yc.y)};
    float sq[4];
#pragma unroll
    for (int i = 0; i < 4; ++i) { const float za = bflo(zr[i]), zc = bfhi(zr[i]); const float ga = y0[i] * (za * sigm(za)), gc = y1[i] * (zc * sigm(zc)); sq[i] = ga * ga + gc * gc; ob[i] = cvtpk(ga, gc); }
    float s2[2];
#pragma unroll
    for (int k2 = 0; k2 < 2; ++k2) { const bool hi = (lane & 16) != 0; const float send = hi ? sq[k2] : sq[2 + k2], keep = hi ? sq[2 + k2] : sq[k2]; s2[k2] = keep + __shfl_xor(send, 16); }
    { const bool hi = (lane & 8) != 0; const float send = hi ? s2[0] : s2[1], keep = hi ? s2[1] : s2[0]; s1 = keep + __int_as_float(__builtin_amdgcn_update_dpp(0, __float_as_int(send), 0x128  , 0xF, 0xF, false)); }
    s1 = dpp_add(s1, 0); s1 = dpp_add(s1, 1); s1 = dpp_add(s1, 2);
}
__device__ __forceinline__ void ssd_dma_main(const Ctx& F, const unsigned char* blob_c, int hsub, int w, int lane, int par) {
    LAS unsigned char* dst = F.lds + SL_MAIN + par * MAIN_BYTES;
#pragma unroll
    for (int k = 0; k < 4; ++k) { const int piece = k * 8 + w; __builtin_amdgcn_global_load_lds((const unsigned*)(blob_c + BL_C + piece * 1024) + lane * 4, (LAS unsigned*)(dst + piece * 1024), 16, 0, 0); }
    if (w == 0) __builtin_amdgcn_global_load_lds((const unsigned*)(blob_c + BL_SC + hsub * SC_BYTES) + lane * 4, (LAS unsigned*)(dst + 32768), 16, 0, 0);
}
__device__ __forceinline__ void ssd_dma_head(const Ctx& F, const unsigned char* blob_c, int hsub, int w, int lane, int par) {
    LAS unsigned char* dst = F.lds + SL_HEAD + par * HEAD_BYTES;
    __builtin_amdgcn_global_load_lds((const unsigned*)(blob_c + BL_CBT + w * 1024) + lane * 4, (LAS unsigned*)(dst + w * 1024), 16, 0, 0);
    if (w == 1 || w == 2) __builtin_amdgcn_global_load_lds((const unsigned*)(blob_c + BL_CBT + (7 + w) * 1024) + lane * 4, (LAS unsigned*)(dst + (7 + w) * 1024), 16, 0, 0);
    if (w == 3) __builtin_amdgcn_global_load_lds((const unsigned*)(blob_c + BL_SC + hsub * SC_BYTES) + lane * 4, (LAS unsigned*)(dst + 10 * 1024), 16, 0, 0);
}
template <bool DRY> __device__ __forceinline__ void phase_ssd(const Ctx& F, const Ptrs& P) {
    const bf16* XBC = (const bf16*)(P.ws + WS_RB); bf16* Z = (bf16*)(P.ws + WS_RA);
    float* ssqp = (float*)(P.ws + WS_SSQP); const unsigned char* IMGS = (const unsigned char*)P.out;
    LAS unsigned char* L = F.lds;
    const int w = F.wave, lane = F.lane, r = lane & 15, q = lane >> 4, pt = w & 3, lh = w >> 2;
    constexpr int NC = SEQ / 64;
    for (int unit = F.vcu; unit < BATCH * NH; unit += F.G) {
        const int b = unit / NH, h = unit % NH, g = h / HPG, hsub = h % HPG, cp = lane & 31, hf = lane >> 5, ch = h * HD + 2 * cp;
        const float Dh = P.ssm_d[h];
        ConvW cw;
#pragma unroll
        for (int t = 0; t < 4; ++t) { cw.a[t] = P.conv_w[t * CONV_DIM + ch]; cw.b[t] = P.conv_w[t * CONV_DIM + ch + 1]; }
        cw.ba = P.conv_b[ch]; cw.bb = P.conv_b[ch + 1];
        const unsigned char* blob0 = IMGS + ((size_t)b * NC * NG + g) * BLOB_BYTES;
        const bf16* x0 = XBC + ((size_t)b * SEQ + 8 * w + 4 * hf) * CONV_DIM + h * HD + 2 * cp;
        bf16* z0 = Z + ((size_t)b * SEQ + 8 * w + 4 * hf) * DI + h * HD + 2 * cp;
        const __amdgpu_buffer_rsrc_t rx = __builtin_amdgcn_make_buffer_rsrc((void*)XBC, 0, (int)((size_t)M * CONV_DIM * 2), 0x00020000), rz = __builtin_amdgcn_make_buffer_rsrc((void*)Z, 0, (int)((size_t)M * DI * 2), 0x00020000);
        const unsigned xs0 = (unsigned)((((size_t)b * SEQ + 8 * w) * CONV_DIM + h * HD) * 2), zs0 = (unsigned)((((size_t)b * SEQ + 8 * w) * DI + h * HD) * 2);
        const int xvo = cp * 4 + hf * (4 * CONV_DIM * 2), zvo = cp * 4 + hf * (4 * DI * 2);
        f32x4 st[8];
#pragma unroll
        for (int j = 0; j < 8; ++j) st[j] = (f32x4){0.f, 0.f, 0.f, 0.f};
        int a256[4], a128[2];
#pragma unroll
        for (int ks = 0; ks < 4; ++ks) a256[ks] = img256(r, 4 * ks + q);
#pragma unroll
        for (int ks = 0; ks < 2; ++ks) a128[ks] = img128(r, 4 * ks + q);
        {
          const int l = F.tid >> 3, cch = F.tid & 7; unsigned zz = 0u; asm volatile("" : "+v"(zz));
          if ((cch >> 1) > (l >> 4)) { *(LAS v4u*)(L + SL_P + img128(l, cch)) = (v4u){zz, zz, zz, zz}; *(LAS v4u*)(L + SL_P + 8192 + img128(l, cch)) = (v4u){zz, zz, zz, zz}; } }
        unsigned xr[7], zr[4];
        {
            unsigned x0r[7], x1r[7];
            ssd_dma_main(F, blob0, hsub, w, lane, 0); ssd_dma_head(F, blob0, hsub, w, lane, 0); ssd_dma_head(F, blob0 + (size_t)NG * BLOB_BYTES, hsub, w, lane, 1);
#pragma unroll
            for (int k = 0; k < 7; ++k) { x0r[k] = *(const unsigned*)(x0 + (long)(k - 3) * CONV_DIM); x1r[k] = *(const unsigned*)(x0 + (long)(64 + k - 3) * CONV_DIM); }
            asm volatile("s_waitcnt vmcnt(0)" ::: "memory");
#pragma unroll
            for (int k = 0; k < 7; ++k) { asm volatile("v_mov_b32 %0, %1" : "=v"(xr[k]) : "v"(x1r[k])); asm volatile("" : "+v"(x0r[k])); }
#pragma unroll
            for (int i = 0; i < 4; ++i) zr[i] = 0u;
            RAW_BARRIER();
            ssd_head(L, 0, 0, true, x0r, w, lane, r, q, cw, Dh);
            RAW_BARRIER();
        }
        for (int j = 0; j < NC; ++j) {
            unsigned nxr[7], nzr[4];
            {
                const int c1 = (j + 1 < NC) ? j + 1 : j, c2 = (j + 2 < NC) ? j + 2 : NC - 1;
                ssd_dma_main(F, blob0 + (size_t)c1 * NG * BLOB_BYTES, hsub, w, lane, (j + 1) & 1);
                if (j + 2 < NC) ssd_dma_head(F, blob0 + (size_t)c2 * NG * BLOB_BYTES, hsub, w, lane, j & 1);
                const unsigned xso = xs0 + (unsigned)(c2 * 64 - 3) * (CONV_DIM * 2), zso = zs0 + (unsigned)(j * 64) * (DI * 2);
#pragma unroll
                for (int k = 0; k < 7; ++k) nxr[k] = __builtin_amdgcn_raw_buffer_load_b32(rx, xvo, xso + k * (CONV_DIM * 2), 0);
#pragma unroll
                for (int i = 0; i < 4; ++i) nzr[i] = __builtin_amdgcn_raw_buffer_load_b32(rz, zvo, zso + i * (DI * 2), 0);
            }
            unsigned eob[4]; float es1;
            ssd_epi(L, (j + 1) & 1, zr, w, lane, eob, es1);
            ssd_mfma(L, j & 1, st, lane, r, q, pt, lh, a256, a128);
            { const int d = (j + 1 < NC) ? j + 1 : j; ssd_head(L, (j + 1) & 1, d & 1, false, xr, w, lane, r, q, cw, Dh); }
            asm volatile("s_waitcnt vmcnt(0)" ::: "memory");
#pragma unroll
            for (int k2 = 0; k2 < 7; ++k2) asm volatile("v_mov_b32 %0, %1" : "=v"(xr[k2]) : "v"(nxr[k2]));
#pragma unroll
            for (int k2 = 0; k2 < 4; ++k2) asm volatile("v_mov_b32 %0, %1" : "=v"(zr[k2]) : "v"(nzr[k2]));
            if (j > 0) {
                const unsigned zso = zs0 + (unsigned)((j - 1) * 64) * (DI * 2);
#pragma unroll
                for (int i = 0; i < 4; ++i) if (!DRY || es1 == 1.2345e30f) __builtin_amdgcn_raw_buffer_store_b32(eob[i], rz, zvo, zso + i * (DI * 2), 0);
                if ((lane & 7) == 0 && (!DRY || es1 == 1.2345e30f)) { const int i = 4 * (lane >> 5) + 2 * ((lane >> 4) & 1) + ((lane >> 3) & 1); ssqp[((size_t)b * SEQ + (j - 1) * 64 + 8 * w + i) * NH + h] = es1; }
            }
            RAW_BARRIER();
        }
        {
            unsigned ob[4]; float s1;
            ssd_epi(L, (NC - 1) & 1, zr, w, lane, ob, s1);
            bf16* zc = z0 + (size_t)(NC - 1) * 64 * DI;
#pragma unroll
            for (int i = 0; i < 4; ++i) if (!DRY || s1 == 1.2345e30f) *(unsigned*)(zc + (long)i * DI) = ob[i];
            if ((lane & 7) == 0 && (!DRY || s1 == 1.2345e30f)) { const int i = 4 * (lane >> 5) + 2 * ((lane >> 4) & 1) + ((lane >> 3) & 1); ssqp[((size_t)b * SEQ + (NC - 1) * 64 + 8 * w + i) * NH + h] = s1; }
        }
        asm volatile("s_waitcnt vmcnt(0)" ::: "memory"); RAW_BARRIER();
    }
}

__device__ __forceinline__ void phase_pool(const Ctx& F, const Ptrs& P) {
    const bf16* V = (const bf16*)(P.ws + WS_RA); const bf16* GT = (const bf16*)(P.ws + WS_RB); bf16* Y2 = (bf16*)(P.ws + WS_RB);
    const int NCG = DP / 8;
    const int nitems = (M / 32) * NCG;
    for (int it = F.vcu * 512 + F.tid; it < nitems; it += F.G * 512) {
        const int cg = it % NCG, tb = it / NCG, c0 = cg * 8, t0 = tb * 32, win = 2 << (c0 / PGD);
        const int pos0 = t0 % SEQ;
        float sc[8]; { const f32x4 a = *(const f32x4*)(P.pool_scale + c0), b = *(const f32x4*)(P.pool_scale + c0 + 4); sc[0] = a.x; sc[1] = a.y; sc[2] = a.z; sc[3] = a.w; sc[4] = b.x; sc[5] = b.y; sc[6] = b.z; sc[7] = b.w; }
        float s[8];
#pragma unroll
        for (int j = 0; j < 8; ++j) s[j] = 0.f;
        for (int d = 1; d < win; ++d) if (pos0 - d >= 0) { const v4u r = *(const v4u*)(V + (size_t)(t0 - d) * DP + c0);
            s[0] += bflo(r.x); s[1] += bfhi(r.x); s[2] += bflo(r.y); s[3] += bfhi(r.y); s[4] += bflo(r.z); s[5] += bfhi(r.z); s[6] += bflo(r.w); s[7] += bfhi(r.w); }
        for (int tt = 0; tt < 32; tt += 8) {
            v4u rv[8], gv[8], qv[8];
#pragma unroll
            for (int u = 0; u < 8; ++u) { const int t = tt + u; rv[u] = *(const v4u*)(V + (size_t)(t0 + t) * DP + c0); gv[u] = *(const v4u*)(GT + (size_t)(t0 + t) * DP + c0);
                const int pd = pos0 + t - (win - 1); qv[u] = *(const v4u*)(V + (size_t)(t0 + t - (pd >= 0 ? win - 1 : 0)) * DP + c0); }
#pragma unroll
            for (int u = 0; u < 8; ++u) { const int t = tt + u, pos = pos0 + t; const v4u r = rv[u], gr = gv[u], q = qv[u];
                const float cur[8] = {bflo(r.x), bfhi(r.x), bflo(r.y), bfhi(r.y), bflo(r.z), bfhi(r.z), bflo(r.w), bfhi(r.w)};
                const float gt[8] = {bflo(gr.x), bfhi(gr.x), bflo(gr.y), bfhi(gr.y), bflo(gr.z), bfhi(gr.z), bflo(gr.w), bfhi(gr.w)};
#pragma unroll
                for (int j = 0; j < 8; ++j) s[j] += cur[j];
                const int cnt = (pos + 1 < win) ? (pos + 1) : win; const float inv = 1.0f / (float)cnt;
                float o[8];
#pragma unroll
                for (int j = 0; j < 8; ++j) o[j] = (s[j] * inv - cur[j]) * sc[j] * (gt[j] * sigm(gt[j]));
                v4u ow; ow.x = pk2(o[0], o[1]); ow.y = pk2(o[2], o[3]); ow.z = pk2(o[4], o[5]); ow.w = pk2(o[6], o[7]);
                *(v4u*)(Y2 + (size_t)(t0 + t) * DP + c0) = ow;
                if (pos - (win - 1) >= 0) {
                    s[0] -= bflo(q.x); s[1] -= bfhi(q.x); s[2] -= bflo(q.y); s[3] -= bfhi(q.y); s[4] -= bflo(q.z); s[5] -= bfhi(q.z); s[6] -= bflo(q.w); s[7] -= bfhi(q.w); } }
        }
    }
}

__device__ __forceinline__ void fin_load(const float* row, int lane, f32x4 (&v)[8]) {
#pragma unroll
    for (int j = 0; j < 8; ++j) v[j] = ((const f32x4*)row)[lane + 64 * j];
}
__device__ __forceinline__ void fin_process(float* row, int lane, const f32x4 (&v)[8], const f32x4 (&gv)[8]) {
    float s = 0.f;
#pragma unroll
    for (int j = 0; j < 8; ++j) s += (v[j].x * v[j].x + v[j].y * v[j].y) + (v[j].z * v[j].z + v[j].w * v[j].w);
    s = wave_sum(s);
    const float rs = rsqrtf(s * (1.0f / DM) + EPS);
#pragma unroll
    for (int j = 0; j < 8; ++j) ((f32x4*)row)[lane + 64 * j] = v[j] * rs * gv[j];
}
__device__ __forceinline__ void phase_final(const Ctx& F, const Ptrs& P) {
    const int gw = F.vcu * NWAVES + F.wave, NGW = F.G * NWAVES, lane = F.lane;
    f32x4 gv[8];
#pragma unroll
    for (int j = 0; j < 8; ++j) gv[j] = ((const f32x4*)P.final_g)[lane + 64 * j];
    const int cnt = (M - gw + NGW - 1) / NGW;
    f32x4 vA[8], vB[8];
    fin_load(P.out + (size_t)gw * DM, lane, vA);
    for (int j = 0; j < cnt; j += 2) {
        { const int jn = (j + 1 < cnt) ? j + 1 : j; fin_load(P.out + (size_t)(gw + jn * NGW) * DM, lane, vB); }
        fin_process(P.out + (size_t)(gw + j * NGW) * DM, lane, vA, gv);
        if (j + 1 < cnt) {
            { const int jn = (j + 2 < cnt) ? j + 2 : j + 1; fin_load(P.out + (size_t)(gw + jn * NGW) * DM, lane, vA); }
            fin_process(P.out + (size_t)(gw + (j + 1) * NGW) * DM, lane, vB, gv);
        }
    }
}

constexpr int N_PHASES = 10;
struct Args { Ptrs p; int ph_lo, ph_hi, li, pad; };
typedef __attribute__((address_space(4))) const Args* KArgsPtr;
__device__ __forceinline__ Ptrs load_ptrs() {
    Ptrs r{};
#if defined(__HIP_DEVICE_COMPILE__)
    KArgsPtr ka = (KArgsPtr)__builtin_amdgcn_kernarg_segment_ptr(); asm volatile("" : "+s"(ka));
    r.x = ka->p.x; r.ln_g = ka->p.ln_g; r.final_g = ka->p.final_g; r.ssm_w_in = ka->p.ssm_w_in; r.conv_w = ka->p.conv_w; r.conv_b = ka->p.conv_b; r.dt_bias = ka->p.dt_bias; r.a_log = ka->p.a_log; r.ssm_d = ka->p.ssm_d;
    r.norm_g = ka->p.norm_g; r.ssm_w_out = ka->p.ssm_w_out; r.pool_w_in = ka->p.pool_w_in; r.pool_w_group = ka->p.pool_w_group; r.pool_scale = ka->p.pool_scale; r.pool_w_out = ka->p.pool_w_out; r.out = ka->p.out; r.ws = ka->p.ws;
#endif
    return r;
}
__global__ void __launch_bounds__(NWAVES * 64, 2) trunk_fwd(Args args) {
    extern __shared__ __attribute__((aligned(16))) unsigned char lds[];
    Ctx F;
    F.lds = (LAS unsigned char*)lds;
    F.tid = threadIdx.x; F.lane = F.tid & 63; F.wave = __builtin_amdgcn_readfirstlane(F.tid >> 6);
    F.G = gridDim.x; { const int bx = blockIdx.x; F.vcu = (F.G % 8 == 0) ? (bx % 8) * (F.G / 8) + bx / 8 : bx; }
    unsigned* ctl0; { const Ptrs P0 = load_ptrs(); ctl0 = (unsigned*)(P0.ws + WS_CTL); }
    for (int u = F.tid; u < (LDS_BYTES - LDSCTL_OFF) / 4; u += NWAVES * 64) ((LAS unsigned*)(F.lds + LDSCTL_OFF))[u] = 0u;
    __syncthreads();
#if MK_ONE_LAUNCH
    XcdBarrier bar = xcd_barrier_post(ctl0 + CW_BAR, (volatile LAS unsigned*)(F.lds + MISC_OFF) + 8);
#define GRID_BAR() xcd_barrier(bar)
#else
#define GRID_BAR() do {} while (0)
#endif
    const int lo = args.ph_lo, hi = args.ph_hi;
#define IN(k) (lo <= (k) && (k) < hi)
#define BOTH(k) (IN(k) && IN((k) + 1))
#define PHASE_VARS const Ptrs P = load_ptrs(); unsigned* ctl = (unsigned*)(P.ws + WS_CTL); \
    float* ssq1 = (float*)ctl + CW_SSQ1; float* ssq3p = (float*)(P.ws + WS_SSQP + 4 * MiB); const float* ssqp = (const float*)(P.ws + WS_SSQP);   \
    bf16* W1T = (bf16*)(P.ws + WS_W1T); bf16* W2T = (bf16*)(P.ws + WS_W2T); bf16* W3T = (bf16*)(P.ws + WS_W3T); bf16* W4T = (bf16*)(P.ws + WS_W4T); bf16* W5T = (bf16*)(P.ws + WS_W5T); \
    bf16* RA = (bf16*)(P.ws + WS_RA); bf16* RB = (bf16*)(P.ws + WS_RB); bf16* RC = (bf16*)(P.ws + WS_RC); \
    (void)ctl; (void)ssq1; (void)ssq3p; (void)ssqp; (void)W1T; (void)W2T; (void)W3T; (void)W4T; (void)W5T; (void)RA; (void)RB; (void)RC;

#define REP(k) (1 + ((REPEAT_MASK >> (k)) & 1))
    unsigned long long ts_a = 0, ts_b = 0;
#define TS_A(k) do { if (STAMP_PHASE == (k)) ts_a = __builtin_amdgcn_s_memrealtime(); } while (0)
#define TS_B(k) do { if (STAMP_PHASE == (k)) ts_b = __builtin_amdgcn_s_memrealtime(); } while (0)
    TS_A(0);
    if (IN(0)) { PHASE_VARS for (int rep = 0; rep < REP(0); ++rep) phase_prep(F, P); if (BOTH(0)) GRID_BAR(); }
    TS_B(0);
    TS_A(1);
    if (IN(1)) {
        PHASE_VARS
        {
          pg8::Gemm g{W4T, (const bf16*)P.out, DP, DM, PGD, PGD, DP, 30, 2}; pg8::StaticOrder S; S.init(DP, DM, F.G, (int)blockIdx.x);
          pg8::EpiPlain E{W3T, DM};
          TS_A(10); pg8::gemm_phase<pg8::EpiPlain, pg8::StaticOrder, true, true>(F.lds + RING_OFF, g, S, E);
          { constexpr int NWC = (DP / 256) * (DM / 256); if ((int)blockIdx.x >= NWC && F.G > NWC) prep_transposes(F, P, 1, ((int)blockIdx.x - NWC) * NWAVES + F.wave, (F.G - NWC) * NWAVES); else if (F.G <= NWC) prep_transposes(F, P, 1, F.vcu * NWAVES + F.wave, F.G * NWAVES); }
          __syncthreads(); TS_B(10); }
        TS_A(11); for (int rep = 0; rep < REP(10); ++rep) phase_dt(F, P); TS_B(11);
        for (int rep = 0; rep < REP(1); ++rep) {
        pg8::Gemm g{RC, W1T, M, N1, DM, DM, DM, 30, 30}; pg8::StaticOrder S; S.init(M, N1, F.G, (int)blockIdx.x);
        pg8::EpiProj E{RA, DI, RB, CONV_DIM, DI / 256, ssq1, 1.0f / DM, nullptr};
        pg8::gemm_phase<pg8::EpiProj, pg8::StaticOrder, true, true>(F.lds + RING_OFF, g, S, E);
        }
        if (BOTH(1)) GRID_BAR();
    }
    TS_B(1);
    TS_A(2);
    if (IN(2)) { PHASE_VARS for (int rep = 0; rep < REP(2); ++rep) phase_bcprep(F, P); if (BOTH(2)) GRID_BAR(); }
    TS_B(2);
    TS_A(3);
    if (IN(3)) { PHASE_VARS if (REP(3) > 1) phase_ssd<true>(F, P); phase_ssd<false>(F, P); if (BOTH(3)) GRID_BAR(); }
    TS_B(3);
    TS_A(4);
    if (IN(4)) {
        PHASE_VARS
        for (int rep = 0; rep < REP(4); ++rep) {
        pg8::Gemm g{RA, W2T, M, DM, DI, DI, DI, 30, 30}; pg8::StaticOrder S; S.init(M, DM, F.G, (int)blockIdx.x);
        LAS float* rs_tab = (LAS float*)(F.lds + pg8::STAGE_BYTES);
        {
          pg8::Unit uu; const int o = F.tid >> 8, rr = F.tid & 255;
          if (S.next(o, uu)) { const f32x4* pp = (const f32x4*)(ssqp + (size_t)(uu.pm * 256 + rr) * NH); f32x4 a = pp[0];
#pragma unroll
              for (int j = 1; j < 16; ++j) a = a + pp[j];
              rs_tab[o * 256 + rr] = rsqrtf(((a[0] + a[1]) + (a[2] + a[3])) * (1.0f / DI) + EPS); }
          __syncthreads(); }
        pg8::EpiResB E{RC, rs_tab, ssq3p, DM};
        pg8::gemm_phase<pg8::EpiResB, pg8::StaticOrder, true, true>(F.lds + RING_OFF, g, S, E);
        }
        if (BOTH(4)) GRID_BAR();
    }
    TS_B(4);
    TS_A(5);
    if (IN(5)) {
        PHASE_VARS
        for (int rep = 0; rep < REP(5); ++rep) {
        pg8::Gemm g{RC, W3T, M, 2 * DP, DM, DM, DM, 30, 30}; pg8::StaticOrder S; S.init(M, 2 * DP, F.G, (int)blockIdx.x);
        LAS float* rs_tab = (LAS float*)(F.lds + pg8::STAGE_BYTES);
        {
          for (int o = F.tid >> 8; o < 8; o += 2) { pg8::Unit uu; const int rr = F.tid & 255;
            if (S.next(o, uu)) { const f32x4* pp = (const f32x4*)(ssq3p + (size_t)(uu.pm * 256 + rr) * 32); f32x4 a = pp[0];
#pragma unroll
              for (int j = 1; j < 8; ++j) a = a + pp[j];
              rs_tab[o * 256 + rr] = rsqrtf(((a[0] + a[1]) + (a[2] + a[3])) * (1.0f / DM) + EPS); } }
          __syncthreads(); }
        pg8::EpiProj E{RA, DP, RB, DP, DP / 256, nullptr, 0.f, rs_tab};
        pg8::gemm_phase<pg8::EpiProj, pg8::StaticOrder, true, true>(F.lds + RING_OFF, g, S, E);
        }
        if (BOTH(5)) GRID_BAR();
    }
    TS_B(5);
    TS_A(6);
    if (IN(6)) { PHASE_VARS for (int rep = 0; rep < REP(6); ++rep) phase_pool(F, P); if (BOTH(6)) GRID_BAR(); }
    TS_B(6);
    TS_A(8);
    if (IN(8)) {
        PHASE_VARS
        pg8::Gemm g{RB, W5T, M, DM, DP, DP, DP, 30, 30}; pg8::PanelOrder S; S.init(F.G, (int)blockIdx.x);
        pg8::EpiFinal E{RC, P.out, P.final_g, (float*)(P.ws + WS_SSQP + 6 * MiB), ctl + CW_FIN, ctl + CW_TMO, F.lds + pg8::STAGE_BYTES, DM};
        pg8::gemm_phase<pg8::EpiFinal, pg8::PanelOrder, true, true>(F.lds + RING_OFF, g, S, E);
    }
    TS_B(8);
    if (STAMP_PHASE >= 0) { const unsigned long long t0 = __builtin_amdgcn_s_memrealtime(); while (__builtin_amdgcn_s_memrealtime() - t0 < ts_b - ts_a) __builtin_amdgcn_s_sleep(8); }
#undef IN
#undef BOTH
}

extern "C" void kernel_launch(void* const* d_in, const int* in_sizes, int n_in, void* d_out, int out_size, void* d_ws, size_t ws_size, hipStream_t stream) {
    static int grid = 0;
    if (grid == 0) {
        if (n_in != 15 || in_sizes[0] != M * DM || out_size != M * DM || ws_size < WS_END) { fprintf(stderr, "kernel_launch: unexpected shapes: n_in %d in0 %d out %d ws %zu (need %zu); nothing launched\n", n_in, n_in > 0 ? in_sizes[0] : -1, out_size, ws_size, (size_t)WS_END); grid = -1; return; }
        int dev = 0, cus = 0, per_cu = 0;
        if (hipGetDevice(&dev) != hipSuccess || hipDeviceGetAttribute(&cus, hipDeviceAttributeMultiprocessorCount, dev) != hipSuccess) { fprintf(stderr, "kernel_launch: device query failed\n"); grid = -1; return; }
        if (hipFuncSetAttribute((const void*)trunk_fwd, hipFuncAttributeMaxDynamicSharedMemorySize, LDS_BYTES) != hipSuccess) { fprintf(stderr, "kernel_launch: hipFuncSetAttribute failed\n"); grid = -1; return; }
        if (hipOccupancyMaxActiveBlocksPerMultiprocessor(&per_cu, (const void*)trunk_fwd, NWAVES * 64, LDS_BYTES) != hipSuccess || per_cu < 1) { fprintf(stderr, "kernel_launch: occupancy query says %d blocks per CU\n", per_cu); }
        (void)hipGetLastError();
        grid = cus;
        if (cus != 256) { fprintf(stderr, "kernel_launch: this kernel's unit orders are built for a 256-CU device (got %d CUs); nothing launched\n", cus); grid = -1; return; }
    }
    if (grid < 0) return;
    if (hipMemsetAsync((char*)d_ws + WS_CTL, 0, CTL_ZERO_BYTES, stream) != hipSuccess) { fprintf(stderr, "kernel_launch: memset failed\n"); return; }
    Args a{};
    a.p.x = (const float*)d_in[0]; a.p.ln_g = (const float*)d_in[1]; a.p.final_g = (const float*)d_in[2]; a.p.ssm_w_in = (const float*)d_in[3]; a.p.conv_w = (const float*)d_in[4];
    a.p.conv_b = (const float*)d_in[5]; a.p.dt_bias = (const float*)d_in[6]; a.p.a_log = (const float*)d_in[7]; a.p.ssm_d = (const float*)d_in[8]; a.p.norm_g = (const float*)d_in[9];
    a.p.ssm_w_out = (const float*)d_in[10]; a.p.pool_w_in = (const float*)d_in[11]; a.p.pool_w_group = (const float*)d_in[12]; a.p.pool_scale = (const float*)d_in[13]; a.p.pool_w_out = (const float*)d_in[14];
    a.p.out = (float*)d_out; a.p.ws = (unsigned char*)d_ws;
#if MK_ONE_LAUNCH
    a.ph_lo = 0; a.ph_hi = N_PHASES; a.li = 0;
    hipLaunchKernelGGL(trunk_fwd, dim3(grid), dim3(NWAVES * 64), LDS_BYTES, stream, a);
#else
    for (int li = 0; li < N_PHASES; ++li) { a.ph_lo = li; a.ph_hi = li + 1; a.li = li;
        hipLaunchKernelGGL(trunk_fwd, dim3(grid), dim3(NWAVES * 64), LDS_BYTES, stream, a); }
#endif
    const hipError_t le = hipPeekAtLastError();
    if (le != hipSuccess) fprintf(stderr, "kernel_launch: launch failed: %s\n", hipGetErrorName(le));
}
```

```cpp
#include <hip/hip_runtime.h>
#include <cstdio>
#include <cstdint>

#ifndef REPEAT_MASK
#define REPEAT_MASK 0
#endif
#ifndef STAMP_PHASE
#define STAMP_PHASE -1
#endif
#ifndef MK_ONE_LAUNCH
#define MK_ONE_LAUNCH 1
#endif

namespace pg8 {
#define PG8_LAS __attribute__((address_space(3)))
typedef unsigned short bf16_t;
typedef short bf16x8 __attribute__((ext_vector_type(8)));
typedef float f32x4 __attribute__((ext_vector_type(4)));
typedef unsigned u32x4 __attribute__((ext_vector_type(4)));
typedef unsigned u32x2 __attribute__((ext_vector_type(2)));
constexpr int BM = 256, BK = 64, HALF = 128, HTB = HALF * BK * 2  , STAGE_BYTES = 8 * HTB, NXCD = 8, WGM = 8;
constexpr float RMS_EPS = 1e-6f;

__host__ __device__ __forceinline__ int lds_byte(int r, int c) { const int st = (r >> 4) * 2 + (c >> 5), rr = r & 15, cc = c & 31, ob = rr * 64 + cc * 2; return st * 1024 + (ob ^ (((ob >> 9) & 1) << 5)); }
__host__ __device__ __forceinline__ void stage_rc(int b, int& R, int& C) { const int st = b / 1024, sb = b % 1024, swz = sb ^ (((sb >> 9) & 1) << 5); R = (st >> 1) * 16 + swz / 64; C = (st & 1) * 32 + (swz % 64) / 2; }
__host__ __device__ __forceinline__ int perm32(int rho) { const int n = rho >> 4, i = rho & 15; return 8 * (i >> 2) + 4 * n + (i & 3); }

struct Unit { int pm, pn, ord; };
struct Gemm { const bf16_t* A; const bf16_t* Bt; int M, N, K, lda, ldb, gsh, bgsh; };

struct StaticOrder {
    int nM, nN, nwg, G, c;
    __host__ __device__ void init(int M, int N, int G_, int c_) { nM = M / BM; nN = N / BM; nwg = nM * nN; G = G_; c = c_; }
    __host__ __device__ bool next(int i, Unit& u) const {
        const long L = (long)i * G + c; if (L >= nwg) return false;
        int wgid = (int)L; { const int q = nwg / NXCD, r = nwg % NXCD, xcd = wgid % NXCD, off = wgid / NXCD; wgid = (xcd < r ? xcd * (q + 1) : r * (q + 1) + (xcd - r) * q) + off; }
        const int nig = WGM * nN, gid = wgid / nig, fm = gid * WGM, gsz = (nM - fm) < WGM ? (nM - fm) : WGM;
        u.pm = fm + ((wgid % nig) % gsz); u.pn = (wgid % nig) / gsz; return true;
    }
    __device__ __forceinline__ void a_ready(const Unit&) const {}
    __device__ __forceinline__ void done(const Unit&) const {}
};

__device__ __forceinline__ unsigned cvt_pk_bf16(float lo, float hi) { unsigned r; asm volatile("v_cvt_pk_bf16_f32 %0, %1, %2" : "=v"(r) : "v"(lo), "v"(hi)); return r; }
__device__ __forceinline__ float bf_lo(unsigned w) { return __uint_as_float(w << 16); }
__device__ __forceinline__ float bf_hi(unsigned w) { return __uint_as_float(w & 0xffff0000u); }
__device__ __forceinline__ float sigmoid_f(float v) { return __builtin_amdgcn_rcpf(1.0f + __builtin_amdgcn_exp2f(-1.4426950408889634f * v)); }

struct EpiProj {
    static constexpr bool PERM = true, AFTER_DRAIN = false;
    bf16_t* O0; int ld0; bf16_t* O1; int ld1; int split_pn; const float* ssq; float inv_n; const PG8_LAS float* rs_lds;
    __device__ __forceinline__ void operator()(const f32x4 (&acc)[2][2][4][2], const Unit& u, int wr, int wc, int fr, int fq) const {
        const int row0 = u.pm * BM + wr * 64 + fr;
        bf16_t* base; int ld, colt;
        if (u.pn < split_pn) { base = O0; ld = ld0; colt = u.pn * BM; } else { base = O1; ld = ld1; colt = (u.pn - split_pn) * BM; }
        const int col0 = colt + wc * 32 + 8 * fq;
#pragma unroll
        for (int ai = 0; ai < 2; ++ai)
#pragma unroll
            for (int m = 0; m < 4; ++m) { const int row = row0 + ai * HALF + m * 16; const float s = rs_lds ? rs_lds[u.ord * BM + wr * 64 + fr + ai * HALF + m * 16] : rsqrtf(ssq[row] * inv_n + RMS_EPS);
                bf16_t* rowp = base + (size_t)row * ld + col0;
#pragma unroll
                for (int bj = 0; bj < 2; ++bj) { const f32x4 v0 = acc[ai][bj][m][0] * s, v1 = acc[ai][bj][m][1] * s;
                    u32x4 w; w.x = cvt_pk_bf16(v0[0], v0[1]); w.y = cvt_pk_bf16(v0[2], v0[3]); w.z = cvt_pk_bf16(v1[0], v1[1]); w.w = cvt_pk_bf16(v1[2], v1[3]);
                    *(u32x4*)(rowp + bj * HALF) = w; } }
    }
};
struct EpiPlain {
    static constexpr bool PERM = true, AFTER_DRAIN = false;
    bf16_t* O; int ld;
    __device__ __forceinline__ void operator()(const f32x4 (&acc)[2][2][4][2], const Unit& u, int wr, int wc, int fr, int fq) const {
        const int row0 = u.pm * BM + wr * 64 + fr, col0 = u.pn * BM + wc * 32 + 8 * fq;
#pragma unroll
        for (int ai = 0; ai < 2; ++ai)
#pragma unroll
            for (int m = 0; m < 4; ++m) { bf16_t* rowp = O + (size_t)(row0 + ai * HALF + m * 16) * ld + col0;
#pragma unroll
                for (int bj = 0; bj < 2; ++bj) { const f32x4 v0 = acc[ai][bj][m][0], v1 = acc[ai][bj][m][1];
                    u32x4 w; w.x = cvt_pk_bf16(v0[0], v0[1]); w.y = cvt_pk_bf16(v0[2], v0[3]); w.z = cvt_pk_bf16(v1[0], v1[1]); w.w = cvt_pk_bf16(v1[2], v1[3]);
                    *(u32x4*)(rowp + bj * HALF) = w; } }
    }
};
struct EpiRes {
    static constexpr bool PERM = false, AFTER_DRAIN = false;
    const float* base; float* out; bf16_t* ob; const PG8_LAS float* rs_lds; float* ssq_out; int ldc;
    __device__ __forceinline__ void operator()(const f32x4 (&acc)[2][2][4][2], const Unit& u, int wr, int wc, int fr, int fq) const {
        const int rl0 = wr * 64 + fr, row0 = u.pm * BM + rl0, col0 = u.pn * BM + wc * 32 + 4 * fq;
#pragma unroll
        for (int ai = 0; ai < 2; ++ai)
#pragma unroll
            for (int m = 0; m < 4; ++m) { const int row = row0 + ai * HALF + m * 16; const float s = rs_lds ? rs_lds[u.ord * BM + rl0 + ai * HALF + m * 16] : 1.0f;
                const size_t off = (size_t)row * ldc + col0; float q = 0.f;
#pragma unroll
                for (int bj = 0; bj < 2; ++bj)
#pragma unroll
                    for (int n = 0; n < 2; ++n) { const size_t o2 = off + bj * HALF + n * 16; const f32x4 b = *(const f32x4*)(base + o2); const f32x4 o = b + acc[ai][bj][m][n] * s;
                        *(f32x4*)(out + o2) = o; q += (o[0] * o[0] + o[1] * o[1]) + (o[2] * o[2] + o[3] * o[3]);
                        if (ob) { u32x2 w; w.x = cvt_pk_bf16(o[0], o[1]); w.y = cvt_pk_bf16(o[2], o[3]); *(u32x2*)(ob + o2) = w; } }
                if (ssq_out) { q += __shfl_xor(q, 16); q += __shfl_xor(q, 32); if (fq == 0) ssq_out[(size_t)row * 32 + u.pn * 4 + wc] = q; }
                if (m & 1) asm volatile("" ::: "memory"); }
    }
};
struct EpiResB {
    static constexpr bool PERM = false, AFTER_DRAIN = false;
    bf16_t* xio; const PG8_LAS float* rs_lds; float* ssq_out; int ldc;
    __device__ __forceinline__ void operator()(const f32x4 (&acc)[2][2][4][2], const Unit& u, int wr, int wc, int fr, int fq) const {
        const int rl0 = wr * 64 + fr, row0 = u.pm * BM + rl0, col0 = u.pn * BM + wc * 32 + 4 * fq;
#pragma unroll
        for (int ai = 0; ai < 2; ++ai)
#pragma unroll
            for (int m = 0; m < 4; ++m) { const int row = row0 + ai * HALF + m * 16; const float s = rs_lds[u.ord * BM + rl0 + ai * HALF + m * 16];
                const size_t off = (size_t)row * ldc + col0; float q = 0.f;
#pragma unroll
                for (int bj = 0; bj < 2; ++bj)
#pragma unroll
                    for (int n = 0; n < 2; ++n) { const size_t o2 = off + bj * HALF + n * 16; const u32x2 bw = *(const u32x2*)(xio + o2);
                        f32x4 o = acc[ai][bj][m][n] * s; o[0] += bf_lo(bw.x); o[1] += bf_hi(bw.x); o[2] += bf_lo(bw.y); o[3] += bf_hi(bw.y);
                        q += (o[0] * o[0] + o[1] * o[1]) + (o[2] * o[2] + o[3] * o[3]);
                        u32x2 w; w.x = cvt_pk_bf16(o[0], o[1]); w.y = cvt_pk_bf16(o[2], o[3]); *(u32x2*)(xio + o2) = w; }
                q += __shfl_xor(q, 16); q += __shfl_xor(q, 32); if (fq == 0) ssq_out[(size_t)row * 32 + u.pn * 4 + wc] = q;
                if (m & 1) asm volatile("" ::: "memory"); }
    }
};
struct PanelOrder {
    int G, c;
    __host__ __device__ void init(int G_, int c_) { G = G_; c = c_; }
    __host__ __device__ bool next(int i, Unit& u) const { if (i >= 2) return false; const int xcd = c & 7, idx = c >> 3; u.pm = 32 * i + 4 * xcd + (idx >> 3); u.pn = idx & 7; return true; }
    __device__ __forceinline__ void a_ready(const Unit&) const {}
    __device__ __forceinline__ void done(const Unit&) const {}
};
struct EpiFinal {
    static constexpr bool PERM = false, AFTER_DRAIN = false;
    const bf16_t* base; float* out; const float* gain; float* xslots; unsigned* cnt; unsigned* tmo; PG8_LAS unsigned char* lds; int ldc;
    __device__ __forceinline__ void operator()(f32x4 (&acc)[2][2][4][2], const Unit& u, int wr, int wc, int fr, int fq) const {
        PG8_LAS float* Pt = (PG8_LAS float*)lds;
        PG8_LAS float* St = (PG8_LAS float*)(lds + 4096);
        const int tid = threadIdx.x, wid = __builtin_amdgcn_readfirstlane(tid >> 6), lane = tid & 63;
        const int rl0 = wr * 64 + fr, row0 = u.pm * BM + rl0, col0 = u.pn * BM + wc * 32 + 4 * fq;
#pragma unroll
        for (int ai = 0; ai < 2; ++ai)
#pragma unroll
            for (int m = 0; m < 4; ++m) { const size_t off = (size_t)(row0 + ai * HALF + m * 16) * ldc + col0; float q = 0.f;
#pragma unroll
                for (int bj = 0; bj < 2; ++bj)
#pragma unroll
                    for (int n = 0; n < 2; ++n) { const u32x2 bw = *(const u32x2*)(base + off + bj * HALF + n * 16);
                        f32x4 o = acc[ai][bj][m][n]; o[0] += bf_lo(bw.x); o[1] += bf_hi(bw.x); o[2] += bf_lo(bw.y); o[3] += bf_hi(bw.y); acc[ai][bj][m][n] = o;
                        q += (o[0] * o[0] + o[1] * o[1]) + (o[2] * o[2] + o[3] * o[3]); }
                q += __shfl_xor(q, 16); q += __shfl_xor(q, 32);
                if (fq == 0) Pt[(rl0 + ai * HALF + m * 16) * 4 + wc] = q; }
        asm volatile("s_waitcnt lgkmcnt(0)" ::: "memory"); __builtin_amdgcn_s_barrier(); asm volatile("" ::: "memory");
        if (tid < BM) { const f32x4 p4 = *(const PG8_LAS f32x4*)(Pt + tid * 4);
            __hip_atomic_store(xslots + (size_t)(u.pm * BM + tid) * 8 + u.pn, (p4[0] + p4[1]) + (p4[2] + p4[3]), __ATOMIC_RELAXED, __HIP_MEMORY_SCOPE_AGENT); }
        asm volatile("s_waitcnt vmcnt(0)" ::: "memory");
        if (tid < BM && lane == 0) __hip_atomic_fetch_add(cnt + 64 * u.pm, 1u, __ATOMIC_RELAXED, __HIP_MEMORY_SCOPE_AGENT);
        if (wid == 0) {
            unsigned sp = 0;
            while ((unsigned)__builtin_amdgcn_readfirstlane(__hip_atomic_load(cnt + 64 * u.pm, __ATOMIC_RELAXED, __HIP_MEMORY_SCOPE_AGENT)) < 32u) {
                __builtin_amdgcn_s_sleep(2);
                if (++sp > (1u << 22)) { if (lane == 0) __hip_atomic_store(tmo, 1u, __ATOMIC_RELAXED, __HIP_MEMORY_SCOPE_AGENT); break; } }
            __builtin_amdgcn_fence(__ATOMIC_ACQUIRE, "agent");
        }
        asm volatile("s_waitcnt vmcnt(0) lgkmcnt(0)" ::: "memory"); __builtin_amdgcn_s_barrier(); asm volatile("" ::: "memory");
        if (tid < BM) { const float* sl = xslots + (size_t)(u.pm * BM + tid) * 8; float t = 0.f;
#pragma unroll
            for (int j = 0; j < 8; ++j) t += __hip_atomic_load(sl + j, __ATOMIC_RELAXED, __HIP_MEMORY_SCOPE_AGENT);
            St[tid] = rsqrtf(t * (1.0f / 2048.0f) + RMS_EPS); }
        asm volatile("s_waitcnt vmcnt(0) lgkmcnt(0)" ::: "memory"); __builtin_amdgcn_s_barrier(); asm volatile("" ::: "memory");
        f32x4 gv[2][2];
#pragma unroll
        for (int bj = 0; bj < 2; ++bj)
#pragma unroll
            for (int n = 0; n < 2; ++n) gv[bj][n] = *(const f32x4*)(gain + col0 + bj * HALF + n * 16);
#pragma unroll
        for (int ai = 0; ai < 2; ++ai)
#pragma unroll
            for (int m = 0; m < 4; ++m) { const int rl = rl0 + ai * HALF + m * 16; const float s = St[rl]; float* rowp = out + (size_t)(u.pm * BM + rl) * ldc + col0;
#pragma unroll
                for (int bj = 0; bj < 2; ++bj)
#pragma unroll
                    for (int n = 0; n < 2; ++n) *(f32x4*)(rowp + bj * HALF + n * 16) = acc[ai][bj][m][n] * s * gv[bj][n]; }
        asm volatile("s_waitcnt lgkmcnt(0)" ::: "memory"); __builtin_amdgcn_s_barrier(); asm volatile("" ::: "memory");
    }
};
struct EpiGate {
    static constexpr bool PERM = true, AFTER_DRAIN = false;
    bf16_t* O; const bf16_t* gate; const float* scale; int ldc;
    __device__ __forceinline__ void operator()(const f32x4 (&acc)[2][2][4][2], const Unit& u, int wr, int wc, int fr, int fq) const {
        const int row0 = u.pm * BM + wr * 64 + fr, col0 = u.pn * BM + wc * 32 + 8 * fq;
        f32x4 sc[2][2];
#pragma unroll
        for (int bj = 0; bj < 2; ++bj)
#pragma unroll
            for (int n = 0; n < 2; ++n) sc[bj][n] = *(const f32x4*)(scale + col0 + bj * HALF + 4 * n);
#pragma unroll
        for (int ai = 0; ai < 2; ++ai)
#pragma unroll
            for (int m = 0; m < 4; ++m) { const size_t off = (size_t)(row0 + ai * HALF + m * 16) * ldc + col0;
#pragma unroll
                for (int bj = 0; bj < 2; ++bj) { const u32x4 gw = *(const u32x4*)(gate + off + bj * HALF);
                    const float g0 = bf_lo(gw.x), g1 = bf_hi(gw.x), g2 = bf_lo(gw.y), g3 = bf_hi(gw.y), g4 = bf_lo(gw.z), g5 = bf_hi(gw.z), g6 = bf_lo(gw.w), g7 = bf_hi(gw.w);
                    const f32x4 v0 = acc[ai][bj][m][0] * sc[bj][0], v1 = acc[ai][bj][m][1] * sc[bj][1];
                    u32x4 w; w.x = cvt_pk_bf16(v0[0] * g0 * sigmoid_f(g0), v0[1] * g1 * sigmoid_f(g1)); w.y = cvt_pk_bf16(v0[2] * g2 * sigmoid_f(g2), v0[3] * g3 * sigmoid_f(g3));
                    w.z = cvt_pk_bf16(v1[0] * g4 * sigmoid_f(g4), v1[1] * g5 * sigmoid_f(g5)); w.w = cvt_pk_bf16(v1[2] * g6 * sigmoid_f(g6), v1[3] * g7 * sigmoid_f(g7));
                    *(u32x4*)(O + off + bj * HALF) = w; } }
    }
};

template <class Epi, class Sched, bool ALIGN_EPI = false, bool SP2 = false>
__device__ __forceinline__ void gemm_phase(PG8_LAS unsigned char* lds, const Gemm g, const Sched& S, const Epi& E) {
    const int tid = threadIdx.x, wid = __builtin_amdgcn_readfirstlane(tid >> 6), lane = tid & 63, wr = wid >> 2, wc = wid & 3, fr = lane & 15, fq = lane >> 4;
    const int K = g.K, nt = K / BK;
    unsigned voffA[2], voffB[2];
#pragma unroll
    for (int i = 0; i < 2; ++i) { int R, C; stage_rc(tid * 16 + i * 8192, R, C); const int Rb = Epi::PERM ? ((R & ~31) + perm32(R & 31)) : R;
        voffA[i] = (unsigned)(R * g.lda + C) * 2u; voffB[i] = (unsigned)(Rb * g.ldb + C) * 2u; }
    const size_t kstep = (size_t)(BK * 2);
    const size_t hstepA = (size_t)HALF * g.lda * 2, hstepB = (size_t)HALF * g.ldb * 2;
    const size_t tstepA = 2 * hstepA, tstepB = 2 * hstepB, gstepA = (size_t)K * 2;
    const unsigned ldsw = (unsigned)wid * 1024u;
    const int aoff = lds_byte(wr * 64 + fr, fq * 8), boff = lds_byte(wc * 32 + fr, fq * 8);
#define PG8_SA(b, h) (((b) * 2 + (h)) * HTB)
#define PG8_SB(b, h) ((4 + (b) * 2 + (h)) * HTB)
#define PG8_STAGE(bufoff, gbase, voff) do { _Pragma("unroll") for (int _i = 0; _i < 2; ++_i) \
        __builtin_amdgcn_global_load_lds((const unsigned*)((const char*)(gbase) + (voff)[_i]), (PG8_LAS unsigned*)(lds + (bufoff) + ldsw + _i * 8192), 16, 0, 0); } while (0)
#define PG8_LDA(dst, b, h) do { _Pragma("unroll") for (int m = 0; m < 4; ++m) _Pragma("unroll") for (int k = 0; k < 2; ++k) dst[m][k] = *(const PG8_LAS bf16x8*)(lds + PG8_SA(b, h) + aoff + m * 2048 + k * 1024); } while (0)
#define PG8_LDB(dst, b, h) do { _Pragma("unroll") for (int n = 0; n < 2; ++n) _Pragma("unroll") for (int k = 0; k < 2; ++k) dst[n][k] = *(const PG8_LAS bf16x8*)(lds + PG8_SB(b, h) + boff + n * 2048 + k * 1024); } while (0)
#define PG8_MMA(ai, bj, At, Bt) do { __builtin_amdgcn_s_setprio(1); _Pragma("unroll") for (int m = 0; m < 4; ++m) _Pragma("unroll") for (int n = 0; n < 2; ++n) _Pragma("unroll") for (int k = 0; k < 2; ++k) \
        acc[ai][bj][m][n] = __builtin_amdgcn_mfma_f32_16x16x32_bf16(Bt[n][k], At[m][k], acc[ai][bj][m][n], 0, 0, 0); __builtin_amdgcn_s_setprio(0); } while (0)
#define PG8_WAIT_V(n) asm volatile("s_waitcnt vmcnt(" #n ")" ::: "memory")
#define PG8_WAIT_L(n) asm volatile("s_waitcnt lgkmcnt(" #n ")" ::: "memory")
#define PG8_BAR __builtin_amdgcn_s_barrier()
#define PG8_SCHED __builtin_amdgcn_sched_barrier(0)
    Unit cur, nxt; int ui = 0;
    if (!S.next(0, cur)) return;
    cur.ord = 0;
    f32x4 acc[2][2][4][2];
#pragma unroll
    for (int a = 0; a < 2; ++a)
#pragma unroll
        for (int b = 0; b < 2; ++b)
#pragma unroll
            for (int m = 0; m < 4; ++m)
#pragma unroll
                for (int n = 0; n < 2; ++n) acc[a][b][m][n] = (f32x4){0.f, 0.f, 0.f, 0.f};
    bf16x8 At[4][2], B0[2][2], B1[2][2];
    const char* cA = (const char*)g.A + (size_t)cur.pm * tstepA + (size_t)(cur.pn >> g.gsh) * gstepA; const char* cB = (const char*)g.Bt + (size_t)cur.pn * tstepB + (size_t)(cur.pm >> g.bgsh) * gstepA;
    S.a_ready(cur);
    if constexpr (SP2) {
        PG8_STAGE(PG8_SB(0, 0), cB, voffB); PG8_STAGE(PG8_SB(0, 1), cB + hstepB, voffB); PG8_STAGE(PG8_SA(0, 0), cA, voffA); PG8_STAGE(PG8_SA(0, 1), cA + hstepA, voffA);
        if (wr == 1) PG8_BAR;
        PG8_WAIT_V(2); PG8_BAR;
        PG8_STAGE(PG8_SB(1, 0), cB + kstep, voffB); PG8_STAGE(PG8_SA(1, 0), cA + kstep, voffA); PG8_STAGE(PG8_SB(1, 1), cB + hstepB + kstep, voffB);
        PG8_WAIT_V(6); PG8_BAR;
    } else {
        PG8_STAGE(PG8_SB(0, 0), cB, voffB); PG8_STAGE(PG8_SA(0, 0), cA, voffA); PG8_STAGE(PG8_SB(0, 1), cB + hstepB, voffB); PG8_STAGE(PG8_SA(0, 1), cA + hstepA, voffA);
        if (wr == 1) PG8_BAR;
        PG8_WAIT_V(4); PG8_BAR;
        PG8_STAGE(PG8_SB(1, 0), cB + kstep, voffB); PG8_STAGE(PG8_SA(1, 0), cA + kstep, voffA); PG8_STAGE(PG8_SB(1, 1), cB + hstepB + kstep, voffB);
        PG8_WAIT_V(6); PG8_BAR;
    }
    for (;;) {
        const bool has_next = S.next(ui + 1, nxt); nxt.ord = ui + 1;
        const char* nA = has_next ? (const char*)g.A + (size_t)nxt.pm * tstepA + (size_t)(nxt.pn >> g.gsh) * gstepA : cA; const char* nB = has_next ? (const char*)g.Bt + (size_t)nxt.pn * tstepB + (size_t)(nxt.pm >> g.bgsh) * gstepA : cB;
        for (int t = 0; t < nt; t += 2) {
            const bool last = (t == nt - 2);
            const char* a1 = cA + (size_t)(t + 1) * kstep;
            const char* a2 = last ? nA : cA + (size_t)(t + 2) * kstep; const char* b2 = last ? nB : cB + (size_t)(t + 2) * kstep;
            const char* a3 = a2 + kstep; const char* b3 = b2 + kstep;
            if (last && has_next) S.a_ready(nxt);
            if constexpr (SP2) {
            PG8_LDB(B0, 0, 0); PG8_LDB(B1, 0, 1); PG8_SCHED; PG8_LDA(At, 0, 0); PG8_STAGE(PG8_SA(1, 1), a1 + hstepA, voffA);
            PG8_WAIT_V(8); PG8_WAIT_L(0); PG8_BAR; PG8_MMA(0, 0, At, B0); PG8_MMA(0, 1, At, B1); PG8_BAR; PG8_SCHED;
            PG8_LDA(At, 0, 1); PG8_STAGE(PG8_SB(0, 0), b2, voffB); PG8_STAGE(PG8_SB(0, 1), b2 + hstepB, voffB); PG8_STAGE(PG8_SA(0, 0), a2, voffA);
            PG8_WAIT_V(8); PG8_WAIT_L(0); PG8_BAR; PG8_MMA(1, 0, At, B0); PG8_MMA(1, 1, At, B1); PG8_BAR; PG8_SCHED;
            PG8_LDB(B0, 1, 0); PG8_LDB(B1, 1, 1); PG8_SCHED; PG8_LDA(At, 1, 0); PG8_STAGE(PG8_SA(0, 1), a2 + hstepA, voffA);
            PG8_WAIT_V(8); PG8_WAIT_L(0); PG8_BAR; PG8_MMA(0, 0, At, B0); PG8_MMA(0, 1, At, B1); PG8_BAR; PG8_SCHED;
            PG8_LDA(At, 1, 1); PG8_STAGE(PG8_SB(1, 0), b3, voffB); PG8_STAGE(PG8_SB(1, 1), b3 + hstepB, voffB); PG8_STAGE(PG8_SA(1, 0), a3, voffA);
            PG8_WAIT_V(8); PG8_WAIT_L(0); PG8_BAR; PG8_MMA(1, 0, At, B0); PG8_MMA(1, 1, At, B1); PG8_BAR; PG8_SCHED;
            } else {
            PG8_LDB(B0, 0, 0); PG8_SCHED; PG8_LDA(At, 0, 0); PG8_STAGE(PG8_SA(1, 1), a1 + hstepA, voffA);
            PG8_WAIT_L(8); PG8_BAR; PG8_WAIT_L(0); PG8_MMA(0, 0, At, B0); PG8_BAR; PG8_SCHED;
            PG8_LDB(B1, 0, 1); PG8_STAGE(PG8_SB(0, 0), b2, voffB);
            PG8_BAR; PG8_WAIT_L(0); PG8_MMA(0, 1, At, B1); PG8_BAR;
            PG8_LDA(At, 0, 1); PG8_STAGE(PG8_SA(0, 0), a2, voffA);
            PG8_BAR; PG8_WAIT_L(0); PG8_MMA(1, 0, At, B0); PG8_BAR; PG8_SCHED;
            PG8_STAGE(PG8_SB(0, 1), b2 + hstepB, voffB);
            PG8_WAIT_V(6); PG8_BAR; PG8_MMA(1, 1, At, B1); PG8_BAR;
            PG8_LDB(B0, 1, 0); PG8_SCHED; PG8_LDA(At, 1, 0); PG8_STAGE(PG8_SA(0, 1), a2 + hstepA, voffA);
            PG8_WAIT_L(8); PG8_BAR; PG8_WAIT_L(0); PG8_MMA(0, 0, At, B0); PG8_BAR; PG8_SCHED;
            PG8_LDB(B1, 1, 1); PG8_STAGE(PG8_SB(1, 0), b3, voffB);
            PG8_BAR; PG8_WAIT_L(0); PG8_MMA(0, 1, At, B1); PG8_BAR;
            PG8_LDA(At, 1, 1); PG8_STAGE(PG8_SA(1, 0), a3, voffA);
            PG8_BAR; PG8_WAIT_L(0); PG8_MMA(1, 0, At, B0); PG8_BAR; PG8_SCHED;
            PG8_STAGE(PG8_SB(1, 1), b3 + hstepB, voffB);
            PG8_WAIT_V(6); PG8_BAR; PG8_MMA(1, 1, At, B1); PG8_BAR;
            }
        }
        if constexpr (ALIGN_EPI) { if (wr == 0) PG8_BAR; }
        if constexpr (!Epi::AFTER_DRAIN) { E(acc, cur, wr, wc, fr, fq); S.done(cur); }
        if (!has_next) break;
#pragma unroll
        for (int a = 0; a < 2; ++a)
#pragma unroll
            for (int b = 0; b < 2; ++b)
#pragma unroll
                for (int m = 0; m < 4; ++m)
#pragma unroll
                    for (int n = 0; n < 2; ++n) acc[a][b][m][n] = (f32x4){0.f, 0.f, 0.f, 0.f};
        cur = nxt; cA = nA; cB = nB; ++ui;
        if constexpr (ALIGN_EPI) { if (wr == 1) PG8_BAR; }
    }
    PG8_WAIT_V(0);
    if constexpr (!ALIGN_EPI) { if (wr == 0) PG8_BAR; }
    PG8_BAR;
    if constexpr (Epi::AFTER_DRAIN) { E.fused(acc, cur, wr, wc, fr, fq, lds, wid, lane); S.done(cur); }
#undef PG8_SA
#undef PG8_SB
#undef PG8_STAGE
#undef PG8_LDA
#undef PG8_LDB
#undef PG8_MMA
#undef PG8_WAIT_V
#undef PG8_WAIT_L
#undef PG8_BAR
#undef PG8_SCHED
}

}

constexpr int NWAVES = 8;
constexpr int BATCH = 4, SEQ = 4096, DM = 2048, M = BATCH * SEQ;
constexpr int DI = 4096, HD = 64, NH = 64, NG = 8, HPG = 8, NS = 128, CONVK = 4;
constexpr int CONV_DIM = DI + 2 * NG * NS;
constexpr int SSM_IN = DI + CONV_DIM + NH;
constexpr int N1 = DI + CONV_DIM;
constexpr int BCW = 2 * NG * NS;
constexpr int DP = 4096, PG = 4, PGD = 1024;
constexpr float EPS = 1e-6f;

constexpr size_t MiB = 1u << 20;
constexpr size_t WS_CTL = 0, CTL_ZERO_BYTES = 1 * MiB;
constexpr size_t WS_DT  = 1 * MiB;
constexpr size_t WS_W1T = 5 * MiB;
constexpr size_t WS_W2T = 46 * MiB;
constexpr size_t WS_W3T = 62 * MiB;
constexpr size_t WS_W4T = 94 * MiB;
constexpr size_t WS_W5T = 102 * MiB;
constexpr size_t WS_RA  = 120 * MiB;
constexpr size_t WS_RB  = 248 * MiB;
constexpr size_t WS_RC  = 440 * MiB;
constexpr size_t WS_SSQP = 504 * MiB;
constexpr size_t WS_END = 512 * MiB;
static_assert(WS_W1T + (size_t)SSM_IN * DM * 2 <= WS_W2T && WS_W2T + (size_t)DM * DI * 2 <= WS_W3T && WS_W3T + (size_t)2 * DP * DM * 2 <= WS_W4T && WS_W4T + (size_t)DP * PGD * 2 <= WS_W5T && WS_W5T + (size_t)DM * DP * 2 <= WS_RA, "weights map");
static_assert(WS_RA + (size_t)M * DI * 2 <= WS_RB && WS_RB + (size_t)M * CONV_DIM * 2 <= WS_RC && WS_RC + (size_t)M * DM * 2 <= WS_END && WS_RB + 128 * MiB + (size_t)M * DP * 2 <= WS_END, "activation map");
constexpr int CW_TMO = 64, CW_FIN = 8192;
constexpr int CW_BAR = 4096;
constexpr int CW_SSQ1 = 16384, CW_SSQ2 = CW_SSQ1 + M, CW_SSQ3 = CW_SSQ2 + M;
static_assert((CW_SSQ3 + M) * 4 <= (int)CTL_ZERO_BYTES, "CTL words inside the memset region");

constexpr int RING_OFF = 0, RING_BYTES = 159744;
constexpr int LDSCTL_OFF = RING_BYTES, MISC_OFF = LDSCTL_OFF + 320;
constexpr int LDS_BYTES = 163840;
static_assert(MISC_OFF + 128 <= LDS_BYTES, "LDS map");

#define LAS __attribute__((address_space(3)))
typedef unsigned short bf16;
typedef unsigned v4u __attribute__((ext_vector_type(4)));
typedef unsigned v2u __attribute__((ext_vector_type(2)));
typedef float f32x4 __attribute__((ext_vector_type(4)));
typedef short bf16x8 __attribute__((ext_vector_type(8)));
#define LDS_WAIT() asm volatile("s_waitcnt lgkmcnt(0)" ::: "memory")
#define VM_WAIT() asm volatile("s_waitcnt vmcnt(0)" ::: "memory")
__device__ __forceinline__ unsigned f2bf(float f) { unsigned u = __builtin_bit_cast(unsigned, f); return (u + 0x7fffu + ((u >> 16) & 1u)) >> 16; }
__device__ __forceinline__ unsigned pk2(float lo, float hi) { return f2bf(lo) | (f2bf(hi) << 16); }
__device__ __forceinline__ float bflo(unsigned w) { return __uint_as_float(w << 16); }
__device__ __forceinline__ float bfhi(unsigned w) { return __uint_as_float(w & 0xffff0000u); }
__device__ __forceinline__ float bf1(bf16 v) { return __uint_as_float(((unsigned)v) << 16); }
__device__ __forceinline__ float sigm(float v) { return __builtin_amdgcn_rcpf(1.0f + __builtin_amdgcn_exp2f(-1.4426950408889634f * v)); }
__device__ __forceinline__ float wave_sum(float v) {
#pragma unroll
    for (int o = 1; o < 64; o <<= 1) v += __shfl_xor(v, o);
    return v;
}

#define XB_TMO      128
#define XB_XCNT(j)  (256  + 64 * (j))
#define XB_XSUB(j)  (1280 + 64 * (j))
#define XB_XGEN(j)  (2304 + 64 * (j))
#define XB_TOP      3328
#define XB_TOPGEN   3392
#define XCD_BAR_WORDS 3456
#define XB_SPIN_CAP (1u << 18)

__device__ __forceinline__ unsigned xb_ld(unsigned* p)              { return __hip_atomic_load(p, __ATOMIC_RELAXED, __HIP_MEMORY_SCOPE_AGENT); }
__device__ __forceinline__ unsigned xb_add(unsigned* p, unsigned v) { return __hip_atomic_fetch_add(p, v, __ATOMIC_RELAXED, __HIP_MEMORY_SCOPE_AGENT); }
__device__ __forceinline__ unsigned xb_xcc_id() { return (unsigned)__builtin_amdgcn_s_getreg((3 << 11) | 20) & 0xFu; }
#define XB_SPIN(cond, bar) do { unsigned _sp = 0; while (cond) { __builtin_amdgcn_s_sleep(1); \
    if ((++_sp & 255u) == 0u) { if (xb_ld(&(bar)[XB_TMO])) break; if (_sp > XB_SPIN_CAP) { atomicAdd(&(bar)[XB_TMO], 1u); break; } } } } while (0)

struct XcdBarrier {
    unsigned* bar; unsigned x;
    volatile LAS unsigned* st;
};

__device__ __forceinline__ XcdBarrier xcd_barrier_post(unsigned* bar, volatile LAS unsigned* st) {
    XcdBarrier b; b.bar = bar; b.x = xb_xcc_id(); b.st = st;
    if (threadIdx.x == 0) (void)xb_add(&bar[XB_XCNT(b.x)], 1u);
    return b;
}
__device__ __forceinline__ void xcd_barrier_complete(unsigned* bar, unsigned x, unsigned& nloc, unsigned& nx) {
    const unsigned G = gridDim.x * gridDim.y * gridDim.z;
    unsigned sum, cnt, mine, sp = 0u;
    for (;;) {
        sum = 0u; cnt = 0u; mine = 0u;
#pragma unroll
        for (unsigned j = 0; j < 16; ++j) { const unsigned c = xb_ld(&bar[XB_XCNT(j)]); sum += c; cnt += (c > 0u) ? 1u : 0u; mine = (j == x) ? c : mine; }
        if (sum == G) break;
        __builtin_amdgcn_s_sleep(1);
        if ((++sp & 255u) == 0u) { if (xb_ld(&bar[XB_TMO])) break; if (sp > XB_SPIN_CAP) { atomicAdd(&bar[XB_TMO], 1u); break; } }
    }
    nloc = mine > 0u ? mine : 1u; nx = cnt > 0u ? cnt : 1u;
}

__device__ __forceinline__ void xcd_barrier(const XcdBarrier& b) {
    asm volatile("s_waitcnt vmcnt(0)" ::: "memory");
    __syncthreads();
    if (threadIdx.x == 0) {
        unsigned* bar = b.bar;
        __builtin_amdgcn_s_waitcnt(0);
        unsigned nloc = b.st[0], nx = b.st[1];
        if (nloc == 0u) { xcd_barrier_complete(bar, b.x, nloc, nx); b.st[0] = nloc; b.st[1] = nx; }
        const unsigned old = xb_add(&bar[XB_XSUB(b.x)], 1u);
        const unsigned gen = old / nloc;
        if (old + 1u == (gen + 1u) * nloc) {
            __builtin_amdgcn_fence(__ATOMIC_RELEASE, "agent");
            asm volatile("s_waitcnt vmcnt(0)" ::: "memory");
            const unsigned og = xb_add(&bar[XB_TOP], 1u);
            const unsigned tg = og / nx;
            if (og + 1u == (tg + 1u) * nx) xb_add(&bar[XB_TOPGEN], 1u);
            else XB_SPIN(xb_ld(&bar[XB_TOPGEN]) == tg, bar);
            __builtin_amdgcn_fence(__ATOMIC_ACQUIRE, "agent");
            xb_add(&bar[XB_XGEN(b.x)], 1u);
            asm volatile("s_waitcnt vmcnt(0)" ::: "memory");
        } else {
            XB_SPIN(xb_ld(&bar[XB_XGEN(b.x)]) == gen, bar);
            __builtin_amdgcn_fence(__ATOMIC_ACQUIRE, "agent");
            asm volatile("s_waitcnt vmcnt(0)" ::: "memory");
        }
    }
    __syncthreads();
}

struct Ctx { LAS unsigned char* lds; int tid, lane, wave, G, vcu; };

struct Ptrs {
    const float *x, *ln_g, *final_g, *ssm_w_in, *conv_w, *conv_b, *dt_bias, *a_log, *ssm_d, *norm_g, *ssm_w_out, *pool_w_in, *pool_w_group, *pool_scale, *pool_w_out;
    float* out; unsigned char* ws;
};

__device__ __forceinline__ void t_decode(const Ptrs& P, int it, const float*& src, const float*& gain, bf16*& dst, int& ldw, int& K) {
    constexpr int I1 = (DM / 64) * (SSM_IN / 32), I2 = (DI / 64) * (DM / 32), I3 = (DM / 64) * (DP / 32), I4G = (PGD / 64) * (PGD / 32), I4 = PG * I4G;
    const float* W; const float* g; bf16* WT; int N, row_off = 0, r = it;
    if (r < I1) { W = P.ssm_w_in; g = P.ln_g; K = DM; N = SSM_IN; ldw = SSM_IN; WT = (bf16*)(P.ws + WS_W1T); }
    else if ((r -= I1) < I2) { W = P.ssm_w_out; g = P.norm_g; K = DI; N = DM; ldw = DM; WT = (bf16*)(P.ws + WS_W2T); }
    else if ((r -= I2) < I3) { W = P.pool_w_in + DP; g = P.ln_g + DM; K = DM; N = DP; ldw = 2 * DP; WT = (bf16*)(P.ws + WS_W3T); row_off = DP; }
    else if ((r -= I3) < I4) { const int gi = r / I4G; r -= gi * I4G; W = P.pool_w_group + (size_t)gi * PGD * PGD; g = nullptr; K = PGD; N = PGD; ldw = PGD; WT = (bf16*)(P.ws + WS_W4T); row_off = gi * PGD; }
    else { r -= I4; W = P.pool_w_out; g = nullptr; K = DP; N = DM; ldw = DM; WT = (bf16*)(P.ws + WS_W5T); }
    const int nblk = N / 32, kb = r / nblk, nb = r - kb * nblk, k0 = 64 * kb, n0 = 32 * nb;
    src = W + (size_t)k0 * ldw + n0; gain = g ? g + k0 : nullptr; dst = WT + (size_t)(row_off + n0) * K + k0;
}
__device__ __forceinline__ void t_load(const float* src, const float* gain, int ldw, int lane, f32x4 (&v)[8], float (&gv)[8]) {
#pragma unroll
    for (int i = 0; i < 8; ++i) { const int kk = 8 * i + (lane >> 3); v[i] = *(const f32x4*)(src + (size_t)kk * ldw + 4 * (lane & 7)); gv[i] = gain ? gain[kk] : 1.0f; }
}
__device__ __forceinline__ void t_process(bf16* dst, int K, int lane, LAS float* scr, const f32x4 (&v)[8], const float (&gv)[8]) {
#pragma unroll
    for (int i = 0; i < 8; ++i) *(LAS f32x4*)(scr + (8 * i + (lane >> 3)) * 32 + (((lane & 7) ^ i) << 2)) = v[i] * gv[i];
    LDS_WAIT(); asm volatile("" ::: "memory");
    const int c = lane & 7, nn = lane >> 3;
#pragma unroll
    for (int j = 0; j < 4; ++j) { const int n = nn + 8 * j; const LAS float* s = scr + (8 * c) * 32 + (((n >> 2) ^ c) << 2) + (n & 3);
        v4u o; o.x = pk2(s[0 * 32], s[1 * 32]); o.y = pk2(s[2 * 32], s[3 * 32]); o.z = pk2(s[4 * 32], s[5 * 32]); o.w = pk2(s[6 * 32], s[7 * 32]);
        *(v4u*)(dst + (size_t)n * K + 8 * c) = o; }
    LDS_WAIT(); asm volatile("" ::: "memory");
}
__device__ __forceinline__ void r_decode(const Ptrs& P, int r, const float*& src, bf16*& dst, float& scale, float*& ssq) {
    if (r < M) { src = P.x + (size_t)r * DM; dst = (bf16*)(P.ws + WS_RC) + (size_t)r * DM; scale = 1.0f; ssq = (float*)(P.ws + WS_CTL) + CW_SSQ1 + r; }
    else { const int rr = r - M, m = rr >> 1, hf = rr & 1; src = P.pool_w_in + (size_t)m * 2 * DP + hf * DM; dst = (bf16*)P.out + (size_t)m * DP + hf * DM; scale = P.ln_g[DM + m]; ssq = nullptr; }
}
__device__ __forceinline__ void r_load(const float* src, int lane, f32x4 (&v)[8]) {
#pragma unroll
    for (int j = 0; j < 8; ++j) v[j] = ((const f32x4*)src)[lane + 64 * j];
}
__device__ __forceinline__ void r_process(bf16* dst, float scale, float* ssq, int lane, const f32x4 (&v)[8]) {
    if (ssq) { float s = 0.f;
#pragma unroll
        for (int j = 0; j < 8; ++j) s += (v[j].x * v[j].x + v[j].y * v[j].y) + (v[j].z * v[j].z + v[j].w * v[j].w);
        s = wave_sum(s); if (lane == 0) *ssq = s; }
#pragma unroll
    for (int j = 0; j < 8; ++j) { v2u w; w.x = pk2(v[j].x * scale, v[j].y * scale); w.y = pk2(v[j].z * scale, v[j].w * scale); ((v2u*)dst)[lane + 64 * j] = w; }
}
__device__ __forceinline__ int t_map(int li, int mode) {
    constexpr int I1 = (DM / 64) * (SSM_IN / 32), I2 = (DI / 64) * (DM / 32), I3 = (DM / 64) * (DP / 32), I4 = PG * (PGD / 64) * (PGD / 32);
    return mode == 0 ? (li < I1 ? li : li + I2) : (li < I2 ? I1 + li : I1 + I3 + I4 + li);
}
__device__ __forceinline__ void prep_transposes(const Ctx& F, const Ptrs& P, int mode, int gw, int NGW) {
    LAS float* scr = (LAS float*)(F.lds + RING_OFF + F.wave * 16384);
    const int lane = F.lane;
    constexpr int I1 = (DM / 64) * (SSM_IN / 32), I2 = (DI / 64) * (DM / 32), I3 = (DM / 64) * (DP / 32), I4 = PG * (PGD / 64) * (PGD / 32), I5 = (DP / 64) * (DM / 32);
    const int NT = mode == 0 ? I1 + I3 + I4 : I2 + I5;
    if (gw >= NT) return;
    const int cnt = (NT - gw + NGW - 1) / NGW;
    const float *sA, *gA, *sB, *gB; bf16 *dA, *dB; int lA, kA, lB, kB; f32x4 vA[8], vB[8]; float fA[8], fB[8];
    t_decode(P, t_map(gw, mode), sA, gA, dA, lA, kA); t_load(sA, gA, lA, lane, vA, fA);
    for (int j = 0; j < cnt; j += 2) {
        { const int jn = (j + 1 < cnt) ? j + 1 : cnt - 1; t_decode(P, t_map(gw + jn * NGW, mode), sB, gB, dB, lB, kB); t_load(sB, gB, lB, lane, vB, fB); }
        t_process(dA, kA, lane, scr, vA, fA);
        { const int jn = (j + 2 < cnt) ? j + 2 : cnt - 1; t_decode(P, t_map(gw + jn * NGW, mode), sA, gA, dA, lA, kA); t_load(sA, gA, lA, lane, vA, fA); }
        if (j + 1 < cnt) t_process(dB, kB, lane, scr, vB, fB);
    }
}
__device__ __forceinline__ void phase_prep(const Ctx& F, const Ptrs& P) {
    const int gw = F.vcu * NWAVES + F.wave, NGW = F.G * NWAVES, lane = F.lane;
    prep_transposes(F, P, 0, gw, NGW);
    {
        constexpr int NR = M + 2 * DM;
        const int cnt = (NR - gw + NGW - 1) / NGW;
        const float *sA, *sB; bf16 *dA, *dB; float cA, cB; float *qA, *qB; f32x4 vA[8], vB[8];
        r_decode(P, gw, sA, dA, cA, qA); r_load(sA, lane, vA);
        for (int j = 0; j < cnt; j += 2) {
            { const int jn = (j + 1 < cnt) ? j + 1 : cnt - 1; r_decode(P, gw + jn * NGW, sB, dB, cB, qB); r_load(sB, lane, vB); }
            r_process(dA, cA, qA, lane, vA);
            { const int jn = (j + 2 < cnt) ? j + 2 : cnt - 1; r_decode(P, gw + jn * NGW, sA, dA, cA, qA); r_load(sA, lane, vA); }
            if (j + 1 < cnt) r_process(dB, cB, qB, lane, vB);
        }
    }
}

__device__ __forceinline__ float softplus_f(float v) { return fmaxf(v, 0.f) + log1pf(expf(-fabsf(v))); }

__device__ __forceinline__ void phase_dt(const Ctx& F, const Ptrs& P) {
    const bf16* XB = (const bf16*)(P.ws + WS_RC); const bf16* WDT = (const bf16*)(P.ws + WS_W1T) + (size_t)N1 * DM;
    const float* ssq1 = (const float*)(P.ws + WS_CTL) + CW_SSQ1; float* DT = (float*)(P.ws + WS_DT);
    LAS float* part = (LAS float*)F.lds;
    const int w = F.wave, lane = F.lane, fr = lane & 15, fq = lane >> 4;
    for (int item = F.vcu; item < M / 64; item += F.G) {
        const int r0 = item * 64;
        f32x4 acc[4][4];
#pragma unroll
        for (int i = 0; i < 4; ++i)
#pragma unroll
            for (int j = 0; j < 4; ++j) acc[i][j] = (f32x4){0.f, 0.f, 0.f, 0.f};
        const bf16* ap = XB + (size_t)(r0 + fr) * DM + w * 256 + 8 * fq;
        const bf16* bp = WDT + (size_t)fr * DM + w * 256 + 8 * fq;
#pragma unroll
        for (int hf = 0; hf < 2; ++hf) {
            bf16x8 a[4][4], b[4][4];
#pragma unroll
            for (int ks = 0; ks < 4; ++ks)
#pragma unroll
                for (int t = 0; t < 4; ++t) { a[ks][t] = *(const bf16x8*)(ap + (size_t)(16 * t) * DM + 32 * (4 * hf + ks)); b[ks][t] = *(const bf16x8*)(bp + (size_t)(16 * t) * DM + 32 * (4 * hf + ks)); }
#pragma unroll
            for (int ks = 0; ks < 4; ++ks)
#pragma unroll
                for (int rt = 0; rt < 4; ++rt)
#pragma unroll
                    for (int ct = 0; ct < 4; ++ct) acc[rt][ct] = __builtin_amdgcn_mfma_f32_16x16x32_bf16(a[ks][rt], b[ks][ct], acc[rt][ct], 0, 0, 0);
        }
#pragma unroll
        for (int rt = 0; rt < 4; ++rt)
#pragma unroll
            for (int ct = 0; ct < 4; ++ct) *(LAS f32x4*)(part + (size_t)w * 4096 + (16 * ct + fr) * 64 + 16 * rt + 4 * fq) = acc[rt][ct];
        __syncthreads();
        {
            const int hd = F.tid & 63, rb = 8 * (F.tid >> 6);
            f32x4 s0 = (f32x4){0.f, 0.f, 0.f, 0.f}, s1 = s0;
#pragma unroll
            for (int pw = 0; pw < 8; ++pw) { s0 = s0 + *(const LAS f32x4*)(part + (size_t)pw * 4096 + hd * 64 + rb); s1 = s1 + *(const LAS f32x4*)(part + (size_t)pw * 4096 + hd * 64 + rb + 4); }
            const float bias = P.dt_bias[hd];
#pragma unroll
            for (int i = 0; i < 8; ++i) { const int row = r0 + rb + i; const float sc = rsqrtf(ssq1[row] * (1.0f / DM) + EPS); const float v = (i < 4 ? s0[i & 3] : s1[i & 3]) * sc + bias;
                DT[(size_t)row * NH + hd] = softplus_f(v); }
        }
        __syncthreads();
    }
}

constexpr int IMG_C = 0, IMG_B = 16384, IMG_BT = 32768, IMG_BYTES = 49152;
constexpr int SC_BYTES = 1024, BL_C = 0, BL_BT = 16384, BL_CBT = 32768, BL_SC = BL_CBT + 10 * 1024, BLOB_BYTES = BL_SC + 8 * SC_BYTES;
constexpr int MAIN_BYTES = 32768 + SC_BYTES, HEAD_BYTES = 10 * 1024 + SC_BYTES;
constexpr int SL_MAIN = 0, SL_HEAD = 2 * MAIN_BYTES, SL_XT = SL_HEAD + 2 * HEAD_BYTES, SL_XWT = SL_XT + 2 * 8192, SL_P = SL_XWT + 2 * 8192, SL_YT = SL_P + 2 * 8192, SL_END = SL_YT + 2 * 8192;
static_assert(SL_END <= RING_BYTES, "SSD LDS map");
__device__ __forceinline__ int img256(int r, int c) { return r * 256 + ((c ^ (r & 15)) << 4); }
__device__ __forceinline__ int img128(int r, int c) { return r * 128 + ((c ^ ((r >> 1) & 7)) << 4); }
typedef __bf16 bf16x2_t __attribute__((ext_vector_type(2)));
typedef float f32x2_t __attribute__((ext_vector_type(2)));
__device__ __forceinline__ unsigned cvtpk(float lo, float hi) { f32x2_t v = {lo, hi}; bf16x2_t b = __builtin_convertvector(v, bf16x2_t); return __builtin_bit_cast(unsigned, b); }
#define RAW_BARRIER() do { asm volatile("s_waitcnt lgkmcnt(0)" ::: "memory"); __builtin_amdgcn_s_barrier(); asm volatile("" ::: "memory"); } while (0)

__device__ __forceinline__ void bc_load(const bf16* XBC, const float* DT, int unit, int isC, int n0, int tg, int wave, int lane, v4u (&raw)[7], float& dtv) {
    const int g = unit % NG, bc = unit / NG, c = bc % (SEQ / 64);
    const int ch = DI + isC * (NG * NS) + g * NS + n0;
    const size_t T0 = (size_t)bc * 64 + 4 * tg;
    const bool nohalo = (c == 0 && tg == 0);
#pragma unroll
    for (int k = 0; k < 7; ++k) { const size_t row = (k < 3 && nohalo) ? T0 : (T0 + k - 3); raw[k] = *(const v4u*)(XBC + row * CONV_DIM + ch); }
    dtv = DT[((size_t)bc * 64 + lane) * NH + g * HPG + wave];
}
__device__ __forceinline__ void bc_process(const Ctx& F, const Ptrs& P, unsigned char* IMGS, int unit, int isC, int n0, int tg, const float (&w)[4][8], const float (&bias)[8], const v4u (&rawv)[7], float dtv) {
    LAS unsigned char* L = F.lds;
    const int g = unit % NG, bc = unit / NG, c = bc % (SEQ / 64);
    const bool nohalo = (c == 0 && tg == 0);
    float raw[7][8];
#pragma unroll
    for (int k = 0; k < 7; ++k) { v4u rr = rawv[k];
        if (k < 3 && nohalo) { rr.x = 0u; rr.y = 0u; rr.z = 0u; rr.w = 0u; }
        raw[k][0] = bflo(rr.x); raw[k][1] = bfhi(rr.x); raw[k][2] = bflo(rr.y); raw[k][3] = bfhi(rr.y); raw[k][4] = bflo(rr.z); raw[k][5] = bfhi(rr.z); raw[k][6] = bflo(rr.w); raw[k][7] = bfhi(rr.w); }
    float o[4][8];
#pragma unroll
    for (int i = 0; i < 4; ++i)
#pragma unroll
        for (int j = 0; j < 8; ++j) { const float v = bias[j] + w[0][j] * raw[i][j] + w[1][j] * raw[i + 1][j] + w[2][j] * raw[i + 2][j] + w[3][j] * raw[i + 3][j]; o[i][j] = v * sigm(v); }
    const int ks = n0 >> 5, hi = (n0 >> 4) & 1, q0 = 2 * ((n0 >> 3) & 1);
    const int ibase = isC ? IMG_C : IMG_B;
#pragma unroll
    for (int i = 0; i < 4; ++i) { const int l = 4 * tg + i;
        v2u lo, hi2; lo.x = cvtpk(o[i][0], o[i][1]); lo.y = cvtpk(o[i][2], o[i][3]); hi2.x = cvtpk(o[i][4], o[i][5]); hi2.y = cvtpk(o[i][6], o[i][7]);
        *(LAS v2u*)(L + ibase + img256(l, 4 * ks + q0) + 8 * hi) = lo;
        *(LAS v2u*)(L + ibase + img256(l, 4 * ks + q0 + 1) + 8 * hi) = hi2; }
    if (!isC) {
#pragma unroll
        for (int e = 0; e < 8; ++e) { v2u t; t.x = cvtpk(o[0][e], o[1][e]); t.y = cvtpk(o[2][e], o[3][e]);
            *(LAS v2u*)(L + IMG_BT + img128(n0 + e, tg >> 1) + 8 * (tg & 1)) = t; }
    }
    RAW_BARRIER();
    unsigned char* blob = IMGS + (size_t)unit * BLOB_BYTES;
#pragma unroll
    for (int k = 0; k < 2; ++k) { const v4u vc = *(const LAS v4u*)(L + IMG_C + F.tid * 16 + k * 8192), vt = *(const LAS v4u*)(L + IMG_BT + F.tid * 16 + k * 8192);
        *(v4u*)(blob + BL_C + F.tid * 16 + k * 8192) = vc; *(v4u*)(blob + BL_BT + F.tid * 16 + k * 8192) = vt; }
    {
        const int w = F.wave, r = F.lane & 15, q = F.lane >> 4;
        const int lt0 = (w < 4) ? w : (w == 4) ? 1 : (w == 5) ? 2 : 3, st0 = (w < 4) ? w : (w == 4) ? 0 : (w == 7) ? 2 : 1;
#pragma unroll
        for (int tt = 0; tt < 2; ++tt) { if (tt == 1 && (w < 4 || w > 5)) break;
            const int lt = tt ? lt0 + 1 : lt0, st = tt ? 0 : st0;
            f32x4 cb = {0.f, 0.f, 0.f, 0.f};
#pragma unroll
            for (int ks = 0; ks < 4; ++ks) { const bf16x8 av = *(const LAS bf16x8*)(L + IMG_C + img256(16 * lt + r, 4 * ks + q)), bv = *(const LAS bf16x8*)(L + IMG_B + img256(16 * st + r, 4 * ks + q));
                cb = __builtin_amdgcn_mfma_f32_16x16x32_bf16(av, bv, cb, 0, 0, 0); }
            *(f32x4*)(blob + BL_CBT + (tt ? 8 + (w - 4) : w) * 1024 + F.lane * 16) = cb; }
    }
    {
        const int hh = g * HPG + F.wave; const float a = -expf(P.a_log[hh]);
        float cs = a * dtv;
#pragma unroll
        for (int o2 = 1; o2 < 64; o2 <<= 1) { const float t = __shfl_up(cs, o2); if (F.lane >= o2) cs += t; }
        const float last = __shfl(cs, 63);
        float* sc = (float*)(blob + BL_SC + F.wave * SC_BYTES);
        sc[F.lane] = dtv; sc[64 + F.lane] = cs; sc[128 + F.lane] = __expf(cs); sc[192 + F.lane] = dtv * __expf(last - cs);
    }
    RAW_BARRIER();
}
__device__ __forceinline__ void phase_bcprep(const Ctx& F, const Ptrs& P) {
    const bf16* XBC = (const bf16*)(P.ws + WS_RB); unsigned char* IMGS = (unsigned char*)P.out; const float* DT = (const float*)(P.ws + WS_DT);
    const int cg = F.tid & 31, tg = F.tid >> 5, isC = cg >> 4, n0 = 8 * (cg & 15);
    constexpr int NU = BATCH * (SEQ / 64) * NG;
    if (F.G % NG != 0 || F.vcu >= NU) return;
    const int g = F.vcu % NG, ch = DI + isC * (NG * NS) + g * NS + n0, cnt = (NU - F.vcu + F.G - 1) / F.G;
    float w[4][8], bias[8];
#pragma unroll
    for (int k = 0; k < 4; ++k) { const f32x4 a = *(const f32x4*)(P.conv_w + (size_t)k * CONV_DIM + ch), b = *(const f32x4*)(P.conv_w + (size_t)k * CONV_DIM + ch + 4);
        w[k][0] = a.x; w[k][1] = a.y; w[k][2] = a.z; w[k][3] = a.w; w[k][4] = b.x; w[k][5] = b.y; w[k][6] = b.z; w[k][7] = b.w; }
    { const f32x4 a = *(const f32x4*)(P.conv_b + ch), b = *(const f32x4*)(P.conv_b + ch + 4); bias[0] = a.x; bias[1] = a.y; bias[2] = a.z; bias[3] = a.w; bias[4] = b.x; bias[5] = b.y; bias[6] = b.z; bias[7] = b.w; }
    v4u rA[7], rB[7]; float dA, dB;
    bc_load(XBC, DT, F.vcu, isC, n0, tg, F.wave, F.lane, rA, dA);
    for (int j = 0; j < cnt; j += 2) {
        { const int jn = (j + 1 < cnt) ? j + 1 : j; bc_load(XBC, DT, F.vcu + jn * F.G, isC, n0, tg, F.wave, F.lane, rB, dB); }
        bc_process(F, P, IMGS, F.vcu + j * F.G, isC, n0, tg, w, bias, rA, dA);
        if (j + 1 < cnt) {
            { const int jn = (j + 2 < cnt) ? j + 2 : j + 1; bc_load(XBC, DT, F.vcu + jn * F.G, isC, n0, tg, F.wave, F.lane, rA, dA); }
            bc_process(F, P, IMGS, F.vcu + (j + 1) * F.G, isC, n0, tg, w, bias, rB, dB);
        }
    }
}

__device__ __forceinline__ int dpp_i(int v, const int ctrl_sel) { return ctrl_sel == 0 ? __builtin_amdgcn_update_dpp(0, v, 0xB1, 0xF, 0xF, false) : ctrl_sel == 1 ? __builtin_amdgcn_update_dpp(0, v, 0x4E, 0xF, 0xF, false) : __builtin_amdgcn_update_dpp(0, v, 0x141, 0xF, 0xF, false); }
__device__ __forceinline__ float dpp_add(float v, const int sel) { return v + __int_as_float(dpp_i(__float_as_int(v), sel)); }
template <bool DIAG> __device__ __forceinline__ void ssd_p_tile(LAS unsigned char* Pbuf, const LAS unsigned char* CBT, const LAS float* SC, int slot, int lane, int lt, int st, int r, int q, float Dh) {
    const f32x4 cb = *(const LAS f32x4*)(CBT + slot * 1024 + lane * 16);
    const f32x4 csl = *(const LAS f32x4*)(SC + 64 + 16 * lt + 4 * q);
    const int s = 16 * st + r; const float cs_s = SC[64 + s], dt_s = SC[s];
#pragma unroll
    for (int rg = 0; rg < 4; ++rg) { const int l = 16 * lt + 4 * q + rg; float v;
        if (DIAG) { v = cb[rg] * __expf(fminf(csl[rg] - cs_s, 0.f)) * dt_s; v = (s <= l) ? v : 0.f; if (s == l) v += Dh; }
        else v = cb[rg] * __expf(csl[rg] - cs_s) * dt_s;
        *(LAS unsigned short*)(Pbuf + img128(l, s >> 3) + (s & 7) * 2) = (unsigned short)(cvtpk(v, 0.f) & 0xffffu); }
}
struct ConvW { float a[4], b[4], ba, bb; };
__device__ __forceinline__ void ssd_head(LAS unsigned char* L, int par, int hpar, bool first_chunk, const unsigned (&xr)[7], int w, int lane, int r, int q, const ConvW& cw, float Dh) {
    const LAS unsigned char* HD = L + SL_HEAD + hpar * HEAD_BYTES; const LAS float* SC = (const LAS float*)(HD + 10 * 1024);
    {
        const int cp = lane & 31, hf = lane >> 5;
        const f32x4 wv4 = *(const LAS f32x4*)(SC + 192 + 8 * w + 4 * hf);
        float xa[7], xc[7];
#pragma unroll
        for (int k = 0; k < 7; ++k) { const bool zpad = first_chunk && w == 0 && hf == 0 && k < 3; xa[k] = zpad ? 0.f : bflo(xr[k]); xc[k] = zpad ? 0.f : bfhi(xr[k]); }
        float oa[4], oc[4], wa[4], wc[4];
#pragma unroll
        for (int i = 0; i < 4; ++i) { const float va = cw.ba + cw.a[0] * xa[i] + cw.a[1] * xa[i + 1] + cw.a[2] * xa[i + 2] + cw.a[3] * xa[i + 3], vc = cw.bb + cw.b[0] * xc[i] + cw.b[1] * xc[i + 1] + cw.b[2] * xc[i + 2] + cw.b[3] * xc[i + 3];
            oa[i] = va * sigm(va); oc[i] = vc * sigm(vc); wa[i] = oa[i] * wv4[i]; wc[i] = oc[i] * wv4[i]; }
        v2u t; LAS unsigned char* XTb = L + SL_XT + par * 8192; LAS unsigned char* XWb = L + SL_XWT + par * 8192;
        const int o0 = img128(2 * cp, w) + 8 * hf, o1 = img128(2 * cp + 1, w) + 8 * hf;
        t.x = cvtpk(oa[0], oa[1]); t.y = cvtpk(oa[2], oa[3]); *(LAS v2u*)(XTb + o0) = t;
        t.x = cvtpk(oc[0], oc[1]); t.y = cvtpk(oc[2], oc[3]); *(LAS v2u*)(XTb + o1) = t;
        t.x = cvtpk(wa[0], wa[1]); t.y = cvtpk(wa[2], wa[3]); *(LAS v2u*)(XWb + o0) = t;
        t.x = cvtpk(wc[0], wc[1]); t.y = cvtpk(wc[2], wc[3]); *(LAS v2u*)(XWb + o1) = t;
    }
    LAS unsigned char* Pb = L + SL_P + par * 8192;
    if (w < 4) ssd_p_tile<true>(Pb, HD, SC, w, lane, w, w, r, q, Dh);
    else { const int lt1 = (w == 4) ? 1 : (w == 5) ? 2 : 3, st1 = (w == 4) ? 0 : (w == 7) ? 2 : 1;
        ssd_p_tile<false>(Pb, HD, SC, w, lane, lt1, st1, r, q, Dh);
        if (w < 6) ssd_p_tile<false>(Pb, HD, SC, 8 + (w - 4), lane, lt1 + 1, 0, r, q, Dh); }
}
__device__ __forceinline__ void ssd_mfma(LAS unsigned char* L, int par, f32x4 (&st)[8], int lane, int r, int q, int pt, int lh, const int (&a256)[4], const int (&a128)[2]) {
    const LAS unsigned char* IC = L + SL_MAIN + par * MAIN_BYTES; const LAS unsigned char* IBT = IC + 16384; const LAS float* SC = (const LAS float*)(IC + 32768);
    f32x4 acc[2] = {(f32x4){0.f, 0.f, 0.f, 0.f}, (f32x4){0.f, 0.f, 0.f, 0.f}};
    {
        bf16x8 yav[4][2], sb[4];
#pragma unroll
        for (int ks = 0; ks < 4; ++ks) {
#pragma unroll
            for (int t = 0; t < 2; ++t) yav[ks][t] = *(const LAS bf16x8*)(IC + 4096 * (2 * lh + t) + a256[ks]);
            v4u sbw; sbw.x = cvtpk(st[2 * ks][0], st[2 * ks][1]); sbw.y = cvtpk(st[2 * ks][2], st[2 * ks][3]); sbw.z = cvtpk(st[2 * ks + 1][0], st[2 * ks + 1][1]); sbw.w = cvtpk(st[2 * ks + 1][2], st[2 * ks + 1][3]);
            sb[ks] = __builtin_bit_cast(bf16x8, sbw); }
#pragma unroll
        for (int ks = 0; ks < 4; ++ks)
#pragma unroll
            for (int t = 0; t < 2; ++t) acc[t] = __builtin_amdgcn_mfma_f32_16x16x32_bf16(yav[ks][t], sb[ks], acc[t], 0, 0, 0);
    }
    { const float elast = SC[128 + 63];
#pragma unroll
      for (int t = 0; t < 2; ++t) { const f32x4 ev4 = *(const LAS f32x4*)(SC + 128 + 16 * (2 * lh + t) + 4 * q); acc[t] = acc[t] * ev4; }
#pragma unroll
      for (int j = 0; j < 8; ++j) st[j] = st[j] * elast; }
    {
        const LAS unsigned char* XTb = L + SL_XT + par * 8192; const LAS unsigned char* XWb = L + SL_XWT + par * 8192; const LAS unsigned char* Pb = L + SL_P + par * 8192;
        bf16x8 xb[2], pav[2][2], xwb[2], bav[2][8];
#pragma unroll
        for (int ks = 0; ks < 2; ++ks) { xb[ks] = *(const LAS bf16x8*)(XTb + 2048 * pt + a128[ks]); xwb[ks] = *(const LAS bf16x8*)(XWb + 2048 * pt + a128[ks]);
#pragma unroll
            for (int t = 0; t < 2; ++t) pav[ks][t] = *(const LAS bf16x8*)(Pb + 2048 * (2 * lh + t) + a128[ks]);
#pragma unroll
            for (int j = 0; j < 8; ++j) bav[ks][j] = *(const LAS bf16x8*)(IBT + 2048 * j + a128[ks]); }
#pragma unroll
        for (int t = 0; t < 2; ++t) acc[t] = __builtin_amdgcn_mfma_f32_16x16x32_bf16(pav[0][t], xb[0], acc[t], 0, 0, 0);
        if (lh == 1) {
#pragma unroll
            for (int t = 0; t < 2; ++t) acc[t] = __builtin_amdgcn_mfma_f32_16x16x32_bf16(pav[1][t], xb[1], acc[t], 0, 0, 0); }
#pragma unroll
        for (int ks = 0; ks < 2; ++ks)
#pragma unroll
            for (int j = 0; j < 8; ++j) st[j] = __builtin_amdgcn_mfma_f32_16x16x32_bf16(bav[ks][j], xwb[ks], st[j], 0, 0, 0);
    }
#pragma unroll
    for (int t = 0; t < 2; ++t) { const int p = 16 * pt + r; v2u yw; yw.x = cvtpk(acc[t][0], acc[t][1]); yw.y = cvtpk(acc[t][2], acc[t][3]);
        *(LAS v2u*)(L + SL_YT + par * 8192 + img128(p, 2 * (2 * lh + t) + (q >> 1)) + 8 * (q & 1)) = yw; }
}
__device__ __forceinline__ void ssd_epi(const LAS unsigned char* L, int par, const unsigned (&zr)[4], int w, int lane, unsigned (&ob)[4], float& s1) {
    const int cp = lane & 31, hf = lane >> 5;
    const v2u ya = *(const LAS v2u*)(L + SL_YT + par * 8192 + img128(2 * cp, w) + 8 * hf), yc = *(const LAS v2u*)(L + SL_YT + par * 8192 + img128(2 * cp + 1, w) + 8 * hf);
    const float y0[4] = {bflo(ya.x), bfhi(ya.x), bflo(ya.y), bfhi(ya.y)}, y1[4] = {bflo(yc.x), bfhi(yc.x), bflo(yc.y), bfhi(yc.y)};
    float sq[4];
#pragma unroll
    for (int i = 0; i < 4; ++i) { const float za = bflo(zr[i]), zc = bfhi(zr[i]); const float ga = y0[i] * (za * sigm(za)), gc = y1[i] * (zc * sigm(zc)); sq[i] = ga * ga + gc * gc; ob[i] = cvtpk(ga, gc); }
    float s2[2];
#pragma unroll
    for (int k2 = 0; k2 < 2; ++k2) { const bool hi = (lane & 16) != 0; const float send = hi ? sq[k2] : sq[2 + k2], keep = hi ? sq[2 + k2] : sq[k2]; s2[k2] = keep + __shfl_xor(send, 16); }
    { const bool hi = (lane & 8) != 0; const float send = hi ? s2[0] : s2[1], keep = hi ? s2[1] : s2[0]; s1 = keep + __int_as_float(__builtin_amdgcn_update_dpp(0, __float_as_int(send), 0x128  , 0xF, 0xF, false)); }
    s1 = dpp_add(s1, 0); s1 = dpp_add(s1, 1); s1 = dpp_add(s1, 2);
}
__device__ __forceinline__ void ssd_dma_main(const Ctx& F, const unsigned char* blob_c, int hsub, int w, int lane, int par) {
    LAS unsigned char* dst = F.lds + SL_MAIN + par * MAIN_BYTES;
#pragma unroll
    for (int k = 0; k < 4; ++k) { const int piece = k * 8 + w; __builtin_amdgcn_global_load_lds((const unsigned*)(blob_c + BL_C + piece * 1024) + lane * 4, (LAS unsigned*)(dst + piece * 1024), 16, 0, 0); }
    if (w == 0) __builtin_amdgcn_global_load_lds((const unsigned*)(blob_c + BL_SC + hsub * SC_BYTES) + lane * 4, (LAS unsigned*)(dst + 32768), 16, 0, 0);
}
__device__ __forceinline__ void ssd_dma_head(const Ctx& F, const unsigned char* blob_c, int hsub, int w, int lane, int par) {
    LAS unsigned char* dst = F.lds + SL_HEAD + par * HEAD_BYTES;
    __builtin_amdgcn_global_load_lds((const unsigned*)(blob_c + BL_CBT + w * 1024) + lane * 4, (LAS unsigned*)(dst + w * 1024), 16, 0, 0);
    if (w == 1 || w == 2) __builtin_amdgcn_global_load_lds((const unsigned*)(blob_c + BL_CBT + (7 + w) * 1024) + lane * 4, (LAS unsigned*)(dst + (7 + w) * 1024), 16, 0, 0);
    if (w == 3) __builtin_amdgcn_global_load_lds((const unsigned*)(blob_c + BL_SC + hsub * SC_BYTES) + lane * 4, (LAS unsigned*)(dst + 10 * 1024), 16, 0, 0);
}
template <bool DRY> __device__ __forceinline__ void phase_ssd(const Ctx& F, const Ptrs& P) {
    const bf16* XBC = (const bf16*)(P.ws + WS_RB); bf16* Z = (bf16*)(P.ws + WS_RA);
    float* ssqp = (float*)(P.ws + WS_SSQP); const unsigned char* IMGS = (const unsigned char*)P.out;
    LAS unsigned char* L = F.lds;
    const int w = F.wave, lane = F.lane, r = lane & 15, q = lane >> 4, pt = w & 3, lh = w >> 2;
    constexpr int NC = SEQ / 64;
    for (int unit = F.vcu; unit < BATCH * NH; unit += F.G) {
        const int b = unit / NH, h = unit % NH, g = h / HPG, hsub = h % HPG, cp = lane & 31, hf = lane >> 5, ch = h * HD + 2 * cp;
        const float Dh = P.ssm_d[h];
        ConvW cw;
#pragma unroll
        for (int t = 0; t < 4; ++t) { cw.a[t] = P.conv_w[t * CONV_DIM + ch]; cw.b[t] = P.conv_w[t * CONV_DIM + ch + 1]; }
        cw.ba = P.conv_b[ch]; cw.bb = P.conv_b[ch + 1];
        const unsigned char* blob0 = IMGS + ((size_t)b * NC * NG + g) * BLOB_BYTES;
        const bf16* x0 = XBC + ((size_t)b * SEQ + 8 * w + 4 * hf) * CONV_DIM + h * HD + 2 * cp;
        bf16* z0 = Z + ((size_t)b * SEQ + 8 * w + 4 * hf) * DI + h * HD + 2 * cp;
        const __amdgpu_buffer_rsrc_t rx = __builtin_amdgcn_make_buffer_rsrc((void*)XBC, 0, (int)((size_t)M * CONV_DIM * 2), 0x00020000), rz = __builtin_amdgcn_make_buffer_rsrc((void*)Z, 0, (int)((size_t)M * DI * 2), 0x00020000);
        const unsigned xs0 = (unsigned)((((size_t)b * SEQ + 8 * w) * CONV_DIM + h * HD) * 2), zs0 = (unsigned)((((size_t)b * SEQ + 8 * w) * DI + h * HD) * 2);
        const int xvo = cp * 4 + hf * (4 * CONV_DIM * 2), zvo = cp * 4 + hf * (4 * DI * 2);
        f32x4 st[8];
#pragma unroll
        for (int j = 0; j < 8; ++j) st[j] = (f32x4){0.f, 0.f, 0.f, 0.f};
        int a256[4], a128[2];
#pragma unroll
        for (int ks = 0; ks < 4; ++ks) a256[ks] = img256(r, 4 * ks + q);
#pragma unroll
        for (int ks = 0; ks < 2; ++ks) a128[ks] = img128(r, 4 * ks + q);
        {
          const int l = F.tid >> 3, cch = F.tid & 7; unsigned zz = 0u; asm volatile("" : "+v"(zz));
          if ((cch >> 1) > (l >> 4)) { *(LAS v4u*)(L + SL_P + img128(l, cch)) = (v4u){zz, zz, zz, zz}; *(LAS v4u*)(L + SL_P + 8192 + img128(l, cch)) = (v4u){zz, zz, zz, zz}; } }
        unsigned xr[7], zr[4];
        {
            unsigned x0r[7], x1r[7];
            ssd_dma_main(F, blob0, hsub, w, lane, 0); ssd_dma_head(F, blob0, hsub, w, lane, 0); ssd_dma_head(F, blob0 + (size_t)NG * BLOB_BYTES, hsub, w, lane, 1);
#pragma unroll
            for (int k = 0; k < 7; ++k) { x0r[k] = *(const unsigned*)(x0 + (long)(k - 3) * CONV_DIM); x1r[k] = *(const unsigned*)(x0 + (long)(64 + k - 3) * CONV_DIM); }
            asm volatile("s_waitcnt vmcnt(0)" ::: "memory");
#pragma unroll
            for (int k = 0; k < 7; ++k) { asm volatile("v_mov_b32 %0, %1" : "=v"(xr[k]) : "v"(x1r[k])); asm volatile("" : "+v"(x0r[k])); }
#pragma unroll
            for (int i = 0; i < 4; ++i) zr[i] = 0u;
            RAW_BARRIER();
            ssd_head(L, 0, 0, true, x0r, w, lane, r, q, cw, Dh);
            RAW_BARRIER();
        }
        for (int j = 0; j < NC; ++j) {
            unsigned nxr[7], nzr[4];
#define SSD_ISSUE()             { \
                const int c1 = (j + 1 < NC) ? j + 1 : j, c2 = (j + 2 < NC) ? j + 2 : NC - 1; \
                ssd_dma_main(F, blob0 + (size_t)c1 * NG * BLOB_BYTES, hsub, w, lane, (j + 1) & 1); \
                if (j + 2 < NC) ssd_dma_head(F, blob0 + (size_t)c2 * NG * BLOB_BYTES, hsub, w, lane, j & 1); \
                const unsigned xso = xs0 + (unsigned)(c2 * 64 - 3) * (CONV_DIM * 2), zso = zs0 + (unsigned)(j * 64) * (DI * 2); \
_Pragma("unroll") \
                for (int k = 0; k < 7; ++k) nxr[k] = __builtin_amdgcn_raw_buffer_load_b32(rx, xvo, xso + k * (CONV_DIM * 2), 0); \
_Pragma("unroll") \
                for (int i = 0; i < 4; ++i) nzr[i] = __builtin_amdgcn_raw_buffer_load_b32(rz, zvo, zso + i * (DI * 2), 0); \
            }
            if (w < 4) SSD_ISSUE()
            unsigned eob[4]; float es1;
            ssd_epi(L, (j + 1) & 1, zr, w, lane, eob, es1);
            if (w >= 4) SSD_ISSUE()
            ssd_mfma(L, j & 1, st, lane, r, q, pt, lh, a256, a128);
            { const int d = (j + 1 < NC) ? j + 1 : j; ssd_head(L, (j + 1) & 1, d & 1, false, xr, w, lane, r, q, cw, Dh); }
            asm volatile("s_waitcnt vmcnt(0)" ::: "memory");
#pragma unroll
            for (int k2 = 0; k2 < 7; ++k2) asm volatile("v_mov_b32 %0, %1" : "=v"(xr[k2]) : "v"(nxr[k2]));
#pragma unroll
            for (int k2 = 0; k2 < 4; ++k2) asm volatile("v_mov_b32 %0, %1" : "=v"(zr[k2]) : "v"(nzr[k2]));
            if (j > 0) {
                const unsigned zso = zs0 + (unsigned)((j - 1) * 64) * (DI * 2);
#pragma unroll
                for (int i = 0; i < 4; ++i) if (!DRY || es1 == 1.2345e30f) __builtin_amdgcn_raw_buffer_store_b32(eob[i], rz, zvo, zso + i * (DI * 2), 0);
                if ((lane & 7) == 0 && (!DRY || es1 == 1.2345e30f)) { const int i = 4 * (lane >> 5) + 2 * ((lane >> 4) & 1) + ((lane >> 3) & 1); ssqp[((size_t)b * SEQ + (j - 1) * 64 + 8 * w + i) * NH + h] = es1; }
            }
            RAW_BARRIER();
        }
        {
            unsigned ob[4]; float s1;
            ssd_epi(L, (NC - 1) & 1, zr, w, lane, ob, s1);
            bf16* zc = z0 + (size_t)(NC - 1) * 64 * DI;
#pragma unroll
            for (int i = 0; i < 4; ++i) if (!DRY || s1 == 1.2345e30f) *(unsigned*)(zc + (long)i * DI) = ob[i];
            if ((lane & 7) == 0 && (!DRY || s1 == 1.2345e30f)) { const int i = 4 * (lane >> 5) + 2 * ((lane >> 4) & 1) + ((lane >> 3) & 1); ssqp[((size_t)b * SEQ + (NC - 1) * 64 + 8 * w + i) * NH + h] = s1; }
        }
        asm volatile("s_waitcnt vmcnt(0)" ::: "memory"); RAW_BARRIER();
    }
}

__device__ __forceinline__ void phase_pool(const Ctx& F, const Ptrs& P) {
    const bf16* V = (const bf16*)(P.ws + WS_RA); const bf16* GT = (const bf16*)(P.ws + WS_RB); bf16* Y2 = (bf16*)(P.ws + WS_RB);
    const int NCG = DP / 8;
    const int nitems = (M / 32) * NCG;
    for (int it = F.vcu * 512 + F.tid; it < nitems; it += F.G * 512) {
        const int cg = it % NCG, tb = it / NCG, c0 = cg * 8, t0 = tb * 32, win = 2 << (c0 / PGD);
        const int pos0 = t0 % SEQ;
        float sc[8]; { const f32x4 a = *(const f32x4*)(P.pool_scale + c0), b = *(const f32x4*)(P.pool_scale + c0 + 4); sc[0] = a.x; sc[1] = a.y; sc[2] = a.z; sc[3] = a.w; sc[4] = b.x; sc[5] = b.y; sc[6] = b.z; sc[7] = b.w; }
        float s[8];
#pragma unroll
        for (int j = 0; j < 8; ++j) s[j] = 0.f;
        for (int d = 1; d < win; ++d) if (pos0 - d >= 0) { const v4u r = *(const v4u*)(V + (size_t)(t0 - d) * DP + c0);
            s[0] += bflo(r.x); s[1] += bfhi(r.x); s[2] += bflo(r.y); s[3] += bfhi(r.y); s[4] += bflo(r.z); s[5] += bfhi(r.z); s[6] += bflo(r.w); s[7] += bfhi(r.w); }
        for (int tt = 0; tt < 32; tt += 8) {
            v4u rv[8], gv[8], qv[8];
#pragma unroll
            for (int u = 0; u < 8; ++u) { const int t = tt + u; rv[u] = *(const v4u*)(V + (size_t)(t0 + t) * DP + c0); gv[u] = *(const v4u*)(GT + (size_t)(t0 + t) * DP + c0);
                const int pd = pos0 + t - (win - 1); qv[u] = *(const v4u*)(V + (size_t)(t0 + t - (pd >= 0 ? win - 1 : 0)) * DP + c0); }
#pragma unroll
            for (int u = 0; u < 8; ++u) { const int t = tt + u, pos = pos0 + t; const v4u r = rv[u], gr = gv[u], q = qv[u];
                const float cur[8] = {bflo(r.x), bfhi(r.x), bflo(r.y), bfhi(r.y), bflo(r.z), bfhi(r.z), bflo(r.w), bfhi(r.w)};
                const float gt[8] = {bflo(gr.x), bfhi(gr.x), bflo(gr.y), bfhi(gr.y), bflo(gr.z), bfhi(gr.z), bflo(gr.w), bfhi(gr.w)};
#pragma unroll
                for (int j = 0; j < 8; ++j) s[j] += cur[j];
                const int cnt = (pos + 1 < win) ? (pos + 1) : win; const float inv = 1.0f / (float)cnt;
                float o[8];
#pragma unroll
                for (int j = 0; j < 8; ++j) o[j] = (s[j] * inv - cur[j]) * sc[j] * (gt[j] * sigm(gt[j]));
                v4u ow; ow.x = pk2(o[0], o[1]); ow.y = pk2(o[2], o[3]); ow.z = pk2(o[4], o[5]); ow.w = pk2(o[6], o[7]);
                *(v4u*)(Y2 + (size_t)(t0 + t) * DP + c0) = ow;
                if (pos - (win - 1) >= 0) {
                    s[0] -= bflo(q.x); s[1] -= bfhi(q.x); s[2] -= bflo(q.y); s[3] -= bfhi(q.y); s[4] -= bflo(q.z); s[5] -= bfhi(q.z); s[6] -= bflo(q.w); s[7] -= bfhi(q.w); } }
        }
    }
}

__device__ __forceinline__ void fin_load(const float* row, int lane, f32x4 (&v)[8]) {
#pragma unroll
    for (int j = 0; j < 8; ++j) v[j] = ((const f32x4*)row)[lane + 64 * j];
}
__device__ __forceinline__ void fin_process(float* row, int lane, const f32x4 (&v)[8], const f32x4 (&gv)[8]) {
    float s = 0.f;
#pragma unroll
    for (int j = 0; j < 8; ++j) s += (v[j].x * v[j].x + v[j].y * v[j].y) + (v[j].z * v[j].z + v[j].w * v[j].w);
    s = wave_sum(s);
    const float rs = rsqrtf(s * (1.0f / DM) + EPS);
#pragma unroll
    for (int j = 0; j < 8; ++j) ((f32x4*)row)[lane + 64 * j] = v[j] * rs * gv[j];
}
__device__ __forceinline__ void phase_final(const Ctx& F, const Ptrs& P) {
    const int gw = F.vcu * NWAVES + F.wave, NGW = F.G * NWAVES, lane = F.lane;
    f32x4 gv[8];
#pragma unroll
    for (int j = 0; j < 8; ++j) gv[j] = ((const f32x4*)P.final_g)[lane + 64 * j];
    const int cnt = (M - gw + NGW - 1) / NGW;
    f32x4 vA[8], vB[8];
    fin_load(P.out + (size_t)gw * DM, lane, vA);
    for (int j = 0; j < cnt; j += 2) {
        { const int jn = (j + 1 < cnt) ? j + 1 : j; fin_load(P.out + (size_t)(gw + jn * NGW) * DM, lane, vB); }
        fin_process(P.out + (size_t)(gw + j * NGW) * DM, lane, vA, gv);
        if (j + 1 < cnt) {
            { const int jn = (j + 2 < cnt) ? j + 2 : j + 1; fin_load(P.out + (size_t)(gw + jn * NGW) * DM, lane, vA); }
            fin_process(P.out + (size_t)(gw + (j + 1) * NGW) * DM, lane, vB, gv);
        }
    }
}

constexpr int N_PHASES = 10;
struct Args { Ptrs p; int ph_lo, ph_hi, li, pad; };
typedef __attribute__((address_space(4))) const Args* KArgsPtr;
__device__ __forceinline__ Ptrs load_ptrs() {
    Ptrs r{};
#if defined(__HIP_DEVICE_COMPILE__)
    KArgsPtr ka = (KArgsPtr)__builtin_amdgcn_kernarg_segment_ptr(); asm volatile("" : "+s"(ka));
    r.x = ka->p.x; r.ln_g = ka->p.ln_g; r.final_g = ka->p.final_g; r.ssm_w_in = ka->p.ssm_w_in; r.conv_w = ka->p.conv_w; r.conv_b = ka->p.conv_b; r.dt_bias = ka->p.dt_bias; r.a_log = ka->p.a_log; r.ssm_d = ka->p.ssm_d;
    r.norm_g = ka->p.norm_g; r.ssm_w_out = ka->p.ssm_w_out; r.pool_w_in = ka->p.pool_w_in; r.pool_w_group = ka->p.pool_w_group; r.pool_scale = ka->p.pool_scale; r.pool_w_out = ka->p.pool_w_out; r.out = ka->p.out; r.ws = ka->p.ws;
#endif
    return r;
}
__global__ void __launch_bounds__(NWAVES * 64, 2) trunk_fwd(Args args) {
    extern __shared__ __attribute__((aligned(16))) unsigned char lds[];
    Ctx F;
    F.lds = (LAS unsigned char*)lds;
    F.tid = threadIdx.x; F.lane = F.tid & 63; F.wave = __builtin_amdgcn_readfirstlane(F.tid >> 6);
    F.G = gridDim.x; { const int bx = blockIdx.x; F.vcu = (F.G % 8 == 0) ? (bx % 8) * (F.G / 8) + bx / 8 : bx; }
    unsigned* ctl0; { const Ptrs P0 = load_ptrs(); ctl0 = (unsigned*)(P0.ws + WS_CTL); }
    for (int u = F.tid; u < (LDS_BYTES - LDSCTL_OFF) / 4; u += NWAVES * 64) ((LAS unsigned*)(F.lds + LDSCTL_OFF))[u] = 0u;
    __syncthreads();
#if MK_ONE_LAUNCH
    XcdBarrier bar = xcd_barrier_post(ctl0 + CW_BAR, (volatile LAS unsigned*)(F.lds + MISC_OFF) + 8);
#define GRID_BAR() xcd_barrier(bar)
#else
#define GRID_BAR() do {} while (0)
#endif
    const int lo = args.ph_lo, hi = args.ph_hi;
#define IN(k) (lo <= (k) && (k) < hi)
#define BOTH(k) (IN(k) && IN((k) + 1))
#define PHASE_VARS const Ptrs P = load_ptrs(); unsigned* ctl = (unsigned*)(P.ws + WS_CTL); \
    float* ssq1 = (float*)ctl + CW_SSQ1; float* ssq3p = (float*)(P.ws + WS_SSQP + 4 * MiB); const float* ssqp = (const float*)(P.ws + WS_SSQP);   \
    bf16* W1T = (bf16*)(P.ws + WS_W1T); bf16* W2T = (bf16*)(P.ws + WS_W2T); bf16* W3T = (bf16*)(P.ws + WS_W3T); bf16* W4T = (bf16*)(P.ws + WS_W4T); bf16* W5T = (bf16*)(P.ws + WS_W5T); \
    bf16* RA = (bf16*)(P.ws + WS_RA); bf16* RB = (bf16*)(P.ws + WS_RB); bf16* RC = (bf16*)(P.ws + WS_RC); \
    (void)ctl; (void)ssq1; (void)ssq3p; (void)ssqp; (void)W1T; (void)W2T; (void)W3T; (void)W4T; (void)W5T; (void)RA; (void)RB; (void)RC;

#define REP(k) (1 + ((REPEAT_MASK >> (k)) & 1))
    unsigned long long ts_a = 0, ts_b = 0;
#define TS_A(k) do { if (STAMP_PHASE == (k)) ts_a = __builtin_amdgcn_s_memrealtime(); } while (0)
#define TS_B(k) do { if (STAMP_PHASE == (k)) ts_b = __builtin_amdgcn_s_memrealtime(); } while (0)
    TS_A(0);
    if (IN(0)) { PHASE_VARS for (int rep = 0; rep < REP(0); ++rep) phase_prep(F, P); if (BOTH(0)) GRID_BAR(); }
    TS_B(0);
    TS_A(1);
    if (IN(1)) {
        PHASE_VARS
        {
          pg8::Gemm g{W4T, (const bf16*)P.out, DP, DM, PGD, PGD, DP, 30, 2}; pg8::StaticOrder S; S.init(DP, DM, F.G, (int)blockIdx.x);
          pg8::EpiPlain E{W3T, DM};
          TS_A(10); pg8::gemm_phase<pg8::EpiPlain, pg8::StaticOrder, true, true>(F.lds + RING_OFF, g, S, E);
          { constexpr int NWC = (DP / 256) * (DM / 256); if ((int)blockIdx.x >= NWC && F.G > NWC) prep_transposes(F, P, 1, ((int)blockIdx.x - NWC) * NWAVES + F.wave, (F.G - NWC) * NWAVES); else if (F.G <= NWC) prep_transposes(F, P, 1, F.vcu * NWAVES + F.wave, F.G * NWAVES); }
          __syncthreads(); TS_B(10); }
        TS_A(11); for (int rep = 0; rep < REP(10); ++rep) phase_dt(F, P); TS_B(11);
        for (int rep = 0; rep < REP(1); ++rep) {
        pg8::Gemm g{RC, W1T, M, N1, DM, DM, DM, 30, 30}; pg8::StaticOrder S; S.init(M, N1, F.G, (int)blockIdx.x);
        pg8::EpiProj E{RA, DI, RB, CONV_DIM, DI / 256, ssq1, 1.0f / DM, nullptr};
        pg8::gemm_phase<pg8::EpiProj, pg8::StaticOrder, true, true>(F.lds + RING_OFF, g, S, E);
        }
        if (BOTH(1)) GRID_BAR();
    }
    TS_B(1);
    TS_A(2);
    if (IN(2)) { PHASE_VARS for (int rep = 0; rep < REP(2); ++rep) phase_bcprep(F, P); if (BOTH(2)) GRID_BAR(); }
    TS_B(2);
    TS_A(3);
    if (IN(3)) { PHASE_VARS if (REP(3) > 1) phase_ssd<true>(F, P); phase_ssd<false>(F, P); if (BOTH(3)) GRID_BAR(); }
    TS_B(3);
    TS_A(4);
    if (IN(4)) {
        PHASE_VARS
        for (int rep = 0; rep < REP(4); ++rep) {
        pg8::Gemm g{RA, W2T, M, DM, DI, DI, DI, 30, 30}; pg8::StaticOrder S; S.init(M, DM, F.G, (int)blockIdx.x);
        LAS float* rs_tab = (LAS float*)(F.lds + pg8::STAGE_BYTES);
        {
          pg8::Unit uu; const int o = F.tid >> 8, rr = F.tid & 255;
          if (S.next(o, uu)) { const f32x4* pp = (const f32x4*)(ssqp + (size_t)(uu.pm * 256 + rr) * NH); f32x4 a = pp[0];
#pragma unroll
              for (int j = 1; j < 16; ++j) a = a + pp[j];
              rs_tab[o * 256 + rr] = rsqrtf(((a[0] + a[1]) + (a[2] + a[3])) * (1.0f / DI) + EPS); }
          __syncthreads(); }
        pg8::EpiResB E{RC, rs_tab, ssq3p, DM};
        pg8::gemm_phase<pg8::EpiResB, pg8::StaticOrder, true, true>(F.lds + RING_OFF, g, S, E);
        }
        if (BOTH(4)) GRID_BAR();
    }
    TS_B(4);
    TS_A(5);
    if (IN(5)) {
        PHASE_VARS
        for (int rep = 0; rep < REP(5); ++rep) {
        pg8::Gemm g{RC, W3T, M, 2 * DP, DM, DM, DM, 30, 30}; pg8::StaticOrder S; S.init(M, 2 * DP, F.G, (int)blockIdx.x);
        LAS float* rs_tab = (LAS float*)(F.lds + pg8::STAGE_BYTES);
        {
          for (int o = F.tid >> 8; o < 8; o += 2) { pg8::Unit uu; const int rr = F.tid & 255;
            if (S.next(o, uu)) { const f32x4* pp = (const f32x4*)(ssq3p + (size_t)(uu.pm * 256 + rr) * 32); f32x4 a = pp[0];
#pragma unroll
              for (int j = 1; j < 8; ++j) a = a + pp[j];
              rs_tab[o * 256 + rr] = rsqrtf(((a[0] + a[1]) + (a[2] + a[3])) * (1.0f / DM) + EPS); } }
          __syncthreads(); }
        pg8::EpiProj E{RA, DP, RB, DP, DP / 256, nullptr, 0.f, rs_tab};
        pg8::gemm_phase<pg8::EpiProj, pg8::StaticOrder, true, true>(F.lds + RING_OFF, g, S, E);
        }
        if (BOTH(5)) GRID_BAR();
    }
    TS_B(5);
    TS_A(6);
    if (IN(6)) { PHASE_VARS for (int rep = 0; rep < REP(6); ++rep) phase_pool(F, P); if (BOTH(6)) GRID_BAR(); }
    TS_B(6);
    TS_A(8);
    if (IN(8)) {
        PHASE_VARS
        pg8::Gemm g{RB, W5T, M, DM, DP, DP, DP, 30, 30}; pg8::PanelOrder S; S.init(F.G, (int)blockIdx.x);
        pg8::EpiFinal E{RC, P.out, P.final_g, (float*)(P.ws + WS_SSQP + 6 * MiB), ctl + CW_FIN, ctl + CW_TMO, F.lds + pg8::STAGE_BYTES, DM};
        pg8::gemm_phase<pg8::EpiFinal, pg8::PanelOrder, true, true>(F.lds + RING_OFF, g, S, E);
    }
    TS_B(8);
    if (STAMP_PHASE >= 0) { const unsigned long long t0 = __builtin_amdgcn_s_memrealtime(); while (__builtin_amdgcn_s_memrealtime() - t0 < ts_b - ts_a) __builtin_amdgcn_s_sleep(8); }
#undef IN
#undef BOTH
}

extern "C" void kernel_launch(void* const* d_in, const int* in_sizes, int n_in, void* d_out, int out_size, void* d_ws, size_t ws_size, hipStream_t stream) {
    static int grid = 0;
    if (grid == 0) {
        if (n_in != 15 || in_sizes[0] != M * DM || out_size != M * DM || ws_size < WS_END) { fprintf(stderr, "kernel_launch: unexpected shapes: n_in %d in0 %d out %d ws %zu (need %zu); nothing launched\n", n_in, n_in > 0 ? in_sizes[0] : -1, out_size, ws_size, (size_t)WS_END); grid = -1; return; }
        int dev = 0, cus = 0, per_cu = 0;
        if (hipGetDevice(&dev) != hipSuccess || hipDeviceGetAttribute(&cus, hipDeviceAttributeMultiprocessorCount, dev) != hipSuccess) { fprintf(stderr, "kernel_launch: device query failed\n"); grid = -1; return; }
        if (hipFuncSetAttribute((const void*)trunk_fwd, hipFuncAttributeMaxDynamicSharedMemorySize, LDS_BYTES) != hipSuccess) { fprintf(stderr, "kernel_launch: hipFuncSetAttribute failed\n"); grid = -1; return; }
        if (hipOccupancyMaxActiveBlocksPerMultiprocessor(&per_cu, (const void*)trunk_fwd, NWAVES * 64, LDS_BYTES) != hipSuccess || per_cu < 1) { fprintf(stderr, "kernel_launch: occupancy query says %d blocks per CU\n", per_cu); }
        (void)hipGetLastError();
        grid = cus;
        if (cus != 256) { fprintf(stderr, "kernel_launch: this kernel's unit orders are built for a 256-CU device (got %d CUs); nothing launched\n", cus); grid = -1; return; }
    }
    if (grid < 0) return;
    if (hipMemsetAsync((char*)d_ws + WS_CTL, 0, CTL_ZERO_BYTES, stream) != hipSuccess) { fprintf(stderr, "kernel_launch: memset failed\n"); return; }
    Args a{};
    a.p.x = (const float*)d_in[0]; a.p.ln_g = (const float*)d_in[1]; a.p.final_g = (const float*)d_in[2]; a.p.ssm_w_in = (const float*)d_in[3]; a.p.conv_w = (const float*)d_in[4];
    a.p.conv_b = (const float*)d_in[5]; a.p.dt_bias = (const float*)d_in[6]; a.p.a_log = (const float*)d_in[7]; a.p.ssm_d = (const float*)d_in[8]; a.p.norm_g = (const float*)d_in[9];
    a.p.ssm_w_out = (const float*)d_in[10]; a.p.pool_w_in = (const float*)d_in[11]; a.p.pool_w_group = (const float*)d_in[12]; a.p.pool_scale = (const float*)d_in[13]; a.p.pool_w_out = (const float*)d_in[14];
    a.p.out = (float*)d_out; a.p.ws = (unsigned char*)d_ws;
#if MK_ONE_LAUNCH
    a.ph_lo = 0; a.ph_hi = N_PHASES; a.li = 0;
    hipLaunchKernelGGL(trunk_fwd, dim3(grid), dim3(NWAVES * 64), LDS_BYTES, stream, a);
#else
    for (int li = 0; li < N_PHASES; ++li) { a.ph_lo = li; a.ph_hi = li + 1; a.li = li;
        hipLaunchKernelGGL(trunk_fwd, dim3(grid), dim3(NWAVES * 64), LDS_BYTES, stream, a); }
#endif
    const hipError_t le = hipPeekAtLastError();
    if (le != hipSuccess) fprintf(stderr, "kernel_launch: launch failed: %s\n", hipGetErrorName(le));
}
```

```cpp
#include <hip/hip_runtime.h>
#include <cstdio>
#include <cstdint>

#ifndef REPEAT_MASK
#define REPEAT_MASK 0
#endif
#ifndef STAMP_PHASE
#define STAMP_PHASE -1
#endif
#ifndef MK_ONE_LAUNCH
#define MK_ONE_LAUNCH 1
#endif

namespace pg8 {
#define PG8_LAS __attribute__((address_space(3)))
typedef unsigned short bf16_t;
typedef short bf16x8 __attribute__((ext_vector_type(8)));
typedef float f32x4 __attribute__((ext_vector_type(4)));
typedef unsigned u32x4 __attribute__((ext_vector_type(4)));
typedef unsigned u32x2 __attribute__((ext_vector_type(2)));
constexpr int BM = 256, BK = 64, HALF = 128, HTB = HALF * BK * 2  , STAGE_BYTES = 8 * HTB, NXCD = 8, WGM = 8;
constexpr float RMS_EPS = 1e-6f;

__host__ __device__ __forceinline__ int lds_byte(int r, int c) { const int st = (r >> 4) * 2 + (c >> 5), rr = r & 15, cc = c & 31, ob = rr * 64 + cc * 2; return st * 1024 + (ob ^ (((ob >> 9) & 1) << 5)); }
__host__ __device__ __forceinline__ void stage_rc(int b, int& R, int& C) { const int st = b / 1024, sb = b % 1024, swz = sb ^ (((sb >> 9) & 1) << 5); R = (st >> 1) * 16 + swz / 64; C = (st & 1) * 32 + (swz % 64) / 2; }
__host__ __device__ __forceinline__ int perm32(int rho) { const int n = rho >> 4, i = rho & 15; return 8 * (i >> 2) + 4 * n + (i & 3); }

struct Unit { int pm, pn, ord; };
struct Gemm { const bf16_t* A; const bf16_t* Bt; int M, N, K, lda, ldb, gsh, bgsh; };

struct StaticOrder {
    int nM, nN, nwg, G, c;
    __host__ __device__ void init(int M, int N, int G_, int c_) { nM = M / BM; nN = N / BM; nwg = nM * nN; G = G_; c = c_; }
    __host__ __device__ bool next(int i, Unit& u) const {
        const long L = (long)i * G + c; if (L >= nwg) return false;
        int wgid = (int)L; { const int q = nwg / NXCD, r = nwg % NXCD, xcd = wgid % NXCD, off = wgid / NXCD; wgid = (xcd < r ? xcd * (q + 1) : r * (q + 1) + (xcd - r) * q) + off; }
        const int nig = WGM * nN, gid = wgid / nig, fm = gid * WGM, gsz = (nM - fm) < WGM ? (nM - fm) : WGM;
        u.pm = fm + ((wgid % nig) % gsz); u.pn = (wgid % nig) / gsz; return true;
    }
    __device__ __forceinline__ void a_ready(const Unit&) const {}
    __device__ __forceinline__ void done(const Unit&) const {}
};

__device__ __forceinline__ unsigned cvt_pk_bf16(float lo, float hi) { unsigned r; asm volatile("v_cvt_pk_bf16_f32 %0, %1, %2" : "=v"(r) : "v"(lo), "v"(hi)); return r; }
__device__ __forceinline__ float bf_lo(unsigned w) { return __uint_as_float(w << 16); }
__device__ __forceinline__ float bf_hi(unsigned w) { return __uint_as_float(w & 0xffff0000u); }
__device__ __forceinline__ float sigmoid_f(float v) { return __builtin_amdgcn_rcpf(1.0f + __builtin_amdgcn_exp2f(-1.4426950408889634f * v)); }

struct EpiProj {
    static constexpr bool PERM = true, AFTER_DRAIN = false;
    bf16_t* O0; int ld0; bf16_t* O1; int ld1; int split_pn; const float* ssq; float inv_n; const PG8_LAS float* rs_lds;
    __device__ __forceinline__ void operator()(const f32x4 (&acc)[2][2][4][2], const Unit& u, int wr, int wc, int fr, int fq) const {
        const int row0 = u.pm * BM + wr * 64 + fr;
        bf16_t* base; int ld, colt;
        if (u.pn < split_pn) { base = O0; ld = ld0; colt = u.pn * BM; } else { base = O1; ld = ld1; colt = (u.pn - split_pn) * BM; }
        const int col0 = colt + wc * 32 + 8 * fq;
#pragma unroll
        for (int ai = 0; ai < 2; ++ai)
#pragma unroll
            for (int m = 0; m < 4; ++m) { const int row = row0 + ai * HALF + m * 16; const float s = rs_lds ? rs_lds[u.ord * BM + wr * 64 + fr + ai * HALF + m * 16] : rsqrtf(ssq[row] * inv_n + RMS_EPS);
                bf16_t* rowp = base + (size_t)row * ld + col0;
#pragma unroll
                for (int bj = 0; bj < 2; ++bj) { const f32x4 v0 = acc[ai][bj][m][0] * s, v1 = acc[ai][bj][m][1] * s;
                    u32x4 w; w.x = cvt_pk_bf16(v0[0], v0[1]); w.y = cvt_pk_bf16(v0[2], v0[3]); w.z = cvt_pk_bf16(v1[0], v1[1]); w.w = cvt_pk_bf16(v1[2], v1[3]);
                    *(u32x4*)(rowp + bj * HALF) = w; } }
    }
};
struct EpiPlain {
    static constexpr bool PERM = true, AFTER_DRAIN = false;
    bf16_t* O; int ld;
    __device__ __forceinline__ void operator()(const f32x4 (&acc)[2][2][4][2], const Unit& u, int wr, int wc, int fr, int fq) const {
        const int row0 = u.pm * BM + wr * 64 + fr, col0 = u.pn * BM + wc * 32 + 8 * fq;
#pragma unroll
        for (int ai = 0; ai < 2; ++ai)
#pragma unroll
            for (int m = 0; m < 4; ++m) { bf16_t* rowp = O + (size_t)(row0 + ai * HALF + m * 16) * ld + col0;
#pragma unroll
                for (int bj = 0; bj < 2; ++bj) { const f32x4 v0 = acc[ai][bj][m][0], v1 = acc[ai][bj][m][1];
                    u32x4 w; w.x = cvt_pk_bf16(v0[0], v0[1]); w.y = cvt_pk_bf16(v0[2], v0[3]); w.z = cvt_pk_bf16(v1[0], v1[1]); w.w = cvt_pk_bf16(v1[2], v1[3]);
                    *(u32x4*)(rowp + bj * HALF) = w; } }
    }
};
struct EpiRes {
    static constexpr bool PERM = false, AFTER_DRAIN = false;
    const float* base; float* out; bf16_t* ob; const PG8_LAS float* rs_lds; float* ssq_out; int ldc;
    __device__ __forceinline__ void operator()(const f32x4 (&acc)[2][2][4][2], const Unit& u, int wr, int wc, int fr, int fq) const {
        const int rl0 = wr * 64 + fr, row0 = u.pm * BM + rl0, col0 = u.pn * BM + wc * 32 + 4 * fq;
#pragma unroll
        for (int ai = 0; ai < 2; ++ai)
#pragma unroll
            for (int m = 0; m < 4; ++m) { const int row = row0 + ai * HALF + m * 16; const float s = rs_lds ? rs_lds[u.ord * BM + rl0 + ai * HALF + m * 16] : 1.0f;
                const size_t off = (size_t)row * ldc + col0; float q = 0.f;
#pragma unroll
                for (int bj = 0; bj < 2; ++bj)
#pragma unroll
                    for (int n = 0; n < 2; ++n) { const size_t o2 = off + bj * HALF + n * 16; const f32x4 b = *(const f32x4*)(base + o2); const f32x4 o = b + acc[ai][bj][m][n] * s;
                        *(f32x4*)(out + o2) = o; q += (o[0] * o[0] + o[1] * o[1]) + (o[2] * o[2] + o[3] * o[3]);
                        if (ob) { u32x2 w; w.x = cvt_pk_bf16(o[0], o[1]); w.y = cvt_pk_bf16(o[2], o[3]); *(u32x2*)(ob + o2) = w; } }
                if (ssq_out) { q += __shfl_xor(q, 16); q += __shfl_xor(q, 32); if (fq == 0) ssq_out[(size_t)row * 32 + u.pn * 4 + wc] = q; }
                if (m & 1) asm volatile("" ::: "memory"); }
    }
};
struct EpiResB {
    static constexpr bool PERM = false, AFTER_DRAIN = false;
    bf16_t* xio; const PG8_LAS float* rs_lds; float* ssq_out; int ldc;
    __device__ __forceinline__ void operator()(const f32x4 (&acc)[2][2][4][2], const Unit& u, int wr, int wc, int fr, int fq) const {
        const int rl0 = wr * 64 + fr, row0 = u.pm * BM + rl0, col0 = u.pn * BM + wc * 32 + 4 * fq;
#pragma unroll
        for (int ai = 0; ai < 2; ++ai)
#pragma unroll
            for (int m = 0; m < 4; ++m) { const int row = row0 + ai * HALF + m * 16; const float s = rs_lds[u.ord * BM + rl0 + ai * HALF + m * 16];
                const size_t off = (size_t)row * ldc + col0; float q = 0.f;
#pragma unroll
                for (int bj = 0; bj < 2; ++bj)
#pragma unroll
                    for (int n = 0; n < 2; ++n) { const size_t o2 = off + bj * HALF + n * 16; const u32x2 bw = *(const u32x2*)(xio + o2);
                        f32x4 o = acc[ai][bj][m][n] * s; o[0] += bf_lo(bw.x); o[1] += bf_hi(bw.x); o[2] += bf_lo(bw.y); o[3] += bf_hi(bw.y);
                        q += (o[0] * o[0] + o[1] * o[1]) + (o[2] * o[2] + o[3] * o[3]);
                        u32x2 w; w.x = cvt_pk_bf16(o[0], o[1]); w.y = cvt_pk_bf16(o[2], o[3]); *(u32x2*)(xio + o2) = w; }
                q += __shfl_xor(q, 16); q += __shfl_xor(q, 32); if (fq == 0) ssq_out[(size_t)row * 32 + u.pn * 4 + wc] = q;
                if (m & 1) asm volatile("" ::: "memory"); }
    }
};
struct PanelOrder {
    int G, c;
    __host__ __device__ void init(int G_, int c_) { G = G_; c = c_; }
    __host__ __device__ bool next(int i, Unit& u) const { if (i >= 2) return false; const int xcd = c & 7, idx = c >> 3; u.pm = 32 * i + 4 * xcd + (idx >> 3); u.pn = idx & 7; return true; }
    __device__ __forceinline__ void a_ready(const Unit&) const {}
    __device__ __forceinline__ void done(const Unit&) const {}
};
struct EpiFinal {
    static constexpr bool PERM = false, AFTER_DRAIN = false;
    const bf16_t* base; float* out; const float* gain; float* xslots; unsigned* cnt; unsigned* tmo; PG8_LAS unsigned char* lds; int ldc;
    __device__ __forceinline__ void operator()(f32x4 (&acc)[2][2][4][2], const Unit& u, int wr, int wc, int fr, int fq) const {
        PG8_LAS float* Pt = (PG8_LAS float*)lds;
        PG8_LAS float* St = (PG8_LAS float*)(lds + 4096);
        const int tid = threadIdx.x, wid = __builtin_amdgcn_readfirstlane(tid >> 6), lane = tid & 63;
        const int rl0 = wr * 64 + fr, row0 = u.pm * BM + rl0, col0 = u.pn * BM + wc * 32 + 4 * fq;
#pragma unroll
        for (int ai = 0; ai < 2; ++ai)
#pragma unroll
            for (int m = 0; m < 4; ++m) { const size_t off = (size_t)(row0 + ai * HALF + m * 16) * ldc + col0; float q = 0.f;
#pragma unroll
                for (int bj = 0; bj < 2; ++bj)
#pragma unroll
                    for (int n = 0; n < 2; ++n) { const u32x2 bw = *(const u32x2*)(base + off + bj * HALF + n * 16);
                        f32x4 o = acc[ai][bj][m][n]; o[0] += bf_lo(bw.x); o[1] += bf_hi(bw.x); o[2] += bf_lo(bw.y); o[3] += bf_hi(bw.y); acc[ai][bj][m][n] = o;
                        q += (o[0] * o[0] + o[1] * o[1]) + (o[2] * o[2] + o[3] * o[3]); }
                q += __shfl_xor(q, 16); q += __shfl_xor(q, 32);
                if (fq == 0) Pt[(rl0 + ai * HALF + m * 16) * 4 + wc] = q; }
        asm volatile("s_waitcnt lgkmcnt(0)" ::: "memory"); __builtin_amdgcn_s_barrier(); asm volatile("" ::: "memory");
        if (tid < BM) { const f32x4 p4 = *(const PG8_LAS f32x4*)(Pt + tid * 4);
            __hip_atomic_store(xslots + (size_t)(u.pm * BM + tid) * 8 + u.pn, (p4[0] + p4[1]) + (p4[2] + p4[3]), __ATOMIC_RELAXED, __HIP_MEMORY_SCOPE_AGENT); }
        asm volatile("s_waitcnt vmcnt(0)" ::: "memory");
        if (tid < BM && lane == 0) __hip_atomic_fetch_add(cnt + 64 * u.pm, 1u, __ATOMIC_RELAXED, __HIP_MEMORY_SCOPE_AGENT);
        if (wid == 0) {
            unsigned sp = 0;
            while ((unsigned)__builtin_amdgcn_readfirstlane(__hip_atomic_load(cnt + 64 * u.pm, __ATOMIC_RELAXED, __HIP_MEMORY_SCOPE_AGENT)) < 32u) {
                __builtin_amdgcn_s_sleep(2);
                if (++sp > (1u << 22)) { if (lane == 0) __hip_atomic_store(tmo, 1u, __ATOMIC_RELAXED, __HIP_MEMORY_SCOPE_AGENT); break; } }
            __builtin_amdgcn_fence(__ATOMIC_ACQUIRE, "agent");
        }
        asm volatile("s_waitcnt vmcnt(0) lgkmcnt(0)" ::: "memory"); __builtin_amdgcn_s_barrier(); asm volatile("" ::: "memory");
        if (tid < BM) { const float* sl = xslots + (size_t)(u.pm * BM + tid) * 8; float t = 0.f;
#pragma unroll
            for (int j = 0; j < 8; ++j) t += __hip_atomic_load(sl + j, __ATOMIC_RELAXED, __HIP_MEMORY_SCOPE_AGENT);
            St[tid] = rsqrtf(t * (1.0f / 2048.0f) + RMS_EPS); }
        asm volatile("s_waitcnt vmcnt(0) lgkmcnt(0)" ::: "memory"); __builtin_amdgcn_s_barrier(); asm volatile("" ::: "memory");
        f32x4 gv[2][2];
#pragma unroll
        for (int bj = 0; bj < 2; ++bj)
#pragma unroll
            for (int n = 0; n < 2; ++n) gv[bj][n] = *(const f32x4*)(gain + col0 + bj * HALF + n * 16);
#pragma unroll
        for (int ai = 0; ai < 2; ++ai)
#pragma unroll
            for (int m = 0; m < 4; ++m) { const int rl = rl0 + ai * HALF + m * 16; const float s = St[rl]; float* rowp = out + (size_t)(u.pm * BM + rl) * ldc + col0;
#pragma unroll
                for (int bj = 0; bj < 2; ++bj)
#pragma unroll
                    for (int n = 0; n < 2; ++n) *(f32x4*)(rowp + bj * HALF + n * 16) = acc[ai][bj][m][n] * s * gv[bj][n]; }
        asm volatile("s_waitcnt lgkmcnt(0)" ::: "memory"); __builtin_amdgcn_s_barrier(); asm volatile("" ::: "memory");
    }
};
struct EpiGate {
    static constexpr bool PERM = true, AFTER_DRAIN = false;
    bf16_t* O; const bf16_t* gate; const float* scale; int ldc;
    __device__ __forceinline__ void operator()(const f32x4 (&acc)[2][2][4][2], const Unit& u, int wr, int wc, int fr, int fq) const {
        const int row0 = u.pm * BM + wr * 64 + fr, col0 = u.pn * BM + wc * 32 + 8 * fq;
        f32x4 sc[2][2];
#pragma unroll
        for (int bj = 0; bj < 2; ++bj)
#pragma unroll
            for (int n = 0; n < 2; ++n) sc[bj][n] = *(const f32x4*)(scale + col0 + bj * HALF + 4 * n);
#pragma unroll
        for (int ai = 0; ai < 2; ++ai)
#pragma unroll
            for (int m = 0; m < 4; ++m) { const size_t off = (size_t)(row0 + ai * HALF + m * 16) * ldc + col0;
#pragma unroll
                for (int bj = 0; bj < 2; ++bj) { const u32x4 gw = *(const u32x4*)(gate + off + bj * HALF);
                    const float g0 = bf_lo(gw.x), g1 = bf_hi(gw.x), g2 = bf_lo(gw.y), g3 = bf_hi(gw.y), g4 = bf_lo(gw.z), g5 = bf_hi(gw.z), g6 = bf_lo(gw.w), g7 = bf_hi(gw.w);
                    const f32x4 v0 = acc[ai][bj][m][0] * sc[bj][0], v1 = acc[ai][bj][m][1] * sc[bj][1];
                    u32x4 w; w.x = cvt_pk_bf16(v0[0] * g0 * sigmoid_f(g0), v0[1] * g1 * sigmoid_f(g1)); w.y = cvt_pk_bf16(v0[2] * g2 * sigmoid_f(g2), v0[3] * g3 * sigmoid_f(g3));
                    w.z = cvt_pk_bf16(v1[0] * g4 * sigmoid_f(g4), v1[1] * g5 * sigmoid_f(g5)); w.w = cvt_pk_bf16(v1[2] * g6 * sigmoid_f(g6), v1[3] * g7 * sigmoid_f(g7));
                    *(u32x4*)(O + off + bj * HALF) = w; } }
    }
};

template <class Epi, class Sched, bool ALIGN_EPI = false, bool SP2 = false>
__device__ __forceinline__ void gemm_phase(PG8_LAS unsigned char* lds, const Gemm g, const Sched& S, const Epi& E) {
    const int tid = threadIdx.x, wid = __builtin_amdgcn_readfirstlane(tid >> 6), lane = tid & 63, wr = wid >> 2, wc = wid & 3, fr = lane & 15, fq = lane >> 4;
    const int K = g.K, nt = K / BK;
    unsigned voffA[2], voffB[2];
#pragma unroll
    for (int i = 0; i < 2; ++i) { int R, C; stage_rc(tid * 16 + i * 8192, R, C); const int Rb = Epi::PERM ? ((R & ~31) + perm32(R & 31)) : R;
        voffA[i] = (unsigned)(R * g.lda + C) * 2u; voffB[i] = (unsigned)(Rb * g.ldb + C) * 2u; }
    const size_t kstep = (size_t)(BK * 2);
    const size_t hstepA = (size_t)HALF * g.lda * 2, hstepB = (size_t)HALF * g.ldb * 2;
    const size_t tstepA = 2 * hstepA, tstepB = 2 * hstepB, gstepA = (size_t)K * 2;
    const unsigned ldsw = (unsigned)wid * 1024u;
    const int aoff = lds_byte(wr * 64 + fr, fq * 8), boff = lds_byte(wc * 32 + fr, fq * 8);
#define PG8_SA(b, h) (((b) * 2 + (h)) * HTB)
#define PG8_SB(b, h) ((4 + (b) * 2 + (h)) * HTB)
#define PG8_STAGE(bufoff, gbase, voff) do { _Pragma("unroll") for (int _i = 0; _i < 2; ++_i) \
        __builtin_amdgcn_global_load_lds((const unsigned*)((const char*)(gbase) + (voff)[_i]), (PG8_LAS unsigned*)(lds + (bufoff) + ldsw + _i * 8192), 16, 0, 0); } while (0)
#define PG8_LDA(dst, b, h) do { _Pragma("unroll") for (int m = 0; m < 4; ++m) _Pragma("unroll") for (int k = 0; k < 2; ++k) dst[m][k] = *(const PG8_LAS bf16x8*)(lds + PG8_SA(b, h) + aoff + m * 2048 + k * 1024); } while (0)
#define PG8_LDB(dst, b, h) do { _Pragma("unroll") for (int n = 0; n < 2; ++n) _Pragma("unroll") for (int k = 0; k < 2; ++k) dst[n][k] = *(const PG8_LAS bf16x8*)(lds + PG8_SB(b, h) + boff + n * 2048 + k * 1024); } while (0)
#define PG8_MMA(ai, bj, At, Bt) do { __builtin_amdgcn_s_setprio(1); _Pragma("unroll") for (int m = 0; m < 4; ++m) _Pragma("unroll") for (int n = 0; n < 2; ++n) _Pragma("unroll") for (int k = 0; k < 2; ++k) \
        acc[ai][bj][m][n] = __builtin_amdgcn_mfma_f32_16x16x32_bf16(Bt[n][k], At[m][k], acc[ai][bj][m][n], 0, 0, 0); __builtin_amdgcn_s_setprio(0); } while (0)
#define PG8_WAIT_V(n) asm volatile("s_waitcnt vmcnt(" #n ")" ::: "memory")
#define PG8_WAIT_L(n) asm volatile("s_waitcnt lgkmcnt(" #n ")" ::: "memory")
#define PG8_BAR __builtin_amdgcn_s_barrier()
#define PG8_SCHED __builtin_amdgcn_sched_barrier(0)
    Unit cur, nxt; int ui = 0;
    if (!S.next(0, cur)) return;
    cur.ord = 0;
    f32x4 acc[2][2][4][2];
#pragma unroll
    for (int a = 0; a < 2; ++a)
#pragma unroll
        for (int b = 0; b < 2; ++b)
#pragma unroll
            for (int m = 0; m < 4; ++m)
#pragma unroll
                for (int n = 0; n < 2; ++n) acc[a][b][m][n] = (f32x4){0.f, 0.f, 0.f, 0.f};
    bf16x8 At[4][2], B0[2][2], B1[2][2];
    const char* cA = (const char*)g.A + (size_t)cur.pm * tstepA + (size_t)(cur.pn >> g.gsh) * gstepA; const char* cB = (const char*)g.Bt + (size_t)cur.pn * tstepB + (size_t)(cur.pm >> g.bgsh) * gstepA;
    S.a_ready(cur);
    if constexpr (SP2) {
        PG8_STAGE(PG8_SB(0, 0), cB, voffB); PG8_STAGE(PG8_SB(0, 1), cB + hstepB, voffB); PG8_STAGE(PG8_SA(0, 0), cA, voffA); PG8_STAGE(PG8_SA(0, 1), cA + hstepA, voffA);
        if (wr == 1) PG8_BAR;
        PG8_WAIT_V(2); PG8_BAR;
        PG8_STAGE(PG8_SB(1, 0), cB + kstep, voffB); PG8_STAGE(PG8_SA(1, 0), cA + kstep, voffA); PG8_STAGE(PG8_SB(1, 1), cB + hstepB + kstep, voffB);
        PG8_WAIT_V(6); PG8_BAR;
    } else {
        PG8_STAGE(PG8_SB(0, 0), cB, voffB); PG8_STAGE(PG8_SA(0, 0), cA, voffA); PG8_STAGE(PG8_SB(0, 1), cB + hstepB, voffB); PG8_STAGE(PG8_SA(0, 1), cA + hstepA, voffA);
        if (wr == 1) PG8_BAR;
        PG8_WAIT_V(4); PG8_BAR;
        PG8_STAGE(PG8_SB(1, 0), cB + kstep, voffB); PG8_STAGE(PG8_SA(1, 0), cA + kstep, voffA); PG8_STAGE(PG8_SB(1, 1), cB + hstepB + kstep, voffB);
        PG8_WAIT_V(6); PG8_BAR;
    }
    for (;;) {
        const bool has_next = S.next(ui + 1, nxt); nxt.ord = ui + 1;
        const char* nA = has_next ? (const char*)g.A + (size_t)nxt.pm * tstepA + (size_t)(nxt.pn >> g.gsh) * gstepA : cA; const char* nB = has_next ? (const char*)g.Bt + (size_t)nxt.pn * tstepB + (size_t)(nxt.pm >> g.bgsh) * gstepA : cB;
        for (int t = 0; t < nt; t += 2) {
            const bool last = (t == nt - 2);
            const char* a1 = cA + (size_t)(t + 1) * kstep;
            const char* a2 = last ? nA : cA + (size_t)(t + 2) * kstep; const char* b2 = last ? nB : cB + (size_t)(t + 2) * kstep;
            const char* a3 = a2 + kstep; const char* b3 = b2 + kstep;
            if (last && has_next) S.a_ready(nxt);
            if constexpr (SP2) {
            PG8_LDB(B0, 0, 0); PG8_LDB(B1, 0, 1); PG8_SCHED; PG8_LDA(At, 0, 0); PG8_STAGE(PG8_SA(1, 1), a1 + hstepA, voffA);
            PG8_WAIT_V(8); PG8_WAIT_L(0); PG8_BAR; PG8_MMA(0, 0, At, B0); PG8_MMA(0, 1, At, B1); PG8_BAR; PG8_SCHED;
            PG8_LDA(At, 0, 1); PG8_STAGE(PG8_SB(0, 0), b2, voffB); PG8_STAGE(PG8_SB(0, 1), b2 + hstepB, voffB); PG8_STAGE(PG8_SA(0, 0), a2, voffA);
            PG8_WAIT_V(8); PG8_WAIT_L(0); PG8_BAR; PG8_MMA(1, 0, At, B0); PG8_MMA(1, 1, At, B1); PG8_BAR; PG8_SCHED;
            PG8_LDB(B0, 1, 0); PG8_LDB(B1, 1, 1); PG8_SCHED; PG8_LDA(At, 1, 0); PG8_STAGE(PG8_SA(0, 1), a2 + hstepA, voffA);
            PG8_WAIT_V(8); PG8_WAIT_L(0); PG8_BAR; PG8_MMA(0, 0, At, B0); PG8_MMA(0, 1, At, B1); PG8_BAR; PG8_SCHED;
            PG8_LDA(At, 1, 1); PG8_STAGE(PG8_SB(1, 0), b3, voffB); PG8_STAGE(PG8_SB(1, 1), b3 + hstepB, voffB); PG8_STAGE(PG8_SA(1, 0), a3, voffA);
            PG8_WAIT_V(8); PG8_WAIT_L(0); PG8_BAR; PG8_MMA(1, 0, At, B0); PG8_MMA(1, 1, At, B1); PG8_BAR; PG8_SCHED;
            } else {
            PG8_LDB(B0, 0, 0); PG8_SCHED; PG8_LDA(At, 0, 0); PG8_STAGE(PG8_SA(1, 1), a1 + hstepA, voffA);
            PG8_WAIT_L(8); PG8_BAR; PG8_WAIT_L(0); PG8_MMA(0, 0, At, B0); PG8_BAR; PG8_SCHED;
            PG8_LDB(B1, 0, 1); PG8_STAGE(PG8_SB(0, 0), b2, voffB);
            PG8_BAR; PG8_WAIT_L(0); PG8_MMA(0, 1, At, B1); PG8_BAR;
            PG8_LDA(At, 0, 1); PG8_STAGE(PG8_SA(0, 0), a2, voffA);
            PG8_BAR; PG8_WAIT_L(0); PG8_MMA(1, 0, At, B0); PG8_BAR; PG8_SCHED;
            PG8_STAGE(PG8_SB(0, 1), b2 + hstepB, voffB);
            PG8_WAIT_V(6); PG8_BAR; PG8_MMA(1, 1, At, B1); PG8_BAR;
            PG8_LDB(B0, 1, 0); PG8_SCHED; PG8_LDA(At, 1, 0); PG8_STAGE(PG8_SA(0, 1), a2 + hstepA, voffA);
            PG8_WAIT_L(8); PG8_BAR; PG8_WAIT_L(0); PG8_MMA(0, 0, At, B0); PG8_BAR; PG8_SCHED;
            PG8_LDB(B1, 1, 1); PG8_STAGE(PG8_SB(1, 0), b3, voffB);
            PG8_BAR; PG8_WAIT_L(0); PG8_MMA(0, 1, At, B1); PG8_BAR;
            PG8_LDA(At, 1, 1); PG8_STAGE(PG8_SA(1, 0), a3, voffA);
            PG8_BAR; PG8_WAIT_L(0); PG8_MMA(1, 0, At, B0); PG8_BAR; PG8_SCHED;
            PG8_STAGE(PG8_SB(1, 1), b3 + hstepB, voffB);
            PG8_WAIT_V(6); PG8_BAR; PG8_MMA(1, 1, At, B1); PG8_BAR;
            }
        }
        if constexpr (ALIGN_EPI) { if (wr == 0) PG8_BAR; }
        if constexpr (!Epi::AFTER_DRAIN) { E(acc, cur, wr, wc, fr, fq); S.done(cur); }
        if (!has_next) break;
#pragma unroll
        for (int a = 0; a < 2; ++a)
#pragma unroll
            for (int b = 0; b < 2; ++b)
#pragma unroll
                for (int m = 0; m < 4; ++m)
#pragma unroll
                    for (int n = 0; n < 2; ++n) acc[a][b][m][n] = (f32x4){0.f, 0.f, 0.f, 0.f};
        cur = nxt; cA = nA; cB = nB; ++ui;
        if constexpr (ALIGN_EPI) { if (wr == 1) PG8_BAR; }
    }
    PG8_WAIT_V(0);
    if constexpr (!ALIGN_EPI) { if (wr == 0) PG8_BAR; }
    PG8_BAR;
    if constexpr (Epi::AFTER_DRAIN) { E.fused(acc, cur, wr, wc, fr, fq, lds, wid, lane); S.done(cur); }
#undef PG8_SA
#undef PG8_SB
#undef PG8_STAGE
#undef PG8_LDA
#undef PG8_LDB
#undef PG8_MMA
#undef PG8_WAIT_V
#undef PG8_WAIT_L
#undef PG8_BAR
#undef PG8_SCHED
}

}

constexpr int NWAVES = 8;
constexpr int BATCH = 4, SEQ = 4096, DM = 2048, M = BATCH * SEQ;
constexpr int DI = 4096, HD = 64, NH = 64, NG = 8, HPG = 8, NS = 128, CONVK = 4;
constexpr int CONV_DIM = DI + 2 * NG * NS;
constexpr int SSM_IN = DI + CONV_DIM + NH;
constexpr int N1 = DI + CONV_DIM;
constexpr int BCW = 2 * NG * NS;
constexpr int DP = 4096, PG = 4, PGD = 1024;
constexpr float EPS = 1e-6f;

constexpr size_t MiB = 1u << 20;
constexpr size_t WS_CTL = 0, CTL_ZERO_BYTES = 1 * MiB;
constexpr size_t WS_DT  = 1 * MiB;
constexpr size_t WS_W1T = 5 * MiB;
constexpr size_t WS_W2T = 46 * MiB;
constexpr size_t WS_W3T = 62 * MiB;
constexpr size_t WS_W4T = 94 * MiB;
constexpr size_t WS_W5T = 102 * MiB;
constexpr size_t WS_RA  = 120 * MiB;
constexpr size_t WS_RB  = 248 * MiB;
constexpr size_t WS_RC  = 440 * MiB;
constexpr size_t WS_SSQP = 504 * MiB;
constexpr size_t WS_END = 512 * MiB;
static_assert(WS_W1T + (size_t)SSM_IN * DM * 2 <= WS_W2T && WS_W2T + (size_t)DM * DI * 2 <= WS_W3T && WS_W3T + (size_t)2 * DP * DM * 2 <= WS_W4T && WS_W4T + (size_t)DP * PGD * 2 <= WS_W5T && WS_W5T + (size_t)DM * DP * 2 <= WS_RA, "weights map");
static_assert(WS_RA + (size_t)M * DI * 2 <= WS_RB && WS_RB + (size_t)M * CONV_DIM * 2 <= WS_RC && WS_RC + (size_t)M * DM * 2 <= WS_END && WS_RB + 128 * MiB + (size_t)M * DP * 2 <= WS_END, "activation map");
constexpr int CW_TMO = 64, CW_FIN = 8192;
constexpr int CW_BAR = 4096;
constexpr int CW_SSQ1 = 16384, CW_SSQ2 = CW_SSQ1 + M, CW_SSQ3 = CW_SSQ2 + M;
static_assert((CW_SSQ3 + M) * 4 <= (int)CTL_ZERO_BYTES, "CTL words inside the memset region");

constexpr int RING_OFF = 0, RING_BYTES = 159744;
constexpr int LDSCTL_OFF = RING_BYTES, MISC_OFF = LDSCTL_OFF + 320;
constexpr int LDS_BYTES = 163840;
static_assert(MISC_OFF + 128 <= LDS_BYTES, "LDS map");

#define LAS __attribute__((address_space(3)))
typedef unsigned short bf16;
typedef unsigned v4u __attribute__((ext_vector_type(4)));
typedef unsigned v2u __attribute__((ext_vector_type(2)));
typedef float f32x4 __attribute__((ext_vector_type(4)));
typedef short bf16x8 __attribute__((ext_vector_type(8)));
#define LDS_WAIT() asm volatile("s_waitcnt lgkmcnt(0)" ::: "memory")
#define VM_WAIT() asm volatile("s_waitcnt vmcnt(0)" ::: "memory")
__device__ __forceinline__ unsigned f2bf(float f) { unsigned u = __builtin_bit_cast(unsigned, f); return (u + 0x7fffu + ((u >> 16) & 1u)) >> 16; }
__device__ __forceinline__ unsigned pk2(float lo, float hi) { return f2bf(lo) | (f2bf(hi) << 16); }
__device__ __forceinline__ float bflo(unsigned w) { return __uint_as_float(w << 16); }
__device__ __forceinline__ float bfhi(unsigned w) { return __uint_as_float(w & 0xffff0000u); }
__device__ __forceinline__ float bf1(bf16 v) { return __uint_as_float(((unsigned)v) << 16); }
__device__ __forceinline__ float sigm(float v) { return __builtin_amdgcn_rcpf(1.0f + __builtin_amdgcn_exp2f(-1.4426950408889634f * v)); }
__device__ __forceinline__ float wave_sum(float v) {
#pragma unroll
    for (int o = 1; o < 64; o <<= 1) v += __shfl_xor(v, o);
    return v;
}

#define XB_TMO      128
#define XB_XCNT(j)  (256  + 64 * (j))
#define XB_XSUB(j)  (1280 + 64 * (j))
#define XB_XGEN(j)  (2304 + 64 * (j))
#define XB_TOP      3328
#define XB_TOPGEN   3392
#define XCD_BAR_WORDS 3456
#define XB_SPIN_CAP (1u << 18)

__device__ __forceinline__ unsigned xb_ld(unsigned* p)              { return __hip_atomic_load(p, __ATOMIC_RELAXED, __HIP_MEMORY_SCOPE_AGENT); }
__device__ __forceinline__ unsigned xb_add(unsigned* p, unsigned v) { return __hip_atomic_fetch_add(p, v, __ATOMIC_RELAXED, __HIP_MEMORY_SCOPE_AGENT); }
__device__ __forceinline__ unsigned xb_xcc_id() { return (unsigned)__builtin_amdgcn_s_getreg((3 << 11) | 20) & 0xFu; }
#define XB_SPIN(cond, bar) do { unsigned _sp = 0; while (cond) { __builtin_amdgcn_s_sleep(1); \
    if ((++_sp & 255u) == 0u) { if (xb_ld(&(bar)[XB_TMO])) break; if (_sp > XB_SPIN_CAP) { atomicAdd(&(bar)[XB_TMO], 1u); break; } } } } while (0)

struct XcdBarrier {
    unsigned* bar; unsigned x;
    volatile LAS unsigned* st;
};

__device__ __forceinline__ XcdBarrier xcd_barrier_post(unsigned* bar, volatile LAS unsigned* st) {
    XcdBarrier b; b.bar = bar; b.x = xb_xcc_id(); b.st = st;
    if (threadIdx.x == 0) (void)xb_add(&bar[XB_XCNT(b.x)], 1u);
    return b;
}
__device__ __forceinline__ void xcd_barrier_complete(unsigned* bar, unsigned x, unsigned& nloc, unsigned& nx) {
    const unsigned G = gridDim.x * gridDim.y * gridDim.z;
    unsigned sum, cnt, mine, sp = 0u;
    for (;;) {
        sum = 0u; cnt = 0u; mine = 0u;
#pragma unroll
        for (unsigned j = 0; j < 16; ++j) { const unsigned c = xb_ld(&bar[XB_XCNT(j)]); sum += c; cnt += (c > 0u) ? 1u : 0u; mine = (j == x) ? c : mine; }
        if (sum == G) break;
        __builtin_amdgcn_s_sleep(1);
        if ((++sp & 255u) == 0u) { if (xb_ld(&bar[XB_TMO])) break; if (sp > XB_SPIN_CAP) { atomicAdd(&bar[XB_TMO], 1u); break; } }
    }
    nloc = mine > 0u ? mine : 1u; nx = cnt > 0u ? cnt : 1u;
}

__device__ __forceinline__ void xcd_barrier(const XcdBarrier& b) {
    asm volatile("s_waitcnt vmcnt(0)" ::: "memory");
    __syncthreads();
    if (threadIdx.x == 0) {
        unsigned* bar = b.bar;
        __builtin_amdgcn_s_waitcnt(0);
        unsigned nloc = b.st[0], nx = b.st[1];
        if (nloc == 0u) { xcd_barrier_complete(bar, b.x, nloc, nx); b.st[0] = nloc; b.st[1] = nx; }
        const unsigned old = xb_add(&bar[XB_XSUB(b.x)], 1u);
        const unsigned gen = old / nloc;
        if (old + 1u == (gen + 1u) * nloc) {
            __builtin_amdgcn_fence(__ATOMIC_RELEASE, "agent");
            asm volatile("s_waitcnt vmcnt(0)" ::: "memory");
            const unsigned og = xb_add(&bar[XB_TOP], 1u);
            const unsigned tg = og / nx;
            if (og + 1u == (tg + 1u) * nx) xb_add(&bar[XB_TOPGEN], 1u);
            else XB_SPIN(xb_ld(&bar[XB_TOPGEN]) == tg, bar);
            __builtin_amdgcn_fence(__ATOMIC_ACQUIRE, "agent");
            xb_add(&bar[XB_XGEN(b.x)], 1u);
            asm volatile("s_waitcnt vmcnt(0)" ::: "memory");
        } else {
            XB_SPIN(xb_ld(&bar[XB_XGEN(b.x)]) == gen, bar);
            __builtin_amdgcn_fence(__ATOMIC_ACQUIRE, "agent");
            asm volatile("s_waitcnt vmcnt(0)" ::: "memory");
        }
    }
    __syncthreads();
}

struct Ctx { LAS unsigned char* lds; int tid, lane, wave, G, vcu; };

struct Ptrs {
    const float *x, *ln_g, *final_g, *ssm_w_in, *conv_w, *conv_b, *dt_bias, *a_log, *ssm_d, *norm_g, *ssm_w_out, *pool_w_in, *pool_w_group, *pool_scale, *pool_w_out;
    float* out; unsigned char* ws;
};

__device__ __forceinline__ void t_decode(const Ptrs& P, int it, const float*& src, const float*& gain, bf16*& dst, int& ldw, int& K) {
    constexpr int I1 = (DM / 64) * (SSM_IN / 32), I2 = (DI / 64) * (DM / 32), I3 = (DM / 64) * (DP / 32), I4G = (PGD / 64) * (PGD / 32), I4 = PG * I4G;
    const float* W; const float* g; bf16* WT; int N, row_off = 0, r = it;
    if (r < I1) { W = P.ssm_w_in; g = P.ln_g; K = DM; N = SSM_IN; ldw = SSM_IN; WT = (bf16*)(P.ws + WS_W1T); }
    else if ((r -= I1) < I2) { W = P.ssm_w_out; g = P.norm_g; K = DI; N = DM; ldw = DM; WT = (bf16*)(P.ws + WS_W2T); }
    else if ((r -= I2) < I3) { W = P.pool_w_in + DP; g = P.ln_g + DM; K = DM; N = DP; ldw = 2 * DP; WT = (bf16*)(P.ws + WS_W3T); row_off = DP; }
    else if ((r -= I3) < I4) { const int gi = r / I4G; r -= gi * I4G; W = P.pool_w_group + (size_t)gi * PGD * PGD; g = nullptr; K = PGD; N = PGD; ldw = PGD; WT = (bf16*)(P.ws + WS_W4T); row_off = gi * PGD; }
    else { r -= I4; W = P.pool_w_out; g = nullptr; K = DP; N = DM; ldw = DM; WT = (bf16*)(P.ws + WS_W5T); }
    const int nblk = N / 32, kb = r / nblk, nb = r - kb * nblk, k0 = 64 * kb, n0 = 32 * nb;
    src = W + (size_t)k0 * ldw + n0; gain = g ? g + k0 : nullptr; dst = WT + (size_t)(row_off + n0) * K + k0;
}
__device__ __forceinline__ void t_load(const float* src, const float* gain, int ldw, int lane, f32x4 (&v)[8], float (&gv)[8]) {
#pragma unroll
    for (int i = 0; i < 8; ++i) { const int kk = 8 * i + (lane >> 3); v[i] = *(const f32x4*)(src + (size_t)kk * ldw + 4 * (lane & 7)); gv[i] = gain ? gain[kk] : 1.0f; }
}
__device__ __forceinline__ void t_process(bf16* dst, int K, int lane, LAS float* scr, const f32x4 (&v)[8], const float (&gv)[8]) {
#pragma unroll
    for (int i = 0; i < 8; ++i) *(LAS f32x4*)(scr + (8 * i + (lane >> 3)) * 32 + (((lane & 7) ^ i) << 2)) = v[i] * gv[i];
    LDS_WAIT(); asm volatile("" ::: "memory");
    const int c = lane & 7, nn = lane >> 3;
#pragma unroll
    for (int j = 0; j < 4; ++j) { const int n = nn + 8 * j; const LAS float* s = scr + (8 * c) * 32 + (((n >> 2) ^ c) << 2) + (n & 3);
        v4u o; o.x = pk2(s[0 * 32], s[1 * 32]); o.y = pk2(s[2 * 32], s[3 * 32]); o.z = pk2(s[4 * 32], s[5 * 32]); o.w = pk2(s[6 * 32], s[7 * 32]);
        *(v4u*)(dst + (size_t)n * K + 8 * c) = o; }
    LDS_WAIT(); asm volatile("" ::: "memory");
}
__device__ __forceinline__ void r_decode(const Ptrs& P, int r, const float*& src, bf16*& dst, float& scale, float*& ssq) {
    if (r < M) { src = P.x + (size_t)r * DM; dst = (bf16*)(P.ws + WS_RC) + (size_t)r * DM; scale = 1.0f; ssq = (float*)(P.ws + WS_CTL) + CW_SSQ1 + r; }
    else { const int rr = r - M, m = rr >> 1, hf = rr & 1; src = P.pool_w_in + (size_t)m * 2 * DP + hf * DM; dst = (bf16*)P.out + (size_t)m * DP + hf * DM; scale = P.ln_g[DM + m]; ssq = nullptr; }
}
__device__ __forceinline__ void r_load(const float* src, int lane, f32x4 (&v)[8]) {
#pragma unroll
    for (int j = 0; j < 8; ++j) v[j] = ((const f32x4*)src)[lane + 64 * j];
}
__device__ __forceinline__ void r_process(bf16* dst, float scale, float* ssq, int lane, const f32x4 (&v)[8]) {
    if (ssq) { float s = 0.f;
#pragma unroll
        for (int j = 0; j < 8; ++j) s += (v[j].x * v[j].x + v[j].y * v[j].y) + (v[j].z * v[j].z + v[j].w * v[j].w);
        s = wave_sum(s); if (lane == 0) *ssq = s; }
#pragma unroll
    for (int j = 0; j < 8; ++j) { v2u w; w.x = pk2(v[j].x * scale, v[j].y * scale); w.y = pk2(v[j].z * scale, v[j].w * scale); ((v2u*)dst)[lane + 64 * j] = w; }
}
__device__ __forceinline__ int t_map(int li, int mode) {
    constexpr int I1 = (DM / 64) * (SSM_IN / 32), I2 = (DI / 64) * (DM / 32), I3 = (DM / 64) * (DP / 32), I4 = PG * (PGD / 64) * (PGD / 32);
    return mode == 0 ? (li < I1 ? li : li + I2) : (li < I2 ? I1 + li : I1 + I3 + I4 + li);
}
__device__ __forceinline__ void prep_transposes(const Ctx& F, const Ptrs& P, int mode, int gw, int NGW) {
    LAS float* scr = (LAS float*)(F.lds + RING_OFF + F.wave * 16384);
    const int lane = F.lane;
    constexpr int I1 = (DM / 64) * (SSM_IN / 32), I2 = (DI / 64) * (DM / 32), I3 = (DM / 64) * (DP / 32), I4 = PG * (PGD / 64) * (PGD / 32), I5 = (DP / 64) * (DM / 32);
    const int NT = mode == 0 ? I1 + I3 + I4 : I2 + I5;
    if (gw >= NT) return;
    const int cnt = (NT - gw + NGW - 1) / NGW;
    const float *sA, *gA, *sB, *gB; bf16 *dA, *dB; int lA, kA, lB, kB; f32x4 vA[8], vB[8]; float fA[8], fB[8];
    t_decode(P, t_map(gw, mode), sA, gA, dA, lA, kA); t_load(sA, gA, lA, lane, vA, fA);
    for (int j = 0; j < cnt; j += 2) {
        { const int jn = (j + 1 < cnt) ? j + 1 : cnt - 1; t_decode(P, t_map(gw + jn * NGW, mode), sB, gB, dB, lB, kB); t_load(sB, gB, lB, lane, vB, fB); }
        t_process(dA, kA, lane, scr, vA, fA);
        { const int jn = (j + 2 < cnt) ? j + 2 : cnt - 1; t_decode(P, t_map(gw + jn * NGW, mode), sA, gA, dA, lA, kA); t_load(sA, gA, lA, lane, vA, fA); }
        if (j + 1 < cnt) t_process(dB, kB, lane, scr, vB, fB);
    }
}
__device__ __forceinline__ void phase_prep(const Ctx& F, const Ptrs& P) {
    const int gw = F.vcu * NWAVES + F.wave, NGW = F.G * NWAVES, lane = F.lane;
    prep_transposes(F, P, 0, gw, NGW);
    {
        constexpr int NR = M + 2 * DM;
        const int cnt = (NR - gw + NGW - 1) / NGW;
        const float *sA, *sB; bf16 *dA, *dB; float cA, cB; float *qA, *qB; f32x4 vA[8], vB[8];
        r_decode(P, gw, sA, dA, cA, qA); r_load(sA, lane, vA);
        for (int j = 0; j < cnt; j += 2) {
            { const int jn = (j + 1 < cnt) ? j + 1 : cnt - 1; r_decode(P, gw + jn * NGW, sB, dB, cB, qB); r_load(sB, lane, vB); }
            r_process(dA, cA, qA, lane, vA);
            { const int jn = (j + 2 < cnt) ? j + 2 : cnt - 1; r_decode(P, gw + jn * NGW, sA, dA, cA, qA); r_load(sA, lane, vA); }
            if (j + 1 < cnt) r_process(dB, cB, qB, lane, vB);
        }
    }
}

__device__ __forceinline__ float softplus_f(float v) { return fmaxf(v, 0.f) + log1pf(expf(-fabsf(v))); }

__device__ __forceinline__ void phase_dt(const Ctx& F, const Ptrs& P) {
    const bf16* XB = (const bf16*)(P.ws + WS_RC); const bf16* WDT = (const bf16*)(P.ws + WS_W1T) + (size_t)N1 * DM;
    const float* ssq1 = (const float*)(P.ws + WS_CTL) + CW_SSQ1; float* DT = (float*)(P.ws + WS_DT);
    LAS float* part = (LAS float*)F.lds;
    const int w = F.wave, lane = F.lane, fr = lane & 15, fq = lane >> 4;
    for (int item = F.vcu; item < M / 64; item += F.G) {
        const int r0 = item * 64;
        f32x4 acc[4][4];
#pragma unroll
        for (int i = 0; i < 4; ++i)
#pragma unroll
            for (int j = 0; j < 4; ++j) acc[i][j] = (f32x4){0.f, 0.f, 0.f, 0.f};
        const bf16* ap = XB + (size_t)(r0 + fr) * DM + w * 256 + 8 * fq;
        const bf16* bp = WDT + (size_t)fr * DM + w * 256 + 8 * fq;
#pragma unroll
        for (int hf = 0; hf < 2; ++hf) {
            bf16x8 a[4][4], b[4][4];
#pragma unroll
            for (int ks = 0; ks < 4; ++ks)
#pragma unroll
                for (int t = 0; t < 4; ++t) { a[ks][t] = *(const bf16x8*)(ap + (size_t)(16 * t) * DM + 32 * (4 * hf + ks)); b[ks][t] = *(const bf16x8*)(bp + (size_t)(16 * t) * DM + 32 * (4 * hf + ks)); }
#pragma unroll
            for (int ks = 0; ks < 4; ++ks)
#pragma unroll
                for (int rt = 0; rt < 4; ++rt)
#pragma unroll
                    for (int ct = 0; ct < 4; ++ct) acc[rt][ct] = __builtin_amdgcn_mfma_f32_16x16x32_bf16(a[ks][rt], b[ks][ct], acc[rt][ct], 0, 0, 0);
        }
#pragma unroll
        for (int rt = 0; rt < 4; ++rt)
#pragma unroll
            for (int ct = 0; ct < 4; ++ct) *(LAS f32x4*)(part + (size_t)w * 4096 + (16 * ct + fr) * 64 + 16 * rt + 4 * fq) = acc[rt][ct];
        __syncthreads();
        {
            const int hd = F.tid & 63, rb = 8 * (F.tid >> 6);
            f32x4 s0 = (f32x4){0.f, 0.f, 0.f, 0.f}, s1 = s0;
#pragma unroll
            for (int pw = 0; pw < 8; ++pw) { s0 = s0 + *(const LAS f32x4*)(part + (size_t)pw * 4096 + hd * 64 + rb); s1 = s1 + *(const LAS f32x4*)(part + (size_t)pw * 4096 + hd * 64 + rb + 4); }
            const float bias = P.dt_bias[hd];
#pragma unroll
            for (int i = 0; i < 8; ++i) { const int row = r0 + rb + i; const float sc = rsqrtf(ssq1[row] * (1.0f / DM) + EPS); const float v = (i < 4 ? s0[i & 3] : s1[i & 3]) * sc + bias;
                DT[(size_t)row * NH + hd] = softplus_f(v); }
        }
        __syncthreads();
    }
}

constexpr int IMG_C = 0, IMG_B = 16384, IMG_BT = 32768, IMG_BYTES = 49152;
constexpr int SC_BYTES = 1024, BL_C = 0, BL_BT = 16384, BL_CBT = 32768, BL_SC = BL_CBT + 10 * 1024, BLOB_BYTES = BL_SC + 8 * SC_BYTES;
constexpr int MAIN_BYTES = 32768 + SC_BYTES, HEAD_BYTES = 10 * 1024 + SC_BYTES;
constexpr int SL_MAIN = 0, SL_HEAD = 2 * MAIN_BYTES, SL_XT = SL_HEAD + 2 * HEAD_BYTES, SL_XWT = SL_XT + 2 * 8192, SL_P = SL_XWT + 2 * 8192, SL_YT = SL_P + 2 * 8192, SL_END = SL_YT + 2 * 8192;
static_assert(SL_END <= RING_BYTES, "SSD LDS map");
__device__ __forceinline__ int img256(int r, int c) { return r * 256 + ((c ^ (r & 15)) << 4); }
__device__ __forceinline__ int img128(int r, int c) { return r * 128 + ((c ^ ((r >> 1) & 7)) << 4); }
typedef __bf16 bf16x2_t __attribute__((ext_vector_type(2)));
typedef float f32x2_t __attribute__((ext_vector_type(2)));
__device__ __forceinline__ unsigned cvtpk(float lo, float hi) { f32x2_t v = {lo, hi}; bf16x2_t b = __builtin_convertvector(v, bf16x2_t); return __builtin_bit_cast(unsigned, b); }
#define RAW_BARRIER() do { asm volatile("s_waitcnt lgkmcnt(0)" ::: "memory"); __builtin_amdgcn_s_barrier(); asm volatile("" ::: "memory"); } while (0)

__device__ __forceinline__ void bc_load(const bf16* XBC, const float* DT, int unit, int isC, int n0, int tg, int wave, int lane, v4u (&raw)[7], float& dtv) {
    const int g = unit % NG, bc = unit / NG, c = bc % (SEQ / 64);
    const int ch = DI + isC * (NG * NS) + g * NS + n0;
    const size_t T0 = (size_t)bc * 64 + 4 * tg;
    const bool nohalo = (c == 0 && tg == 0);
#pragma unroll
    for (int k = 0; k < 7; ++k) { const size_t row = (k < 3 && nohalo) ? T0 : (T0 + k - 3); raw[k] = *(const v4u*)(XBC + row * CONV_DIM + ch); }
    dtv = DT[((size_t)bc * 64 + lane) * NH + g * HPG + wave];
}
__device__ __forceinline__ void bc_process(const Ctx& F, const Ptrs& P, unsigned char* IMGS, int unit, int isC, int n0, int tg, const float (&w)[4][8], const float (&bias)[8], const v4u (&rawv)[7], float dtv) {
    LAS unsigned char* L = F.lds;
    const int g = unit % NG, bc = unit / NG, c = bc % (SEQ / 64);
    const bool nohalo = (c == 0 && tg == 0);
    float raw[7][8];
#pragma unroll
    for (int k = 0; k < 7; ++k) { v4u rr = rawv[k];
        if (k < 3 && nohalo) { rr.x = 0u; rr.y = 0u; rr.z = 0u; rr.w = 0u; }
        raw[k][0] = bflo(rr.x); raw[k][1] = bfhi(rr.x); raw[k][2] = bflo(rr.y); raw[k][3] = bfhi(rr.y); raw[k][4] = bflo(rr.z); raw[k][5] = bfhi(rr.z); raw[k][6] = bflo(rr.w); raw[k][7] = bfhi(rr.w); }
    float o[4][8];
#pragma unroll
    for (int i = 0; i < 4; ++i)
#pragma unroll
        for (int j = 0; j < 8; ++j) { const float v = bias[j] + w[0][j] * raw[i][j] + w[1][j] * raw[i + 1][j] + w[2][j] * raw[i + 2][j] + w[3][j] * raw[i + 3][j]; o[i][j] = v * sigm(v); }
    const int ks = n0 >> 5, hi = (n0 >> 4) & 1, q0 = 2 * ((n0 >> 3) & 1);
    const int ibase = isC ? IMG_C : IMG_B;
#pragma unroll
    for (int i = 0; i < 4; ++i) { const int l = 4 * tg + i;
        v2u lo, hi2; lo.x = cvtpk(o[i][0], o[i][1]); lo.y = cvtpk(o[i][2], o[i][3]); hi2.x = cvtpk(o[i][4], o[i][5]); hi2.y = cvtpk(o[i][6], o[i][7]);
        *(LAS v2u*)(L + ibase + img256(l, 4 * ks + q0) + 8 * hi) = lo;
        *(LAS v2u*)(L + ibase + img256(l, 4 * ks + q0 + 1) + 8 * hi) = hi2; }
    if (!isC) {
#pragma unroll
        for (int e = 0; e < 8; ++e) { v2u t; t.x = cvtpk(o[0][e], o[1][e]); t.y = cvtpk(o[2][e], o[3][e]);
            *(LAS v2u*)(L + IMG_BT + img128(n0 + e, tg >> 1) + 8 * (tg & 1)) = t; }
    }
    RAW_BARRIER();
    unsigned char* blob = IMGS + (size_t)unit * BLOB_BYTES;
#pragma unroll
    for (int k = 0; k < 2; ++k) { const v4u vc = *(const LAS v4u*)(L + IMG_C + F.tid * 16 + k * 8192), vt = *(const LAS v4u*)(L + IMG_BT + F.tid * 16 + k * 8192);
        *(v4u*)(blob + BL_C + F.tid * 16 + k * 8192) = vc; *(v4u*)(blob + BL_BT + F.tid * 16 + k * 8192) = vt; }
    {
        const int w = F.wave, r = F.lane & 15, q = F.lane >> 4;
        const int lt0 = (w < 4) ? w : (w == 4) ? 1 : (w == 5) ? 2 : 3, st0 = (w < 4) ? w : (w == 4) ? 0 : (w == 7) ? 2 : 1;
#pragma unroll
        for (int tt = 0; tt < 2; ++tt) { if (tt == 1 && (w < 4 || w > 5)) break;
            const int lt = tt ? lt0 + 1 : lt0, st = tt ? 0 : st0;
            f32x4 cb = {0.f, 0.f, 0.f, 0.f};
#pragma unroll
            for (int ks = 0; ks < 4; ++ks) { const bf16x8 av = *(const LAS bf16x8*)(L + IMG_C + img256(16 * lt + r, 4 * ks + q)), bv = *(const LAS bf16x8*)(L + IMG_B + img256(16 * st + r, 4 * ks + q));
                cb = __builtin_amdgcn_mfma_f32_16x16x32_bf16(av, bv, cb, 0, 0, 0); }
            *(f32x4*)(blob + BL_CBT + (tt ? 8 + (w - 4) : w) * 1024 + F.lane * 16) = cb; }
    }
    {
        const int hh = g * HPG + F.wave; const float a = -expf(P.a_log[hh]);
        float cs = a * dtv;
#pragma unroll
        for (int o2 = 1; o2 < 64; o2 <<= 1) { const float t = __shfl_up(cs, o2); if (F.lane >= o2) cs += t; }
        const float last = __shfl(cs, 63);
        float* sc = (float*)(blob + BL_SC + F.wave * SC_BYTES);
        sc[F.lane] = dtv; sc[64 + F.lane] = cs; sc[128 + F.lane] = __expf(cs); sc[192 + F.lane] = dtv * __expf(last - cs);
    }
    RAW_BARRIER();
}
__device__ __forceinline__ void phase_bcprep(const Ctx& F, const Ptrs& P) {
    const bf16* XBC = (const bf16*)(P.ws + WS_RB); unsigned char* IMGS = (unsigned char*)P.out; const float* DT = (const float*)(P.ws + WS_DT);
    const int cg = F.tid & 31, tg = F.tid >> 5, isC = cg >> 4, n0 = 8 * (cg & 15);
    constexpr int NU = BATCH * (SEQ / 64) * NG;
    if (F.G % NG != 0 || F.vcu >= NU) return;
    const int g = F.vcu % NG, ch = DI + isC * (NG * NS) + g * NS + n0, cnt = (NU - F.vcu + F.G - 1) / F.G;
    float w[4][8], bias[8];
#pragma unroll
    for (int k = 0; k < 4; ++k) { const f32x4 a = *(const f32x4*)(P.conv_w + (size_t)k * CONV_DIM + ch), b = *(const f32x4*)(P.conv_w + (size_t)k * CONV_DIM + ch + 4);
        w[k][0] = a.x; w[k][1] = a.y; w[k][2] = a.z; w[k][3] = a.w; w[k][4] = b.x; w[k][5] = b.y; w[k][6] = b.z; w[k][7] = b.w; }
    { const f32x4 a = *(const f32x4*)(P.conv_b + ch), b = *(const f32x4*)(P.conv_b + ch + 4); bias[0] = a.x; bias[1] = a.y; bias[2] = a.z; bias[3] = a.w; bias[4] = b.x; bias[5] = b.y; bias[6] = b.z; bias[7] = b.w; }
    v4u rA[7], rB[7]; float dA, dB;
    bc_load(XBC, DT, F.vcu, isC, n0, tg, F.wave, F.lane, rA, dA);
    for (int j = 0; j < cnt; j += 2) {
        { const int jn = (j + 1 < cnt) ? j + 1 : j; bc_load(XBC, DT, F.vcu + jn * F.G, isC, n0, tg, F.wave, F.lane, rB, dB); }
        bc_process(F, P, IMGS, F.vcu + j * F.G, isC, n0, tg, w, bias, rA, dA);
        if (j + 1 < cnt) {
            { const int jn = (j + 2 < cnt) ? j + 2 : j + 1; bc_load(XBC, DT, F.vcu + jn * F.G, isC, n0, tg, F.wave, F.lane, rA, dA); }
            bc_process(F, P, IMGS, F.vcu + (j + 1) * F.G, isC, n0, tg, w, bias, rB, dB);
        }
    }
}

__device__ __forceinline__ int dpp_i(int v, const int ctrl_sel) { return ctrl_sel == 0 ? __builtin_amdgcn_update_dpp(0, v, 0xB1, 0xF, 0xF, false) : ctrl_sel == 1 ? __builtin_amdgcn_update_dpp(0, v, 0x4E, 0xF, 0xF, false) : __builtin_amdgcn_update_dpp(0, v, 0x141, 0xF, 0xF, false); }
__device__ __forceinline__ float dpp_add(float v, const int sel) { return v + __int_as_float(dpp_i(__float_as_int(v), sel)); }
template <bool DIAG> __device__ __forceinline__ void ssd_p_tile(LAS unsigned char* Pbuf, const LAS unsigned char* CBT, const LAS float* SC, int slot, int lane, int lt, int st, int r, int q, float Dh) {
    const f32x4 cb = *(const LAS f32x4*)(CBT + slot * 1024 + lane * 16);
    const f32x4 csl = *(const LAS f32x4*)(SC + 64 + 16 * lt + 4 * q);
    const int s = 16 * st + r; const float cs_s = SC[64 + s], dt_s = SC[s];
#pragma unroll
    for (int rg = 0; rg < 4; ++rg) { const int l = 16 * lt + 4 * q + rg; float v;
        if (DIAG) { v = cb[rg] * __expf(fminf(csl[rg] - cs_s, 0.f)) * dt_s; v = (s <= l) ? v : 0.f; if (s == l) v += Dh; }
        else v = cb[rg] * __expf(csl[rg] - cs_s) * dt_s;
        *(LAS unsigned short*)(Pbuf + img128(l, s >> 3) + (s & 7) * 2) = (unsigned short)(cvtpk(v, 0.f) & 0xffffu); }
}
struct ConvW { float a[4], b[4], ba, bb; };
__device__ __forceinline__ void ssd_head(LAS unsigned char* L, int par, int hpar, bool first_chunk, const unsigned (&xr)[7], int w, int lane, int r, int q, const ConvW& cw, float Dh) {
    const LAS unsigned char* HD = L + SL_HEAD + hpar * HEAD_BYTES; const LAS float* SC = (const LAS float*)(HD + 10 * 1024);
    {
        const int cp = lane & 31, hf = lane >> 5;
        const f32x4 wv4 = *(const LAS f32x4*)(SC + 192 + 8 * w + 4 * hf);
        float xa[7], xc[7];
#pragma unroll
        for (int k = 0; k < 7; ++k) { const bool zpad = first_chunk && w == 0 && hf == 0 && k < 3; xa[k] = zpad ? 0.f : bflo(xr[k]); xc[k] = zpad ? 0.f : bfhi(xr[k]); }
        float oa[4], oc[4], wa[4], wc[4];
#pragma unroll
        for (int i = 0; i < 4; ++i) { const float va = cw.ba + cw.a[0] * xa[i] + cw.a[1] * xa[i + 1] + cw.a[2] * xa[i + 2] + cw.a[3] * xa[i + 3], vc = cw.bb + cw.b[0] * xc[i] + cw.b[1] * xc[i + 1] + cw.b[2] * xc[i + 2] + cw.b[3] * xc[i + 3];
            oa[i] = va * sigm(va); oc[i] = vc * sigm(vc); wa[i] = oa[i] * wv4[i]; wc[i] = oc[i] * wv4[i]; }
        v2u t; LAS unsigned char* XTb = L + SL_XT + par * 8192; LAS unsigned char* XWb = L + SL_XWT + par * 8192;
        const int o0 = img128(2 * cp, w) + 8 * hf, o1 = img128(2 * cp + 1, w) + 8 * hf;
        t.x = cvtpk(oa[0], oa[1]); t.y = cvtpk(oa[2], oa[3]); *(LAS v2u*)(XTb + o0) = t;
        t.x = cvtpk(oc[0], oc[1]); t.y = cvtpk(oc[2], oc[3]); *(LAS v2u*)(XTb + o1) = t;
        t.x = cvtpk(wa[0], wa[1]); t.y = cvtpk(wa[2], wa[3]); *(LAS v2u*)(XWb + o0) = t;
        t.x = cvtpk(wc[0], wc[1]); t.y = cvtpk(wc[2], wc[3]); *(LAS v2u*)(XWb + o1) = t;
    }
    LAS unsigned char* Pb = L + SL_P + par * 8192;
    if (w < 4) ssd_p_tile<true>(Pb, HD, SC, w, lane, w, w, r, q, Dh);
    else { const int lt1 = (w == 4) ? 1 : (w == 5) ? 2 : 3, st1 = (w == 4) ? 0 : (w == 7) ? 2 : 1;
        ssd_p_tile<false>(Pb, HD, SC, w, lane, lt1, st1, r, q, Dh);
        if (w < 6) ssd_p_tile<false>(Pb, HD, SC, 8 + (w - 4), lane, lt1 + 1, 0, r, q, Dh); }
}
__device__ __forceinline__ void ssd_mfma(LAS unsigned char* L, int par, f32x4 (&st)[8], int lane, int r, int q, int pt, int lh, const int (&a256)[4], const int (&a128)[2]) {
    const LAS unsigned char* IC = L + SL_MAIN + par * MAIN_BYTES; const LAS unsigned char* IBT = IC + 16384; const LAS float* SC = (const LAS float*)(IC + 32768);
    f32x4 acc[2] = {(f32x4){0.f, 0.f, 0.f, 0.f}, (f32x4){0.f, 0.f, 0.f, 0.f}};
    {
        bf16x8 yav[4][2], sb[4];
#pragma unroll
        for (int ks = 0; ks < 4; ++ks) {
#pragma unroll
            for (int t = 0; t < 2; ++t) yav[ks][t] = *(const LAS bf16x8*)(IC + 4096 * (2 * lh + t) + a256[ks]);
            v4u sbw; sbw.x = cvtpk(st[2 * ks][0], st[2 * ks][1]); sbw.y = cvtpk(st[2 * ks][2], st[2 * ks][3]); sbw.z = cvtpk(st[2 * ks + 1][0], st[2 * ks + 1][1]); sbw.w = cvtpk(st[2 * ks + 1][2], st[2 * ks + 1][3]);
            sb[ks] = __builtin_bit_cast(bf16x8, sbw); }
#pragma unroll
        for (int ks = 0; ks < 4; ++ks)
#pragma unroll
            for (int t = 0; t < 2; ++t) acc[t] = __builtin_amdgcn_mfma_f32_16x16x32_bf16(yav[ks][t], sb[ks], acc[t], 0, 0, 0);
    }
    { const float elast = SC[128 + 63];
#pragma unroll
      for (int t = 0; t < 2; ++t) { const f32x4 ev4 = *(const LAS f32x4*)(SC + 128 + 16 * (2 * lh + t) + 4 * q); acc[t] = acc[t] * ev4; }
#pragma unroll
      for (int j = 0; j < 8; ++j) st[j] = st[j] * elast; }
    {
        const LAS unsigned char* XTb = L + SL_XT + par * 8192; const LAS unsigned char* XWb = L + SL_XWT + par * 8192; const LAS unsigned char* Pb = L + SL_P + par * 8192;
        bf16x8 xb[2], pav[2][2], xwb[2], bav[2][8];
#pragma unroll
        for (int ks = 0; ks < 2; ++ks) { xb[ks] = *(const LAS bf16x8*)(XTb + 2048 * pt + a128[ks]); xwb[ks] = *(const LAS bf16x8*)(XWb + 2048 * pt + a128[ks]);
#pragma unroll
            for (int t = 0; t < 2; ++t) pav[ks][t] = *(const LAS bf16x8*)(Pb + 2048 * (2 * lh + t) + a128[ks]);
#pragma unroll
            for (int j = 0; j < 8; ++j) bav[ks][j] = *(const LAS bf16x8*)(IBT + 2048 * j + a128[ks]); }
#pragma unroll
        for (int t = 0; t < 2; ++t) acc[t] = __builtin_amdgcn_mfma_f32_16x16x32_bf16(pav[0][t], xb[0], acc[t], 0, 0, 0);
        if (lh == 1) {
#pragma unroll
            for (int t = 0; t < 2; ++t) acc[t] = __builtin_amdgcn_mfma_f32_16x16x32_bf16(pav[1][t], xb[1], acc[t], 0, 0, 0); }
#pragma unroll
        for (int ks = 0; ks < 2; ++ks)
#pragma unroll
            for (int j = 0; j < 8; ++j) st[j] = __builtin_amdgcn_mfma_f32_16x16x32_bf16(bav[ks][j], xwb[ks], st[j], 0, 0, 0);
    }
#pragma unroll
    for (int t = 0; t < 2; ++t) { const int p = 16 * pt + r; v2u yw; yw.x = cvtpk(acc[t][0], acc[t][1]); yw.y = cvtpk(acc[t][2], acc[t][3]);
        *(LAS v2u*)(L + SL_YT + par * 8192 + img128(p, 2 * (2 * lh + t) + (q >> 1)) + 8 * (q & 1)) = yw; }
}
__device__ __forceinline__ void ssd_epi(const LAS unsigned char* L, int par, const unsigned (&zr)[4], int w, int lane, unsigned (&ob)[4], float& s1) {
    const int cp = lane & 31, hf = lane >> 5;
    const v2u ya = *(const LAS v2u*)(L + SL_YT + par * 8192 + img128(2 * cp, w) + 8 * hf), yc = *(const LAS v2u*)(L + SL_YT + par * 8192 + img128(2 * cp + 1, w) + 8 * hf);
    const float y0[4] = {bflo(ya.x), bfhi(ya.x), bflo(ya.y), bfhi(ya.y)}, y1[4] = {bflo(yc.x), bfhi(yc.x), bflo(yc.y), bfhi(yc.y)};
    float sq[4];
#pragma unroll
    for (int i = 0; i < 4; ++i) { const float za = bflo(zr[i]), zc = bfhi(zr[i]); const float ga = y0[i] * (za * sigm(za)), gc = y1[i] * (zc * sigm(zc)); sq[i] = ga * ga + gc * gc; ob[i] = cvtpk(ga, gc); }
    float s2[2];
#pragma unroll
    for (int k2 = 0; k2 < 2; ++k2) { const bool hi = (lane & 16) != 0; const float send = hi ? sq[k2] : sq[2 + k2], keep = hi ? sq[2 + k2] : sq[k2]; s2[k2] = keep + __shfl_xor(send, 16); }
    { const bool hi = (lane & 8) != 0; const float send = hi ? s2[0] : s2[1], keep = hi ? s2[1] : s2[0]; s1 = keep + __int_as_float(__builtin_amdgcn_update_dpp(0, __float_as_int(send), 0x128  , 0xF, 0xF, false)); }
    s1 = dpp_add(s1, 0); s1 = dpp_add(s1, 1); s1 = dpp_add(s1, 2);
}
__device__ __forceinline__ void ssd_dma_main(const Ctx& F, const unsigned char* blob_c, int hsub, int w, int lane, int par) {
    LAS unsigned char* dst = F.lds + SL_MAIN + par * MAIN_BYTES;
#pragma unroll
    for (int k = 0; k < 4; ++k) { const int piece = k * 8 + w; __builtin_amdgcn_global_load_lds((const unsigned*)(blob_c + BL_C + piece * 1024) + lane * 4, (LAS unsigned*)(dst + piece * 1024), 16, 0, 0); }
    if (w == 0) __builtin_amdgcn_global_load_lds((const unsigned*)(blob_c + BL_SC + hsub * SC_BYTES) + lane * 4, (LAS unsigned*)(dst + 32768), 16, 0, 0);
}
__device__ __forceinline__ void ssd_dma_head(const Ctx& F, const unsigned char* blob_c, int hsub, int w, int lane, int par) {
    LAS unsigned char* dst = F.lds + SL_HEAD + par * HEAD_BYTES;
    __builtin_amdgcn_global_load_lds((const unsigned*)(blob_c + BL_CBT + w * 1024) + lane * 4, (LAS unsigned*)(dst + w * 1024), 16, 0, 0);
    if (w == 1 || w == 2) __builtin_amdgcn_global_load_lds((const unsigned*)(blob_c + BL_CBT + (7 + w) * 1024) + lane * 4, (LAS unsigned*)(dst + (7 + w) * 1024), 16, 0, 0);
    if (w == 3) __builtin_amdgcn_global_load_lds((const unsigned*)(blob_c + BL_SC + hsub * SC_BYTES) + lane * 4, (LAS unsigned*)(dst + 10 * 1024), 16, 0, 0);
}
template <bool DRY> __device__ __forceinline__ void phase_ssd(const Ctx& F, const Ptrs& P) {
    const bf16* XBC = (const bf16*)(P.ws + WS_RB); bf16* Z = (bf16*)(P.ws + WS_RA);
    float* ssqp = (float*)(P.ws + WS_SSQP); const unsigned char* IMGS = (const unsigned char*)P.out;
    LAS unsigned char* L = F.lds;
    const int w = F.wave, lane = F.lane, r = lane & 15, q = lane >> 4, pt = w & 3, lh = w >> 2;
    constexpr int NC = SEQ / 64;
    for (int unit = F.vcu; unit < BATCH * NH; unit += F.G) {
        const int b = unit / NH, h = unit % NH, g = h / HPG, hsub = h % HPG, cp = lane & 31, hf = lane >> 5, ch = h * HD + 2 * cp;
        const float Dh = P.ssm_d[h];
        ConvW cw;
#pragma unroll
        for (int t = 0; t < 4; ++t) { cw.a[t] = P.conv_w[t * CONV_DIM + ch]; cw.b[t] = P.conv_w[t * CONV_DIM + ch + 1]; }
        cw.ba = P.conv_b[ch]; cw.bb = P.conv_b[ch + 1];
        const unsigned char* blob0 = IMGS + ((size_t)b * NC * NG + g) * BLOB_BYTES;
        const bf16* x0 = XBC + ((size_t)b * SEQ + 8 * w + 4 * hf) * CONV_DIM + h * HD + 2 * cp;
        bf16* z0 = Z + ((size_t)b * SEQ + 8 * w + 4 * hf) * DI + h * HD + 2 * cp;
        const __amdgpu_buffer_rsrc_t rx = __builtin_amdgcn_make_buffer_rsrc((void*)XBC, 0, (int)((size_t)M * CONV_DIM * 2), 0x00020000), rz = __builtin_amdgcn_make_buffer_rsrc((void*)Z, 0, (int)((size_t)M * DI * 2), 0x00020000);
        const unsigned xs0 = (unsigned)((((size_t)b * SEQ + 8 * w) * CONV_DIM + h * HD) * 2), zs0 = (unsigned)((((size_t)b * SEQ + 8 * w) * DI + h * HD) * 2);
        const int xvo = cp * 4 + hf * (4 * CONV_DIM * 2), zvo = cp * 4 + hf * (4 * DI * 2);
        f32x4 st[8];
#pragma unroll
        for (int j = 0; j < 8; ++j) st[j] = (f32x4){0.f, 0.f, 0.f, 0.f};
        int a256[4], a128[2];
#pragma unroll
        for (int ks = 0; ks < 4; ++ks) a256[ks] = img256(r, 4 * ks + q);
#pragma unroll
        for (int ks = 0; ks < 2; ++ks) a128[ks] = img128(r, 4 * ks + q);
        {
          const int l = F.tid >> 3, cch = F.tid & 7; unsigned zz = 0u; asm volatile("" : "+v"(zz));
          if ((cch >> 1) > (l >> 4)) { *(LAS v4u*)(L + SL_P + img128(l, cch)) = (v4u){zz, zz, zz, zz}; *(LAS v4u*)(L + SL_P + 8192 + img128(l, cch)) = (v4u){zz, zz, zz, zz}; } }
        unsigned xr[7], zr[4];
        {
            unsigned x0r[7], x1r[7];
            ssd_dma_main(F, blob0, hsub, w, lane, 0); ssd_dma_head(F, blob0, hsub, w, lane, 0); ssd_dma_head(F, blob0 + (size_t)NG * BLOB_BYTES, hsub, w, lane, 1);
#pragma unroll
            for (int k = 0; k < 7; ++k) { x0r[k] = *(const unsigned*)(x0 + (long)(k - 3) * CONV_DIM); x1r[k] = *(const unsigned*)(x0 + (long)(64 + k - 3) * CONV_DIM); }
            asm volatile("s_waitcnt vmcnt(0)" ::: "memory");
#pragma unroll
            for (int k = 0; k < 7; ++k) { asm volatile("v_mov_b32 %0, %1" : "=v"(xr[k]) : "v"(x1r[k])); asm volatile("" : "+v"(x0r[k])); }
#pragma unroll
            for (int i = 0; i < 4; ++i) zr[i] = 0u;
            RAW_BARRIER();
            ssd_head(L, 0, 0, true, x0r, w, lane, r, q, cw, Dh);
            RAW_BARRIER();
        }
        for (int j = 0; j < NC; ++j) {
            unsigned nxr[7], nzr[4];
#define SSD_ISSUE()             { \
                const int c1 = (j + 1 < NC) ? j + 1 : j, c2 = (j + 2 < NC) ? j + 2 : NC - 1; \
                ssd_dma_main(F, blob0 + (size_t)c1 * NG * BLOB_BYTES, hsub, w, lane, (j + 1) & 1); \
                if (j + 2 < NC) ssd_dma_head(F, blob0 + (size_t)c2 * NG * BLOB_BYTES, hsub, w, lane, j & 1); \
                const unsigned xso = xs0 + (unsigned)(c2 * 64 - 3) * (CONV_DIM * 2), zso = zs0 + (unsigned)(j * 64) * (DI * 2); \
_Pragma("unroll") \
                for (int k = 0; k < 7; ++k) nxr[k] = __builtin_amdgcn_raw_buffer_load_b32(rx, xvo, xso + k * (CONV_DIM * 2), 0); \
_Pragma("unroll") \
                for (int i = 0; i < 4; ++i) nzr[i] = __builtin_amdgcn_raw_buffer_load_b32(rz, zvo, zso + i * (DI * 2), 0); \
            }
            const int igrp = w % 3;
            if (igrp == 0) SSD_ISSUE()
            unsigned eob[4]; float es1;
            ssd_epi(L, (j + 1) & 1, zr, w, lane, eob, es1);
            if (igrp == 1) SSD_ISSUE()
            ssd_mfma(L, j & 1, st, lane, r, q, pt, lh, a256, a128);
            if (igrp == 2) SSD_ISSUE()
            { const int d = (j + 1 < NC) ? j + 1 : j; ssd_head(L, (j + 1) & 1, d & 1, false, xr, w, lane, r, q, cw, Dh); }
            asm volatile("s_waitcnt vmcnt(0)" ::: "memory");
#pragma unroll
            for (int k2 = 0; k2 < 7; ++k2) asm volatile("v_mov_b32 %0, %1" : "=v"(xr[k2]) : "v"(nxr[k2]));
#pragma unroll
            for (int k2 = 0; k2 < 4; ++k2) asm volatile("v_mov_b32 %0, %1" : "=v"(zr[k2]) : "v"(nzr[k2]));
            if (j > 0) {
                const unsigned zso = zs0 + (unsigned)((j - 1) * 64) * (DI * 2);
#pragma unroll
                for (int i = 0; i < 4; ++i) if (!DRY || es1 == 1.2345e30f) __builtin_amdgcn_raw_buffer_store_b32(eob[i], rz, zvo, zso + i * (DI * 2), 0);
                if ((lane & 7) == 0 && (!DRY || es1 == 1.2345e30f)) { const int i = 4 * (lane >> 5) + 2 * ((lane >> 4) & 1) + ((lane >> 3) & 1); ssqp[((size_t)b * SEQ + (j - 1) * 64 + 8 * w + i) * NH + h] = es1; }
            }
            RAW_BARRIER();
        }
        {
            unsigned ob[4]; float s1;
            ssd_epi(L, (NC - 1) & 1, zr, w, lane, ob, s1);
            bf16* zc = z0 + (size_t)(NC - 1) * 64 * DI;
#pragma unroll
            for (int i = 0; i < 4; ++i) if (!DRY || s1 == 1.2345e30f) *(unsigned*)(zc + (long)i * DI) = ob[i];
            if ((lane & 7) == 0 && (!DRY || s1 == 1.2345e30f)) { const int i = 4 * (lane >> 5) + 2 * ((lane >> 4) & 1) + ((lane >> 3) & 1); ssqp[((size_t)b * SEQ + (NC - 1) * 64 + 8 * w + i) * NH + h] = s1; }
        }
        asm volatile("s_waitcnt vmcnt(0)" ::: "memory"); RAW_BARRIER();
    }
}

__device__ __forceinline__ void phase_pool(const Ctx& F, const Ptrs& P) {
    const bf16* V = (const bf16*)(P.ws + WS_RA); const bf16* GT = (const bf16*)(P.ws + WS_RB); bf16* Y2 = (bf16*)(P.ws + WS_RB);
    const int NCG = DP / 8;
    const int nitems = (M / 32) * NCG;
    for (int it = F.vcu * 512 + F.tid; it < nitems; it += F.G * 512) {
        const int cg = it % NCG, tb = it / NCG, c0 = cg * 8, t0 = tb * 32, win = 2 << (c0 / PGD);
        const int pos0 = t0 % SEQ;
        float sc[8]; { const f32x4 a = *(const f32x4*)(P.pool_scale + c0), b = *(const f32x4*)(P.pool_scale + c0 + 4); sc[0] = a.x; sc[1] = a.y; sc[2] = a.z; sc[3] = a.w; sc[4] = b.x; sc[5] = b.y; sc[6] = b.z; sc[7] = b.w; }
        float s[8];
#pragma unroll
        for (int j = 0; j < 8; ++j) s[j] = 0.f;
        for (int d = 1; d < win; ++d) if (pos0 - d >= 0) { const v4u r = *(const v4u*)(V + (size_t)(t0 - d) * DP + c0);
            s[0] += bflo(r.x); s[1] += bfhi(r.x); s[2] += bflo(r.y); s[3] += bfhi(r.y); s[4] += bflo(r.z); s[5] += bfhi(r.z); s[6] += bflo(r.w); s[7] += bfhi(r.w); }
        for (int tt = 0; tt < 32; tt += 8) {
            v4u rv[8], gv[8], qv[8];
#pragma unroll
            for (int u = 0; u < 8; ++u) { const int t = tt + u; rv[u] = *(const v4u*)(V + (size_t)(t0 + t) * DP + c0); gv[u] = *(const v4u*)(GT + (size_t)(t0 + t) * DP + c0);
                const int pd = pos0 + t - (win - 1); qv[u] = *(const v4u*)(V + (size_t)(t0 + t - (pd >= 0 ? win - 1 : 0)) * DP + c0); }
#pragma unroll
            for (int u = 0; u < 8; ++u) { const int t = tt + u, pos = pos0 + t; const v4u r = rv[u], gr = gv[u], q = qv[u];
                const float cur[8] = {bflo(r.x), bfhi(r.x), bflo(r.y), bfhi(r.y), bflo(r.z), bfhi(r.z), bflo(r.w), bfhi(r.w)};
                const float gt[8] = {bflo(gr.x), bfhi(gr.x), bflo(gr.y), bfhi(gr.y), bflo(gr.z), bfhi(gr.z), bflo(gr.w), bfhi(gr.w)};
#pragma unroll
                for (int j = 0; j < 8; ++j) s[j] += cur[j];
                const int cnt = (pos + 1 < win) ? (pos + 1) : win; const float inv = 1.0f / (float)cnt;
                float o[8];
#pragma unroll
                for (int j = 0; j < 8; ++j) o[j] = (s[j] * inv - cur[j]) * sc[j] * (gt[j] * sigm(gt[j]));
                v4u ow; ow.x = pk2(o[0], o[1]); ow.y = pk2(o[2], o[3]); ow.z = pk2(o[4], o[5]); ow.w = pk2(o[6], o[7]);
                *(v4u*)(Y2 + (size_t)(t0 + t) * DP + c0) = ow;
                if (pos - (win - 1) >= 0) {
                    s[0] -= bflo(q.x); s[1] -= bfhi(q.x); s[2] -= bflo(q.y); s[3] -= bfhi(q.y); s[4] -= bflo(q.z); s[5] -= bfhi(q.z); s[6] -= bflo(q.w); s[7] -= bfhi(q.w); } }
        }
    }
}

__device__ __forceinline__ void fin_load(const float* row, int lane, f32x4 (&v)[8]) {
#pragma unroll
    for (int j = 0; j < 8; ++j) v[j] = ((const f32x4*)row)[lane + 64 * j];
}
__device__ __forceinline__ void fin_process(float* row, int lane, const f32x4 (&v)[8], const f32x4 (&gv)[8]) {
    float s = 0.f;
#pragma unroll
    for (int j = 0; j < 8; ++j) s += (v[j].x * v[j].x + v[j].y * v[j].y) + (v[j].z * v[j].z + v[j].w * v[j].w);
    s = wave_sum(s);
    const float rs = rsqrtf(s * (1.0f / DM) + EPS);
#pragma unroll
    for (int j = 0; j < 8; ++j) ((f32x4*)row)[lane + 64 * j] = v[j] * rs * gv[j];
}
__device__ __forceinline__ void phase_final(const Ctx& F, const Ptrs& P) {
    const int gw = F.vcu * NWAVES + F.wave, NGW = F.G * NWAVES, lane = F.lane;
    f32x4 gv[8];
#pragma unroll
    for (int j = 0; j < 8; ++j) gv[j] = ((const f32x4*)P.final_g)[lane + 64 * j];
    const int cnt = (M - gw + NGW - 1) / NGW;
    f32x4 vA[8], vB[8];
    fin_load(P.out + (size_t)gw * DM, lane, vA);
    for (int j = 0; j < cnt; j += 2) {
        { const int jn = (j + 1 < cnt) ? j + 1 : j; fin_load(P.out + (size_t)(gw + jn * NGW) * DM, lane, vB); }
        fin_process(P.out + (size_t)(gw + j * NGW) * DM, lane, vA, gv);
        if (j + 1 < cnt) {
            { const int jn = (j + 2 < cnt) ? j + 2 : j + 1; fin_load(P.out + (size_t)(gw + jn * NGW) * DM, lane, vA); }
            fin_process(P.out + (size_t)(gw + (j + 1) * NGW) * DM, lane, vB, gv);
        }
    }
}

constexpr int N_PHASES = 10;
struct Args { Ptrs p; int ph_lo, ph_hi, li, pad; };
typedef __attribute__((address_space(4))) const Args* KArgsPtr;
__device__ __forceinline__ Ptrs load_ptrs() {
    Ptrs r{};
#if defined(__HIP_DEVICE_COMPILE__)
    KArgsPtr ka = (KArgsPtr)__builtin_amdgcn_kernarg_segment_ptr(); asm volatile("" : "+s"(ka));
    r.x = ka->p.x; r.ln_g = ka->p.ln_g; r.final_g = ka->p.final_g; r.ssm_w_in = ka->p.ssm_w_in; r.conv_w = ka->p.conv_w; r.conv_b = ka->p.conv_b; r.dt_bias = ka->p.dt_bias; r.a_log = ka->p.a_log; r.ssm_d = ka->p.ssm_d;
    r.norm_g = ka->p.norm_g; r.ssm_w_out = ka->p.ssm_w_out; r.pool_w_in = ka->p.pool_w_in; r.pool_w_group = ka->p.pool_w_group; r.pool_scale = ka->p.pool_scale; r.pool_w_out = ka->p.pool_w_out; r.out = ka->p.out; r.ws = ka->p.ws;
#endif
    return r;
}
__global__ void __launch_bounds__(NWAVES * 64, 2) trunk_fwd(Args args) {
    extern __shared__ __attribute__((aligned(16))) unsigned char lds[];
    Ctx F;
    F.lds = (LAS unsigned char*)lds;
    F.tid = threadIdx.x; F.lane = F.tid & 63; F.wave = __builtin_amdgcn_readfirstlane(F.tid >> 6);
    F.G = gridDim.x; { const int bx = blockIdx.x; F.vcu = (F.G % 8 == 0) ? (bx % 8) * (F.G / 8) + bx / 8 : bx; }
    unsigned* ctl0; { const Ptrs P0 = load_ptrs(); ctl0 = (unsigned*)(P0.ws + WS_CTL); }
    for (int u = F.tid; u < (LDS_BYTES - LDSCTL_OFF) / 4; u += NWAVES * 64) ((LAS unsigned*)(F.lds + LDSCTL_OFF))[u] = 0u;
    __syncthreads();
#if MK_ONE_LAUNCH
    XcdBarrier bar = xcd_barrier_post(ctl0 + CW_BAR, (volatile LAS unsigned*)(F.lds + MISC_OFF) + 8);
#define GRID_BAR() xcd_barrier(bar)
#else
#define GRID_BAR() do {} while (0)
#endif
    const int lo = args.ph_lo, hi = args.ph_hi;
#define IN(k) (lo <= (k) && (k) < hi)
#define BOTH(k) (IN(k) && IN((k) + 1))
#define PHASE_VARS const Ptrs P = load_ptrs(); unsigned* ctl = (unsigned*)(P.ws + WS_CTL); \
    float* ssq1 = (float*)ctl + CW_SSQ1; float* ssq3p = (float*)(P.ws + WS_SSQP + 4 * MiB); const float* ssqp = (const float*)(P.ws + WS_SSQP);   \
    bf16* W1T = (bf16*)(P.ws + WS_W1T); bf16* W2T = (bf16*)(P.ws + WS_W2T); bf16* W3T = (bf16*)(P.ws + WS_W3T); bf16* W4T = (bf16*)(P.ws + WS_W4T); bf16* W5T = (bf16*)(P.ws + WS_W5T); \
    bf16* RA = (bf16*)(P.ws + WS_RA); bf16* RB = (bf16*)(P.ws + WS_RB); bf16* RC = (bf16*)(P.ws + WS_RC); \
    (void)ctl; (void)ssq1; (void)ssq3p; (void)ssqp; (void)W1T; (void)W2T; (void)W3T; (void)W4T; (void)W5T; (void)RA; (void)RB; (void)RC;

#define REP(k) (1 + ((REPEAT_MASK >> (k)) & 1))
    unsigned long long ts_a = 0, ts_b = 0;
#define TS_A(k) do { if (STAMP_PHASE == (k)) ts_a = __builtin_amdgcn_s_memrealtime(); } while (0)
#define TS_B(k) do { if (STAMP_PHASE == (k)) ts_b = __builtin_amdgcn_s_memrealtime(); } while (0)
    TS_A(0);
    if (IN(0)) { PHASE_VARS for (int rep = 0; rep < REP(0); ++rep) phase_prep(F, P); if (BOTH(0)) GRID_BAR(); }
    TS_B(0);
    TS_A(1);
    if (IN(1)) {
        PHASE_VARS
        {
          pg8::Gemm g{W4T, (const bf16*)P.out, DP, DM, PGD, PGD, DP, 30, 2}; pg8::StaticOrder S; S.init(DP, DM, F.G, (int)blockIdx.x);
          pg8::EpiPlain E{W3T, DM};
          TS_A(10); pg8::gemm_phase<pg8::EpiPlain, pg8::StaticOrder, true, true>(F.lds + RING_OFF, g, S, E);
          { constexpr int NWC = (DP / 256) * (DM / 256); if ((int)blockIdx.x >= NWC && F.G > NWC) prep_transposes(F, P, 1, ((int)blockIdx.x - NWC) * NWAVES + F.wave, (F.G - NWC) * NWAVES); else if (F.G <= NWC) prep_transposes(F, P, 1, F.vcu * NWAVES + F.wave, F.G * NWAVES); }
          __syncthreads(); TS_B(10); }
        TS_A(11); for (int rep = 0; rep < REP(10); ++rep) phase_dt(F, P); TS_B(11);
        for (int rep = 0; rep < REP(1); ++rep) {
        pg8::Gemm g{RC, W1T, M, N1, DM, DM, DM, 30, 30}; pg8::StaticOrder S; S.init(M, N1, F.G, (int)blockIdx.x);
        pg8::EpiProj E{RA, DI, RB, CONV_DIM, DI / 256, ssq1, 1.0f / DM, nullptr};
        pg8::gemm_phase<pg8::EpiProj, pg8::StaticOrder, true, true>(F.lds + RING_OFF, g, S, E);
        }
        if (BOTH(1)) GRID_BAR();
    }
    TS_B(1);
    TS_A(2);
    if (IN(2)) { PHASE_VARS for (int rep = 0; rep < REP(2); ++rep) phase_bcprep(F, P); if (BOTH(2)) GRID_BAR(); }
    TS_B(2);
    TS_A(3);
    if (IN(3)) { PHASE_VARS if (REP(3) > 1) phase_ssd<true>(F, P); phase_ssd<false>(F, P); if (BOTH(3)) GRID_BAR(); }
    TS_B(3);
    TS_A(4);
    if (IN(4)) {
        PHASE_VARS
        for (int rep = 0; rep < REP(4); ++rep) {
        pg8::Gemm g{RA, W2T, M, DM, DI, DI, DI, 30, 30}; pg8::StaticOrder S; S.init(M, DM, F.G, (int)blockIdx.x);
        LAS float* rs_tab = (LAS float*)(F.lds + pg8::STAGE_BYTES);
        {
          pg8::Unit uu; const int o = F.tid >> 8, rr = F.tid & 255;
          if (S.next(o, uu)) { const f32x4* pp = (const f32x4*)(ssqp + (size_t)(uu.pm * 256 + rr) * NH); f32x4 a = pp[0];
#pragma unroll
              for (int j = 1; j < 16; ++j) a = a + pp[j];
              rs_tab[o * 256 + rr] = rsqrtf(((a[0] + a[1]) + (a[2] + a[3])) * (1.0f / DI) + EPS); }
          __syncthreads(); }
        pg8::EpiResB E{RC, rs_tab, ssq3p, DM};
        pg8::gemm_phase<pg8::EpiResB, pg8::StaticOrder, true, true>(F.lds + RING_OFF, g, S, E);
        }
        if (BOTH(4)) GRID_BAR();
    }
    TS_B(4);
    TS_A(5);
    if (IN(5)) {
        PHASE_VARS
        for (int rep = 0; rep < REP(5); ++rep) {
        pg8::Gemm g{RC, W3T, M, 2 * DP, DM, DM, DM, 30, 30}; pg8::StaticOrder S; S.init(M, 2 * DP, F.G, (int)blockIdx.x);
        LAS float* rs_tab = (LAS float*)(F.lds + pg8::STAGE_BYTES);
        {
          for (int o = F.tid >> 8; o < 8; o += 2) { pg8::Unit uu; const int rr = F.tid & 255;
            if (S.next(o, uu)) { const f32x4* pp = (const f32x4*)(ssq3p + (size_t)(uu.pm * 256 + rr) * 32); f32x4 a = pp[0];
#pragma unroll
              for (int j = 1; j < 8; ++j) a = a + pp[j];
              rs_tab[o * 256 + rr] = rsqrtf(((a[0] + a[1]) + (a[2] + a[3])) * (1.0f / DM) + EPS); } }
          __syncthreads(); }
        pg8::EpiProj E{RA, DP, RB, DP, DP / 256, nullptr, 0.f, rs_tab};
        pg8::gemm_phase<pg8::EpiProj, pg8::StaticOrder, true, true>(F.lds + RING_OFF, g, S, E);
        }
        if (BOTH(5)) GRID_BAR();
    }
    TS_B(5);
    TS_A(6);
    if (IN(6)) { PHASE_VARS for (int rep = 0; rep < REP(6); ++rep) phase_pool(F, P); if (BOTH(6)) GRID_BAR(); }
    TS_B(6);
    TS_A(8);
    if (IN(8)) {
        PHASE_VARS
        pg8::Gemm g{RB, W5T, M, DM, DP, DP, DP, 30, 30}; pg8::PanelOrder S; S.init(F.G, (int)blockIdx.x);
        pg8::EpiFinal E{RC, P.out, P.final_g, (float*)(P.ws + WS_SSQP + 6 * MiB), ctl + CW_FIN, ctl + CW_TMO, F.lds + pg8::STAGE_BYTES, DM};
        pg8::gemm_phase<pg8::EpiFinal, pg8::PanelOrder, true, true>(F.lds + RING_OFF, g, S, E);
    }
    TS_B(8);
    if (STAMP_PHASE >= 0) { const unsigned long long t0 = __builtin_amdgcn_s_memrealtime(); while (__builtin_amdgcn_s_memrealtime() - t0 < ts_b - ts_a) __builtin_amdgcn_s_sleep(8); }
#undef IN
#undef BOTH
}

extern "C" void kernel_launch(void* const* d_in, const int* in_sizes, int n_in, void* d_out, int out_size, void* d_ws, size_t ws_size, hipStream_t stream) {
    static int grid = 0;
    if (grid == 0) {
        if (n_in != 15 || in_sizes[0] != M * DM || out_size != M * DM || ws_size < WS_END) { fprintf(stderr, "kernel_launch: unexpected shapes: n_in %d in0 %d out %d ws %zu (need %zu); nothing launched\n", n_in, n_in > 0 ? in_sizes[0] : -1, out_size, ws_size, (size_t)WS_END); grid = -1; return; }
        int dev = 0, cus = 0, per_cu = 0;
        if (hipGetDevice(&dev) != hipSuccess || hipDeviceGetAttribute(&cus, hipDeviceAttributeMultiprocessorCount, dev) != hipSuccess) { fprintf(stderr, "kernel_launch: device query failed\n"); grid = -1; return; }
        if (hipFuncSetAttribute((const void*)trunk_fwd, hipFuncAttributeMaxDynamicSharedMemorySize, LDS_BYTES) != hipSuccess) { fprintf(stderr, "kernel_launch: hipFuncSetAttribute failed\n"); grid = -1; return; }
        if (hipOccupancyMaxActiveBlocksPerMultiprocessor(&per_cu, (const void*)trunk_fwd, NWAVES * 64, LDS_BYTES) != hipSuccess || per_cu < 1) { fprintf(stderr, "kernel_launch: occupancy query says %d blocks per CU\n", per_cu); }
        (void)hipGetLastError();
        grid = cus;
        if (cus != 256) { fprintf(stderr, "kernel_launch: this kernel's unit orders are built for a 256-CU device (got %d CUs); nothing launched\n", cus); grid = -1; return; }
    }
    if (grid < 0) return;
    if (hipMemsetAsync((char*)d_ws + WS_CTL, 0, CTL_ZERO_BYTES, stream) != hipSuccess) { fprintf(stderr, "kernel_launch: memset failed\n"); return; }
    Args a{};
    a.p.x = (const float*)d_in[0]; a.p.ln_g = (const float*)d_in[1]; a.p.final_g = (const float*)d_in[2]; a.p.ssm_w_in = (const float*)d_in[3]; a.p.conv_w = (const float*)d_in[4];
    a.p.conv_b = (const float*)d_in[5]; a.p.dt_bias = (const float*)d_in[6]; a.p.a_log = (const float*)d_in[7]; a.p.ssm_d = (const float*)d_in[8]; a.p.norm_g = (const float*)d_in[9];
    a.p.ssm_w_out = (const float*)d_in[10]; a.p.pool_w_in = (const float*)d_in[11]; a.p.pool_w_group = (const float*)d_in[12]; a.p.pool_scale = (const float*)d_in[13]; a.p.pool_w_out = (const float*)d_in[14];
    a.p.out = (float*)d_out; a.p.ws = (unsigned char*)d_ws;
#if MK_ONE_LAUNCH
    a.ph_lo = 0; a.ph_hi = N_PHASES; a.li = 0;
    hipLaunchKernelGGL(trunk_fwd, dim3(grid), dim3(NWAVES * 64), LDS_BYTES, stream, a);
#else
    for (int li = 0; li < N_PHASES; ++li) { a.ph_lo = li; a.ph_hi = li + 1; a.li = li;
        hipLaunchKernelGGL(trunk_fwd, dim3(grid), dim3(NWAVES * 64), LDS_BYTES, stream, a); }
#endif
    const hipError_t le = hipPeekAtLastError();
    if (le != hipSuccess) fprintf(stderr, "kernel_launch: launch failed: %s\n", hipGetErrorName(le));
}
```

```cpp
#include <hip/hip_runtime.h>
#include <cstdio>
#include <cstdint>

#ifndef REPEAT_MASK
#define REPEAT_MASK 0
#endif
#ifndef STAMP_PHASE
#define STAMP_PHASE -1
#endif
#ifndef MK_ONE_LAUNCH
#define MK_ONE_LAUNCH 1
#endif

namespace pg8 {
#define PG8_LAS __attribute__((address_space(3)))
typedef unsigned short bf16_t;
typedef short bf16x8 __attribute__((ext_vector_type(8)));
typedef float f32x4 __attribute__((ext_vector_type(4)));
typedef unsigned u32x4 __attribute__((ext_vector_type(4)));
typedef unsigned u32x2 __attribute__((ext_vector_type(2)));
constexpr int BM = 256, BK = 64, HALF = 128, HTB = HALF * BK * 2  , STAGE_BYTES = 8 * HTB, NXCD = 8, WGM = 8;
constexpr float RMS_EPS = 1e-6f;

__host__ __device__ __forceinline__ int lds_byte(int r, int c) { return r * 128 + ((((c >> 3) ^ (r & 7))) << 4) + (c & 7) * 2; }
__host__ __device__ __forceinline__ void stage_rc(int b, int& R, int& C) { R = b / 128; C = ((((b % 128) / 16) ^ (R & 7))) * 8; }
__host__ __device__ __forceinline__ int perm32(int rho) { const int n = rho >> 4, i = rho & 15; return 8 * (i >> 2) + 4 * n + (i & 3); }

struct Unit { int pm, pn, ord; };
struct Gemm { const bf16_t* A; const bf16_t* Bt; int M, N, K, lda, ldb, gsh, bgsh; };

struct StaticOrder {
    int nM, nN, nwg, G, c;
    __host__ __device__ void init(int M, int N, int G_, int c_) { nM = M / BM; nN = N / BM; nwg = nM * nN; G = G_; c = c_; }
    __host__ __device__ bool next(int i, Unit& u) const {
        const long L = (long)i * G + c; if (L >= nwg) return false;
        int wgid = (int)L; { const int q = nwg / NXCD, r = nwg % NXCD, xcd = wgid % NXCD, off = wgid / NXCD; wgid = (xcd < r ? xcd * (q + 1) : r * (q + 1) + (xcd - r) * q) + off; }
        const int nig = WGM * nN, gid = wgid / nig, fm = gid * WGM, gsz = (nM - fm) < WGM ? (nM - fm) : WGM;
        u.pm = fm + ((wgid % nig) % gsz); u.pn = (wgid % nig) / gsz; return true;
    }
    __device__ __forceinline__ void a_ready(const Unit&) const {}
    __device__ __forceinline__ void done(const Unit&) const {}
};

__device__ __forceinline__ unsigned cvt_pk_bf16(float lo, float hi) { unsigned r; asm volatile("v_cvt_pk_bf16_f32 %0, %1, %2" : "=v"(r) : "v"(lo), "v"(hi)); return r; }
__device__ __forceinline__ float bf_lo(unsigned w) { return __uint_as_float(w << 16); }
__device__ __forceinline__ float bf_hi(unsigned w) { return __uint_as_float(w & 0xffff0000u); }
__device__ __forceinline__ float sigmoid_f(float v) { return __builtin_amdgcn_rcpf(1.0f + __builtin_amdgcn_exp2f(-1.4426950408889634f * v)); }

struct EpiProj {
    static constexpr bool PERM = true, AFTER_DRAIN = false;
    bf16_t* O0; int ld0; bf16_t* O1; int ld1; int split_pn; const float* ssq; float inv_n; const PG8_LAS float* rs_lds;
    __device__ __forceinline__ void operator()(const f32x4 (&acc)[2][2][4][2], const Unit& u, int wr, int wc, int fr, int fq) const {
        const int row0 = u.pm * BM + wr * 64 + fr;
        bf16_t* base; int ld, colt;
        if (u.pn < split_pn) { base = O0; ld = ld0; colt = u.pn * BM; } else { base = O1; ld = ld1; colt = (u.pn - split_pn) * BM; }
        const int col0 = colt + wc * 32 + 8 * fq;
#pragma unroll
        for (int ai = 0; ai < 2; ++ai)
#pragma unroll
            for (int m = 0; m < 4; ++m) { const int row = row0 + ai * HALF + m * 16; const float s = rs_lds ? rs_lds[u.ord * BM + wr * 64 + fr + ai * HALF + m * 16] : rsqrtf(ssq[row] * inv_n + RMS_EPS);
                bf16_t* rowp = base + (size_t)row * ld + col0;
#pragma unroll
                for (int bj = 0; bj < 2; ++bj) { const f32x4 v0 = acc[ai][bj][m][0] * s, v1 = acc[ai][bj][m][1] * s;
                    u32x4 w; w.x = cvt_pk_bf16(v0[0], v0[1]); w.y = cvt_pk_bf16(v0[2], v0[3]); w.z = cvt_pk_bf16(v1[0], v1[1]); w.w = cvt_pk_bf16(v1[2], v1[3]);
                    *(u32x4*)(rowp + bj * HALF) = w; } }
    }
};
struct EpiPlain {
    static constexpr bool PERM = true, AFTER_DRAIN = false;
    bf16_t* O; int ld;
    __device__ __forceinline__ void operator()(const f32x4 (&acc)[2][2][4][2], const Unit& u, int wr, int wc, int fr, int fq) const {
        const int row0 = u.pm * BM + wr * 64 + fr, col0 = u.pn * BM + wc * 32 + 8 * fq;
#pragma unroll
        for (int ai = 0; ai < 2; ++ai)
#pragma unroll
            for (int m = 0; m < 4; ++m) { bf16_t* rowp = O + (size_t)(row0 + ai * HALF + m * 16) * ld + col0;
#pragma unroll
                for (int bj = 0; bj < 2; ++bj) { const f32x4 v0 = acc[ai][bj][m][0], v1 = acc[ai][bj][m][1];
                    u32x4 w; w.x = cvt_pk_bf16(v0[0], v0[1]); w.y = cvt_pk_bf16(v0[2], v0[3]); w.z = cvt_pk_bf16(v1[0], v1[1]); w.w = cvt_pk_bf16(v1[2], v1[3]);
                    *(u32x4*)(rowp + bj * HALF) = w; } }
    }
};
struct EpiRes {
    static constexpr bool PERM = false, AFTER_DRAIN = false;
    const float* base; float* out; bf16_t* ob; const PG8_LAS float* rs_lds; float* ssq_out; int ldc;
    __device__ __forceinline__ void operator()(const f32x4 (&acc)[2][2][4][2], const Unit& u, int wr, int wc, int fr, int fq) const {
        const int rl0 = wr * 64 + fr, row0 = u.pm * BM + rl0, col0 = u.pn * BM + wc * 32 + 4 * fq;
#pragma unroll
        for (int ai = 0; ai < 2; ++ai)
#pragma unroll
            for (int m = 0; m < 4; ++m) { const int row = row0 + ai * HALF + m * 16; const float s = rs_lds ? rs_lds[u.ord * BM + rl0 + ai * HALF + m * 16] : 1.0f;
                const size_t off = (size_t)row * ldc + col0; float q = 0.f;
#pragma unroll
                for (int bj = 0; bj < 2; ++bj)
#pragma unroll
                    for (int n = 0; n < 2; ++n) { const size_t o2 = off + bj * HALF + n * 16; const f32x4 b = *(const f32x4*)(base + o2); const f32x4 o = b + acc[ai][bj][m][n] * s;
                        *(f32x4*)(out + o2) = o; q += (o[0] * o[0] + o[1] * o[1]) + (o[2] * o[2] + o[3] * o[3]);
                        if (ob) { u32x2 w; w.x = cvt_pk_bf16(o[0], o[1]); w.y = cvt_pk_bf16(o[2], o[3]); *(u32x2*)(ob + o2) = w; } }
                if (ssq_out) { q += __shfl_xor(q, 16); q += __shfl_xor(q, 32); if (fq == 0) ssq_out[(size_t)row * 32 + u.pn * 4 + wc] = q; }
                if (m & 1) asm volatile("" ::: "memory"); }
    }
};
struct EpiResB {
    static constexpr bool PERM = false, AFTER_DRAIN = false;
    bf16_t* xio; const PG8_LAS float* rs_lds; float* ssq_out; int ldc;
    __device__ __forceinline__ void operator()(const f32x4 (&acc)[2][2][4][2], const Unit& u, int wr, int wc, int fr, int fq) const {
        const int rl0 = wr * 64 + fr, row0 = u.pm * BM + rl0, col0 = u.pn * BM + wc * 32 + 4 * fq;
#pragma unroll
        for (int ai = 0; ai < 2; ++ai)
#pragma unroll
            for (int m = 0; m < 4; ++m) { const int row = row0 + ai * HALF + m * 16; const float s = rs_lds[u.ord * BM + rl0 + ai * HALF + m * 16];
                const size_t off = (size_t)row * ldc + col0; float q = 0.f;
#pragma unroll
                for (int bj = 0; bj < 2; ++bj)
#pragma unroll
                    for (int n = 0; n < 2; ++n) { const size_t o2 = off + bj * HALF + n * 16; const u32x2 bw = *(const u32x2*)(xio + o2);
                        f32x4 o = acc[ai][bj][m][n] * s; o[0] += bf_lo(bw.x); o[1] += bf_hi(bw.x); o[2] += bf_lo(bw.y); o[3] += bf_hi(bw.y);
                        q += (o[0] * o[0] + o[1] * o[1]) + (o[2] * o[2] + o[3] * o[3]);
                        u32x2 w; w.x = cvt_pk_bf16(o[0], o[1]); w.y = cvt_pk_bf16(o[2], o[3]); *(u32x2*)(xio + o2) = w; }
                q += __shfl_xor(q, 16); q += __shfl_xor(q, 32); if (fq == 0) ssq_out[(size_t)row * 32 + u.pn * 4 + wc] = q;
                if (m & 1) asm volatile("" ::: "memory"); }
    }
};
struct PanelOrder {
    int G, c;
    __host__ __device__ void init(int G_, int c_) { G = G_; c = c_; }
    __host__ __device__ bool next(int i, Unit& u) const { if (i >= 2) return false; const int xcd = c & 7, idx = c >> 3; u.pm = 32 * i + 4 * xcd + (idx >> 3); u.pn = idx & 7; return true; }
    __device__ __forceinline__ void a_ready(const Unit&) const {}
    __device__ __forceinline__ void done(const Unit&) const {}
};
struct EpiFinal {
    static constexpr bool PERM = false, AFTER_DRAIN = false;
    const bf16_t* base; float* out; const float* gain; float* xslots; unsigned* cnt; unsigned* tmo; PG8_LAS unsigned char* lds; int ldc;
    __device__ __forceinline__ void operator()(f32x4 (&acc)[2][2][4][2], const Unit& u, int wr, int wc, int fr, int fq) const {
        PG8_LAS float* Pt = (PG8_LAS float*)lds;
        PG8_LAS float* St = (PG8_LAS float*)(lds + 4096);
        const int tid = threadIdx.x, wid = __builtin_amdgcn_readfirstlane(tid >> 6), lane = tid & 63;
        const int rl0 = wr * 64 + fr, row0 = u.pm * BM + rl0, col0 = u.pn * BM + wc * 32 + 4 * fq;
#pragma unroll
        for (int ai = 0; ai < 2; ++ai)
#pragma unroll
            for (int m = 0; m < 4; ++m) { const size_t off = (size_t)(row0 + ai * HALF + m * 16) * ldc + col0; float q = 0.f;
#pragma unroll
                for (int bj = 0; bj < 2; ++bj)
#pragma unroll
                    for (int n = 0; n < 2; ++n) { const u32x2 bw = *(const u32x2*)(base + off + bj * HALF + n * 16);
                        f32x4 o = acc[ai][bj][m][n]; o[0] += bf_lo(bw.x); o[1] += bf_hi(bw.x); o[2] += bf_lo(bw.y); o[3] += bf_hi(bw.y); acc[ai][bj][m][n] = o;
                        q += (o[0] * o[0] + o[1] * o[1]) + (o[2] * o[2] + o[3] * o[3]); }
                q += __shfl_xor(q, 16); q += __shfl_xor(q, 32);
                if (fq == 0) Pt[(rl0 + ai * HALF + m * 16) * 4 + wc] = q; }
        asm volatile("s_waitcnt lgkmcnt(0)" ::: "memory"); __builtin_amdgcn_s_barrier(); asm volatile("" ::: "memory");
        if (tid < BM) { const f32x4 p4 = *(const PG8_LAS f32x4*)(Pt + tid * 4);
            __hip_atomic_store(xslots + (size_t)(u.pm * BM + tid) * 8 + u.pn, (p4[0] + p4[1]) + (p4[2] + p4[3]), __ATOMIC_RELAXED, __HIP_MEMORY_SCOPE_AGENT); }
        asm volatile("s_waitcnt vmcnt(0)" ::: "memory");
        if (tid < BM && lane == 0) __hip_atomic_fetch_add(cnt + 64 * u.pm, 1u, __ATOMIC_RELAXED, __HIP_MEMORY_SCOPE_AGENT);
        if (wid == 0) {
            unsigned sp = 0;
            while ((unsigned)__builtin_amdgcn_readfirstlane(__hip_atomic_load(cnt + 64 * u.pm, __ATOMIC_RELAXED, __HIP_MEMORY_SCOPE_AGENT)) < 32u) {
                __builtin_amdgcn_s_sleep(2);
                if (++sp > (1u << 22)) { if (lane == 0) __hip_atomic_store(tmo, 1u, __ATOMIC_RELAXED, __HIP_MEMORY_SCOPE_AGENT); break; } }
            __builtin_amdgcn_fence(__ATOMIC_ACQUIRE, "agent");
        }
        asm volatile("s_waitcnt vmcnt(0) lgkmcnt(0)" ::: "memory"); __builtin_amdgcn_s_barrier(); asm volatile("" ::: "memory");
        if (tid < BM) { const float* sl = xslots + (size_t)(u.pm * BM + tid) * 8; float t = 0.f;
#pragma unroll
            for (int j = 0; j < 8; ++j) t += __hip_atomic_load(sl + j, __ATOMIC_RELAXED, __HIP_MEMORY_SCOPE_AGENT);
            St[tid] = rsqrtf(t * (1.0f / 2048.0f) + RMS_EPS); }
        asm volatile("s_waitcnt vmcnt(0) lgkmcnt(0)" ::: "memory"); __builtin_amdgcn_s_barrier(); asm volatile("" ::: "memory");
        f32x4 gv[2][2];
#pragma unroll
        for (int bj = 0; bj < 2; ++bj)
#pragma unroll
            for (int n = 0; n < 2; ++n) gv[bj][n] = *(const f32x4*)(gain + col0 + bj * HALF + n * 16);
#pragma unroll
        for (int ai = 0; ai < 2; ++ai)
#pragma unroll
            for (int m = 0; m < 4; ++m) { const int rl = rl0 + ai * HALF + m * 16; const float s = St[rl]; float* rowp = out + (size_t)(u.pm * BM + rl) * ldc + col0;
#pragma unroll
                for (int bj = 0; bj < 2; ++bj)
#pragma unroll
                    for (int n = 0; n < 2; ++n) *(f32x4*)(rowp + bj * HALF + n * 16) = acc[ai][bj][m][n] * s * gv[bj][n]; }
        asm volatile("s_waitcnt lgkmcnt(0)" ::: "memory"); __builtin_amdgcn_s_barrier(); asm volatile("" ::: "memory");
    }
};
struct EpiGate {
    static constexpr bool PERM = true, AFTER_DRAIN = false;
    bf16_t* O; const bf16_t* gate; const float* scale; int ldc;
    __device__ __forceinline__ void operator()(const f32x4 (&acc)[2][2][4][2], const Unit& u, int wr, int wc, int fr, int fq) const {
        const int row0 = u.pm * BM + wr * 64 + fr, col0 = u.pn * BM + wc * 32 + 8 * fq;
        f32x4 sc[2][2];
#pragma unroll
        for (int bj = 0; bj < 2; ++bj)
#pragma unroll
            for (int n = 0; n < 2; ++n) sc[bj][n] = *(const f32x4*)(scale + col0 + bj * HALF + 4 * n);
#pragma unroll
        for (int ai = 0; ai < 2; ++ai)
#pragma unroll
            for (int m = 0; m < 4; ++m) { const size_t off = (size_t)(row0 + ai * HALF + m * 16) * ldc + col0;
#pragma unroll
                for (int bj = 0; bj < 2; ++bj) { const u32x4 gw = *(const u32x4*)(gate + off + bj * HALF);
                    const float g0 = bf_lo(gw.x), g1 = bf_hi(gw.x), g2 = bf_lo(gw.y), g3 = bf_hi(gw.y), g4 = bf_lo(gw.z), g5 = bf_hi(gw.z), g6 = bf_lo(gw.w), g7 = bf_hi(gw.w);
                    const f32x4 v0 = acc[ai][bj][m][0] * sc[bj][0], v1 = acc[ai][bj][m][1] * sc[bj][1];
                    u32x4 w; w.x = cvt_pk_bf16(v0[0] * g0 * sigmoid_f(g0), v0[1] * g1 * sigmoid_f(g1)); w.y = cvt_pk_bf16(v0[2] * g2 * sigmoid_f(g2), v0[3] * g3 * sigmoid_f(g3));
                    w.z = cvt_pk_bf16(v1[0] * g4 * sigmoid_f(g4), v1[1] * g5 * sigmoid_f(g5)); w.w = cvt_pk_bf16(v1[2] * g6 * sigmoid_f(g6), v1[3] * g7 * sigmoid_f(g7));
                    *(u32x4*)(O + off + bj * HALF) = w; } }
    }
};

template <class Epi, class Sched, bool ALIGN_EPI = false, bool SP2 = false>
__device__ __forceinline__ void gemm_phase(PG8_LAS unsigned char* lds, const Gemm g, const Sched& S, const Epi& E) {
    const int tid = threadIdx.x, wid = __builtin_amdgcn_readfirstlane(tid >> 6), lane = tid & 63, wr = wid >> 2, wc = wid & 3, fr = lane & 15, fq = lane >> 4;
    const int K = g.K, nt = K / BK;
    unsigned voffA[2], voffB[2];
#pragma unroll
    for (int i = 0; i < 2; ++i) { int R, C; stage_rc(tid * 16 + i * 8192, R, C); const int Rb = Epi::PERM ? ((R & ~31) + perm32(R & 31)) : R;
        voffA[i] = (unsigned)(R * g.lda + C) * 2u; voffB[i] = (unsigned)(Rb * g.ldb + C) * 2u; }
    const size_t kstep = (size_t)(BK * 2);
    const size_t hstepA = (size_t)HALF * g.lda * 2, hstepB = (size_t)HALF * g.ldb * 2;
    const size_t tstepA = 2 * hstepA, tstepB = 2 * hstepB, gstepA = (size_t)K * 2;
    const unsigned ldsw = (unsigned)wid * 1024u;
    const int aoffk[2] = {lds_byte(wr * 64 + fr, fq * 8), lds_byte(wr * 64 + fr, 32 + fq * 8)}, boffk[2] = {lds_byte(wc * 32 + fr, fq * 8), lds_byte(wc * 32 + fr, 32 + fq * 8)};
#define PG8_SA(b, h) (((b) * 2 + (h)) * HTB)
#define PG8_SB(b, h) ((4 + (b) * 2 + (h)) * HTB)
#define PG8_STAGE(bufoff, gbase, voff) do { _Pragma("unroll") for (int _i = 0; _i < 2; ++_i) \
        __builtin_amdgcn_global_load_lds((const unsigned*)((const char*)(gbase) + (voff)[_i]), (PG8_LAS unsigned*)(lds + (bufoff) + ldsw + _i * 8192), 16, 0, 0); } while (0)
#define PG8_LDA(dst, b, h) do { _Pragma("unroll") for (int m = 0; m < 4; ++m) _Pragma("unroll") for (int k = 0; k < 2; ++k) dst[m][k] = *(const PG8_LAS bf16x8*)(lds + PG8_SA(b, h) + aoffk[k] + m * 2048); } while (0)
#define PG8_LDB(dst, b, h) do { _Pragma("unroll") for (int n = 0; n < 2; ++n) _Pragma("unroll") for (int k = 0; k < 2; ++k) dst[n][k] = *(const PG8_LAS bf16x8*)(lds + PG8_SB(b, h) + boffk[k] + n * 2048); } while (0)
#define PG8_MMA(ai, bj, At, Bt) do { __builtin_amdgcn_s_setprio(1); _Pragma("unroll") for (int m = 0; m < 4; ++m) _Pragma("unroll") for (int n = 0; n < 2; ++n) _Pragma("unroll") for (int k = 0; k < 2; ++k) \
        acc[ai][bj][m][n] = __builtin_amdgcn_mfma_f32_16x16x32_bf16(Bt[n][k], At[m][k], acc[ai][bj][m][n], 0, 0, 0); __builtin_amdgcn_s_setprio(0); } while (0)
#define PG8_WAIT_V(n) asm volatile("s_waitcnt vmcnt(" #n ")" ::: "memory")
#define PG8_WAIT_L(n) asm volatile("s_waitcnt lgkmcnt(" #n ")" ::: "memory")
#define PG8_BAR __builtin_amdgcn_s_barrier()
#define PG8_SCHED __builtin_amdgcn_sched_barrier(0)
    Unit cur, nxt; int ui = 0;
    if (!S.next(0, cur)) return;
    cur.ord = 0;
    f32x4 acc[2][2][4][2];
#pragma unroll
    for (int a = 0; a < 2; ++a)
#pragma unroll
        for (int b = 0; b < 2; ++b)
#pragma unroll
            for (int m = 0; m < 4; ++m)
#pragma unroll
                for (int n = 0; n < 2; ++n) acc[a][b][m][n] = (f32x4){0.f, 0.f, 0.f, 0.f};
    bf16x8 At[4][2], B0[2][2], B1[2][2];
    const char* cA = (const char*)g.A + (size_t)cur.pm * tstepA + (size_t)(cur.pn >> g.gsh) * gstepA; const char* cB = (const char*)g.Bt + (size_t)cur.pn * tstepB + (size_t)(cur.pm >> g.bgsh) * gstepA;
    S.a_ready(cur);
    if constexpr (SP2) {
        PG8_STAGE(PG8_SB(0, 0), cB, voffB); PG8_STAGE(PG8_SB(0, 1), cB + hstepB, voffB); PG8_STAGE(PG8_SA(0, 0), cA, voffA); PG8_STAGE(PG8_SA(0, 1), cA + hstepA, voffA);
        if (wr == 1) PG8_BAR;
        PG8_WAIT_V(2); PG8_BAR;
        PG8_STAGE(PG8_SB(1, 0), cB + kstep, voffB); PG8_STAGE(PG8_SA(1, 0), cA + kstep, voffA); PG8_STAGE(PG8_SB(1, 1), cB + hstepB + kstep, voffB);
        PG8_WAIT_V(6); PG8_BAR;
    } else {
        PG8_STAGE(PG8_SB(0, 0), cB, voffB); PG8_STAGE(PG8_SA(0, 0), cA, voffA); PG8_STAGE(PG8_SB(0, 1), cB + hstepB, voffB); PG8_STAGE(PG8_SA(0, 1), cA + hstepA, voffA);
        if (wr == 1) PG8_BAR;
        PG8_WAIT_V(4); PG8_BAR;
        PG8_STAGE(PG8_SB(1, 0), cB + kstep, voffB); PG8_STAGE(PG8_SA(1, 0), cA + kstep, voffA); PG8_STAGE(PG8_SB(1, 1), cB + hstepB + kstep, voffB);
        PG8_WAIT_V(6); PG8_BAR;
    }
    for (;;) {
        const bool has_next = S.next(ui + 1, nxt); nxt.ord = ui + 1;
        const char* nA = has_next ? (const char*)g.A + (size_t)nxt.pm * tstepA + (size_t)(nxt.pn >> g.gsh) * gstepA : cA; const char* nB = has_next ? (const char*)g.Bt + (size_t)nxt.pn * tstepB + (size_t)(nxt.pm >> g.bgsh) * gstepA : cB;
        for (int t = 0; t < nt; t += 2) {
            const bool last = (t == nt - 2);
            const char* a1 = cA + (size_t)(t + 1) * kstep;
            const char* a2 = last ? nA : cA + (size_t)(t + 2) * kstep; const char* b2 = last ? nB : cB + (size_t)(t + 2) * kstep;
            const char* a3 = a2 + kstep; const char* b3 = b2 + kstep;
            if (last && has_next) S.a_ready(nxt);
            if constexpr (SP2) {
            PG8_LDB(B0, 0, 0); PG8_LDB(B1, 0, 1); PG8_SCHED; PG8_LDA(At, 0, 0); PG8_STAGE(PG8_SA(1, 1), a1 + hstepA, voffA);
            PG8_WAIT_V(8); PG8_WAIT_L(0); PG8_BAR; PG8_MMA(0, 0, At, B0); PG8_MMA(0, 1, At, B1); PG8_BAR; PG8_SCHED;
            PG8_LDA(At, 0, 1); PG8_STAGE(PG8_SB(0, 0), b2, voffB); PG8_STAGE(PG8_SB(0, 1), b2 + hstepB, voffB); PG8_STAGE(PG8_SA(0, 0), a2, voffA);
            PG8_WAIT_V(8); PG8_WAIT_L(0); PG8_BAR; PG8_MMA(1, 0, At, B0); PG8_MMA(1, 1, At, B1); PG8_BAR; PG8_SCHED;
            PG8_LDB(B0, 1, 0); PG8_LDB(B1, 1, 1); PG8_SCHED; PG8_LDA(At, 1, 0); PG8_STAGE(PG8_SA(0, 1), a2 + hstepA, voffA);
            PG8_WAIT_V(8); PG8_WAIT_L(0); PG8_BAR; PG8_MMA(0, 0, At, B0); PG8_MMA(0, 1, At, B1); PG8_BAR; PG8_SCHED;
            PG8_LDA(At, 1, 1); PG8_STAGE(PG8_SB(1, 0), b3, voffB); PG8_STAGE(PG8_SB(1, 1), b3 + hstepB, voffB); PG8_STAGE(PG8_SA(1, 0), a3, voffA);
            PG8_WAIT_V(8); PG8_WAIT_L(0); PG8_BAR; PG8_MMA(1, 0, At, B0); PG8_MMA(1, 1, At, B1); PG8_BAR; PG8_SCHED;
            } else {
            PG8_LDB(B0, 0, 0); PG8_SCHED; PG8_LDA(At, 0, 0); PG8_STAGE(PG8_SA(1, 1), a1 + hstepA, voffA);
            PG8_WAIT_L(8); PG8_BAR; PG8_WAIT_L(0); PG8_MMA(0, 0, At, B0); PG8_BAR; PG8_SCHED;
            PG8_LDB(B1, 0, 1); PG8_STAGE(PG8_SB(0, 0), b2, voffB);
            PG8_BAR; PG8_WAIT_L(0); PG8_MMA(0, 1, At, B1); PG8_BAR;
            PG8_LDA(At, 0, 1); PG8_STAGE(PG8_SA(0, 0), a2, voffA);
            PG8_BAR; PG8_WAIT_L(0); PG8_MMA(1, 0, At, B0); PG8_BAR; PG8_SCHED;
            PG8_STAGE(PG8_SB(0, 1), b2 + hstepB, voffB);
            PG8_WAIT_V(6); PG8_BAR; PG8_MMA(1, 1, At, B1); PG8_BAR;
            PG8_LDB(B0, 1, 0); PG8_SCHED; PG8_LDA(At, 1, 0); PG8_STAGE(PG8_SA(0, 1), a2 + hstepA, voffA);
            PG8_WAIT_L(8); PG8_BAR; PG8_WAIT_L(0); PG8_MMA(0, 0, At, B0); PG8_BAR; PG8_SCHED;
            PG8_LDB(B1, 1, 1); PG8_STAGE(PG8_SB(1, 0), b3, voffB);
            PG8_BAR; PG8_WAIT_L(0); PG8_MMA(0, 1, At, B1); PG8_BAR;
            PG8_LDA(At, 1, 1); PG8_STAGE(PG8_SA(1, 0), a3, voffA);
            PG8_BAR; PG8_WAIT_L(0); PG8_MMA(1, 0, At, B0); PG8_BAR; PG8_SCHED;
            PG8_STAGE(PG8_SB(1, 1), b3 + hstepB, voffB);
            PG8_WAIT_V(6); PG8_BAR; PG8_MMA(1, 1, At, B1); PG8_BAR;
            }
        }
        if constexpr (ALIGN_EPI) { if (wr == 0) PG8_BAR; }
        if constexpr (!Epi::AFTER_DRAIN) { E(acc, cur, wr, wc, fr, fq); S.done(cur); }
        if (!has_next) break;
#pragma unroll
        for (int a = 0; a < 2; ++a)
#pragma unroll
            for (int b = 0; b < 2; ++b)
#pragma unroll
                for (int m = 0; m < 4; ++m)
#pragma unroll
                    for (int n = 0; n < 2; ++n) acc[a][b][m][n] = (f32x4){0.f, 0.f, 0.f, 0.f};
        cur = nxt; cA = nA; cB = nB; ++ui;
        if constexpr (ALIGN_EPI) { if (wr == 1) PG8_BAR; }
    }
    PG8_WAIT_V(0);
    if constexpr (!ALIGN_EPI) { if (wr == 0) PG8_BAR; }
    PG8_BAR;
    if constexpr (Epi::AFTER_DRAIN) { E.fused(acc, cur, wr, wc, fr, fq, lds, wid, lane); S.done(cur); }
#undef PG8_SA
#undef PG8_SB
#undef PG8_STAGE
#undef PG8_LDA
#undef PG8_LDB
#undef PG8_MMA
#undef PG8_WAIT_V
#undef PG8_WAIT_L
#undef PG8_BAR
#undef PG8_SCHED
}

}

constexpr int NWAVES = 8;
constexpr int BATCH = 4, SEQ = 4096, DM = 2048, M = BATCH * SEQ;
constexpr int DI = 4096, HD = 64, NH = 64, NG = 8, HPG = 8, NS = 128, CONVK = 4;
constexpr int CONV_DIM = DI + 2 * NG * NS;
constexpr int SSM_IN = DI + CONV_DIM + NH;
constexpr int N1 = DI + CONV_DIM;
constexpr int BCW = 2 * NG * NS;
constexpr int DP = 4096, PG = 4, PGD = 1024;
constexpr float EPS = 1e-6f;

constexpr size_t MiB = 1u << 20;
constexpr size_t WS_CTL = 0, CTL_ZERO_BYTES = 1 * MiB;
constexpr size_t WS_DT  = 1 * MiB;
constexpr size_t WS_W1T = 5 * MiB;
constexpr size_t WS_W2T = 46 * MiB;
constexpr size_t WS_W3T = 62 * MiB;
constexpr size_t WS_W4T = 94 * MiB;
constexpr size_t WS_W5T = 102 * MiB;
constexpr size_t WS_RA  = 120 * MiB;
constexpr size_t WS_RB  = 248 * MiB;
constexpr size_t WS_RC  = 440 * MiB;
constexpr size_t WS_SSQP = 504 * MiB;
constexpr size_t WS_END = 512 * MiB;
static_assert(WS_W1T + (size_t)SSM_IN * DM * 2 <= WS_W2T && WS_W2T + (size_t)DM * DI * 2 <= WS_W3T && WS_W3T + (size_t)2 * DP * DM * 2 <= WS_W4T && WS_W4T + (size_t)DP * PGD * 2 <= WS_W5T && WS_W5T + (size_t)DM * DP * 2 <= WS_RA, "weights map");
static_assert(WS_RA + (size_t)M * DI * 2 <= WS_RB && WS_RB + (size_t)M * CONV_DIM * 2 <= WS_RC && WS_RC + (size_t)M * DM * 2 <= WS_END && WS_RB + 128 * MiB + (size_t)M * DP * 2 <= WS_END, "activation map");
constexpr int CW_TMO = 64, CW_FIN = 8192;
constexpr int CW_BAR = 4096;
constexpr int CW_SSQ1 = 16384, CW_SSQ2 = CW_SSQ1 + M, CW_SSQ3 = CW_SSQ2 + M;
static_assert((CW_SSQ3 + M) * 4 <= (int)CTL_ZERO_BYTES, "CTL words inside the memset region");

constexpr int RING_OFF = 0, RING_BYTES = 159744;
constexpr int LDSCTL_OFF = RING_BYTES, MISC_OFF = LDSCTL_OFF + 320;
constexpr int LDS_BYTES = 163840;
static_assert(MISC_OFF + 128 <= LDS_BYTES, "LDS map");

#define LAS __attribute__((address_space(3)))
typedef unsigned short bf16;
typedef unsigned v4u __attribute__((ext_vector_type(4)));
typedef unsigned v2u __attribute__((ext_vector_type(2)));
typedef float f32x4 __attribute__((ext_vector_type(4)));
typedef short bf16x8 __attribute__((ext_vector_type(8)));
#define LDS_WAIT() asm volatile("s_waitcnt lgkmcnt(0)" ::: "memory")
#define VM_WAIT() asm volatile("s_waitcnt vmcnt(0)" ::: "memory")
__device__ __forceinline__ unsigned f2bf(float f) { unsigned u = __builtin_bit_cast(unsigned, f); return (u + 0x7fffu + ((u >> 16) & 1u)) >> 16; }
__device__ __forceinline__ unsigned pk2(float lo, float hi) { return f2bf(lo) | (f2bf(hi) << 16); }
__device__ __forceinline__ float bflo(unsigned w) { return __uint_as_float(w << 16); }
__device__ __forceinline__ float bfhi(unsigned w) { return __uint_as_float(w & 0xffff0000u); }
__device__ __forceinline__ float bf1(bf16 v) { return __uint_as_float(((unsigned)v) << 16); }
__device__ __forceinline__ float sigm(float v) { return __builtin_amdgcn_rcpf(1.0f + __builtin_amdgcn_exp2f(-1.4426950408889634f * v)); }
__device__ __forceinline__ float wave_sum(float v) {
#pragma unroll
    for (int o = 1; o < 64; o <<= 1) v += __shfl_xor(v, o);
    return v;
}

#define XB_TMO      128
#define XB_XCNT(j)  (256  + 64 * (j))
#define XB_XSUB(j)  (1280 + 64 * (j))
#define XB_XGEN(j)  (2304 + 64 * (j))
#define XB_TOP      3328
#define XB_TOPGEN   3392
#define XCD_BAR_WORDS 3456
#define XB_SPIN_CAP (1u << 18)

__device__ __forceinline__ unsigned xb_ld(unsigned* p)              { return __hip_atomic_load(p, __ATOMIC_RELAXED, __HIP_MEMORY_SCOPE_AGENT); }
__device__ __forceinline__ unsigned xb_add(unsigned* p, unsigned v) { return __hip_atomic_fetch_add(p, v, __ATOMIC_RELAXED, __HIP_MEMORY_SCOPE_AGENT); }
__device__ __forceinline__ unsigned xb_xcc_id() { return (unsigned)__builtin_amdgcn_s_getreg((3 << 11) | 20) & 0xFu; }
#define XB_SPIN(cond, bar) do { unsigned _sp = 0; while (cond) { __builtin_amdgcn_s_sleep(1); \
    if ((++_sp & 255u) == 0u) { if (xb_ld(&(bar)[XB_TMO])) break; if (_sp > XB_SPIN_CAP) { atomicAdd(&(bar)[XB_TMO], 1u); break; } } } } while (0)

struct XcdBarrier {
    unsigned* bar; unsigned x;
    volatile LAS unsigned* st;
};

__device__ __forceinline__ XcdBarrier xcd_barrier_post(unsigned* bar, volatile LAS unsigned* st) {
    XcdBarrier b; b.bar = bar; b.x = xb_xcc_id(); b.st = st;
    if (threadIdx.x == 0) (void)xb_add(&bar[XB_XCNT(b.x)], 1u);
    return b;
}
__device__ __forceinline__ void xcd_barrier_complete(unsigned* bar, unsigned x, unsigned& nloc, unsigned& nx) {
    const unsigned G = gridDim.x * gridDim.y * gridDim.z;
    unsigned sum, cnt, mine, sp = 0u;
    for (;;) {
        sum = 0u; cnt = 0u; mine = 0u;
#pragma unroll
        for (unsigned j = 0; j < 16; ++j) { const unsigned c = xb_ld(&bar[XB_XCNT(j)]); sum += c; cnt += (c > 0u) ? 1u : 0u; mine = (j == x) ? c : mine; }
        if (sum == G) break;
        __builtin_amdgcn_s_sleep(1);
        if ((++sp & 255u) == 0u) { if (xb_ld(&bar[XB_TMO])) break; if (sp > XB_SPIN_CAP) { atomicAdd(&bar[XB_TMO], 1u); break; } }
    }
    nloc = mine > 0u ? mine : 1u; nx = cnt > 0u ? cnt : 1u;
}

__device__ __forceinline__ void xcd_barrier(const XcdBarrier& b) {
    asm volatile("s_waitcnt vmcnt(0)" ::: "memory");
    __syncthreads();
    if (threadIdx.x == 0) {
        unsigned* bar = b.bar;
        __builtin_amdgcn_s_waitcnt(0);
        unsigned nloc = b.st[0], nx = b.st[1];
        if (nloc == 0u) { xcd_barrier_complete(bar, b.x, nloc, nx); b.st[0] = nloc; b.st[1] = nx; }
        const unsigned old = xb_add(&bar[XB_XSUB(b.x)], 1u);
        const unsigned gen = old / nloc;
        if (old + 1u == (gen + 1u) * nloc) {
            __builtin_amdgcn_fence(__ATOMIC_RELEASE, "agent");
            asm volatile("s_waitcnt vmcnt(0)" ::: "memory");
            const unsigned og = xb_add(&bar[XB_TOP], 1u);
            const unsigned tg = og / nx;
            if (og + 1u == (tg + 1u) * nx) xb_add(&bar[XB_TOPGEN], 1u);
            else XB_SPIN(xb_ld(&bar[XB_TOPGEN]) == tg, bar);
            __builtin_amdgcn_fence(__ATOMIC_ACQUIRE, "agent");
            xb_add(&bar[XB_XGEN(b.x)], 1u);
            asm volatile("s_waitcnt vmcnt(0)" ::: "memory");
        } else {
            XB_SPIN(xb_ld(&bar[XB_XGEN(b.x)]) == gen, bar);
            __builtin_amdgcn_fence(__ATOMIC_ACQUIRE, "agent");
            asm volatile("s_waitcnt vmcnt(0)" ::: "memory");
        }
    }
    __syncthreads();
}

struct Ctx { LAS unsigned char* lds; int tid, lane, wave, G, vcu; };

struct Ptrs {
    const float *x, *ln_g, *final_g, *ssm_w_in, *conv_w, *conv_b, *dt_bias, *a_log, *ssm_d, *norm_g, *ssm_w_out, *pool_w_in, *pool_w_group, *pool_scale, *pool_w_out;
    float* out; unsigned char* ws;
};

__device__ __forceinline__ void t_decode(const Ptrs& P, int it, const float*& src, const float*& gain, bf16*& dst, int& ldw, int& K) {
    constexpr int I1 = (DM / 64) * (SSM_IN / 32), I2 = (DI / 64) * (DM / 32), I3 = (DM / 64) * (DP / 32), I4G = (PGD / 64) * (PGD / 32), I4 = PG * I4G;
    const float* W; const float* g; bf16* WT; int N, row_off = 0, r = it;
    if (r < I1) { W = P.ssm_w_in; g = P.ln_g; K = DM; N = SSM_IN; ldw = SSM_IN; WT = (bf16*)(P.ws + WS_W1T); }
    else if ((r -= I1) < I2) { W = P.ssm_w_out; g = P.norm_g; K = DI; N = DM; ldw = DM; WT = (bf16*)(P.ws + WS_W2T); }
    else if ((r -= I2) < I3) { W = P.pool_w_in + DP; g = P.ln_g + DM; K = DM; N = DP; ldw = 2 * DP; WT = (bf16*)(P.ws + WS_W3T); row_off = DP; }
    else if ((r -= I3) < I4) { const int gi = r / I4G; r -= gi * I4G; W = P.pool_w_group + (size_t)gi * PGD * PGD; g = nullptr; K = PGD; N = PGD; ldw = PGD; WT = (bf16*)(P.ws + WS_W4T); row_off = gi * PGD; }
    else { r -= I4; W = P.pool_w_out; g = nullptr; K = DP; N = DM; ldw = DM; WT = (bf16*)(P.ws + WS_W5T); }
    const int nblk = N / 32, kb = r / nblk, nb = r - kb * nblk, k0 = 64 * kb, n0 = 32 * nb;
    src = W + (size_t)k0 * ldw + n0; gain = g ? g + k0 : nullptr; dst = WT + (size_t)(row_off + n0) * K + k0;
}
__device__ __forceinline__ void t_load(const float* src, const float* gain, int ldw, int lane, f32x4 (&v)[8], float (&gv)[8]) {
#pragma unroll
    for (int i = 0; i < 8; ++i) { const int kk = 8 * i + (lane >> 3); v[i] = *(const f32x4*)(src + (size_t)kk * ldw + 4 * (lane & 7)); gv[i] = gain ? gain[kk] : 1.0f; }
}
__device__ __forceinline__ void t_process(bf16* dst, int K, int lane, LAS float* scr, const f32x4 (&v)[8], const float (&gv)[8]) {
#pragma unroll
    for (int i = 0; i < 8; ++i) *(LAS f32x4*)(scr + (8 * i + (lane >> 3)) * 32 + (((lane & 7) ^ i) << 2)) = v[i] * gv[i];
    LDS_WAIT(); asm volatile("" ::: "memory");
    const int c = lane & 7, nn = lane >> 3;
#pragma unroll
    for (int j = 0; j < 4; ++j) { const int n = nn + 8 * j; const LAS float* s = scr + (8 * c) * 32 + (((n >> 2) ^ c) << 2) + (n & 3);
        v4u o; o.x = pk2(s[0 * 32], s[1 * 32]); o.y = pk2(s[2 * 32], s[3 * 32]); o.z = pk2(s[4 * 32], s[5 * 32]); o.w = pk2(s[6 * 32], s[7 * 32]);
        *(v4u*)(dst + (size_t)n * K + 8 * c) = o; }
    LDS_WAIT(); asm volatile("" ::: "memory");
}
__device__ __forceinline__ void r_decode(const Ptrs& P, int r, const float*& src, bf16*& dst, float& scale, float*& ssq) {
    if (r < M) { src = P.x + (size_t)r * DM; dst = (bf16*)(P.ws + WS_RC) + (size_t)r * DM; scale = 1.0f; ssq = (float*)(P.ws + WS_CTL) + CW_SSQ1 + r; }
    else { const int rr = r - M, m = rr >> 1, hf = rr & 1; src = P.pool_w_in + (size_t)m * 2 * DP + hf * DM; dst = (bf16*)P.out + (size_t)m * DP + hf * DM; scale = P.ln_g[DM + m]; ssq = nullptr; }
}
__device__ __forceinline__ void r_load(const float* src, int lane, f32x4 (&v)[8]) {
#pragma unroll
    for (int j = 0; j < 8; ++j) v[j] = ((const f32x4*)src)[lane + 64 * j];
}
__device__ __forceinline__ void r_process(bf16* dst, float scale, float* ssq, int lane, const f32x4 (&v)[8]) {
    if (ssq) { float s = 0.f;
#pragma unroll
        for (int j = 0; j < 8; ++j) s += (v[j].x * v[j].x + v[j].y * v[j].y) + (v[j].z * v[j].z + v[j].w * v[j].w);
        s = wave_sum(s); if (lane == 0) *ssq = s; }
#pragma unroll
    for (int j = 0; j < 8; ++j) { v2u w; w.x = pk2(v[j].x * scale, v[j].y * scale); w.y = pk2(v[j].z * scale, v[j].w * scale); ((v2u*)dst)[lane + 64 * j] = w; }
}
__device__ __forceinline__ int t_map(int li, int mode) {
    constexpr int I1 = (DM / 64) * (SSM_IN / 32), I2 = (DI / 64) * (DM / 32), I3 = (DM / 64) * (DP / 32), I4 = PG * (PGD / 64) * (PGD / 32);
    return mode == 0 ? (li < I1 ? li : li + I2) : (li < I2 ? I1 + li : I1 + I3 + I4 + li);
}
__device__ __forceinline__ void prep_transposes(const Ctx& F, const Ptrs& P, int mode, int gw, int NGW) {
    LAS float* scr = (LAS float*)(F.lds + RING_OFF + F.wave * 16384);
    const int lane = F.lane;
    constexpr int I1 = (DM / 64) * (SSM_IN / 32), I2 = (DI / 64) * (DM / 32), I3 = (DM / 64) * (DP / 32), I4 = PG * (PGD / 64) * (PGD / 32), I5 = (DP / 64) * (DM / 32);
    const int NT = mode == 0 ? I1 + I3 + I4 : I2 + I5;
    if (gw >= NT) return;
    const int cnt = (NT - gw + NGW - 1) / NGW;
    const float *sA, *gA, *sB, *gB; bf16 *dA, *dB; int lA, kA, lB, kB; f32x4 vA[8], vB[8]; float fA[8], fB[8];
    t_decode(P, t_map(gw, mode), sA, gA, dA, lA, kA); t_load(sA, gA, lA, lane, vA, fA);
    for (int j = 0; j < cnt; j += 2) {
        { const int jn = (j + 1 < cnt) ? j + 1 : cnt - 1; t_decode(P, t_map(gw + jn * NGW, mode), sB, gB, dB, lB, kB); t_load(sB, gB, lB, lane, vB, fB); }
        t_process(dA, kA, lane, scr, vA, fA);
        { const int jn = (j + 2 < cnt) ? j + 2 : cnt - 1; t_decode(P, t_map(gw + jn * NGW, mode), sA, gA, dA, lA, kA); t_load(sA, gA, lA, lane, vA, fA); }
        if (j + 1 < cnt) t_process(dB, kB, lane, scr, vB, fB);
    }
}
__device__ __forceinline__ void phase_prep(const Ctx& F, const Ptrs& P) {
    const int gw = F.vcu * NWAVES + F.wave, NGW = F.G * NWAVES, lane = F.lane;
    prep_transposes(F, P, 0, gw, NGW);
    {
        constexpr int NR = M + 2 * DM;
        const int cnt = (NR - gw + NGW - 1) / NGW;
        const float *sA, *sB; bf16 *dA, *dB; float cA, cB; float *qA, *qB; f32x4 vA[8], vB[8];
        r_decode(P, gw, sA, dA, cA, qA); r_load(sA, lane, vA);
        for (int j = 0; j < cnt; j += 2) {
            { const int jn = (j + 1 < cnt) ? j + 1 : cnt - 1; r_decode(P, gw + jn * NGW, sB, dB, cB, qB); r_load(sB, lane, vB); }
            r_process(dA, cA, qA, lane, vA);
            { const int jn = (j + 2 < cnt) ? j + 2 : cnt - 1; r_decode(P, gw + jn * NGW, sA, dA, cA, qA); r_load(sA, lane, vA); }
            if (j + 1 < cnt) r_process(dB, cB, qB, lane, vB);
        }
    }
}

__device__ __forceinline__ float softplus_f(float v) { return fmaxf(v, 0.f) + log1pf(expf(-fabsf(v))); }

__device__ __forceinline__ void phase_dt(const Ctx& F, const Ptrs& P) {
    const bf16* XB = (const bf16*)(P.ws + WS_RC); const bf16* WDT = (const bf16*)(P.ws + WS_W1T) + (size_t)N1 * DM;
    const float* ssq1 = (const float*)(P.ws + WS_CTL) + CW_SSQ1; float* DT = (float*)(P.ws + WS_DT);
    LAS float* part = (LAS float*)F.lds;
    const int w = F.wave, lane = F.lane, fr = lane & 15, fq = lane >> 4;
    for (int item = F.vcu; item < M / 64; item += F.G) {
        const int r0 = item * 64;
        f32x4 acc[4][4];
#pragma unroll
        for (int i = 0; i < 4; ++i)
#pragma unroll
            for (int j = 0; j < 4; ++j) acc[i][j] = (f32x4){0.f, 0.f, 0.f, 0.f};
        const bf16* ap = XB + (size_t)(r0 + fr) * DM + w * 256 + 8 * fq;
        const bf16* bp = WDT + (size_t)fr * DM + w * 256 + 8 * fq;
#pragma unroll
        for (int hf = 0; hf < 2; ++hf) {
            bf16x8 a[4][4], b[4][4];
#pragma unroll
            for (int ks = 0; ks < 4; ++ks)
#pragma unroll
                for (int t = 0; t < 4; ++t) { a[ks][t] = *(const bf16x8*)(ap + (size_t)(16 * t) * DM + 32 * (4 * hf + ks)); b[ks][t] = *(const bf16x8*)(bp + (size_t)(16 * t) * DM + 32 * (4 * hf + ks)); }
#pragma unroll
            for (int ks = 0; ks < 4; ++ks)
#pragma unroll
                for (int rt = 0; rt < 4; ++rt)
#pragma unroll
                    for (int ct = 0; ct < 4; ++ct) acc[rt][ct] = __builtin_amdgcn_mfma_f32_16x16x32_bf16(a[ks][rt], b[ks][ct], acc[rt][ct], 0, 0, 0);
        }
#pragma unroll
        for (int rt = 0; rt < 4; ++rt)
#pragma unroll
            for (int ct = 0; ct < 4; ++ct) *(LAS f32x4*)(part + (size_t)w * 4096 + (16 * ct + fr) * 64 + 16 * rt + 4 * fq) = acc[rt][ct];
        __syncthreads();
        {
            const int hd = F.tid & 63, rb = 8 * (F.tid >> 6);
            f32x4 s0 = (f32x4){0.f, 0.f, 0.f, 0.f}, s1 = s0;
#pragma unroll
            for (int pw = 0; pw < 8; ++pw) { s0 = s0 + *(const LAS f32x4*)(part + (size_t)pw * 4096 + hd * 64 + rb); s1 = s1 + *(const LAS f32x4*)(part + (size_t)pw * 4096 + hd * 64 + rb + 4); }
            const float bias = P.dt_bias[hd];
#pragma unroll
            for (int i = 0; i < 8; ++i) { const int row = r0 + rb + i; const float sc = rsqrtf(ssq1[row] * (1.0f / DM) + EPS); const float v = (i < 4 ? s0[i & 3] : s1[i & 3]) * sc + bias;
                DT[(size_t)row * NH + hd] = softplus_f(v); }
        }
        __syncthreads();
    }
}

constexpr int IMG_C = 0, IMG_B = 16384, IMG_BT = 32768, IMG_BYTES = 49152;
constexpr int SC_BYTES = 1024, BL_C = 0, BL_BT = 16384, BL_CBT = 32768, BL_SC = BL_CBT + 10 * 1024, BLOB_BYTES = BL_SC + 8 * SC_BYTES;
constexpr int MAIN_BYTES = 32768 + SC_BYTES, HEAD_BYTES = 10 * 1024 + SC_BYTES;
constexpr int SL_MAIN = 0, SL_HEAD = 2 * MAIN_BYTES, SL_XT = SL_HEAD + 2 * HEAD_BYTES, SL_XWT = SL_XT + 2 * 8192, SL_P = SL_XWT + 2 * 8192, SL_YT = SL_P + 2 * 8192, SL_END = SL_YT + 2 * 8192;
static_assert(SL_END <= RING_BYTES, "SSD LDS map");
__device__ __forceinline__ int img256(int r, int c) { return r * 256 + ((c ^ (r & 15)) << 4); }
__device__ __forceinline__ int img128(int r, int c) { return r * 128 + ((c ^ ((r >> 1) & 7)) << 4); }
typedef __bf16 bf16x2_t __attribute__((ext_vector_type(2)));
typedef float f32x2_t __attribute__((ext_vector_type(2)));
__device__ __forceinline__ unsigned cvtpk(float lo, float hi) { f32x2_t v = {lo, hi}; bf16x2_t b = __builtin_convertvector(v, bf16x2_t); return __builtin_bit_cast(unsigned, b); }
#define RAW_BARRIER() do { asm volatile("s_waitcnt lgkmcnt(0)" ::: "memory"); __builtin_amdgcn_s_barrier(); asm volatile("" ::: "memory"); } while (0)

__device__ __forceinline__ void bc_load(const bf16* XBC, const float* DT, int unit, int isC, int n0, int tg, int wave, int lane, v4u (&raw)[7], float& dtv) {
    const int g = unit % NG, bc = unit / NG, c = bc % (SEQ / 64);
    const int ch = DI + isC * (NG * NS) + g * NS + n0;
    const size_t T0 = (size_t)bc * 64 + 4 * tg;
    const bool nohalo = (c == 0 && tg == 0);
#pragma unroll
    for (int k = 0; k < 7; ++k) { const size_t row = (k < 3 && nohalo) ? T0 : (T0 + k - 3); raw[k] = *(const v4u*)(XBC + row * CONV_DIM + ch); }
    dtv = DT[((size_t)bc * 64 + lane) * NH + g * HPG + wave];
}
__device__ __forceinline__ void bc_process(const Ctx& F, const Ptrs& P, unsigned char* IMGS, int unit, int isC, int n0, int tg, const float (&w)[4][8], const float (&bias)[8], const v4u (&rawv)[7], float dtv) {
    LAS unsigned char* L = F.lds;
    const int g = unit % NG, bc = unit / NG, c = bc % (SEQ / 64);
    const bool nohalo = (c == 0 && tg == 0);
    float raw[7][8];
#pragma unroll
    for (int k = 0; k < 7; ++k) { v4u rr = rawv[k];
        if (k < 3 && nohalo) { rr.x = 0u; rr.y = 0u; rr.z = 0u; rr.w = 0u; }
        raw[k][0] = bflo(rr.x); raw[k][1] = bfhi(rr.x); raw[k][2] = bflo(rr.y); raw[k][3] = bfhi(rr.y); raw[k][4] = bflo(rr.z); raw[k][5] = bfhi(rr.z); raw[k][6] = bflo(rr.w); raw[k][7] = bfhi(rr.w); }
    float o[4][8];
#pragma unroll
    for (int i = 0; i < 4; ++i)
#pragma unroll
        for (int j = 0; j < 8; ++j) { const float v = bias[j] + w[0][j] * raw[i][j] + w[1][j] * raw[i + 1][j] + w[2][j] * raw[i + 2][j] + w[3][j] * raw[i + 3][j]; o[i][j] = v * sigm(v); }
    const int ks = n0 >> 5, hi = (n0 >> 4) & 1, q0 = 2 * ((n0 >> 3) & 1);
    const int ibase = isC ? IMG_C : IMG_B;
#pragma unroll
    for (int i = 0; i < 4; ++i) { const int l = 4 * tg + i;
        v2u lo, hi2; lo.x = cvtpk(o[i][0], o[i][1]); lo.y = cvtpk(o[i][2], o[i][3]); hi2.x = cvtpk(o[i][4], o[i][5]); hi2.y = cvtpk(o[i][6], o[i][7]);
        *(LAS v2u*)(L + ibase + img256(l, 4 * ks + q0) + 8 * hi) = lo;
        *(LAS v2u*)(L + ibase + img256(l, 4 * ks + q0 + 1) + 8 * hi) = hi2; }
    if (!isC) {
#pragma unroll
        for (int e = 0; e < 8; ++e) { v2u t; t.x = cvtpk(o[0][e], o[1][e]); t.y = cvtpk(o[2][e], o[3][e]);
            *(LAS v2u*)(L + IMG_BT + img128(n0 + e, tg >> 1) + 8 * (tg & 1)) = t; }
    }
    RAW_BARRIER();
    unsigned char* blob = IMGS + (size_t)unit * BLOB_BYTES;
#pragma unroll
    for (int k = 0; k < 2; ++k) { const v4u vc = *(const LAS v4u*)(L + IMG_C + F.tid * 16 + k * 8192), vt = *(const LAS v4u*)(L + IMG_BT + F.tid * 16 + k * 8192);
        *(v4u*)(blob + BL_C + F.tid * 16 + k * 8192) = vc; *(v4u*)(blob + BL_BT + F.tid * 16 + k * 8192) = vt; }
    {
        const int w = F.wave, r = F.lane & 15, q = F.lane >> 4;
        const int lt0 = (w < 4) ? w : (w == 4) ? 1 : (w == 5) ? 2 : 3, st0 = (w < 4) ? w : (w == 4) ? 0 : (w == 7) ? 2 : 1;
#pragma unroll
        for (int tt = 0; tt < 2; ++tt) { if (tt == 1 && (w < 4 || w > 5)) break;
            const int lt = tt ? lt0 + 1 : lt0, st = tt ? 0 : st0;
            f32x4 cb = {0.f, 0.f, 0.f, 0.f};
#pragma unroll
            for (int ks = 0; ks < 4; ++ks) { const bf16x8 av = *(const LAS bf16x8*)(L + IMG_C + img256(16 * lt + r, 4 * ks + q)), bv = *(const LAS bf16x8*)(L + IMG_B + img256(16 * st + r, 4 * ks + q));
                cb = __builtin_amdgcn_mfma_f32_16x16x32_bf16(av, bv, cb, 0, 0, 0); }
            *(f32x4*)(blob + BL_CBT + (tt ? 8 + (w - 4) : w) * 1024 + F.lane * 16) = cb; }
    }
    {
        const int hh = g * HPG + F.wave; const float a = -expf(P.a_log[hh]);
        float cs = a * dtv;
#pragma unroll
        for (int o2 = 1; o2 < 64; o2 <<= 1) { const float t = __shfl_up(cs, o2); if (F.lane >= o2) cs += t; }
        const float last = __shfl(cs, 63);
        float* sc = (float*)(blob + BL_SC + F.wave * SC_BYTES);
        sc[F.lane] = dtv; sc[64 + F.lane] = cs; sc[128 + F.lane] = __expf(cs); sc[192 + F.lane] = dtv * __expf(last - cs);
    }
    RAW_BARRIER();
}
__device__ __forceinline__ void phase_bcprep(const Ctx& F, const Ptrs& P) {
    const bf16* XBC = (const bf16*)(P.ws + WS_RB); unsigned char* IMGS = (unsigned char*)P.out; const float* DT = (const float*)(P.ws + WS_DT);
    const int cg = F.tid & 31, tg = F.tid >> 5, isC = cg >> 4, n0 = 8 * (cg & 15);
    constexpr int NU = BATCH * (SEQ / 64) * NG;
    if (F.G % NG != 0 || F.vcu >= NU) return;
    const int g = F.vcu % NG, ch = DI + isC * (NG * NS) + g * NS + n0, cnt = (NU - F.vcu + F.G - 1) / F.G;
    float w[4][8], bias[8];
#pragma unroll
    for (int k = 0; k < 4; ++k) { const f32x4 a = *(const f32x4*)(P.conv_w + (size_t)k * CONV_DIM + ch), b = *(const f32x4*)(P.conv_w + (size_t)k * CONV_DIM + ch + 4);
        w[k][0] = a.x; w[k][1] = a.y; w[k][2] = a.z; w[k][3] = a.w; w[k][4] = b.x; w[k][5] = b.y; w[k][6] = b.z; w[k][7] = b.w; }
    { const f32x4 a = *(const f32x4*)(P.conv_b + ch), b = *(const f32x4*)(P.conv_b + ch + 4); bias[0] = a.x; bias[1] = a.y; bias[2] = a.z; bias[3] = a.w; bias[4] = b.x; bias[5] = b.y; bias[6] = b.z; bias[7] = b.w; }
    v4u rA[7], rB[7]; float dA, dB;
    bc_load(XBC, DT, F.vcu, isC, n0, tg, F.wave, F.lane, rA, dA);
    for (int j = 0; j < cnt; j += 2) {
        { const int jn = (j + 1 < cnt) ? j + 1 : j; bc_load(XBC, DT, F.vcu + jn * F.G, isC, n0, tg, F.wave, F.lane, rB, dB); }
        bc_process(F, P, IMGS, F.vcu + j * F.G, isC, n0, tg, w, bias, rA, dA);
        if (j + 1 < cnt) {
            { const int jn = (j + 2 < cnt) ? j + 2 : j + 1; bc_load(XBC, DT, F.vcu + jn * F.G, isC, n0, tg, F.wave, F.lane, rA, dA); }
            bc_process(F, P, IMGS, F.vcu + (j + 1) * F.G, isC, n0, tg, w, bias, rB, dB);
        }
    }
}

__device__ __forceinline__ int dpp_i(int v, const int ctrl_sel) { return ctrl_sel == 0 ? __builtin_amdgcn_update_dpp(0, v, 0xB1, 0xF, 0xF, false) : ctrl_sel == 1 ? __builtin_amdgcn_update_dpp(0, v, 0x4E, 0xF, 0xF, false) : __builtin_amdgcn_update_dpp(0, v, 0x141, 0xF, 0xF, false); }
__device__ __forceinline__ float dpp_add(float v, const int sel) { return v + __int_as_float(dpp_i(__float_as_int(v), sel)); }
template <bool DIAG> __device__ __forceinline__ void ssd_p_tile(LAS unsigned char* Pbuf, const LAS unsigned char* CBT, const LAS float* SC, int slot, int lane, int lt, int st, int r, int q, float Dh) {
    const f32x4 cb = *(const LAS f32x4*)(CBT + slot * 1024 + lane * 16);
    const f32x4 csl = *(const LAS f32x4*)(SC + 64 + 16 * lt + 4 * q);
    const int s = 16 * st + r; const float cs_s = SC[64 + s], dt_s = SC[s];
#pragma unroll
    for (int rg = 0; rg < 4; ++rg) { const int l = 16 * lt + 4 * q + rg; float v;
        if (DIAG) { v = cb[rg] * __expf(fminf(csl[rg] - cs_s, 0.f)) * dt_s; v = (s <= l) ? v : 0.f; if (s == l) v += Dh; }
        else v = cb[rg] * __expf(csl[rg] - cs_s) * dt_s;
        *(LAS unsigned short*)(Pbuf + img128(l, s >> 3) + (s & 7) * 2) = (unsigned short)(cvtpk(v, 0.f) & 0xffffu); }
}
struct ConvW { float a[4], b[4], ba, bb; };
__device__ __forceinline__ void ssd_head(LAS unsigned char* L, int par, int hpar, bool first_chunk, const unsigned (&xr)[7], int w, int lane, int r, int q, const ConvW& cw, float Dh) {
    const LAS unsigned char* HD = L + SL_HEAD + hpar * HEAD_BYTES; const LAS float* SC = (const LAS float*)(HD + 10 * 1024);
    {
        const int cp = lane & 31, hf = lane >> 5;
        const f32x4 wv4 = *(const LAS f32x4*)(SC + 192 + 8 * w + 4 * hf);
        float xa[7], xc[7];
#pragma unroll
        for (int k = 0; k < 7; ++k) { const bool zpad = first_chunk && w == 0 && hf == 0 && k < 3; xa[k] = zpad ? 0.f : bflo(xr[k]); xc[k] = zpad ? 0.f : bfhi(xr[k]); }
        float oa[4], oc[4], wa[4], wc[4];
#pragma unroll
        for (int i = 0; i < 4; ++i) { const float va = cw.ba + cw.a[0] * xa[i] + cw.a[1] * xa[i + 1] + cw.a[2] * xa[i + 2] + cw.a[3] * xa[i + 3], vc = cw.bb + cw.b[0] * xc[i] + cw.b[1] * xc[i + 1] + cw.b[2] * xc[i + 2] + cw.b[3] * xc[i + 3];
            oa[i] = va * sigm(va); oc[i] = vc * sigm(vc); wa[i] = oa[i] * wv4[i]; wc[i] = oc[i] * wv4[i]; }
        v2u t; LAS unsigned char* XTb = L + SL_XT + par * 8192; LAS unsigned char* XWb = L + SL_XWT + par * 8192;
        const int o0 = img128(2 * cp, w) + 8 * hf, o1 = img128(2 * cp + 1, w) + 8 * hf;
        t.x = cvtpk(oa[0], oa[1]); t.y = cvtpk(oa[2], oa[3]); *(LAS v2u*)(XTb + o0) = t;
        t.x = cvtpk(oc[0], oc[1]); t.y = cvtpk(oc[2], oc[3]); *(LAS v2u*)(XTb + o1) = t;
        t.x = cvtpk(wa[0], wa[1]); t.y = cvtpk(wa[2], wa[3]); *(LAS v2u*)(XWb + o0) = t;
        t.x = cvtpk(wc[0], wc[1]); t.y = cvtpk(wc[2], wc[3]); *(LAS v2u*)(XWb + o1) = t;
    }
    LAS unsigned char* Pb = L + SL_P + par * 8192;
    if (w < 4) ssd_p_tile<true>(Pb, HD, SC, w, lane, w, w, r, q, Dh);
    else { const int lt1 = (w == 4) ? 1 : (w == 5) ? 2 : 3, st1 = (w == 4) ? 0 : (w == 7) ? 2 : 1;
        ssd_p_tile<false>(Pb, HD, SC, w, lane, lt1, st1, r, q, Dh);
        if (w < 6) ssd_p_tile<false>(Pb, HD, SC, 8 + (w - 4), lane, lt1 + 1, 0, r, q, Dh); }
}
__device__ __forceinline__ void ssd_mfma(LAS unsigned char* L, int par, f32x4 (&st)[8], int lane, int r, int q, int pt, int lh, const int (&a256)[4], const int (&a128)[2]) {
    const LAS unsigned char* IC = L + SL_MAIN + par * MAIN_BYTES; const LAS unsigned char* IBT = IC + 16384; const LAS float* SC = (const LAS float*)(IC + 32768);
    f32x4 acc[2] = {(f32x4){0.f, 0.f, 0.f, 0.f}, (f32x4){0.f, 0.f, 0.f, 0.f}};
    {
        bf16x8 yav[4][2], sb[4];
#pragma unroll
        for (int ks = 0; ks < 4; ++ks) {
#pragma unroll
            for (int t = 0; t < 2; ++t) yav[ks][t] = *(const LAS bf16x8*)(IC + 4096 * (2 * lh + t) + a256[ks]);
            v4u sbw; sbw.x = cvtpk(st[2 * ks][0], st[2 * ks][1]); sbw.y = cvtpk(st[2 * ks][2], st[2 * ks][3]); sbw.z = cvtpk(st[2 * ks + 1][0], st[2 * ks + 1][1]); sbw.w = cvtpk(st[2 * ks + 1][2], st[2 * ks + 1][3]);
            sb[ks] = __builtin_bit_cast(bf16x8, sbw); }
#pragma unroll
        for (int ks = 0; ks < 4; ++ks)
#pragma unroll
            for (int t = 0; t < 2; ++t) acc[t] = __builtin_amdgcn_mfma_f32_16x16x32_bf16(yav[ks][t], sb[ks], acc[t], 0, 0, 0);
    }
    { const float elast = SC[128 + 63];
#pragma unroll
      for (int t = 0; t < 2; ++t) { const f32x4 ev4 = *(const LAS f32x4*)(SC + 128 + 16 * (2 * lh + t) + 4 * q); acc[t] = acc[t] * ev4; }
#pragma unroll
      for (int j = 0; j < 8; ++j) st[j] = st[j] * elast; }
    {
        const LAS unsigned char* XTb = L + SL_XT + par * 8192; const LAS unsigned char* XWb = L + SL_XWT + par * 8192; const LAS unsigned char* Pb = L + SL_P + par * 8192;
        bf16x8 xb[2], pav[2][2], xwb[2], bav[2][8];
#pragma unroll
        for (int ks = 0; ks < 2; ++ks) { xb[ks] = *(const LAS bf16x8*)(XTb + 2048 * pt + a128[ks]); xwb[ks] = *(const LAS bf16x8*)(XWb + 2048 * pt + a128[ks]);
#pragma unroll
            for (int t = 0; t < 2; ++t) pav[ks][t] = *(const LAS bf16x8*)(Pb + 2048 * (2 * lh + t) + a128[ks]);
#pragma unroll
            for (int j = 0; j < 8; ++j) bav[ks][j] = *(const LAS bf16x8*)(IBT + 2048 * j + a128[ks]); }
#pragma unroll
        for (int t = 0; t < 2; ++t) acc[t] = __builtin_amdgcn_mfma_f32_16x16x32_bf16(pav[0][t], xb[0], acc[t], 0, 0, 0);
        if (lh == 1) {
#pragma unroll
            for (int t = 0; t < 2; ++t) acc[t] = __builtin_amdgcn_mfma_f32_16x16x32_bf16(pav[1][t], xb[1], acc[t], 0, 0, 0); }
#pragma unroll
        for (int ks = 0; ks < 2; ++ks)
#pragma unroll
            for (int j = 0; j < 8; ++j) st[j] = __builtin_amdgcn_mfma_f32_16x16x32_bf16(bav[ks][j], xwb[ks], st[j], 0, 0, 0);
    }
#pragma unroll
    for (int t = 0; t < 2; ++t) { const int p = 16 * pt + r; v2u yw; yw.x = cvtpk(acc[t][0], acc[t][1]); yw.y = cvtpk(acc[t][2], acc[t][3]);
        *(LAS v2u*)(L + SL_YT + par * 8192 + img128(p, 2 * (2 * lh + t) + (q >> 1)) + 8 * (q & 1)) = yw; }
}
__device__ __forceinline__ void ssd_epi(const LAS unsigned char* L, int par, const unsigned (&zr)[4], int w, int lane, unsigned (&ob)[4], float& s1) {
    const int cp = lane & 31, hf = lane >> 5;
    const v2u ya = *(const LAS v2u*)(L + SL_YT + par * 8192 + img128(2 * cp, w) + 8 * hf), yc = *(const LAS v2u*)(L + SL_YT + par * 8192 + img128(2 * cp + 1, w) + 8 * hf);
    const float y0[4] = {bflo(ya.x), bfhi(ya.x), bflo(ya.y), bfhi(ya.y)}, y1[4] = {bflo(yc.x), bfhi(yc.x), bflo(yc.y), bfhi(yc.y)};
    float sq[4];
#pragma unroll
    for (int i = 0; i < 4; ++i) { const float za = bflo(zr[i]), zc = bfhi(zr[i]); const float ga = y0[i] * (za * sigm(za)), gc = y1[i] * (zc * sigm(zc)); sq[i] = ga * ga + gc * gc; ob[i] = cvtpk(ga, gc); }
    float s2[2];
#pragma unroll
    for (int k2 = 0; k2 < 2; ++k2) { const bool hi = (lane & 16) != 0; const float send = hi ? sq[k2] : sq[2 + k2], keep = hi ? sq[2 + k2] : sq[k2]; s2[k2] = keep + __shfl_xor(send, 16); }
    { const bool hi = (lane & 8) != 0; const float send = hi ? s2[0] : s2[1], keep = hi ? s2[1] : s2[0]; s1 = keep + __int_as_float(__builtin_amdgcn_update_dpp(0, __float_as_int(send), 0x128  , 0xF, 0xF, false)); }
    s1 = dpp_add(s1, 0); s1 = dpp_add(s1, 1); s1 = dpp_add(s1, 2);
}
__device__ __forceinline__ void ssd_dma_main(const Ctx& F, const unsigned char* blob_c, int hsub, int w, int lane, int par) {
    LAS unsigned char* dst = F.lds + SL_MAIN + par * MAIN_BYTES;
#pragma unroll
    for (int k = 0; k < 4; ++k) { const int piece = k * 8 + w; __builtin_amdgcn_global_load_lds((const unsigned*)(blob_c + BL_C + piece * 1024) + lane * 4, (LAS unsigned*)(dst + piece * 1024), 16, 0, 0); }
    if (w == 0) __builtin_amdgcn_global_load_lds((const unsigned*)(blob_c + BL_SC + hsub * SC_BYTES) + lane * 4, (LAS unsigned*)(dst + 32768), 16, 0, 0);
}
__device__ __forceinline__ void ssd_dma_head(const Ctx& F, const unsigned char* blob_c, int hsub, int w, int lane, int par) {
    LAS unsigned char* dst = F.lds + SL_HEAD + par * HEAD_BYTES;
    __builtin_amdgcn_global_load_lds((const unsigned*)(blob_c + BL_CBT + w * 1024) + lane * 4, (LAS unsigned*)(dst + w * 1024), 16, 0, 0);
    if (w == 1 || w == 2) __builtin_amdgcn_global_load_lds((const unsigned*)(blob_c + BL_CBT + (7 + w) * 1024) + lane * 4, (LAS unsigned*)(dst + (7 + w) * 1024), 16, 0, 0);
    if (w == 3) __builtin_amdgcn_global_load_lds((const unsigned*)(blob_c + BL_SC + hsub * SC_BYTES) + lane * 4, (LAS unsigned*)(dst + 10 * 1024), 16, 0, 0);
}
template <bool DRY> __device__ __forceinline__ void phase_ssd(const Ctx& F, const Ptrs& P) {
    const bf16* XBC = (const bf16*)(P.ws + WS_RB); bf16* Z = (bf16*)(P.ws + WS_RA);
    float* ssqp = (float*)(P.ws + WS_SSQP); const unsigned char* IMGS = (const unsigned char*)P.out;
    LAS unsigned char* L = F.lds;
    const int w = F.wave, lane = F.lane, r = lane & 15, q = lane >> 4, pt = w & 3, lh = w >> 2;
    constexpr int NC = SEQ / 64;
    for (int unit = F.vcu; unit < BATCH * NH; unit += F.G) {
        const int b = unit / NH, h = unit % NH, g = h / HPG, hsub = h % HPG, cp = lane & 31, hf = lane >> 5, ch = h * HD + 2 * cp;
        const float Dh = P.ssm_d[h];
        ConvW cw;
#pragma unroll
        for (int t = 0; t < 4; ++t) { cw.a[t] = P.conv_w[t * CONV_DIM + ch]; cw.b[t] = P.conv_w[t * CONV_DIM + ch + 1]; }
        cw.ba = P.conv_b[ch]; cw.bb = P.conv_b[ch + 1];
        const unsigned char* blob0 = IMGS + ((size_t)b * NC * NG + g) * BLOB_BYTES;
        const bf16* x0 = XBC + ((size_t)b * SEQ + 8 * w + 4 * hf) * CONV_DIM + h * HD + 2 * cp;
        bf16* z0 = Z + ((size_t)b * SEQ + 8 * w + 4 * hf) * DI + h * HD + 2 * cp;
        const __amdgpu_buffer_rsrc_t rx = __builtin_amdgcn_make_buffer_rsrc((void*)XBC, 0, (int)((size_t)M * CONV_DIM * 2), 0x00020000), rz = __builtin_amdgcn_make_buffer_rsrc((void*)Z, 0, (int)((size_t)M * DI * 2), 0x00020000);
        const unsigned xs0 = (unsigned)((((size_t)b * SEQ + 8 * w) * CONV_DIM + h * HD) * 2), zs0 = (unsigned)((((size_t)b * SEQ + 8 * w) * DI + h * HD) * 2);
        const int xvo = cp * 4 + hf * (4 * CONV_DIM * 2), zvo = cp * 4 + hf * (4 * DI * 2);
        f32x4 st[8];
#pragma unroll
        for (int j = 0; j < 8; ++j) st[j] = (f32x4){0.f, 0.f, 0.f, 0.f};
        int a256[4], a128[2];
#pragma unroll
        for (int ks = 0; ks < 4; ++ks) a256[ks] = img256(r, 4 * ks + q);
#pragma unroll
        for (int ks = 0; ks < 2; ++ks) a128[ks] = img128(r, 4 * ks + q);
        {
          const int l = F.tid >> 3, cch = F.tid & 7; unsigned zz = 0u; asm volatile("" : "+v"(zz));
          if ((cch >> 1) > (l >> 4)) { *(LAS v4u*)(L + SL_P + img128(l, cch)) = (v4u){zz, zz, zz, zz}; *(LAS v4u*)(L + SL_P + 8192 + img128(l, cch)) = (v4u){zz, zz, zz, zz}; } }
        unsigned xr[7], zr[4];
        {
            unsigned x0r[7], x1r[7];
            ssd_dma_main(F, blob0, hsub, w, lane, 0); ssd_dma_head(F, blob0, hsub, w, lane, 0); ssd_dma_head(F, blob0 + (size_t)NG * BLOB_BYTES, hsub, w, lane, 1);
#pragma unroll
            for (int k = 0; k < 7; ++k) { x0r[k] = *(const unsigned*)(x0 + (long)(k - 3) * CONV_DIM); x1r[k] = *(const unsigned*)(x0 + (long)(64 + k - 3) * CONV_DIM); }
            asm volatile("s_waitcnt vmcnt(0)" ::: "memory");
#pragma unroll
            for (int k = 0; k < 7; ++k) { asm volatile("v_mov_b32 %0, %1" : "=v"(xr[k]) : "v"(x1r[k])); asm volatile("" : "+v"(x0r[k])); }
#pragma unroll
            for (int i = 0; i < 4; ++i) zr[i] = 0u;
            RAW_BARRIER();
            ssd_head(L, 0, 0, true, x0r, w, lane, r, q, cw, Dh);
            RAW_BARRIER();
        }
        for (int j = 0; j < NC; ++j) {
            unsigned nxr[7], nzr[4];
#define SSD_ISSUE()             { \
                const int c1 = (j + 1 < NC) ? j + 1 : j, c2 = (j + 2 < NC) ? j + 2 : NC - 1; \
                ssd_dma_main(F, blob0 + (size_t)c1 * NG * BLOB_BYTES, hsub, w, lane, (j + 1) & 1); \
                if (j + 2 < NC) ssd_dma_head(F, blob0 + (size_t)c2 * NG * BLOB_BYTES, hsub, w, lane, j & 1); \
                const unsigned xso = xs0 + (unsigned)(c2 * 64 - 3) * (CONV_DIM * 2), zso = zs0 + (unsigned)(j * 64) * (DI * 2); \
_Pragma("unroll") \
                for (int k = 0; k < 7; ++k) nxr[k] = __builtin_amdgcn_raw_buffer_load_b32(rx, xvo, xso + k * (CONV_DIM * 2), 0); \
_Pragma("unroll") \
                for (int i = 0; i < 4; ++i) nzr[i] = __builtin_amdgcn_raw_buffer_load_b32(rz, zvo, zso + i * (DI * 2), 0); \
            }
            const int igrp = w % 3;
            if (igrp == 0) SSD_ISSUE()
            unsigned eob[4]; float es1;
            ssd_epi(L, (j + 1) & 1, zr, w, lane, eob, es1);
            if (igrp == 1) SSD_ISSUE()
            ssd_mfma(L, j & 1, st, lane, r, q, pt, lh, a256, a128);
            if (igrp == 2) SSD_ISSUE()
            { const int d = (j + 1 < NC) ? j + 1 : j; ssd_head(L, (j + 1) & 1, d & 1, false, xr, w, lane, r, q, cw, Dh); }
            asm volatile("s_waitcnt vmcnt(0)" ::: "memory");
#pragma unroll
            for (int k2 = 0; k2 < 7; ++k2) asm volatile("v_mov_b32 %0, %1" : "=v"(xr[k2]) : "v"(nxr[k2]));
#pragma unroll
            for (int k2 = 0; k2 < 4; ++k2) asm volatile("v_mov_b32 %0, %1" : "=v"(zr[k2]) : "v"(nzr[k2]));
            if (j > 0) {
                const unsigned zso = zs0 + (unsigned)((j - 1) * 64) * (DI * 2);
#pragma unroll
                for (int i = 0; i < 4; ++i) if (!DRY || es1 == 1.2345e30f) __builtin_amdgcn_raw_buffer_store_b32(eob[i], rz, zvo, zso + i * (DI * 2), 0);
                if ((lane & 7) == 0 && (!DRY || es1 == 1.2345e30f)) { const int i = 4 * (lane >> 5) + 2 * ((lane >> 4) & 1) + ((lane >> 3) & 1); ssqp[((size_t)b * SEQ + (j - 1) * 64 + 8 * w + i) * NH + h] = es1; }
            }
            RAW_BARRIER();
        }
        {
            unsigned ob[4]; float s1;
            ssd_epi(L, (NC - 1) & 1, zr, w, lane, ob, s1);
            bf16* zc = z0 + (size_t)(NC - 1) * 64 * DI;
#pragma unroll
            for (int i = 0; i < 4; ++i) if (!DRY || s1 == 1.2345e30f) *(unsigned*)(zc + (long)i * DI) = ob[i];
            if ((lane & 7) == 0 && (!DRY || s1 == 1.2345e30f)) { const int i = 4 * (lane >> 5) + 2 * ((lane >> 4) & 1) + ((lane >> 3) & 1); ssqp[((size_t)b * SEQ + (NC - 1) * 64 + 8 * w + i) * NH + h] = s1; }
        }
        asm volatile("s_waitcnt vmcnt(0)" ::: "memory"); RAW_BARRIER();
    }
}

__device__ __forceinline__ void phase_pool(const Ctx& F, const Ptrs& P) {
    const bf16* V = (const bf16*)(P.ws + WS_RA); const bf16* GT = (const bf16*)(P.ws + WS_RB); bf16* Y2 = (bf16*)(P.ws + WS_RB);
    const int NCG = DP / 8;
    const int nitems = (M / 32) * NCG;
    for (int it = F.vcu * 512 + F.tid; it < nitems; it += F.G * 512) {
        const int cg = it % NCG, tb = it / NCG, c0 = cg * 8, t0 = tb * 32, win = 2 << (c0 / PGD);
        const int pos0 = t0 % SEQ;
        float sc[8]; { const f32x4 a = *(const f32x4*)(P.pool_scale + c0), b = *(const f32x4*)(P.pool_scale + c0 + 4); sc[0] = a.x; sc[1] = a.y; sc[2] = a.z; sc[3] = a.w; sc[4] = b.x; sc[5] = b.y; sc[6] = b.z; sc[7] = b.w; }
        float s[8];
#pragma unroll
        for (int j = 0; j < 8; ++j) s[j] = 0.f;
        for (int d = 1; d < win; ++d) if (pos0 - d >= 0) { const v4u r = *(const v4u*)(V + (size_t)(t0 - d) * DP + c0);
            s[0] += bflo(r.x); s[1] += bfhi(r.x); s[2] += bflo(r.y); s[3] += bfhi(r.y); s[4] += bflo(r.z); s[5] += bfhi(r.z); s[6] += bflo(r.w); s[7] += bfhi(r.w); }
        for (int tt = 0; tt < 32; tt += 8) {
            v4u rv[8], gv[8], qv[8];
#pragma unroll
            for (int u = 0; u < 8; ++u) { const int t = tt + u; rv[u] = *(const v4u*)(V + (size_t)(t0 + t) * DP + c0); gv[u] = *(const v4u*)(GT + (size_t)(t0 + t) * DP + c0);
                const int pd = pos0 + t - (win - 1); qv[u] = *(const v4u*)(V + (size_t)(t0 + t - (pd >= 0 ? win - 1 : 0)) * DP + c0); }
#pragma unroll
            for (int u = 0; u < 8; ++u) { const int t = tt + u, pos = pos0 + t; const v4u r = rv[u], gr = gv[u], q = qv[u];
                const float cur[8] = {bflo(r.x), bfhi(r.x), bflo(r.y), bfhi(r.y), bflo(r.z), bfhi(r.z), bflo(r.w), bfhi(r.w)};
                const float gt[8] = {bflo(gr.x), bfhi(gr.x), bflo(gr.y), bfhi(gr.y), bflo(gr.z), bfhi(gr.z), bflo(gr.w), bfhi(gr.w)};
#pragma unroll
                for (int j = 0; j < 8; ++j) s[j] += cur[j];
                const int cnt = (pos + 1 < win) ? (pos + 1) : win; const float inv = 1.0f / (float)cnt;
                float o[8];
#pragma unroll
                for (int j = 0; j < 8; ++j) o[j] = (s[j] * inv - cur[j]) * sc[j] * (gt[j] * sigm(gt[j]));
                v4u ow; ow.x = pk2(o[0], o[1]); ow.y = pk2(o[2], o[3]); ow.z = pk2(o[4], o[5]); ow.w = pk2(o[6], o[7]);
                *(v4u*)(Y2 + (size_t)(t0 + t) * DP + c0) = ow;
                if (pos - (win - 1) >= 0) {
                    s[0] -= bflo(q.x); s[1] -= bfhi(q.x); s[2] -= bflo(q.y); s[3] -= bfhi(q.y); s[4] -= bflo(q.z); s[5] -= bfhi(q.z); s[6] -= bflo(q.w); s[7] -= bfhi(q.w); } }
        }
    }
}

__device__ __forceinline__ void fin_load(const float* row, int lane, f32x4 (&v)[8]) {
#pragma unroll
    for (int j = 0; j < 8; ++j) v[j] = ((const f32x4*)row)[lane + 64 * j];
}
__device__ __forceinline__ void fin_process(float* row, int lane, const f32x4 (&v)[8], const f32x4 (&gv)[8]) {
    float s = 0.f;
#pragma unroll
    for (int j = 0; j < 8; ++j) s += (v[j].x * v[j].x + v[j].y * v[j].y) + (v[j].z * v[j].z + v[j].w * v[j].w);
    s = wave_sum(s);
    const float rs = rsqrtf(s * (1.0f / DM) + EPS);
#pragma unroll
    for (int j = 0; j < 8; ++j) ((f32x4*)row)[lane + 64 * j] = v[j] * rs * gv[j];
}
__device__ __forceinline__ void phase_final(const Ctx& F, const Ptrs& P) {
    const int gw = F.vcu * NWAVES + F.wave, NGW = F.G * NWAVES, lane = F.lane;
    f32x4 gv[8];
#pragma unroll
    for (int j = 0; j < 8; ++j) gv[j] = ((const f32x4*)P.final_g)[lane + 64 * j];
    const int cnt = (M - gw + NGW - 1) / NGW;
    f32x4 vA[8], vB[8];
    fin_load(P.out + (size_t)gw * DM, lane, vA);
    for (int j = 0; j < cnt; j += 2) {
        { const int jn = (j + 1 < cnt) ? j + 1 : j; fin_load(P.out + (size_t)(gw + jn * NGW) * DM, lane, vB); }
        fin_process(P.out + (size_t)(gw + j * NGW) * DM, lane, vA, gv);
        if (j + 1 < cnt) {
            { const int jn = (j + 2 < cnt) ? j + 2 : j + 1; fin_load(P.out + (size_t)(gw + jn * NGW) * DM, lane, vA); }
            fin_process(P.out + (size_t)(gw + (j + 1) * NGW) * DM, lane, vB, gv);
        }
    }
}

constexpr int N_PHASES = 10;
struct Args { Ptrs p; int ph_lo, ph_hi, li, pad; };
typedef __attribute__((address_space(4))) const Args* KArgsPtr;
__device__ __forceinline__ Ptrs load_ptrs() {
    Ptrs r{};
#if defined(__HIP_DEVICE_COMPILE__)
    KArgsPtr ka = (KArgsPtr)__builtin_amdgcn_kernarg_segment_ptr(); asm volatile("" : "+s"(ka));
    r.x = ka->p.x; r.ln_g = ka->p.ln_g; r.final_g = ka->p.final_g; r.ssm_w_in = ka->p.ssm_w_in; r.conv_w = ka->p.conv_w; r.conv_b = ka->p.conv_b; r.dt_bias = ka->p.dt_bias; r.a_log = ka->p.a_log; r.ssm_d = ka->p.ssm_d;
    r.norm_g = ka->p.norm_g; r.ssm_w_out = ka->p.ssm_w_out; r.pool_w_in = ka->p.pool_w_in; r.pool_w_group = ka->p.pool_w_group; r.pool_scale = ka->p.pool_scale; r.pool_w_out = ka->p.pool_w_out; r.out = ka->p.out; r.ws = ka->p.ws;
#endif
    return r;
}
__global__ void __launch_bounds__(NWAVES * 64, 2) trunk_fwd(Args args) {
    extern __shared__ __attribute__((aligned(16))) unsigned char lds[];
    Ctx F;
    F.lds = (LAS unsigned char*)lds;
    F.tid = threadIdx.x; F.lane = F.tid & 63; F.wave = __builtin_amdgcn_readfirstlane(F.tid >> 6);
    F.G = gridDim.x; { const int bx = blockIdx.x; F.vcu = (F.G % 8 == 0) ? (bx % 8) * (F.G / 8) + bx / 8 : bx; }
    unsigned* ctl0; { const Ptrs P0 = load_ptrs(); ctl0 = (unsigned*)(P0.ws + WS_CTL); }
    for (int u = F.tid; u < (LDS_BYTES - LDSCTL_OFF) / 4; u += NWAVES * 64) ((LAS unsigned*)(F.lds + LDSCTL_OFF))[u] = 0u;
    __syncthreads();
#if MK_ONE_LAUNCH
    XcdBarrier bar = xcd_barrier_post(ctl0 + CW_BAR, (volatile LAS unsigned*)(F.lds + MISC_OFF) + 8);
#define GRID_BAR() xcd_barrier(bar)
#else
#define GRID_BAR() do {} while (0)
#endif
    const int lo = args.ph_lo, hi = args.ph_hi;
#define IN(k) (lo <= (k) && (k) < hi)
#define BOTH(k) (IN(k) && IN((k) + 1))
#define PHASE_VARS const Ptrs P = load_ptrs(); unsigned* ctl = (unsigned*)(P.ws + WS_CTL); \
    float* ssq1 = (float*)ctl + CW_SSQ1; float* ssq3p = (float*)(P.ws + WS_SSQP + 4 * MiB); const float* ssqp = (const float*)(P.ws + WS_SSQP);   \
    bf16* W1T = (bf16*)(P.ws + WS_W1T); bf16* W2T = (bf16*)(P.ws + WS_W2T); bf16* W3T = (bf16*)(P.ws + WS_W3T); bf16* W4T = (bf16*)(P.ws + WS_W4T); bf16* W5T = (bf16*)(P.ws + WS_W5T); \
    bf16* RA = (bf16*)(P.ws + WS_RA); bf16* RB = (bf16*)(P.ws + WS_RB); bf16* RC = (bf16*)(P.ws + WS_RC); \
    (void)ctl; (void)ssq1; (void)ssq3p; (void)ssqp; (void)W1T; (void)W2T; (void)W3T; (void)W4T; (void)W5T; (void)RA; (void)RB; (void)RC;

#define REP(k) (1 + ((REPEAT_MASK >> (k)) & 1))
    unsigned long long ts_a = 0, ts_b = 0;
#define TS_A(k) do { if (STAMP_PHASE == (k)) ts_a = __builtin_amdgcn_s_memrealtime(); } while (0)
#define TS_B(k) do { if (STAMP_PHASE == (k)) ts_b = __builtin_amdgcn_s_memrealtime(); } while (0)
    TS_A(0);
    if (IN(0)) { PHASE_VARS for (int rep = 0; rep < REP(0); ++rep) phase_prep(F, P); if (BOTH(0)) GRID_BAR(); }
    TS_B(0);
    TS_A(1);
    if (IN(1)) {
        PHASE_VARS
        {
          pg8::Gemm g{W4T, (const bf16*)P.out, DP, DM, PGD, PGD, DP, 30, 2}; pg8::StaticOrder S; S.init(DP, DM, F.G, (int)blockIdx.x);
          pg8::EpiPlain E{W3T, DM};
          TS_A(10); pg8::gemm_phase<pg8::EpiPlain, pg8::StaticOrder, true, true>(F.lds + RING_OFF, g, S, E);
          { constexpr int NWC = (DP / 256) * (DM / 256); if ((int)blockIdx.x >= NWC && F.G > NWC) prep_transposes(F, P, 1, ((int)blockIdx.x - NWC) * NWAVES + F.wave, (F.G - NWC) * NWAVES); else if (F.G <= NWC) prep_transposes(F, P, 1, F.vcu * NWAVES + F.wave, F.G * NWAVES); }
          __syncthreads(); TS_B(10); }
        TS_A(11); for (int rep = 0; rep < REP(10); ++rep) phase_dt(F, P); TS_B(11);
        for (int rep = 0; rep < REP(1); ++rep) {
        pg8::Gemm g{RC, W1T, M, N1, DM, DM, DM, 30, 30}; pg8::StaticOrder S; S.init(M, N1, F.G, (int)blockIdx.x);
        pg8::EpiProj E{RA, DI, RB, CONV_DIM, DI / 256, ssq1, 1.0f / DM, nullptr};
        pg8::gemm_phase<pg8::EpiProj, pg8::StaticOrder, true, true>(F.lds + RING_OFF, g, S, E);
        }
        if (BOTH(1)) GRID_BAR();
    }
    TS_B(1);
    TS_A(2);
    if (IN(2)) { PHASE_VARS for (int rep = 0; rep < REP(2); ++rep) phase_bcprep(F, P); if (BOTH(2)) GRID_BAR(); }
    TS_B(2);
    TS_A(3);
    if (IN(3)) { PHASE_VARS if (REP(3) > 1) phase_ssd<true>(F, P); phase_ssd<false>(F, P); if (BOTH(3)) GRID_BAR(); }
    TS_B(3);
    TS_A(4);
    if (IN(4)) {
        PHASE_VARS
        for (int rep = 0; rep < REP(4); ++rep) {
        pg8::Gemm g{RA, W2T, M, DM, DI, DI, DI, 30, 30}; pg8::StaticOrder S; S.init(M, DM, F.G, (int)blockIdx.x);
        LAS float* rs_tab = (LAS float*)(F.lds + pg8::STAGE_BYTES);
        {
          pg8::Unit uu; const int o = F.tid >> 8, rr = F.tid & 255;
          if (S.next(o, uu)) { const f32x4* pp = (const f32x4*)(ssqp + (size_t)(uu.pm * 256 + rr) * NH); f32x4 a = pp[0];
#pragma unroll
              for (int j = 1; j < 16; ++j) a = a + pp[j];
              rs_tab[o * 256 + rr] = rsqrtf(((a[0] + a[1]) + (a[2] + a[3])) * (1.0f / DI) + EPS); }
          __syncthreads(); }
        pg8::EpiResB E{RC, rs_tab, ssq3p, DM};
        pg8::gemm_phase<pg8::EpiResB, pg8::StaticOrder, true, true>(F.lds + RING_OFF, g, S, E);
        }
        if (BOTH(4)) GRID_BAR();
    }
    TS_B(4);
    TS_A(5);
    if (IN(5)) {
        PHASE_VARS
        for (int rep = 0; rep < REP(5); ++rep) {
        pg8::Gemm g{RC, W3T, M, 2 * DP, DM, DM, DM, 30, 30}; pg8::StaticOrder S; S.init(M, 2 * DP, F.G, (int)blockIdx.x);
        LAS float* rs_tab = (LAS float*)(F.lds + pg8::STAGE_BYTES);
        {
          for (int o = F.tid >> 8; o < 8; o += 2) { pg8::Unit uu; const int rr = F.tid & 255;
            if (S.next(o, uu)) { const f32x4* pp = (const f32x4*)(ssq3p + (size_t)(uu.pm * 256 + rr) * 32); f32x4 a = pp[0];
#pragma unroll
              for (int j = 1; j < 8; ++j) a = a + pp[j];
              rs_tab[o * 256 + rr] = rsqrtf(((a[0] + a[1]) + (a[2] + a[3])) * (1.0f / DM) + EPS); } }
          __syncthreads(); }
        pg8::EpiProj E{RA, DP, RB, DP, DP / 256, nullptr, 0.f, rs_tab};
        pg8::gemm_phase<pg8::EpiProj, pg8::StaticOrder, true, true>(F.lds + RING_OFF, g, S, E);
        }
        if (BOTH(5)) GRID_BAR();
    }
    TS_B(5);
    TS_A(6);
    if (IN(6)) { PHASE_VARS for (int rep = 0; rep < REP(6); ++rep) phase_pool(F, P); if (BOTH(6)) GRID_BAR(); }
    TS_B(6);
    TS_A(8);
    if (IN(8)) {
        PHASE_VARS
        pg8::Gemm g{RB, W5T, M, DM, DP, DP, DP, 30, 30}; pg8::PanelOrder S; S.init(F.G, (int)blockIdx.x);
        pg8::EpiFinal E{RC, P.out, P.final_g, (float*)(P.ws + WS_SSQP + 6 * MiB), ctl + CW_FIN, ctl + CW_TMO, F.lds + pg8::STAGE_BYTES, DM};
        pg8::gemm_phase<pg8::EpiFinal, pg8::PanelOrder, true, true>(F.lds + RING_OFF, g, S, E);
    }
    TS_B(8);
    if (STAMP_PHASE >= 0) { const unsigned long long t0 = __builtin_amdgcn_s_memrealtime(); while (__builtin_amdgcn_s_memrealtime() - t0 < ts_b - ts_a) __builtin_amdgcn_s_sleep(8); }
#undef IN
#undef BOTH
}

extern "C" void kernel_launch(void* const* d_in, const int* in_sizes, int n_in, void* d_out, int out_size, void* d_ws, size_t ws_size, hipStream_t stream) {
    static int grid = 0;
    if (grid == 0) {
        if (n_in != 15 || in_sizes[0] != M * DM || out_size != M * DM || ws_size < WS_END) { fprintf(stderr, "kernel_launch: unexpected shapes: n_in %d in0 %d out %d ws %zu (need %zu); nothing launched\n", n_in, n_in > 0 ? in_sizes[0] : -1, out_size, ws_size, (size_t)WS_END); grid = -1; return; }
        int dev = 0, cus = 0, per_cu = 0;
        if (hipGetDevice(&dev) != hipSuccess || hipDeviceGetAttribute(&cus, hipDeviceAttributeMultiprocessorCount, dev) != hipSuccess) { fprintf(stderr, "kernel_launch: device query failed\n"); grid = -1; return; }
        if (hipFuncSetAttribute((const void*)trunk_fwd, hipFuncAttributeMaxDynamicSharedMemorySize, LDS_BYTES) != hipSuccess) { fprintf(stderr, "kernel_launch: hipFuncSetAttribute failed\n"); grid = -1; return; }
        if (hipOccupancyMaxActiveBlocksPerMultiprocessor(&per_cu, (const void*)trunk_fwd, NWAVES * 64, LDS_BYTES) != hipSuccess || per_cu < 1) { fprintf(stderr, "kernel_launch: occupancy query says %d blocks per CU\n", per_cu); }
        (void)hipGetLastError();
        grid = cus;
        if (cus != 256) { fprintf(stderr, "kernel_launch: this kernel's unit orders are built for a 256-CU device (got %d CUs); nothing launched\n", cus); grid = -1; return; }
    }
    if (grid < 0) return;
    if (hipMemsetAsync((char*)d_ws + WS_CTL, 0, CTL_ZERO_BYTES, stream) != hipSuccess) { fprintf(stderr, "kernel_launch: memset failed\n"); return; }
    Args a{};
    a.p.x = (const float*)d_in[0]; a.p.ln_g = (const float*)d_in[1]; a.p.final_g = (const float*)d_in[2]; a.p.ssm_w_in = (const float*)d_in[3]; a.p.conv_w = (const float*)d_in[4];
    a.p.conv_b = (const float*)d_in[5]; a.p.dt_bias = (const float*)d_in[6]; a.p.a_log = (const float*)d_in[7]; a.p.ssm_d = (const float*)d_in[8]; a.p.norm_g = (const float*)d_in[9];
    a.p.ssm_w_out = (const float*)d_in[10]; a.p.pool_w_in = (const float*)d_in[11]; a.p.pool_w_group = (const float*)d_in[12]; a.p.pool_scale = (const float*)d_in[13]; a.p.pool_w_out = (const float*)d_in[14];
    a.p.out = (float*)d_out; a.p.ws = (unsigned char*)d_ws;
#if MK_ONE_LAUNCH
    a.ph_lo = 0; a.ph_hi = N_PHASES; a.li = 0;
    hipLaunchKernelGGL(trunk_fwd, dim3(grid), dim3(NWAVES * 64), LDS_BYTES, stream, a);
#else
    for (int li = 0; li < N_PHASES; ++li) { a.ph_lo = li; a.ph_hi = li + 1; a.li = li;
        hipLaunchKernelGGL(trunk_fwd, dim3(grid), dim3(NWAVES * 64), LDS_BYTES, stream, a); }
#endif
    const hipError_t le = hipPeekAtLastError();
    if (le != hipSuccess) fprintf(stderr, "kernel_launch: launch failed: %s\n", hipGetErrorName(le));
}
```

```cpp
#include <hip/hip_runtime.h>
#include <cstdio>
#include <cstdint>

#ifndef REPEAT_MASK
#define REPEAT_MASK 0
#endif
#ifndef STAMP_PHASE
#define STAMP_PHASE -1
#endif
#ifndef MK_ONE_LAUNCH
#define MK_ONE_LAUNCH 1
#endif

namespace pg8 {
#define PG8_LAS __attribute__((address_space(3)))
typedef unsigned short bf16_t;
typedef short bf16x8 __attribute__((ext_vector_type(8)));
typedef float f32x4 __attribute__((ext_vector_type(4)));
typedef unsigned u32x4 __attribute__((ext_vector_type(4)));
typedef unsigned u32x2 __attribute__((ext_vector_type(2)));
constexpr int BM = 256, BK = 64, HALF = 128, HTB = HALF * BK * 2  , STAGE_BYTES = 8 * HTB, NXCD = 8, WGM = 8;
constexpr float RMS_EPS = 1e-6f;

__host__ __device__ __forceinline__ int lds_byte(int r, int c) { return r * 128 + ((((c >> 3) ^ (r & 7))) << 4) + (c & 7) * 2; }
__host__ __device__ __forceinline__ void stage_rc(int b, int& R, int& C) { R = b / 128; C = ((((b % 128) / 16) ^ (R & 7))) * 8; }
__host__ __device__ __forceinline__ int perm32(int rho) { const int n = rho >> 4, i = rho & 15; return 8 * (i >> 2) + 4 * n + (i & 3); }

struct Unit { int pm, pn, ord; };
struct Gemm { const bf16_t* A; const bf16_t* Bt; int M, N, K, lda, ldb, gsh, bgsh; };

struct StaticOrder {
    int nM, nN, nwg, G, c;
    __host__ __device__ void init(int M, int N, int G_, int c_) { nM = M / BM; nN = N / BM; nwg = nM * nN; G = G_; c = c_; }
    __host__ __device__ bool next(int i, Unit& u) const {
        const long L = (long)i * G + c; if (L >= nwg) return false;
        int wgid = (int)L; { const int q = nwg / NXCD, r = nwg % NXCD, xcd = wgid % NXCD, off = wgid / NXCD; wgid = (xcd < r ? xcd * (q + 1) : r * (q + 1) + (xcd - r) * q) + off; }
        const int nig = WGM * nN, gid = wgid / nig, fm = gid * WGM, gsz = (nM - fm) < WGM ? (nM - fm) : WGM;
        u.pm = fm + ((wgid % nig) % gsz); u.pn = (wgid % nig) / gsz; return true;
    }
    __device__ __forceinline__ void a_ready(const Unit&) const {}
    __device__ __forceinline__ void done(const Unit&) const {}
};

__device__ __forceinline__ unsigned cvt_pk_bf16(float lo, float hi) { unsigned r; asm volatile("v_cvt_pk_bf16_f32 %0, %1, %2" : "=v"(r) : "v"(lo), "v"(hi)); return r; }
__device__ __forceinline__ float bf_lo(unsigned w) { return __uint_as_float(w << 16); }
__device__ __forceinline__ float bf_hi(unsigned w) { return __uint_as_float(w & 0xffff0000u); }
__device__ __forceinline__ float sigmoid_f(float v) { return __builtin_amdgcn_rcpf(1.0f + __builtin_amdgcn_exp2f(-1.4426950408889634f * v)); }

struct EpiProj {
    static constexpr bool PERM = true, AFTER_DRAIN = false;
    bf16_t* O0; int ld0; bf16_t* O1; int ld1; int split_pn; const float* ssq; float inv_n; const PG8_LAS float* rs_lds;
    __device__ __forceinline__ void operator()(const f32x4 (&acc)[2][2][4][2], const Unit& u, int wr, int wc, int fr, int fq) const {
        const int row0 = u.pm * BM + wr * 64 + fr;
        bf16_t* base; int ld, colt;
        if (u.pn < split_pn) { base = O0; ld = ld0; colt = u.pn * BM; } else { base = O1; ld = ld1; colt = (u.pn - split_pn) * BM; }
        const int col0 = colt + wc * 32 + 8 * fq;
#pragma unroll
        for (int ai = 0; ai < 2; ++ai)
#pragma unroll
            for (int m = 0; m < 4; ++m) { const int row = row0 + ai * HALF + m * 16; const float s = rs_lds ? rs_lds[u.ord * BM + wr * 64 + fr + ai * HALF + m * 16] : rsqrtf(ssq[row] * inv_n + RMS_EPS);
                bf16_t* rowp = base + (size_t)row * ld + col0;
#pragma unroll
                for (int bj = 0; bj < 2; ++bj) { const f32x4 v0 = acc[ai][bj][m][0] * s, v1 = acc[ai][bj][m][1] * s;
                    u32x4 w; w.x = cvt_pk_bf16(v0[0], v0[1]); w.y = cvt_pk_bf16(v0[2], v0[3]); w.z = cvt_pk_bf16(v1[0], v1[1]); w.w = cvt_pk_bf16(v1[2], v1[3]);
                    *(u32x4*)(rowp + bj * HALF) = w; } }
    }
};
struct EpiPlain {
    static constexpr bool PERM = true, AFTER_DRAIN = false;
    bf16_t* O; int ld;
    __device__ __forceinline__ void operator()(const f32x4 (&acc)[2][2][4][2], const Unit& u, int wr, int wc, int fr, int fq) const {
        const int row0 = u.pm * BM + wr * 64 + fr, col0 = u.pn * BM + wc * 32 + 8 * fq;
#pragma unroll
        for (int ai = 0; ai < 2; ++ai)
#pragma unroll
            for (int m = 0; m < 4; ++m) { bf16_t* rowp = O + (size_t)(row0 + ai * HALF + m * 16) * ld + col0;
#pragma unroll
                for (int bj = 0; bj < 2; ++bj) { const f32x4 v0 = acc[ai][bj][m][0], v1 = acc[ai][bj][m][1];
                    u32x4 w; w.x = cvt_pk_bf16(v0[0], v0[1]); w.y = cvt_pk_bf16(v0[2], v0[3]); w.z = cvt_pk_bf16(v1[0], v1[1]); w.w = cvt_pk_bf16(v1[2], v1[3]);
                    *(u32x4*)(rowp + bj * HALF) = w; } }
    }
};
struct EpiRes {
    static constexpr bool PERM = false, AFTER_DRAIN = false;
    const float* base; float* out; bf16_t* ob; const PG8_LAS float* rs_lds; float* ssq_out; int ldc;
    __device__ __forceinline__ void operator()(const f32x4 (&acc)[2][2][4][2], const Unit& u, int wr, int wc, int fr, int fq) const {
        const int rl0 = wr * 64 + fr, row0 = u.pm * BM + rl0, col0 = u.pn * BM + wc * 32 + 4 * fq;
#pragma unroll
        for (int ai = 0; ai < 2; ++ai)
#pragma unroll
            for (int m = 0; m < 4; ++m) { const int row = row0 + ai * HALF + m * 16; const float s = rs_lds ? rs_lds[u.ord * BM + rl0 + ai * HALF + m * 16] : 1.0f;
                const size_t off = (size_t)row * ldc + col0; float q = 0.f;
#pragma unroll
                for (int bj = 0; bj < 2; ++bj)
#pragma unroll
                    for (int n = 0; n < 2; ++n) { const size_t o2 = off + bj * HALF + n * 16; const f32x4 b = *(const f32x4*)(base + o2); const f32x4 o = b + acc[ai][bj][m][n] * s;
                        *(f32x4*)(out + o2) = o; q += (o[0] * o[0] + o[1] * o[1]) + (o[2] * o[2] + o[3] * o[3]);
                        if (ob) { u32x2 w; w.x = cvt_pk_bf16(o[0], o[1]); w.y = cvt_pk_bf16(o[2], o[3]); *(u32x2*)(ob + o2) = w; } }
                if (ssq_out) { q += __shfl_xor(q, 16); q += __shfl_xor(q, 32); if (fq == 0) ssq_out[(size_t)row * 32 + u.pn * 4 + wc] = q; }
                if (m & 1) asm volatile("" ::: "memory"); }
    }
};
struct EpiResB {
    static constexpr bool PERM = true, AFTER_DRAIN = false;
    bf16_t* xio; const PG8_LAS float* rs_lds; float* ssq_out; int ldc;
    __device__ __forceinline__ void operator()(const f32x4 (&acc)[2][2][4][2], const Unit& u, int wr, int wc, int fr, int fq) const {
        const int rl0 = wr * 64 + fr, row0 = u.pm * BM + rl0, col0 = u.pn * BM + wc * 32 + 8 * fq;
#pragma unroll
        for (int ai = 0; ai < 2; ++ai)
#pragma unroll
            for (int m = 0; m < 4; ++m) { const int row = row0 + ai * HALF + m * 16; const float s = rs_lds[u.ord * BM + rl0 + ai * HALF + m * 16];
                const size_t off = (size_t)row * ldc + col0; float q = 0.f;
#pragma unroll
                for (int bj = 0; bj < 2; ++bj) { const size_t o2 = off + bj * HALF; const u32x4 bw = *(const u32x4*)(xio + o2);
                    f32x4 o0 = acc[ai][bj][m][0] * s, o1 = acc[ai][bj][m][1] * s;
                    o0[0] += bf_lo(bw.x); o0[1] += bf_hi(bw.x); o0[2] += bf_lo(bw.y); o0[3] += bf_hi(bw.y); o1[0] += bf_lo(bw.z); o1[1] += bf_hi(bw.z); o1[2] += bf_lo(bw.w); o1[3] += bf_hi(bw.w);
                    q += ((o0[0] * o0[0] + o0[1] * o0[1]) + (o0[2] * o0[2] + o0[3] * o0[3])) + ((o1[0] * o1[0] + o1[1] * o1[1]) + (o1[2] * o1[2] + o1[3] * o1[3]));
                    u32x4 w; w.x = cvt_pk_bf16(o0[0], o0[1]); w.y = cvt_pk_bf16(o0[2], o0[3]); w.z = cvt_pk_bf16(o1[0], o1[1]); w.w = cvt_pk_bf16(o1[2], o1[3]); *(u32x4*)(xio + o2) = w; }
                q += __shfl_xor(q, 16); q += __shfl_xor(q, 32); if (fq == 0) ssq_out[(size_t)row * 32 + u.pn * 4 + wc] = q;
                if (m & 1) asm volatile("" ::: "memory"); }
    }
};
struct PanelOrder {
    int G, c;
    __host__ __device__ void init(int G_, int c_) { G = G_; c = c_; }
    __host__ __device__ bool next(int i, Unit& u) const { if (i >= 2) return false; const int xcd = c & 7, idx = c >> 3; u.pm = 32 * i + 4 * xcd + (idx >> 3); u.pn = idx & 7; return true; }
    __device__ __forceinline__ void a_ready(const Unit&) const {}
    __device__ __forceinline__ void done(const Unit&) const {}
};
struct EpiFinal {
    static constexpr bool PERM = false, AFTER_DRAIN = false;
    const bf16_t* base; float* out; const float* gain; float* xslots; unsigned* cnt; unsigned* tmo; PG8_LAS unsigned char* lds; int ldc;
    __device__ __forceinline__ void operator()(f32x4 (&acc)[2][2][4][2], const Unit& u, int wr, int wc, int fr, int fq) const {
        PG8_LAS float* Pt = (PG8_LAS float*)lds;
        PG8_LAS float* St = (PG8_LAS float*)(lds + 4096);
        const int tid = threadIdx.x, wid = __builtin_amdgcn_readfirstlane(tid >> 6), lane = tid & 63;
        const int rl0 = wr * 64 + fr, row0 = u.pm * BM + rl0, col0 = u.pn * BM + wc * 32 + 4 * fq;
#pragma unroll
        for (int ai = 0; ai < 2; ++ai)
#pragma unroll
            for (int m = 0; m < 4; ++m) { const size_t off = (size_t)(row0 + ai * HALF + m * 16) * ldc + col0; float q = 0.f;
#pragma unroll
                for (int bj = 0; bj < 2; ++bj)
#pragma unroll
                    for (int n = 0; n < 2; ++n) { const u32x2 bw = *(const u32x2*)(base + off + bj * HALF + n * 16);
                        f32x4 o = acc[ai][bj][m][n]; o[0] += bf_lo(bw.x); o[1] += bf_hi(bw.x); o[2] += bf_lo(bw.y); o[3] += bf_hi(bw.y); acc[ai][bj][m][n] = o;
                        q += (o[0] * o[0] + o[1] * o[1]) + (o[2] * o[2] + o[3] * o[3]); }
                q += __shfl_xor(q, 16); q += __shfl_xor(q, 32);
                if (fq == 0) Pt[(rl0 + ai * HALF + m * 16) * 4 + wc] = q; }
        asm volatile("s_waitcnt lgkmcnt(0)" ::: "memory"); __builtin_amdgcn_s_barrier(); asm volatile("" ::: "memory");
        if (tid < BM) { const f32x4 p4 = *(const PG8_LAS f32x4*)(Pt + tid * 4);
            __hip_atomic_store(xslots + (size_t)(u.pm * BM + tid) * 8 + u.pn, (p4[0] + p4[1]) + (p4[2] + p4[3]), __ATOMIC_RELAXED, __HIP_MEMORY_SCOPE_AGENT); }
        asm volatile("s_waitcnt vmcnt(0)" ::: "memory");
        if (tid < BM && lane == 0) __hip_atomic_fetch_add(cnt + 64 * u.pm, 1u, __ATOMIC_RELAXED, __HIP_MEMORY_SCOPE_AGENT);
        if (wid == 0) {
            unsigned sp = 0;
            while ((unsigned)__builtin_amdgcn_readfirstlane(__hip_atomic_load(cnt + 64 * u.pm, __ATOMIC_RELAXED, __HIP_MEMORY_SCOPE_AGENT)) < 32u) {
                __builtin_amdgcn_s_sleep(2);
                if (++sp > (1u << 22)) { if (lane == 0) __hip_atomic_store(tmo, 1u, __ATOMIC_RELAXED, __HIP_MEMORY_SCOPE_AGENT); break; } }
            __builtin_amdgcn_fence(__ATOMIC_ACQUIRE, "agent");
        }
        asm volatile("s_waitcnt vmcnt(0) lgkmcnt(0)" ::: "memory"); __builtin_amdgcn_s_barrier(); asm volatile("" ::: "memory");
        if (tid < BM) { const float* sl = xslots + (size_t)(u.pm * BM + tid) * 8; float t = 0.f;
#pragma unroll
            for (int j = 0; j < 8; ++j) t += __hip_atomic_load(sl + j, __ATOMIC_RELAXED, __HIP_MEMORY_SCOPE_AGENT);
            St[tid] = rsqrtf(t * (1.0f / 2048.0f) + RMS_EPS); }
        asm volatile("s_waitcnt vmcnt(0) lgkmcnt(0)" ::: "memory"); __builtin_amdgcn_s_barrier(); asm volatile("" ::: "memory");
        f32x4 gv[2][2];
#pragma unroll
        for (int bj = 0; bj < 2; ++bj)
#pragma unroll
            for (int n = 0; n < 2; ++n) gv[bj][n] = *(const f32x4*)(gain + col0 + bj * HALF + n * 16);
#pragma unroll
        for (int ai = 0; ai < 2; ++ai)
#pragma unroll
            for (int m = 0; m < 4; ++m) { const int rl = rl0 + ai * HALF + m * 16; const float s = St[rl]; float* rowp = out + (size_t)(u.pm * BM + rl) * ldc + col0;
#pragma unroll
                for (int bj = 0; bj < 2; ++bj)
#pragma unroll
                    for (int n = 0; n < 2; ++n) *(f32x4*)(rowp + bj * HALF + n * 16) = acc[ai][bj][m][n] * s * gv[bj][n]; }
        asm volatile("s_waitcnt lgkmcnt(0)" ::: "memory"); __builtin_amdgcn_s_barrier(); asm volatile("" ::: "memory");
    }
};
struct EpiGate {
    static constexpr bool PERM = true, AFTER_DRAIN = false;
    bf16_t* O; const bf16_t* gate; const float* scale; int ldc;
    __device__ __forceinline__ void operator()(const f32x4 (&acc)[2][2][4][2], const Unit& u, int wr, int wc, int fr, int fq) const {
        const int row0 = u.pm * BM + wr * 64 + fr, col0 = u.pn * BM + wc * 32 + 8 * fq;
        f32x4 sc[2][2];
#pragma unroll
        for (int bj = 0; bj < 2; ++bj)
#pragma unroll
            for (int n = 0; n < 2; ++n) sc[bj][n] = *(const f32x4*)(scale + col0 + bj * HALF + 4 * n);
#pragma unroll
        for (int ai = 0; ai < 2; ++ai)
#pragma unroll
            for (int m = 0; m < 4; ++m) { const size_t off = (size_t)(row0 + ai * HALF + m * 16) * ldc + col0;
#pragma unroll
                for (int bj = 0; bj < 2; ++bj) { const u32x4 gw = *(const u32x4*)(gate + off + bj * HALF);
                    const float g0 = bf_lo(gw.x), g1 = bf_hi(gw.x), g2 = bf_lo(gw.y), g3 = bf_hi(gw.y), g4 = bf_lo(gw.z), g5 = bf_hi(gw.z), g6 = bf_lo(gw.w), g7 = bf_hi(gw.w);
                    const f32x4 v0 = acc[ai][bj][m][0] * sc[bj][0], v1 = acc[ai][bj][m][1] * sc[bj][1];
                    u32x4 w; w.x = cvt_pk_bf16(v0[0] * g0 * sigmoid_f(g0), v0[1] * g1 * sigmoid_f(g1)); w.y = cvt_pk_bf16(v0[2] * g2 * sigmoid_f(g2), v0[3] * g3 * sigmoid_f(g3));
                    w.z = cvt_pk_bf16(v1[0] * g4 * sigmoid_f(g4), v1[1] * g5 * sigmoid_f(g5)); w.w = cvt_pk_bf16(v1[2] * g6 * sigmoid_f(g6), v1[3] * g7 * sigmoid_f(g7));
                    *(u32x4*)(O + off + bj * HALF) = w; } }
    }
};

template <class Epi, class Sched, bool ALIGN_EPI = false, bool SP2 = false>
__device__ __forceinline__ void gemm_phase(PG8_LAS unsigned char* lds, const Gemm g, const Sched& S, const Epi& E) {
    const int tid = threadIdx.x, wid = __builtin_amdgcn_readfirstlane(tid >> 6), lane = tid & 63, wr = wid >> 2, wc = wid & 3, fr = lane & 15, fq = lane >> 4;
    const int K = g.K, nt = K / BK;
    unsigned voffA[2], voffB[2];
#pragma unroll
    for (int i = 0; i < 2; ++i) { int R, C; stage_rc(tid * 16 + i * 8192, R, C); const int Rb = Epi::PERM ? ((R & ~31) + perm32(R & 31)) : R;
        voffA[i] = (unsigned)(R * g.lda + C) * 2u; voffB[i] = (unsigned)(Rb * g.ldb + C) * 2u; }
    const size_t kstep = (size_t)(BK * 2);
    const size_t hstepA = (size_t)HALF * g.lda * 2, hstepB = (size_t)HALF * g.ldb * 2;
    const size_t tstepA = 2 * hstepA, tstepB = 2 * hstepB, gstepA = (size_t)K * 2;
    const unsigned ldsw = (unsigned)wid * 1024u;
    const int aoffk[2] = {lds_byte(wr * 64 + fr, fq * 8), lds_byte(wr * 64 + fr, 32 + fq * 8)}, boffk[2] = {lds_byte(wc * 32 + fr, fq * 8), lds_byte(wc * 32 + fr, 32 + fq * 8)};
#define PG8_SA(b, h) (((b) * 2 + (h)) * HTB)
#define PG8_SB(b, h) ((4 + (b) * 2 + (h)) * HTB)
#define PG8_STAGE(bufoff, gbase, voff) do { _Pragma("unroll") for (int _i = 0; _i < 2; ++_i) \
        __builtin_amdgcn_global_load_lds((const unsigned*)((const char*)(gbase) + (voff)[_i]), (PG8_LAS unsigned*)(lds + (bufoff) + ldsw + _i * 8192), 16, 0, 0); } while (0)
#define PG8_LDA(dst, b, h) do { _Pragma("unroll") for (int m = 0; m < 4; ++m) _Pragma("unroll") for (int k = 0; k < 2; ++k) dst[m][k] = *(const PG8_LAS bf16x8*)(lds + PG8_SA(b, h) + aoffk[k] + m * 2048); } while (0)
#define PG8_LDB(dst, b, h) do { _Pragma("unroll") for (int n = 0; n < 2; ++n) _Pragma("unroll") for (int k = 0; k < 2; ++k) dst[n][k] = *(const PG8_LAS bf16x8*)(lds + PG8_SB(b, h) + boffk[k] + n * 2048); } while (0)
#define PG8_MMA(ai, bj, At, Bt) do { __builtin_amdgcn_s_setprio(1); _Pragma("unroll") for (int m = 0; m < 4; ++m) _Pragma("unroll") for (int n = 0; n < 2; ++n) _Pragma("unroll") for (int k = 0; k < 2; ++k) \
        acc[ai][bj][m][n] = __builtin_amdgcn_mfma_f32_16x16x32_bf16(Bt[n][k], At[m][k], acc[ai][bj][m][n], 0, 0, 0); __builtin_amdgcn_s_setprio(0); } while (0)
#define PG8_WAIT_V(n) asm volatile("s_waitcnt vmcnt(" #n ")" ::: "memory")
#define PG8_WAIT_L(n) asm volatile("s_waitcnt lgkmcnt(" #n ")" ::: "memory")
#define PG8_BAR __builtin_amdgcn_s_barrier()
#define PG8_SCHED __builtin_amdgcn_sched_barrier(0)
    Unit cur, nxt; int ui = 0;
    if (!S.next(0, cur)) return;
    cur.ord = 0;
    f32x4 acc[2][2][4][2];
#pragma unroll
    for (int a = 0; a < 2; ++a)
#pragma unroll
        for (int b = 0; b < 2; ++b)
#pragma unroll
            for (int m = 0; m < 4; ++m)
#pragma unroll
                for (int n = 0; n < 2; ++n) acc[a][b][m][n] = (f32x4){0.f, 0.f, 0.f, 0.f};
    bf16x8 At[4][2], B0[2][2], B1[2][2];
    const char* cA = (const char*)g.A + (size_t)cur.pm * tstepA + (size_t)(cur.pn >> g.gsh) * gstepA; const char* cB = (const char*)g.Bt + (size_t)cur.pn * tstepB + (size_t)(cur.pm >> g.bgsh) * gstepA;
    S.a_ready(cur);
    if constexpr (SP2) {
        PG8_STAGE(PG8_SB(0, 0), cB, voffB); PG8_STAGE(PG8_SB(0, 1), cB + hstepB, voffB); PG8_STAGE(PG8_SA(0, 0), cA, voffA); PG8_STAGE(PG8_SA(0, 1), cA + hstepA, voffA);
        if (wr == 1) PG8_BAR;
        PG8_WAIT_V(2); PG8_BAR;
        PG8_STAGE(PG8_SB(1, 0), cB + kstep, voffB); PG8_STAGE(PG8_SA(1, 0), cA + kstep, voffA); PG8_STAGE(PG8_SB(1, 1), cB + hstepB + kstep, voffB);
        PG8_WAIT_V(6); PG8_BAR;
    } else {
        PG8_STAGE(PG8_SB(0, 0), cB, voffB); PG8_STAGE(PG8_SA(0, 0), cA, voffA); PG8_STAGE(PG8_SB(0, 1), cB + hstepB, voffB); PG8_STAGE(PG8_SA(0, 1), cA + hstepA, voffA);
        if (wr == 1) PG8_BAR;
        PG8_WAIT_V(4); PG8_BAR;
        PG8_STAGE(PG8_SB(1, 0), cB + kstep, voffB); PG8_STAGE(PG8_SA(1, 0), cA + kstep, voffA); PG8_STAGE(PG8_SB(1, 1), cB + hstepB + kstep, voffB);
        PG8_WAIT_V(6); PG8_BAR;
    }
    for (;;) {
        const bool has_next = S.next(ui + 1, nxt); nxt.ord = ui + 1;
        const char* nA = has_next ? (const char*)g.A + (size_t)nxt.pm * tstepA + (size_t)(nxt.pn >> g.gsh) * gstepA : cA; const char* nB = has_next ? (const char*)g.Bt + (size_t)nxt.pn * tstepB + (size_t)(nxt.pm >> g.bgsh) * gstepA : cB;
        for (int t = 0; t < nt; t += 2) {
            const bool last = (t == nt - 2);
            const char* a1 = cA + (size_t)(t + 1) * kstep;
            const char* a2 = last ? nA : cA + (size_t)(t + 2) * kstep; const char* b2 = last ? nB : cB + (size_t)(t + 2) * kstep;
            const char* a3 = a2 + kstep; const char* b3 = b2 + kstep;
            if (last && has_next) S.a_ready(nxt);
            if constexpr (SP2) {
            PG8_LDB(B0, 0, 0); PG8_LDB(B1, 0, 1); PG8_SCHED; PG8_LDA(At, 0, 0); PG8_STAGE(PG8_SA(1, 1), a1 + hstepA, voffA);
            PG8_WAIT_V(8); PG8_WAIT_L(0); PG8_BAR; PG8_MMA(0, 0, At, B0); PG8_MMA(0, 1, At, B1); PG8_BAR; PG8_SCHED;
            PG8_LDA(At, 0, 1); PG8_STAGE(PG8_SB(0, 0), b2, voffB); PG8_STAGE(PG8_SB(0, 1), b2 + hstepB, voffB); PG8_STAGE(PG8_SA(0, 0), a2, voffA);
            PG8_WAIT_V(8); PG8_WAIT_L(0); PG8_BAR; PG8_MMA(1, 0, At, B0); PG8_MMA(1, 1, At, B1); PG8_BAR; PG8_SCHED;
            PG8_LDB(B0, 1, 0); PG8_LDB(B1, 1, 1); PG8_SCHED; PG8_LDA(At, 1, 0); PG8_STAGE(PG8_SA(0, 1), a2 + hstepA, voffA);
            PG8_WAIT_V(8); PG8_WAIT_L(0); PG8_BAR; PG8_MMA(0, 0, At, B0); PG8_MMA(0, 1, At, B1); PG8_BAR; PG8_SCHED;
            PG8_LDA(At, 1, 1); PG8_STAGE(PG8_SB(1, 0), b3, voffB); PG8_STAGE(PG8_SB(1, 1), b3 + hstepB, voffB); PG8_STAGE(PG8_SA(1, 0), a3, voffA);
            PG8_WAIT_V(8); PG8_WAIT_L(0); PG8_BAR; PG8_MMA(1, 0, At, B0); PG8_MMA(1, 1, At, B1); PG8_BAR; PG8_SCHED;
            } else {
            PG8_LDB(B0, 0, 0); PG8_SCHED; PG8_LDA(At, 0, 0); PG8_STAGE(PG8_SA(1, 1), a1 + hstepA, voffA);
            PG8_WAIT_L(8); PG8_BAR; PG8_WAIT_L(0); PG8_MMA(0, 0, At, B0); PG8_BAR; PG8_SCHED;
            PG8_LDB(B1, 0, 1); PG8_STAGE(PG8_SB(0, 0), b2, voffB);
            PG8_BAR; PG8_WAIT_L(0); PG8_MMA(0, 1, At, B1); PG8_BAR;
            PG8_LDA(At, 0, 1); PG8_STAGE(PG8_SA(0, 0), a2, voffA);
            PG8_BAR; PG8_WAIT_L(0); PG8_MMA(1, 0, At, B0); PG8_BAR; PG8_SCHED;
            PG8_STAGE(PG8_SB(0, 1), b2 + hstepB, voffB);
            PG8_WAIT_V(6); PG8_BAR; PG8_MMA(1, 1, At, B1); PG8_BAR;
            PG8_LDB(B0, 1, 0); PG8_SCHED; PG8_LDA(At, 1, 0); PG8_STAGE(PG8_SA(0, 1), a2 + hstepA, voffA);
            PG8_WAIT_L(8); PG8_BAR; PG8_WAIT_L(0); PG8_MMA(0, 0, At, B0); PG8_BAR; PG8_SCHED;
            PG8_LDB(B1, 1, 1); PG8_STAGE(PG8_SB(1, 0), b3, voffB);
            PG8_BAR; PG8_WAIT_L(0); PG8_MMA(0, 1, At, B1); PG8_BAR;
            PG8_LDA(At, 1, 1); PG8_STAGE(PG8_SA(1, 0), a3, voffA);
            PG8_BAR; PG8_WAIT_L(0); PG8_MMA(1, 0, At, B0); PG8_BAR; PG8_SCHED;
            PG8_STAGE(PG8_SB(1, 1), b3 + hstepB, voffB);
            PG8_WAIT_V(6); PG8_BAR; PG8_MMA(1, 1, At, B1); PG8_BAR;
            }
        }
        if constexpr (ALIGN_EPI) { if (wr == 0) PG8_BAR; }
        if constexpr (!Epi::AFTER_DRAIN) { E(acc, cur, wr, wc, fr, fq); S.done(cur); }
        if (!has_next) break;
#pragma unroll
        for (int a = 0; a < 2; ++a)
#pragma unroll
            for (int b = 0; b < 2; ++b)
#pragma unroll
                for (int m = 0; m < 4; ++m)
#pragma unroll
                    for (int n = 0; n < 2; ++n) acc[a][b][m][n] = (f32x4){0.f, 0.f, 0.f, 0.f};
        cur = nxt; cA = nA; cB = nB; ++ui;
        if constexpr (ALIGN_EPI) { if (wr == 1) PG8_BAR; }
    }
    PG8_WAIT_V(0);
    if constexpr (!ALIGN_EPI) { if (wr == 0) PG8_BAR; }
    PG8_BAR;
    if constexpr (Epi::AFTER_DRAIN) { E.fused(acc, cur, wr, wc, fr, fq, lds, wid, lane); S.done(cur); }
#undef PG8_SA
#undef PG8_SB
#undef PG8_STAGE
#undef PG8_LDA
#undef PG8_LDB
#undef PG8_MMA
#undef PG8_WAIT_V
#undef PG8_WAIT_L
#undef PG8_BAR
#undef PG8_SCHED
}

}

constexpr int NWAVES = 8;
constexpr int BATCH = 4, SEQ = 4096, DM = 2048, M = BATCH * SEQ;
constexpr int DI = 4096, HD = 64, NH = 64, NG = 8, HPG = 8, NS = 128, CONVK = 4;
constexpr int CONV_DIM = DI + 2 * NG * NS;
constexpr int SSM_IN = DI + CONV_DIM + NH;
constexpr int N1 = DI + CONV_DIM;
constexpr int BCW = 2 * NG * NS;
constexpr int DP = 4096, PG = 4, PGD = 1024;
constexpr float EPS = 1e-6f;

constexpr size_t MiB = 1u << 20;
constexpr size_t WS_CTL = 0, CTL_ZERO_BYTES = 1 * MiB;
constexpr size_t WS_DT  = 1 * MiB;
constexpr size_t WS_W1T = 5 * MiB;
constexpr size_t WS_W2T = 46 * MiB;
constexpr size_t WS_W3T = 62 * MiB;
constexpr size_t WS_W4T = 94 * MiB;
constexpr size_t WS_W5T = 102 * MiB;
constexpr size_t WS_RA  = 120 * MiB;
constexpr size_t WS_RB  = 248 * MiB;
constexpr size_t WS_RC  = 440 * MiB;
constexpr size_t WS_SSQP = 504 * MiB;
constexpr size_t WS_END = 512 * MiB;
static_assert(WS_W1T + (size_t)SSM_IN * DM * 2 <= WS_W2T && WS_W2T + (size_t)DM * DI * 2 <= WS_W3T && WS_W3T + (size_t)2 * DP * DM * 2 <= WS_W4T && WS_W4T + (size_t)DP * PGD * 2 <= WS_W5T && WS_W5T + (size_t)DM * DP * 2 <= WS_RA, "weights map");
static_assert(WS_RA + (size_t)M * DI * 2 <= WS_RB && WS_RB + (size_t)M * CONV_DIM * 2 <= WS_RC && WS_RC + (size_t)M * DM * 2 <= WS_END && WS_RB + 128 * MiB + (size_t)M * DP * 2 <= WS_END, "activation map");
constexpr int CW_TMO = 64, CW_FIN = 8192;
constexpr int CW_BAR = 4096;
constexpr int CW_SSQ1 = 16384, CW_SSQ2 = CW_SSQ1 + M, CW_SSQ3 = CW_SSQ2 + M;
static_assert((CW_SSQ3 + M) * 4 <= (int)CTL_ZERO_BYTES, "CTL words inside the memset region");

constexpr int RING_OFF = 0, RING_BYTES = 159744;
constexpr int LDSCTL_OFF = RING_BYTES, MISC_OFF = LDSCTL_OFF + 320;
constexpr int LDS_BYTES = 163840;
static_assert(MISC_OFF + 128 <= LDS_BYTES, "LDS map");

#define LAS __attribute__((address_space(3)))
typedef unsigned short bf16;
typedef unsigned v4u __attribute__((ext_vector_type(4)));
typedef unsigned v2u __attribute__((ext_vector_type(2)));
typedef float f32x4 __attribute__((ext_vector_type(4)));
typedef short bf16x8 __attribute__((ext_vector_type(8)));
#define LDS_WAIT() asm volatile("s_waitcnt lgkmcnt(0)" ::: "memory")
#define VM_WAIT() asm volatile("s_waitcnt vmcnt(0)" ::: "memory")
__device__ __forceinline__ unsigned f2bf(float f) { unsigned u = __builtin_bit_cast(unsigned, f); return (u + 0x7fffu + ((u >> 16) & 1u)) >> 16; }
__device__ __forceinline__ unsigned pk2(float lo, float hi) { return f2bf(lo) | (f2bf(hi) << 16); }
__device__ __forceinline__ float bflo(unsigned w) { return __uint_as_float(w << 16); }
__device__ __forceinline__ float bfhi(unsigned w) { return __uint_as_float(w & 0xffff0000u); }
__device__ __forceinline__ float bf1(bf16 v) { return __uint_as_float(((unsigned)v) << 16); }
__device__ __forceinline__ float sigm(float v) { return __builtin_amdgcn_rcpf(1.0f + __builtin_amdgcn_exp2f(-1.4426950408889634f * v)); }
__device__ __forceinline__ float wave_sum(float v) {
#pragma unroll
    for (int o = 1; o < 64; o <<= 1) v += __shfl_xor(v, o);
    return v;
}

#define XB_TMO      128
#define XB_XCNT(j)  (256  + 64 * (j))
#define XB_XSUB(j)  (1280 + 64 * (j))
#define XB_XGEN(j)  (2304 + 64 * (j))
#define XB_TOP      3328
#define XB_TOPGEN   3392
#define XCD_BAR_WORDS 3456
#define XB_SPIN_CAP (1u << 18)

__device__ __forceinline__ unsigned xb_ld(unsigned* p)              { return __hip_atomic_load(p, __ATOMIC_RELAXED, __HIP_MEMORY_SCOPE_AGENT); }
__device__ __forceinline__ unsigned xb_add(unsigned* p, unsigned v) { return __hip_atomic_fetch_add(p, v, __ATOMIC_RELAXED, __HIP_MEMORY_SCOPE_AGENT); }
__device__ __forceinline__ unsigned xb_xcc_id() { return (unsigned)__builtin_amdgcn_s_getreg((3 << 11) | 20) & 0xFu; }
#define XB_SPIN(cond, bar) do { unsigned _sp = 0; while (cond) { __builtin_amdgcn_s_sleep(1); \
    if ((++_sp & 255u) == 0u) { if (xb_ld(&(bar)[XB_TMO])) break; if (_sp > XB_SPIN_CAP) { atomicAdd(&(bar)[XB_TMO], 1u); break; } } } } while (0)

struct XcdBarrier {
    unsigned* bar; unsigned x;
    volatile LAS unsigned* st;
};

__device__ __forceinline__ XcdBarrier xcd_barrier_post(unsigned* bar, volatile LAS unsigned* st) {
    XcdBarrier b; b.bar = bar; b.x = xb_xcc_id(); b.st = st;
    if (threadIdx.x == 0) (void)xb_add(&bar[XB_XCNT(b.x)], 1u);
    return b;
}
__device__ __forceinline__ void xcd_barrier_complete(unsigned* bar, unsigned x, unsigned& nloc, unsigned& nx) {
    const unsigned G = gridDim.x * gridDim.y * gridDim.z;
    unsigned sum, cnt, mine, sp = 0u;
    for (;;) {
        sum = 0u; cnt = 0u; mine = 0u;
#pragma unroll
        for (unsigned j = 0; j < 16; ++j) { const unsigned c = xb_ld(&bar[XB_XCNT(j)]); sum += c; cnt += (c > 0u) ? 1u : 0u; mine = (j == x) ? c : mine; }
        if (sum == G) break;
        __builtin_amdgcn_s_sleep(1);
        if ((++sp & 255u) == 0u) { if (xb_ld(&bar[XB_TMO])) break; if (sp > XB_SPIN_CAP) { atomicAdd(&bar[XB_TMO], 1u); break; } }
    }
    nloc = mine > 0u ? mine : 1u; nx = cnt > 0u ? cnt : 1u;
}

__device__ __forceinline__ void xcd_barrier(const XcdBarrier& b) {
    asm volatile("s_waitcnt vmcnt(0)" ::: "memory");
    __syncthreads();
    if (threadIdx.x == 0) {
        unsigned* bar = b.bar;
        __builtin_amdgcn_s_waitcnt(0);
        unsigned nloc = b.st[0], nx = b.st[1];
        if (nloc == 0u) { xcd_barrier_complete(bar, b.x, nloc, nx); b.st[0] = nloc; b.st[1] = nx; }
        const unsigned old = xb_add(&bar[XB_XSUB(b.x)], 1u);
        const unsigned gen = old / nloc;
        if (old + 1u == (gen + 1u) * nloc) {
            __builtin_amdgcn_fence(__ATOMIC_RELEASE, "agent");
            asm volatile("s_waitcnt vmcnt(0)" ::: "memory");
            const unsigned og = xb_add(&bar[XB_TOP], 1u);
            const unsigned tg = og / nx;
            if (og + 1u == (tg + 1u) * nx) xb_add(&bar[XB_TOPGEN], 1u);
            else XB_SPIN(xb_ld(&bar[XB_TOPGEN]) == tg, bar);
            __builtin_amdgcn_fence(__ATOMIC_ACQUIRE, "agent");
            xb_add(&bar[XB_XGEN(b.x)], 1u);
            asm volatile("s_waitcnt vmcnt(0)" ::: "memory");
        } else {
            XB_SPIN(xb_ld(&bar[XB_XGEN(b.x)]) == gen, bar);
            __builtin_amdgcn_fence(__ATOMIC_ACQUIRE, "agent");
            asm volatile("s_waitcnt vmcnt(0)" ::: "memory");
        }
    }
    __syncthreads();
}

struct Ctx { LAS unsigned char* lds; int tid, lane, wave, G, vcu; };

struct Ptrs {
    const float *x, *ln_g, *final_g, *ssm_w_in, *conv_w, *conv_b, *dt_bias, *a_log, *ssm_d, *norm_g, *ssm_w_out, *pool_w_in, *pool_w_group, *pool_scale, *pool_w_out;
    float* out; unsigned char* ws;
};

__device__ __forceinline__ void t_decode(const Ptrs& P, int it, const float*& src, const float*& gain, bf16*& dst, int& ldw, int& K) {
    constexpr int I1 = (DM / 64) * (SSM_IN / 32), I2 = (DI / 64) * (DM / 32), I3 = (DM / 64) * (DP / 32), I4G = (PGD / 64) * (PGD / 32), I4 = PG * I4G;
    const float* W; const float* g; bf16* WT; int N, row_off = 0, r = it;
    if (r < I1) { W = P.ssm_w_in; g = P.ln_g; K = DM; N = SSM_IN; ldw = SSM_IN; WT = (bf16*)(P.ws + WS_W1T); }
    else if ((r -= I1) < I2) { W = P.ssm_w_out; g = P.norm_g; K = DI; N = DM; ldw = DM; WT = (bf16*)(P.ws + WS_W2T); }
    else if ((r -= I2) < I3) { W = P.pool_w_in + DP; g = P.ln_g + DM; K = DM; N = DP; ldw = 2 * DP; WT = (bf16*)(P.ws + WS_W3T); row_off = DP; }
    else if ((r -= I3) < I4) { const int gi = r / I4G; r -= gi * I4G; W = P.pool_w_group + (size_t)gi * PGD * PGD; g = nullptr; K = PGD; N = PGD; ldw = PGD; WT = (bf16*)(P.ws + WS_W4T); row_off = gi * PGD; }
    else { r -= I4; W = P.pool_w_out; g = nullptr; K = DP; N = DM; ldw = DM; WT = (bf16*)(P.ws + WS_W5T); }
    const int nblk = N / 32, kb = r / nblk, nb = r - kb * nblk, k0 = 64 * kb, n0 = 32 * nb;
    src = W + (size_t)k0 * ldw + n0; gain = g ? g + k0 : nullptr; dst = WT + (size_t)(row_off + n0) * K + k0;
}
__device__ __forceinline__ void t_load(const float* src, const float* gain, int ldw, int lane, f32x4 (&v)[8], float (&gv)[8]) {
#pragma unroll
    for (int i = 0; i < 8; ++i) { const int kk = 8 * i + (lane >> 3); v[i] = *(const f32x4*)(src + (size_t)kk * ldw + 4 * (lane & 7)); gv[i] = gain ? gain[kk] : 1.0f; }
}
__device__ __forceinline__ void t_process(bf16* dst, int K, int lane, LAS float* scr, const f32x4 (&v)[8], const float (&gv)[8]) {
#pragma unroll
    for (int i = 0; i < 8; ++i) *(LAS f32x4*)(scr + (8 * i + (lane >> 3)) * 32 + (((lane & 7) ^ i) << 2)) = v[i] * gv[i];
    LDS_WAIT(); asm volatile("" ::: "memory");
    const int c = lane & 7, nn = lane >> 3;
#pragma unroll
    for (int j = 0; j < 4; ++j) { const int n = nn + 8 * j; const LAS float* s = scr + (8 * c) * 32 + (((n >> 2) ^ c) << 2) + (n & 3);
        v4u o; o.x = pk2(s[0 * 32], s[1 * 32]); o.y = pk2(s[2 * 32], s[3 * 32]); o.z = pk2(s[4 * 32], s[5 * 32]); o.w = pk2(s[6 * 32], s[7 * 32]);
        *(v4u*)(dst + (size_t)n * K + 8 * c) = o; }
    LDS_WAIT(); asm volatile("" ::: "memory");
}
__device__ __forceinline__ void r_decode(const Ptrs& P, int r, const float*& src, bf16*& dst, float& scale, float*& ssq) {
    if (r < M) { src = P.x + (size_t)r * DM; dst = (bf16*)(P.ws + WS_RC) + (size_t)r * DM; scale = 1.0f; ssq = (float*)(P.ws + WS_CTL) + CW_SSQ1 + r; }
    else { const int rr = r - M, m = rr >> 1, hf = rr & 1; src = P.pool_w_in + (size_t)m * 2 * DP + hf * DM; dst = (bf16*)P.out + (size_t)m * DP + hf * DM; scale = P.ln_g[DM + m]; ssq = nullptr; }
}
__device__ __forceinline__ void r_load(const float* src, int lane, f32x4 (&v)[8]) {
#pragma unroll
    for (int j = 0; j < 8; ++j) v[j] = ((const f32x4*)src)[lane + 64 * j];
}
__device__ __forceinline__ void r_process(bf16* dst, float scale, float* ssq, int lane, const f32x4 (&v)[8]) {
    if (ssq) { float s = 0.f;
#pragma unroll
        for (int j = 0; j < 8; ++j) s += (v[j].x * v[j].x + v[j].y * v[j].y) + (v[j].z * v[j].z + v[j].w * v[j].w);
        s = wave_sum(s); if (lane == 0) *ssq = s; }
#pragma unroll
    for (int j = 0; j < 8; ++j) { v2u w; w.x = pk2(v[j].x * scale, v[j].y * scale); w.y = pk2(v[j].z * scale, v[j].w * scale); ((v2u*)dst)[lane + 64 * j] = w; }
}
__device__ __forceinline__ int t_map(int li, int mode) {
    constexpr int I1 = (DM / 64) * (SSM_IN / 32), I2 = (DI / 64) * (DM / 32), I3 = (DM / 64) * (DP / 32), I4 = PG * (PGD / 64) * (PGD / 32);
    return mode == 0 ? (li < I1 ? li : li + I2) : (li < I2 ? I1 + li : I1 + I3 + I4 + li);
}
__device__ __forceinline__ void prep_transposes(const Ctx& F, const Ptrs& P, int mode, int gw, int NGW) {
    LAS float* scr = (LAS float*)(F.lds + RING_OFF + F.wave * 16384);
    const int lane = F.lane;
    constexpr int I1 = (DM / 64) * (SSM_IN / 32), I2 = (DI / 64) * (DM / 32), I3 = (DM / 64) * (DP / 32), I4 = PG * (PGD / 64) * (PGD / 32), I5 = (DP / 64) * (DM / 32);
    const int NT = mode == 0 ? I1 + I3 + I4 : I2 + I5;
    if (gw >= NT) return;
    const int cnt = (NT - gw + NGW - 1) / NGW;
    const float *sA, *gA, *sB, *gB; bf16 *dA, *dB; int lA, kA, lB, kB; f32x4 vA[8], vB[8]; float fA[8], fB[8];
    t_decode(P, t_map(gw, mode), sA, gA, dA, lA, kA); t_load(sA, gA, lA, lane, vA, fA);
    for (int j = 0; j < cnt; j += 2) {
        { const int jn = (j + 1 < cnt) ? j + 1 : cnt - 1; t_decode(P, t_map(gw + jn * NGW, mode), sB, gB, dB, lB, kB); t_load(sB, gB, lB, lane, vB, fB); }
        t_process(dA, kA, lane, scr, vA, fA);
        { const int jn = (j + 2 < cnt) ? j + 2 : cnt - 1; t_decode(P, t_map(gw + jn * NGW, mode), sA, gA, dA, lA, kA); t_load(sA, gA, lA, lane, vA, fA); }
        if (j + 1 < cnt) t_process(dB, kB, lane, scr, vB, fB);
    }
}
__device__ __forceinline__ void phase_prep(const Ctx& F, const Ptrs& P) {
    const int gw = F.vcu * NWAVES + F.wave, NGW = F.G * NWAVES, lane = F.lane;
    prep_transposes(F, P, 0, gw, NGW);
    {
        constexpr int NR = M + 2 * DM;
        const int cnt = (NR - gw + NGW - 1) / NGW;
        const float *sA, *sB; bf16 *dA, *dB; float cA, cB; float *qA, *qB; f32x4 vA[8], vB[8];
        r_decode(P, gw, sA, dA, cA, qA); r_load(sA, lane, vA);
        for (int j = 0; j < cnt; j += 2) {
            { const int jn = (j + 1 < cnt) ? j + 1 : cnt - 1; r_decode(P, gw + jn * NGW, sB, dB, cB, qB); r_load(sB, lane, vB); }
            r_process(dA, cA, qA, lane, vA);
            { const int jn = (j + 2 < cnt) ? j + 2 : cnt - 1; r_decode(P, gw + jn * NGW, sA, dA, cA, qA); r_load(sA, lane, vA); }
            if (j + 1 < cnt) r_process(dB, cB, qB, lane, vB);
        }
    }
}

__device__ __forceinline__ float softplus_f(float v) { return fmaxf(v, 0.f) + log1pf(expf(-fabsf(v))); }

__device__ __forceinline__ void phase_dt(const Ctx& F, const Ptrs& P) {
    const bf16* XB = (const bf16*)(P.ws + WS_RC); const bf16* WDT = (const bf16*)(P.ws + WS_W1T) + (size_t)N1 * DM;
    const float* ssq1 = (const float*)(P.ws + WS_CTL) + CW_SSQ1; float* DT = (float*)(P.ws + WS_DT);
    LAS float* part = (LAS float*)F.lds;
    const int w = F.wave, lane = F.lane, fr = lane & 15, fq = lane >> 4;
    for (int item = F.vcu; item < M / 64; item += F.G) {
        const int r0 = item * 64;
        f32x4 acc[4][4];
#pragma unroll
        for (int i = 0; i < 4; ++i)
#pragma unroll
            for (int j = 0; j < 4; ++j) acc[i][j] = (f32x4){0.f, 0.f, 0.f, 0.f};
        const bf16* ap = XB + (size_t)(r0 + fr) * DM + w * 256 + 8 * fq;
        const bf16* bp = WDT + (size_t)fr * DM + w * 256 + 8 * fq;
#pragma unroll
        for (int hf = 0; hf < 2; ++hf) {
            bf16x8 a[4][4], b[4][4];
#pragma unroll
            for (int ks = 0; ks < 4; ++ks)
#pragma unroll
                for (int t = 0; t < 4; ++t) { a[ks][t] = *(const bf16x8*)(ap + (size_t)(16 * t) * DM + 32 * (4 * hf + ks)); b[ks][t] = *(const bf16x8*)(bp + (size_t)(16 * t) * DM + 32 * (4 * hf + ks)); }
#pragma unroll
            for (int ks = 0; ks < 4; ++ks)
#pragma unroll
                for (int rt = 0; rt < 4; ++rt)
#pragma unroll
                    for (int ct = 0; ct < 4; ++ct) acc[rt][ct] = __builtin_amdgcn_mfma_f32_16x16x32_bf16(a[ks][rt], b[ks][ct], acc[rt][ct], 0, 0, 0);
        }
#pragma unroll
        for (int rt = 0; rt < 4; ++rt)
#pragma unroll
            for (int ct = 0; ct < 4; ++ct) *(LAS f32x4*)(part + (size_t)w * 4096 + (16 * ct + fr) * 64 + 16 * rt + 4 * fq) = acc[rt][ct];
        __syncthreads();
        {
            const int hd = F.tid & 63, rb = 8 * (F.tid >> 6);
            f32x4 s0 = (f32x4){0.f, 0.f, 0.f, 0.f}, s1 = s0;
#pragma unroll
            for (int pw = 0; pw < 8; ++pw) { s0 = s0 + *(const LAS f32x4*)(part + (size_t)pw * 4096 + hd * 64 + rb); s1 = s1 + *(const LAS f32x4*)(part + (size_t)pw * 4096 + hd * 64 + rb + 4); }
            const float bias = P.dt_bias[hd];
#pragma unroll
            for (int i = 0; i < 8; ++i) { const int row = r0 + rb + i; const float sc = rsqrtf(ssq1[row] * (1.0f / DM) + EPS); const float v = (i < 4 ? s0[i & 3] : s1[i & 3]) * sc + bias;
                DT[(size_t)row * NH + hd] = softplus_f(v); }
        }
        __syncthreads();
    }
}

constexpr int IMG_C = 0, IMG_B = 16384, IMG_BT = 32768, IMG_BYTES = 49152;
constexpr int SC_BYTES = 1024, BL_C = 0, BL_BT = 16384, BL_CBT = 32768, BL_SC = BL_CBT + 10 * 1024, BLOB_BYTES = BL_SC + 8 * SC_BYTES;
constexpr int MAIN_BYTES = 32768 + SC_BYTES, HEAD_BYTES = 10 * 1024 + SC_BYTES;
constexpr int SL_MAIN = 0, SL_HEAD = 2 * MAIN_BYTES, SL_XT = SL_HEAD + 2 * HEAD_BYTES, SL_XWT = SL_XT + 2 * 8192, SL_P = SL_XWT + 2 * 8192, SL_YT = SL_P + 2 * 8192, SL_END = SL_YT + 2 * 8192;
static_assert(SL_END <= RING_BYTES, "SSD LDS map");
__device__ __forceinline__ int img256(int r, int c) { return r * 256 + ((c ^ (r & 15)) << 4); }
__device__ __forceinline__ int img128(int r, int c) { return r * 128 + ((c ^ ((r >> 1) & 7)) << 4); }
typedef __bf16 bf16x2_t __attribute__((ext_vector_type(2)));
typedef float f32x2_t __attribute__((ext_vector_type(2)));
__device__ __forceinline__ unsigned cvtpk(float lo, float hi) { f32x2_t v = {lo, hi}; bf16x2_t b = __builtin_convertvector(v, bf16x2_t); return __builtin_bit_cast(unsigned, b); }
#define RAW_BARRIER() do { asm volatile("s_waitcnt lgkmcnt(0)" ::: "memory"); __builtin_amdgcn_s_barrier(); asm volatile("" ::: "memory"); } while (0)

__device__ __forceinline__ void bc_load(const bf16* XBC, const float* DT, int unit, int isC, int n0, int tg, int wave, int lane, v4u (&raw)[7], float& dtv) {
    const int g = unit % NG, bc = unit / NG, c = bc % (SEQ / 64);
    const int ch = DI + isC * (NG * NS) + g * NS + n0;
    const size_t T0 = (size_t)bc * 64 + 4 * tg;
    const bool nohalo = (c == 0 && tg == 0);
#pragma unroll
    for (int k = 0; k < 7; ++k) { const size_t row = (k < 3 && nohalo) ? T0 : (T0 + k - 3); raw[k] = *(const v4u*)(XBC + row * CONV_DIM + ch); }
    dtv = DT[((size_t)bc * 64 + lane) * NH + g * HPG + wave];
}
__device__ __forceinline__ void bc_process(const Ctx& F, const Ptrs& P, unsigned char* IMGS, int unit, int isC, int n0, int tg, const float (&w)[4][8], const float (&bias)[8], const v4u (&rawv)[7], float dtv) {
    LAS unsigned char* L = F.lds;
    const int g = unit % NG, bc = unit / NG, c = bc % (SEQ / 64);
    const bool nohalo = (c == 0 && tg == 0);
    float raw[7][8];
#pragma unroll
    for (int k = 0; k < 7; ++k) { v4u rr = rawv[k];
        if (k < 3 && nohalo) { rr.x = 0u; rr.y = 0u; rr.z = 0u; rr.w = 0u; }
        raw[k][0] = bflo(rr.x); raw[k][1] = bfhi(rr.x); raw[k][2] = bflo(rr.y); raw[k][3] = bfhi(rr.y); raw[k][4] = bflo(rr.z); raw[k][5] = bfhi(rr.z); raw[k][6] = bflo(rr.w); raw[k][7] = bfhi(rr.w); }
    float o[4][8];
#pragma unroll
    for (int i = 0; i < 4; ++i)
#pragma unroll
        for (int j = 0; j < 8; ++j) { const float v = bias[j] + w[0][j] * raw[i][j] + w[1][j] * raw[i + 1][j] + w[2][j] * raw[i + 2][j] + w[3][j] * raw[i + 3][j]; o[i][j] = v * sigm(v); }
    const int ks = n0 >> 5, hi = (n0 >> 4) & 1, q0 = 2 * ((n0 >> 3) & 1);
    const int ibase = isC ? IMG_C : IMG_B;
#pragma unroll
    for (int i = 0; i < 4; ++i) { const int l = 4 * tg + i;
        v2u lo, hi2; lo.x = cvtpk(o[i][0], o[i][1]); lo.y = cvtpk(o[i][2], o[i][3]); hi2.x = cvtpk(o[i][4], o[i][5]); hi2.y = cvtpk(o[i][6], o[i][7]);
        *(LAS v2u*)(L + ibase + img256(l, 4 * ks + q0) + 8 * hi) = lo;
        *(LAS v2u*)(L + ibase + img256(l, 4 * ks + q0 + 1) + 8 * hi) = hi2; }
    if (!isC) {
#pragma unroll
        for (int e = 0; e < 8; ++e) { v2u t; t.x = cvtpk(o[0][e], o[1][e]); t.y = cvtpk(o[2][e], o[3][e]);
            *(LAS v2u*)(L + IMG_BT + img128(n0 + e, tg >> 1) + 8 * (tg & 1)) = t; }
    }
    RAW_BARRIER();
    unsigned char* blob = IMGS + (size_t)unit * BLOB_BYTES;
#pragma unroll
    for (int k = 0; k < 2; ++k) { const v4u vc = *(const LAS v4u*)(L + IMG_C + F.tid * 16 + k * 8192), vt = *(const LAS v4u*)(L + IMG_BT + F.tid * 16 + k * 8192);
        *(v4u*)(blob + BL_C + F.tid * 16 + k * 8192) = vc; *(v4u*)(blob + BL_BT + F.tid * 16 + k * 8192) = vt; }
    {
        const int w = F.wave, r = F.lane & 15, q = F.lane >> 4;
        const int lt0 = (w < 4) ? w : (w == 4) ? 1 : (w == 5) ? 2 : 3, st0 = (w < 4) ? w : (w == 4) ? 0 : (w == 7) ? 2 : 1;
#pragma unroll
        for (int tt = 0; tt < 2; ++tt) { if (tt == 1 && (w < 4 || w > 5)) break;
            const int lt = tt ? lt0 + 1 : lt0, st = tt ? 0 : st0;
            f32x4 cb = {0.f, 0.f, 0.f, 0.f};
#pragma unroll
            for (int ks = 0; ks < 4; ++ks) { const bf16x8 av = *(const LAS bf16x8*)(L + IMG_C + img256(16 * lt + r, 4 * ks + q)), bv = *(const LAS bf16x8*)(L + IMG_B + img256(16 * st + r, 4 * ks + q));
                cb = __builtin_amdgcn_mfma_f32_16x16x32_bf16(av, bv, cb, 0, 0, 0); }
            *(f32x4*)(blob + BL_CBT + (tt ? 8 + (w - 4) : w) * 1024 + F.lane * 16) = cb; }
    }
    {
        const int hh = g * HPG + F.wave; const float a = -expf(P.a_log[hh]);
        float cs = a * dtv;
#pragma unroll
        for (int o2 = 1; o2 < 64; o2 <<= 1) { const float t = __shfl_up(cs, o2); if (F.lane >= o2) cs += t; }
        const float last = __shfl(cs, 63);
        float* sc = (float*)(blob + BL_SC + F.wave * SC_BYTES);
        sc[F.lane] = dtv; sc[64 + F.lane] = cs; sc[128 + F.lane] = __expf(cs); sc[192 + F.lane] = dtv * __expf(last - cs);
    }
    RAW_BARRIER();
}
__device__ __forceinline__ void phase_bcprep(const Ctx& F, const Ptrs& P) {
    const bf16* XBC = (const bf16*)(P.ws + WS_RB); unsigned char* IMGS = (unsigned char*)P.out; const float* DT = (const float*)(P.ws + WS_DT);
    const int cg = F.tid & 31, tg = F.tid >> 5, isC = cg >> 4, n0 = 8 * (cg & 15);
    constexpr int NU = BATCH * (SEQ / 64) * NG;
    if (F.G % NG != 0 || F.vcu >= NU) return;
    const int g = F.vcu % NG, ch = DI + isC * (NG * NS) + g * NS + n0, cnt = (NU - F.vcu + F.G - 1) / F.G;
    float w[4][8], bias[8];
#pragma unroll
    for (int k = 0; k < 4; ++k) { const f32x4 a = *(const f32x4*)(P.conv_w + (size_t)k * CONV_DIM + ch), b = *(const f32x4*)(P.conv_w + (size_t)k * CONV_DIM + ch + 4);
        w[k][0] = a.x; w[k][1] = a.y; w[k][2] = a.z; w[k][3] = a.w; w[k][4] = b.x; w[k][5] = b.y; w[k][6] = b.z; w[k][7] = b.w; }
    { const f32x4 a = *(const f32x4*)(P.conv_b + ch), b = *(const f32x4*)(P.conv_b + ch + 4); bias[0] = a.x; bias[1] = a.y; bias[2] = a.z; bias[3] = a.w; bias[4] = b.x; bias[5] = b.y; bias[6] = b.z; bias[7] = b.w; }
    v4u rA[7], rB[7]; float dA, dB;
    bc_load(XBC, DT, F.vcu, isC, n0, tg, F.wave, F.lane, rA, dA);
    for (int j = 0; j < cnt; j += 2) {
        { const int jn = (j + 1 < cnt) ? j + 1 : j; bc_load(XBC, DT, F.vcu + jn * F.G, isC, n0, tg, F.wave, F.lane, rB, dB); }
        bc_process(F, P, IMGS, F.vcu + j * F.G, isC, n0, tg, w, bias, rA, dA);
        if (j + 1 < cnt) {
            { const int jn = (j + 2 < cnt) ? j + 2 : j + 1; bc_load(XBC, DT, F.vcu + jn * F.G, isC, n0, tg, F.wave, F.lane, rA, dA); }
            bc_process(F, P, IMGS, F.vcu + (j + 1) * F.G, isC, n0, tg, w, bias, rB, dB);
        }
    }
}

__device__ __forceinline__ int dpp_i(int v, const int ctrl_sel) { return ctrl_sel == 0 ? __builtin_amdgcn_update_dpp(0, v, 0xB1, 0xF, 0xF, false) : ctrl_sel == 1 ? __builtin_amdgcn_update_dpp(0, v, 0x4E, 0xF, 0xF, false) : __builtin_amdgcn_update_dpp(0, v, 0x141, 0xF, 0xF, false); }
__device__ __forceinline__ float dpp_add(float v, const int sel) { return v + __int_as_float(dpp_i(__float_as_int(v), sel)); }
template <bool DIAG> __device__ __forceinline__ void ssd_p_tile(LAS unsigned char* Pbuf, const LAS unsigned char* CBT, const LAS float* SC, int slot, int lane, int lt, int st, int r, int q, float Dh) {
    const f32x4 cb = *(const LAS f32x4*)(CBT + slot * 1024 + lane * 16);
    const f32x4 csl = *(const LAS f32x4*)(SC + 64 + 16 * lt + 4 * q);
    const int s = 16 * st + r; const float cs_s = SC[64 + s], dt_s = SC[s];
#pragma unroll
    for (int rg = 0; rg < 4; ++rg) { const int l = 16 * lt + 4 * q + rg; float v;
        if (DIAG) { v = cb[rg] * __expf(fminf(csl[rg] - cs_s, 0.f)) * dt_s; v = (s <= l) ? v : 0.f; if (s == l) v += Dh; }
        else v = cb[rg] * __expf(csl[rg] - cs_s) * dt_s;
        *(LAS unsigned short*)(Pbuf + img128(l, s >> 3) + (s & 7) * 2) = (unsigned short)(cvtpk(v, 0.f) & 0xffffu); }
}
struct ConvW { float a[4], b[4], ba, bb; };
__device__ __forceinline__ void ssd_head(LAS unsigned char* L, int par, int hpar, bool first_chunk, const unsigned (&xr)[7], int w, int lane, int r, int q, const ConvW& cw, float Dh) {
    const LAS unsigned char* HD = L + SL_HEAD + hpar * HEAD_BYTES; const LAS float* SC = (const LAS float*)(HD + 10 * 1024);
    {
        const int cp = lane & 31, hf = lane >> 5;
        const f32x4 wv4 = *(const LAS f32x4*)(SC + 192 + 8 * w + 4 * hf);
        float xa[7], xc[7];
#pragma unroll
        for (int k = 0; k < 7; ++k) { const bool zpad = first_chunk && w == 0 && hf == 0 && k < 3; xa[k] = zpad ? 0.f : bflo(xr[k]); xc[k] = zpad ? 0.f : bfhi(xr[k]); }
        float oa[4], oc[4], wa[4], wc[4];
#pragma unroll
        for (int i = 0; i < 4; ++i) { const float va = cw.ba + cw.a[0] * xa[i] + cw.a[1] * xa[i + 1] + cw.a[2] * xa[i + 2] + cw.a[3] * xa[i + 3], vc = cw.bb + cw.b[0] * xc[i] + cw.b[1] * xc[i + 1] + cw.b[2] * xc[i + 2] + cw.b[3] * xc[i + 3];
            oa[i] = va * sigm(va); oc[i] = vc * sigm(vc); wa[i] = oa[i] * wv4[i]; wc[i] = oc[i] * wv4[i]; }
        v2u t; LAS unsigned char* XTb = L + SL_XT + par * 8192; LAS unsigned char* XWb = L + SL_XWT + par * 8192;
        const int o0 = img128(2 * cp, w) + 8 * hf, o1 = img128(2 * cp + 1, w) + 8 * hf;
        t.x = cvtpk(oa[0], oa[1]); t.y = cvtpk(oa[2], oa[3]); *(LAS v2u*)(XTb + o0) = t;
        t.x = cvtpk(oc[0], oc[1]); t.y = cvtpk(oc[2], oc[3]); *(LAS v2u*)(XTb + o1) = t;
        t.x = cvtpk(wa[0], wa[1]); t.y = cvtpk(wa[2], wa[3]); *(LAS v2u*)(XWb + o0) = t;
        t.x = cvtpk(wc[0], wc[1]); t.y = cvtpk(wc[2], wc[3]); *(LAS v2u*)(XWb + o1) = t;
    }
    LAS unsigned char* Pb = L + SL_P + par * 8192;
    if (w < 4) ssd_p_tile<true>(Pb, HD, SC, w, lane, w, w, r, q, Dh);
    else { const int lt1 = (w == 4) ? 1 : (w == 5) ? 2 : 3, st1 = (w == 4) ? 0 : (w == 7) ? 2 : 1;
        ssd_p_tile<false>(Pb, HD, SC, w, lane, lt1, st1, r, q, Dh);
        if (w < 6) ssd_p_tile<false>(Pb, HD, SC, 8 + (w - 4), lane, lt1 + 1, 0, r, q, Dh); }
}
__device__ __forceinline__ void ssd_mfma(LAS unsigned char* L, int par, f32x4 (&st)[8], int lane, int r, int q, int pt, int lh, const int (&a256)[4], const int (&a128)[2]) {
    const LAS unsigned char* IC = L + SL_MAIN + par * MAIN_BYTES; const LAS unsigned char* IBT = IC + 16384; const LAS float* SC = (const LAS float*)(IC + 32768);
    f32x4 acc[2] = {(f32x4){0.f, 0.f, 0.f, 0.f}, (f32x4){0.f, 0.f, 0.f, 0.f}};
    {
        bf16x8 yav[4][2], sb[4];
#pragma unroll
        for (int ks = 0; ks < 4; ++ks) {
#pragma unroll
            for (int t = 0; t < 2; ++t) yav[ks][t] = *(const LAS bf16x8*)(IC + 4096 * (2 * lh + t) + a256[ks]);
            v4u sbw; sbw.x = cvtpk(st[2 * ks][0], st[2 * ks][1]); sbw.y = cvtpk(st[2 * ks][2], st[2 * ks][3]); sbw.z = cvtpk(st[2 * ks + 1][0], st[2 * ks + 1][1]); sbw.w = cvtpk(st[2 * ks + 1][2], st[2 * ks + 1][3]);
            sb[ks] = __builtin_bit_cast(bf16x8, sbw); }
#pragma unroll
        for (int ks = 0; ks < 4; ++ks)
#pragma unroll
            for (int t = 0; t < 2; ++t) acc[t] = __builtin_amdgcn_mfma_f32_16x16x32_bf16(yav[ks][t], sb[ks], acc[t], 0, 0, 0);
    }
    { const float elast = SC[128 + 63];
#pragma unroll
      for (int t = 0; t < 2; ++t) { const f32x4 ev4 = *(const LAS f32x4*)(SC + 128 + 16 * (2 * lh + t) + 4 * q); acc[t] = acc[t] * ev4; }
#pragma unroll
      for (int j = 0; j < 8; ++j) st[j] = st[j] * elast; }
    {
        const LAS unsigned char* XTb = L + SL_XT + par * 8192; const LAS unsigned char* XWb = L + SL_XWT + par * 8192; const LAS unsigned char* Pb = L + SL_P + par * 8192;
        bf16x8 xb[2], pav[2][2], xwb[2], bav[2][8];
#pragma unroll
        for (int ks = 0; ks < 2; ++ks) { xb[ks] = *(const LAS bf16x8*)(XTb + 2048 * pt + a128[ks]); xwb[ks] = *(const LAS bf16x8*)(XWb + 2048 * pt + a128[ks]);
#pragma unroll
            for (int t = 0; t < 2; ++t) pav[ks][t] = *(const LAS bf16x8*)(Pb + 2048 * (2 * lh + t) + a128[ks]);
#pragma unroll
            for (int j = 0; j < 8; ++j) bav[ks][j] = *(const LAS bf16x8*)(IBT + 2048 * j + a128[ks]); }
#pragma unroll
        for (int t = 0; t < 2; ++t) acc[t] = __builtin_amdgcn_mfma_f32_16x16x32_bf16(pav[0][t], xb[0], acc[t], 0, 0, 0);
        if (lh == 1) {
#pragma unroll
            for (int t = 0; t < 2; ++t) acc[t] = __builtin_amdgcn_mfma_f32_16x16x32_bf16(pav[1][t], xb[1], acc[t], 0, 0, 0); }
#pragma unroll
        for (int ks = 0; ks < 2; ++ks)
#pragma unroll
            for (int j = 0; j < 8; ++j) st[j] = __builtin_amdgcn_mfma_f32_16x16x32_bf16(bav[ks][j], xwb[ks], st[j], 0, 0, 0);
    }
#pragma unroll
    for (int t = 0; t < 2; ++t) { const int p = 16 * pt + r; v2u yw; yw.x = cvtpk(acc[t][0], acc[t][1]); yw.y = cvtpk(acc[t][2], acc[t][3]);
        *(LAS v2u*)(L + SL_YT + par * 8192 + img128(p, 2 * (2 * lh + t) + (q >> 1)) + 8 * (q & 1)) = yw; }
}
__device__ __forceinline__ void ssd_epi(const LAS unsigned char* L, int par, const unsigned (&zr)[4], int w, int lane, unsigned (&ob)[4], float& s1) {
    const int cp = lane & 31, hf = lane >> 5;
    const v2u ya = *(const LAS v2u*)(L + SL_YT + par * 8192 + img128(2 * cp, w) + 8 * hf), yc = *(const LAS v2u*)(L + SL_YT + par * 8192 + img128(2 * cp + 1, w) + 8 * hf);
    const float y0[4] = {bflo(ya.x), bfhi(ya.x), bflo(ya.y), bfhi(ya.y)}, y1[4] = {bflo(yc.x), bfhi(yc.x), bflo(yc.y), bfhi(yc.y)};
    float sq[4];
#pragma unroll
    for (int i = 0; i < 4; ++i) { const float za = bflo(zr[i]), zc = bfhi(zr[i]); const float ga = y0[i] * (za * sigm(za)), gc = y1[i] * (zc * sigm(zc)); sq[i] = ga * ga + gc * gc; ob[i] = cvtpk(ga, gc); }
    float s2[2];
#pragma unroll
    for (int k2 = 0; k2 < 2; ++k2) { const bool hi = (lane & 16) != 0; const float send = hi ? sq[k2] : sq[2 + k2], keep = hi ? sq[2 + k2] : sq[k2]; s2[k2] = keep + __shfl_xor(send, 16); }
    { const bool hi = (lane & 8) != 0; const float send = hi ? s2[0] : s2[1], keep = hi ? s2[1] : s2[0]; s1 = keep + __int_as_float(__builtin_amdgcn_update_dpp(0, __float_as_int(send), 0x128  , 0xF, 0xF, false)); }
    s1 = dpp_add(s1, 0); s1 = dpp_add(s1, 1); s1 = dpp_add(s1, 2);
}
__device__ __forceinline__ void ssd_dma_main(const Ctx& F, const unsigned char* blob_c, int hsub, int w, int lane, int par) {
    LAS unsigned char* dst = F.lds + SL_MAIN + par * MAIN_BYTES;
#pragma unroll
    for (int k = 0; k < 4; ++k) { const int piece = k * 8 + w; __builtin_amdgcn_global_load_lds((const unsigned*)(blob_c + BL_C + piece * 1024) + lane * 4, (LAS unsigned*)(dst + piece * 1024), 16, 0, 0); }
    if (w == 0) __builtin_amdgcn_global_load_lds((const unsigned*)(blob_c + BL_SC + hsub * SC_BYTES) + lane * 4, (LAS unsigned*)(dst + 32768), 16, 0, 0);
}
__device__ __forceinline__ void ssd_dma_head(const Ctx& F, const unsigned char* blob_c, int hsub, int w, int lane, int par) {
    LAS unsigned char* dst = F.lds + SL_HEAD + par * HEAD_BYTES;
    __builtin_amdgcn_global_load_lds((const unsigned*)(blob_c + BL_CBT + w * 1024) + lane * 4, (LAS unsigned*)(dst + w * 1024), 16, 0, 0);
    if (w == 1 || w == 2) __builtin_amdgcn_global_load_lds((const unsigned*)(blob_c + BL_CBT + (7 + w) * 1024) + lane * 4, (LAS unsigned*)(dst + (7 + w) * 1024), 16, 0, 0);
    if (w == 3) __builtin_amdgcn_global_load_lds((const unsigned*)(blob_c + BL_SC + hsub * SC_BYTES) + lane * 4, (LAS unsigned*)(dst + 10 * 1024), 16, 0, 0);
}
template <bool DRY> __device__ __forceinline__ void phase_ssd(const Ctx& F, const Ptrs& P) {
    const bf16* XBC = (const bf16*)(P.ws + WS_RB); bf16* Z = (bf16*)(P.ws + WS_RA);
    float* ssqp = (float*)(P.ws + WS_SSQP); const unsigned char* IMGS = (const unsigned char*)P.out;
    LAS unsigned char* L = F.lds;
    const int w = F.wave, lane = F.lane, r = lane & 15, q = lane >> 4, pt = w & 3, lh = w >> 2;
    constexpr int NC = SEQ / 64;
    for (int unit = F.vcu; unit < BATCH * NH; unit += F.G) {
        const int b = unit / NH, h = unit % NH, g = h / HPG, hsub = h % HPG, cp = lane & 31, hf = lane >> 5, ch = h * HD + 2 * cp;
        const float Dh = P.ssm_d[h];
        ConvW cw;
#pragma unroll
        for (int t = 0; t < 4; ++t) { cw.a[t] = P.conv_w[t * CONV_DIM + ch]; cw.b[t] = P.conv_w[t * CONV_DIM + ch + 1]; }
        cw.ba = P.conv_b[ch]; cw.bb = P.conv_b[ch + 1];
        const unsigned char* blob0 = IMGS + ((size_t)b * NC * NG + g) * BLOB_BYTES;
        const bf16* x0 = XBC + ((size_t)b * SEQ + 8 * w + 4 * hf) * CONV_DIM + h * HD + 2 * cp;
        bf16* z0 = Z + ((size_t)b * SEQ + 8 * w + 4 * hf) * DI + h * HD + 2 * cp;
        const __amdgpu_buffer_rsrc_t rx = __builtin_amdgcn_make_buffer_rsrc((void*)XBC, 0, (int)((size_t)M * CONV_DIM * 2), 0x00020000), rz = __builtin_amdgcn_make_buffer_rsrc((void*)Z, 0, (int)((size_t)M * DI * 2), 0x00020000);
        const unsigned xs0 = (unsigned)((((size_t)b * SEQ + 8 * w) * CONV_DIM + h * HD) * 2), zs0 = (unsigned)((((size_t)b * SEQ + 8 * w) * DI + h * HD) * 2);
        const int xvo = cp * 4 + hf * (4 * CONV_DIM * 2), zvo = cp * 4 + hf * (4 * DI * 2);
        f32x4 st[8];
#pragma unroll
        for (int j = 0; j < 8; ++j) st[j] = (f32x4){0.f, 0.f, 0.f, 0.f};
        int a256[4], a128[2];
#pragma unroll
        for (int ks = 0; ks < 4; ++ks) a256[ks] = img256(r, 4 * ks + q);
#pragma unroll
        for (int ks = 0; ks < 2; ++ks) a128[ks] = img128(r, 4 * ks + q);
        {
          const int l = F.tid >> 3, cch = F.tid & 7; unsigned zz = 0u; asm volatile("" : "+v"(zz));
          if ((cch >> 1) > (l >> 4)) { *(LAS v4u*)(L + SL_P + img128(l, cch)) = (v4u){zz, zz, zz, zz}; *(LAS v4u*)(L + SL_P + 8192 + img128(l, cch)) = (v4u){zz, zz, zz, zz}; } }
        unsigned xr[7], zr[4];
        {
            unsigned x0r[7], x1r[7];
            ssd_dma_main(F, blob0, hsub, w, lane, 0); ssd_dma_head(F, blob0, hsub, w, lane, 0); ssd_dma_head(F, blob0 + (size_t)NG * BLOB_BYTES, hsub, w, lane, 1);
#pragma unroll
            for (int k = 0; k < 7; ++k) { x0r[k] = *(const unsigned*)(x0 + (long)(k - 3) * CONV_DIM); x1r[k] = *(const unsigned*)(x0 + (long)(64 + k - 3) * CONV_DIM); }
            asm volatile("s_waitcnt vmcnt(0)" ::: "memory");
#pragma unroll
            for (int k = 0; k < 7; ++k) { asm volatile("v_mov_b32 %0, %1" : "=v"(xr[k]) : "v"(x1r[k])); asm volatile("" : "+v"(x0r[k])); }
#pragma unroll
            for (int i = 0; i < 4; ++i) zr[i] = 0u;
            RAW_BARRIER();
            ssd_head(L, 0, 0, true, x0r, w, lane, r, q, cw, Dh);
            RAW_BARRIER();
        }
        for (int j = 0; j < NC; ++j) {
            unsigned nxr[7], nzr[4];
#define SSD_ISSUE()             { \
                const int c1 = (j + 1 < NC) ? j + 1 : j, c2 = (j + 2 < NC) ? j + 2 : NC - 1; \
                ssd_dma_main(F, blob0 + (size_t)c1 * NG * BLOB_BYTES, hsub, w, lane, (j + 1) & 1); \
                if (j + 2 < NC) ssd_dma_head(F, blob0 + (size_t)c2 * NG * BLOB_BYTES, hsub, w, lane, j & 1); \
                const unsigned xso = xs0 + (unsigned)(c2 * 64 - 3) * (CONV_DIM * 2), zso = zs0 + (unsigned)(j * 64) * (DI * 2); \
_Pragma("unroll") \
                for (int k = 0; k < 7; ++k) nxr[k] = __builtin_amdgcn_raw_buffer_load_b32(rx, xvo, xso + k * (CONV_DIM * 2), 0); \
_Pragma("unroll") \
                for (int i = 0; i < 4; ++i) nzr[i] = __builtin_amdgcn_raw_buffer_load_b32(rz, zvo, zso + i * (DI * 2), 0); \
            }
            const int igrp = w % 3;
            if (igrp == 0) SSD_ISSUE()
            unsigned eob[4]; float es1;
            ssd_epi(L, (j + 1) & 1, zr, w, lane, eob, es1);
            if (igrp == 1) SSD_ISSUE()
            ssd_mfma(L, j & 1, st, lane, r, q, pt, lh, a256, a128);
            if (igrp == 2) SSD_ISSUE()
            { const int d = (j + 1 < NC) ? j + 1 : j; ssd_head(L, (j + 1) & 1, d & 1, false, xr, w, lane, r, q, cw, Dh); }
            asm volatile("s_waitcnt vmcnt(0)" ::: "memory");
#pragma unroll
            for (int k2 = 0; k2 < 7; ++k2) asm volatile("v_mov_b32 %0, %1" : "=v"(xr[k2]) : "v"(nxr[k2]));
#pragma unroll
            for (int k2 = 0; k2 < 4; ++k2) asm volatile("v_mov_b32 %0, %1" : "=v"(zr[k2]) : "v"(nzr[k2]));
            if (j > 0) {
                const unsigned zso = zs0 + (unsigned)((j - 1) * 64) * (DI * 2);
#pragma unroll
                for (int i = 0; i < 4; ++i) if (!DRY || es1 == 1.2345e30f) __builtin_amdgcn_raw_buffer_store_b32(eob[i], rz, zvo, zso + i * (DI * 2), 0);
                if ((lane & 7) == 0 && (!DRY || es1 == 1.2345e30f)) { const int i = 4 * (lane >> 5) + 2 * ((lane >> 4) & 1) + ((lane >> 3) & 1); ssqp[((size_t)b * SEQ + (j - 1) * 64 + 8 * w + i) * NH + h] = es1; }
            }
            RAW_BARRIER();
        }
        {
            unsigned ob[4]; float s1;
            ssd_epi(L, (NC - 1) & 1, zr, w, lane, ob, s1);
            bf16* zc = z0 + (size_t)(NC - 1) * 64 * DI;
#pragma unroll
            for (int i = 0; i < 4; ++i) if (!DRY || s1 == 1.2345e30f) *(unsigned*)(zc + (long)i * DI) = ob[i];
            if ((lane & 7) == 0 && (!DRY || s1 == 1.2345e30f)) { const int i = 4 * (lane >> 5) + 2 * ((lane >> 4) & 1) + ((lane >> 3) & 1); ssqp[((size_t)b * SEQ + (NC - 1) * 64 + 8 * w + i) * NH + h] = s1; }
        }
        asm volatile("s_waitcnt vmcnt(0)" ::: "memory"); RAW_BARRIER();
    }
}

__device__ __forceinline__ void phase_pool(const Ctx& F, const Ptrs& P) {
    const bf16* V = (const bf16*)(P.ws + WS_RA); const bf16* GT = (const bf16*)(P.ws + WS_RB); bf16* Y2 = (bf16*)(P.ws + WS_RB);
    const int NCG = DP / 8;
    const int nitems = (M / 32) * NCG;
    for (int it = F.vcu * 512 + F.tid; it < nitems; it += F.G * 512) {
        const int cg = it % NCG, tb = it / NCG, c0 = cg * 8, t0 = tb * 32, win = 2 << (c0 / PGD);
        const int pos0 = t0 % SEQ;
        float sc[8]; { const f32x4 a = *(const f32x4*)(P.pool_scale + c0), b = *(const f32x4*)(P.pool_scale + c0 + 4); sc[0] = a.x; sc[1] = a.y; sc[2] = a.z; sc[3] = a.w; sc[4] = b.x; sc[5] = b.y; sc[6] = b.z; sc[7] = b.w; }
        float s[8];
#pragma unroll
        for (int j = 0; j < 8; ++j) s[j] = 0.f;
        for (int d = 1; d < win; ++d) if (pos0 - d >= 0) { const v4u r = *(const v4u*)(V + (size_t)(t0 - d) * DP + c0);
            s[0] += bflo(r.x); s[1] += bfhi(r.x); s[2] += bflo(r.y); s[3] += bfhi(r.y); s[4] += bflo(r.z); s[5] += bfhi(r.z); s[6] += bflo(r.w); s[7] += bfhi(r.w); }
        for (int tt = 0; tt < 32; tt += 8) {
            v4u rv[8], gv[8], qv[8];
#pragma unroll
            for (int u = 0; u < 8; ++u) { const int t = tt + u; rv[u] = *(const v4u*)(V + (size_t)(t0 + t) * DP + c0); gv[u] = *(const v4u*)(GT + (size_t)(t0 + t) * DP + c0);
                const int pd = pos0 + t - (win - 1); qv[u] = *(const v4u*)(V + (size_t)(t0 + t - (pd >= 0 ? win - 1 : 0)) * DP + c0); }
#pragma unroll
            for (int u = 0; u < 8; ++u) { const int t = tt + u, pos = pos0 + t; const v4u r = rv[u], gr = gv[u], q = qv[u];
                const float cur[8] = {bflo(r.x), bfhi(r.x), bflo(r.y), bfhi(r.y), bflo(r.z), bfhi(r.z), bflo(r.w), bfhi(r.w)};
                const float gt[8] = {bflo(gr.x), bfhi(gr.x), bflo(gr.y), bfhi(gr.y), bflo(gr.z), bfhi(gr.z), bflo(gr.w), bfhi(gr.w)};
#pragma unroll
                for (int j = 0; j < 8; ++j) s[j] += cur[j];
                const int cnt = (pos + 1 < win) ? (pos + 1) : win; const float inv = 1.0f / (float)cnt;
                float o[8];
#pragma unroll
                for (int j = 0; j < 8; ++j) o[j] = (s[j] * inv - cur[j]) * sc[j] * (gt[j] * sigm(gt[j]));
                v4u ow; ow.x = pk2(o[0], o[1]); ow.y = pk2(o[2], o[3]); ow.z = pk2(o[4], o[5]); ow.w = pk2(o[6], o[7]);
                *(v4u*)(Y2 + (size_t)(t0 + t) * DP + c0) = ow;
                if (pos - (win - 1) >= 0) {
                    s[0] -= bflo(q.x); s[1] -= bfhi(q.x); s[2] -= bflo(q.y); s[3] -= bfhi(q.y); s[4] -= bflo(q.z); s[5] -= bfhi(q.z); s[6] -= bflo(q.w); s[7] -= bfhi(q.w); } }
        }
    }
}

__device__ __forceinline__ void fin_load(const float* row, int lane, f32x4 (&v)[8]) {
#pragma unroll
    for (int j = 0; j < 8; ++j) v[j] = ((const f32x4*)row)[lane + 64 * j];
}
__device__ __forceinline__ void fin_process(float* row, int lane, const f32x4 (&v)[8], const f32x4 (&gv)[8]) {
    float s = 0.f;
#pragma unroll
    for (int j = 0; j < 8; ++j) s += (v[j].x * v[j].x + v[j].y * v[j].y) + (v[j].z * v[j].z + v[j].w * v[j].w);
    s = wave_sum(s);
    const float rs = rsqrtf(s * (1.0f / DM) + EPS);
#pragma unroll
    for (int j = 0; j < 8; ++j) ((f32x4*)row)[lane + 64 * j] = v[j] * rs * gv[j];
}
__device__ __forceinline__ void phase_final(const Ctx& F, const Ptrs& P) {
    const int gw = F.vcu * NWAVES + F.wave, NGW = F.G * NWAVES, lane = F.lane;
    f32x4 gv[8];
#pragma unroll
    for (int j = 0; j < 8; ++j) gv[j] = ((const f32x4*)P.final_g)[lane + 64 * j];
    const int cnt = (M - gw + NGW - 1) / NGW;
    f32x4 vA[8], vB[8];
    fin_load(P.out + (size_t)gw * DM, lane, vA);
    for (int j = 0; j < cnt; j += 2) {
        { const int jn = (j + 1 < cnt) ? j + 1 : j; fin_load(P.out + (size_t)(gw + jn * NGW) * DM, lane, vB); }
        fin_process(P.out + (size_t)(gw + j * NGW) * DM, lane, vA, gv);
        if (j + 1 < cnt) {
            { const int jn = (j + 2 < cnt) ? j + 2 : j + 1; fin_load(P.out + (size_t)(gw + jn * NGW) * DM, lane, vA); }
            fin_process(P.out + (size_t)(gw + (j + 1) * NGW) * DM, lane, vB, gv);
        }
    }
}

constexpr int N_PHASES = 10;
struct Args { Ptrs p; int ph_lo, ph_hi, li, pad; };
typedef __attribute__((address_space(4))) const Args* KArgsPtr;
__device__ __forceinline__ Ptrs load_ptrs() {
    Ptrs r{};
#if defined(__HIP_DEVICE_COMPILE__)
    KArgsPtr ka = (KArgsPtr)__builtin_amdgcn_kernarg_segment_ptr(); asm volatile("" : "+s"(ka));
    r.x = ka->p.x; r.ln_g = ka->p.ln_g; r.final_g = ka->p.final_g; r.ssm_w_in = ka->p.ssm_w_in; r.conv_w = ka->p.conv_w; r.conv_b = ka->p.conv_b; r.dt_bias = ka->p.dt_bias; r.a_log = ka->p.a_log; r.ssm_d = ka->p.ssm_d;
    r.norm_g = ka->p.norm_g; r.ssm_w_out = ka->p.ssm_w_out; r.pool_w_in = ka->p.pool_w_in; r.pool_w_group = ka->p.pool_w_group; r.pool_scale = ka->p.pool_scale; r.pool_w_out = ka->p.pool_w_out; r.out = ka->p.out; r.ws = ka->p.ws;
#endif
    return r;
}
__global__ void __launch_bounds__(NWAVES * 64, 2) trunk_fwd(Args args) {
    extern __shared__ __attribute__((aligned(16))) unsigned char lds[];
    Ctx F;
    F.lds = (LAS unsigned char*)lds;
    F.tid = threadIdx.x; F.lane = F.tid & 63; F.wave = __builtin_amdgcn_readfirstlane(F.tid >> 6);
    F.G = gridDim.x; { const int bx = blockIdx.x; F.vcu = (F.G % 8 == 0) ? (bx % 8) * (F.G / 8) + bx / 8 : bx; }
    unsigned* ctl0; { const Ptrs P0 = load_ptrs(); ctl0 = (unsigned*)(P0.ws + WS_CTL); }
    for (int u = F.tid; u < (LDS_BYTES - LDSCTL_OFF) / 4; u += NWAVES * 64) ((LAS unsigned*)(F.lds + LDSCTL_OFF))[u] = 0u;
    __syncthreads();
#if MK_ONE_LAUNCH
    XcdBarrier bar = xcd_barrier_post(ctl0 + CW_BAR, (volatile LAS unsigned*)(F.lds + MISC_OFF) + 8);
#define GRID_BAR() xcd_barrier(bar)
#else
#define GRID_BAR() do {} while (0)
#endif
    const int lo = args.ph_lo, hi = args.ph_hi;
#define IN(k) (lo <= (k) && (k) < hi)
#define BOTH(k) (IN(k) && IN((k) + 1))
#define PHASE_VARS const Ptrs P = load_ptrs(); unsigned* ctl = (unsigned*)(P.ws + WS_CTL); \
    float* ssq1 = (float*)ctl + CW_SSQ1; float* ssq3p = (float*)(P.ws + WS_SSQP + 4 * MiB); const float* ssqp = (const float*)(P.ws + WS_SSQP);   \
    bf16* W1T = (bf16*)(P.ws + WS_W1T); bf16* W2T = (bf16*)(P.ws + WS_W2T); bf16* W3T = (bf16*)(P.ws + WS_W3T); bf16* W4T = (bf16*)(P.ws + WS_W4T); bf16* W5T = (bf16*)(P.ws + WS_W5T); \
    bf16* RA = (bf16*)(P.ws + WS_RA); bf16* RB = (bf16*)(P.ws + WS_RB); bf16* RC = (bf16*)(P.ws + WS_RC); \
    (void)ctl; (void)ssq1; (void)ssq3p; (void)ssqp; (void)W1T; (void)W2T; (void)W3T; (void)W4T; (void)W5T; (void)RA; (void)RB; (void)RC;

#define REP(k) (1 + ((REPEAT_MASK >> (k)) & 1))
    unsigned long long ts_a = 0, ts_b = 0;
#define TS_A(k) do { if (STAMP_PHASE == (k)) ts_a = __builtin_amdgcn_s_memrealtime(); } while (0)
#define TS_B(k) do { if (STAMP_PHASE == (k)) ts_b = __builtin_amdgcn_s_memrealtime(); } while (0)
    TS_A(0);
    if (IN(0)) { PHASE_VARS for (int rep = 0; rep < REP(0); ++rep) phase_prep(F, P); if (BOTH(0)) GRID_BAR(); }
    TS_B(0);
    TS_A(1);
    if (IN(1)) {
        PHASE_VARS
        {
          pg8::Gemm g{W4T, (const bf16*)P.out, DP, DM, PGD, PGD, DP, 30, 2}; pg8::StaticOrder S; S.init(DP, DM, F.G, (int)blockIdx.x);
          pg8::EpiPlain E{W3T, DM};
          TS_A(10); pg8::gemm_phase<pg8::EpiPlain, pg8::StaticOrder, true, true>(F.lds + RING_OFF, g, S, E);
          { constexpr int NWC = (DP / 256) * (DM / 256); if ((int)blockIdx.x >= NWC && F.G > NWC) prep_transposes(F, P, 1, ((int)blockIdx.x - NWC) * NWAVES + F.wave, (F.G - NWC) * NWAVES); else if (F.G <= NWC) prep_transposes(F, P, 1, F.vcu * NWAVES + F.wave, F.G * NWAVES); }
          __syncthreads(); TS_B(10); }
        TS_A(11); for (int rep = 0; rep < REP(10); ++rep) phase_dt(F, P); TS_B(11);
        for (int rep = 0; rep < REP(1); ++rep) {
        pg8::Gemm g{RC, W1T, M, N1, DM, DM, DM, 30, 30}; pg8::StaticOrder S; S.init(M, N1, F.G, (int)blockIdx.x);
        pg8::EpiProj E{RA, DI, RB, CONV_DIM, DI / 256, ssq1, 1.0f / DM, nullptr};
        pg8::gemm_phase<pg8::EpiProj, pg8::StaticOrder, true, true>(F.lds + RING_OFF, g, S, E);
        }
        if (BOTH(1)) GRID_BAR();
    }
    TS_B(1);
    TS_A(2);
    if (IN(2)) { PHASE_VARS for (int rep = 0; rep < REP(2); ++rep) phase_bcprep(F, P); if (BOTH(2)) GRID_BAR(); }
    TS_B(2);
    TS_A(3);
    if (IN(3)) { PHASE_VARS if (REP(3) > 1) phase_ssd<true>(F, P); phase_ssd<false>(F, P); if (BOTH(3)) GRID_BAR(); }
    TS_B(3);
    TS_A(4);
    if (IN(4)) {
        PHASE_VARS
        for (int rep = 0; rep < REP(4); ++rep) {
        pg8::Gemm g{RA, W2T, M, DM, DI, DI, DI, 30, 30}; pg8::StaticOrder S; S.init(M, DM, F.G, (int)blockIdx.x);
        LAS float* rs_tab = (LAS float*)(F.lds + pg8::STAGE_BYTES);
        {
          pg8::Unit uu; const int o = F.tid >> 8, rr = F.tid & 255;
          if (S.next(o, uu)) { const f32x4* pp = (const f32x4*)(ssqp + (size_t)(uu.pm * 256 + rr) * NH); f32x4 a = pp[0];
#pragma unroll
              for (int j = 1; j < 16; ++j) a = a + pp[j];
              rs_tab[o * 256 + rr] = rsqrtf(((a[0] + a[1]) + (a[2] + a[3])) * (1.0f / DI) + EPS); }
          __syncthreads(); }
        pg8::EpiResB E{RC, rs_tab, ssq3p, DM};
        pg8::gemm_phase<pg8::EpiResB, pg8::StaticOrder, true, true>(F.lds + RING_OFF, g, S, E);
        }
        if (BOTH(4)) GRID_BAR();
    }
    TS_B(4);
    TS_A(5);
    if (IN(5)) {
        PHASE_VARS
        for (int rep = 0; rep < REP(5); ++rep) {
        pg8::Gemm g{RC, W3T, M, 2 * DP, DM, DM, DM, 30, 30}; pg8::StaticOrder S; S.init(M, 2 * DP, F.G, (int)blockIdx.x);
        LAS float* rs_tab = (LAS float*)(F.lds + pg8::STAGE_BYTES);
        {
          for (int o = F.tid >> 8; o < 8; o += 2) { pg8::Unit uu; const int rr = F.tid & 255;
            if (S.next(o, uu)) { const f32x4* pp = (const f32x4*)(ssq3p + (size_t)(uu.pm * 256 + rr) * 32); f32x4 a = pp[0];
#pragma unroll
              for (int j = 1; j < 8; ++j) a = a + pp[j];
              rs_tab[o * 256 + rr] = rsqrtf(((a[0] + a[1]) + (a[2] + a[3])) * (1.0f / DM) + EPS); } }
          __syncthreads(); }
        pg8::EpiProj E{RA, DP, RB, DP, DP / 256, nullptr, 0.f, rs_tab};
        pg8::gemm_phase<pg8::EpiProj, pg8::StaticOrder, true, true>(F.lds + RING_OFF, g, S, E);
        }
        if (BOTH(5)) GRID_BAR();
    }
    TS_B(5);
    TS_A(6);
    if (IN(6)) { PHASE_VARS for (int rep = 0; rep < REP(6); ++rep) phase_pool(F, P); if (BOTH(6)) GRID_BAR(); }
    TS_B(6);
    TS_A(8);
    if (IN(8)) {
        PHASE_VARS
        pg8::Gemm g{RB, W5T, M, DM, DP, DP, DP, 30, 30}; pg8::PanelOrder S; S.init(F.G, (int)blockIdx.x);
        pg8::EpiFinal E{RC, P.out, P.final_g, (float*)(P.ws + WS_SSQP + 6 * MiB), ctl + CW_FIN, ctl + CW_TMO, F.lds + pg8::STAGE_BYTES, DM};
        pg8::gemm_phase<pg8::EpiFinal, pg8::PanelOrder, true, true>(F.lds + RING_OFF, g, S, E);
    }
    TS_B(8);
    if (STAMP_PHASE >= 0) { const unsigned long long t0 = __builtin_amdgcn_s_memrealtime(); while (__builtin_amdgcn_s_memrealtime() - t0 < ts_b - ts_a) __builtin_amdgcn_s_sleep(8); }
#undef IN
#undef BOTH
}

extern "C" void kernel_launch(void* const* d_in, const int* in_sizes, int n_in, void* d_out, int out_size, void* d_ws, size_t ws_size, hipStream_t stream) {
    static int grid = 0;
    if (grid == 0) {
        if (n_in != 15 || in_sizes[0] != M * DM || out_size != M * DM || ws_size < WS_END) { fprintf(stderr, "kernel_launch: unexpected shapes: n_in %d in0 %d out %d ws %zu (need %zu); nothing launched\n", n_in, n_in > 0 ? in_sizes[0] : -1, out_size, ws_size, (size_t)WS_END); grid = -1; return; }
        int dev = 0, cus = 0, per_cu = 0;
        if (hipGetDevice(&dev) != hipSuccess || hipDeviceGetAttribute(&cus, hipDeviceAttributeMultiprocessorCount, dev) != hipSuccess) { fprintf(stderr, "kernel_launch: device query failed\n"); grid = -1; return; }
        if (hipFuncSetAttribute((const void*)trunk_fwd, hipFuncAttributeMaxDynamicSharedMemorySize, LDS_BYTES) != hipSuccess) { fprintf(stderr, "kernel_launch: hipFuncSetAttribute failed\n"); grid = -1; return; }
        if (hipOccupancyMaxActiveBlocksPerMultiprocessor(&per_cu, (const void*)trunk_fwd, NWAVES * 64, LDS_BYTES) != hipSuccess || per_cu < 1) { fprintf(stderr, "kernel_launch: occupancy query says %d blocks per CU\n", per_cu); }
        (void)hipGetLastError();
        grid = cus;
        if (cus != 256) { fprintf(stderr, "kernel_launch: this kernel's unit orders are built for a 256-CU device (got %d CUs); nothing launched\n", cus); grid = -1; return; }
    }
    if (grid < 0) return;
    if (hipMemsetAsync((char*)d_ws + WS_CTL, 0, CTL_ZERO_BYTES, stream) != hipSuccess) { fprintf(stderr, "kernel_launch: memset failed\n"); return; }
    Args a{};
    a.p.x = (const float*)d_in[0]; a.p.ln_g = (const float*)d_in[1]; a.p.final_g = (const float*)d_in[2]; a.p.ssm_w_in = (const float*)d_in[3]; a.p.conv_w = (const float*)d_in[4];
    a.p.conv_b = (const float*)d_in[5]; a.p.dt_bias = (const float*)d_in[6]; a.p.a_log = (const float*)d_in[7]; a.p.ssm_d = (const float*)d_in[8]; a.p.norm_g = (const float*)d_in[9];
    a.p.ssm_w_out = (const float*)d_in[10]; a.p.pool_w_in = (const float*)d_in[11]; a.p.pool_w_group = (const float*)d_in[12]; a.p.pool_scale = (const float*)d_in[13]; a.p.pool_w_out = (const float*)d_in[14];
    a.p.out = (float*)d_out; a.p.ws = (unsigned char*)d_ws;
#if MK_ONE_LAUNCH
    a.ph_lo = 0; a.ph_hi = N_PHASES; a.li = 0;
    hipLaunchKernelGGL(trunk_fwd, dim3(grid), dim3(NWAVES * 64), LDS_BYTES, stream, a);
#else
    for (int li = 0; li < N_PHASES; ++li) { a.ph_lo = li; a.ph_hi = li + 1; a.li = li;
        hipLaunchKernelGGL(trunk_fwd, dim3(grid), dim3(NWAVES * 64), LDS_BYTES, stream, a); }
#endif
    const hipError_t le = hipPeekAtLastError();
    if (le != hipSuccess) fprintf(stderr, "kernel_launch: launch failed: %s\n", hipGetErrorName(le));
}
```

```cpp
#include <hip/hip_runtime.h>
#include <cstdio>
#include <cstdint>

#ifndef REPEAT_MASK
#define REPEAT_MASK 0
#endif
#ifndef STAMP_PHASE
#define STAMP_PHASE -1
#endif
#ifndef MK_ONE_LAUNCH
#define MK_ONE_LAUNCH 1
#endif

namespace pg8 {
#define PG8_LAS __attribute__((address_space(3)))
typedef unsigned short bf16_t;
typedef short bf16x8 __attribute__((ext_vector_type(8)));
typedef float f32x4 __attribute__((ext_vector_type(4)));
typedef unsigned u32x4 __attribute__((ext_vector_type(4)));
typedef unsigned u32x2 __attribute__((ext_vector_type(2)));
constexpr int BM = 256, BK = 64, HALF = 128, HTB = HALF * BK * 2  , STAGE_BYTES = 8 * HTB, NXCD = 8, WGM = 8;
constexpr float RMS_EPS = 1e-6f;

__host__ __device__ __forceinline__ int lds_byte(int r, int c) { return r * 128 + ((((c >> 3) ^ (r & 7))) << 4) + (c & 7) * 2; }
__host__ __device__ __forceinline__ void stage_rc(int b, int& R, int& C) { R = b / 128; C = ((((b % 128) / 16) ^ (R & 7))) * 8; }
__host__ __device__ __forceinline__ int perm32(int rho) { const int n = rho >> 4, i = rho & 15; return 8 * (i >> 2) + 4 * n + (i & 3); }

struct Unit { int pm, pn, ord; };
struct Gemm { const bf16_t* A; const bf16_t* Bt; int M, N, K, lda, ldb, gsh, bgsh; };

struct StaticOrder {
    int nM, nN, nwg, G, c;
    __host__ __device__ void init(int M, int N, int G_, int c_) { nM = M / BM; nN = N / BM; nwg = nM * nN; G = G_; c = c_; }
    __host__ __device__ bool next(int i, Unit& u) const {
        const long L = (long)i * G + c; if (L >= nwg) return false;
        int wgid = (int)L; { const int q = nwg / NXCD, r = nwg % NXCD, xcd = wgid % NXCD, off = wgid / NXCD; wgid = (xcd < r ? xcd * (q + 1) : r * (q + 1) + (xcd - r) * q) + off; }
        const int nig = WGM * nN, gid = wgid / nig, fm = gid * WGM, gsz = (nM - fm) < WGM ? (nM - fm) : WGM;
        u.pm = fm + ((wgid % nig) % gsz); u.pn = (wgid % nig) / gsz; return true;
    }
    __device__ __forceinline__ void a_ready(const Unit&) const {}
    __device__ __forceinline__ void done(const Unit&) const {}
};

__device__ __forceinline__ unsigned cvt_pk_bf16(float lo, float hi) { unsigned r; asm volatile("v_cvt_pk_bf16_f32 %0, %1, %2" : "=v"(r) : "v"(lo), "v"(hi)); return r; }
__device__ __forceinline__ float bf_lo(unsigned w) { return __uint_as_float(w << 16); }
__device__ __forceinline__ float bf_hi(unsigned w) { return __uint_as_float(w & 0xffff0000u); }
__device__ __forceinline__ float sigmoid_f(float v) { return __builtin_amdgcn_rcpf(1.0f + __builtin_amdgcn_exp2f(-1.4426950408889634f * v)); }

struct EpiProj {
    static constexpr bool PERM = true, AFTER_DRAIN = false;
    bf16_t* O0; int ld0; bf16_t* O1; int ld1; int split_pn; const float* ssq; float inv_n; const PG8_LAS float* rs_lds;
    __device__ __forceinline__ void operator()(const f32x4 (&acc)[2][2][4][2], const Unit& u, int wr, int wc, int fr, int fq) const {
        const int row0 = u.pm * BM + wr * 64 + fr;
        bf16_t* base; int ld, colt;
        if (u.pn < split_pn) { base = O0; ld = ld0; colt = u.pn * BM; } else { base = O1; ld = ld1; colt = (u.pn - split_pn) * BM; }
        const int col0 = colt + wc * 32 + 8 * fq;
#pragma unroll
        for (int ai = 0; ai < 2; ++ai)
#pragma unroll
            for (int m = 0; m < 4; ++m) { const int row = row0 + ai * HALF + m * 16; const float s = rs_lds ? rs_lds[u.ord * BM + wr * 64 + fr + ai * HALF + m * 16] : rsqrtf(ssq[row] * inv_n + RMS_EPS);
                bf16_t* rowp = base + (size_t)row * ld + col0;
#pragma unroll
                for (int bj = 0; bj < 2; ++bj) { const f32x4 v0 = acc[ai][bj][m][0] * s, v1 = acc[ai][bj][m][1] * s;
                    u32x4 w; w.x = cvt_pk_bf16(v0[0], v0[1]); w.y = cvt_pk_bf16(v0[2], v0[3]); w.z = cvt_pk_bf16(v1[0], v1[1]); w.w = cvt_pk_bf16(v1[2], v1[3]);
                    *(u32x4*)(rowp + bj * HALF) = w; } }
    }
};
struct EpiPlain {
    static constexpr bool PERM = true, AFTER_DRAIN = false;
    bf16_t* O; int ld;
    __device__ __forceinline__ void operator()(const f32x4 (&acc)[2][2][4][2], const Unit& u, int wr, int wc, int fr, int fq) const {
        const int row0 = u.pm * BM + wr * 64 + fr, col0 = u.pn * BM + wc * 32 + 8 * fq;
#pragma unroll
        for (int ai = 0; ai < 2; ++ai)
#pragma unroll
            for (int m = 0; m < 4; ++m) { bf16_t* rowp = O + (size_t)(row0 + ai * HALF + m * 16) * ld + col0;
#pragma unroll
                for (int bj = 0; bj < 2; ++bj) { const f32x4 v0 = acc[ai][bj][m][0], v1 = acc[ai][bj][m][1];
                    u32x4 w; w.x = cvt_pk_bf16(v0[0], v0[1]); w.y = cvt_pk_bf16(v0[2], v0[3]); w.z = cvt_pk_bf16(v1[0], v1[1]); w.w = cvt_pk_bf16(v1[2], v1[3]);
                    *(u32x4*)(rowp + bj * HALF) = w; } }
    }
};
struct EpiRes {
    static constexpr bool PERM = false, AFTER_DRAIN = false;
    const float* base; float* out; bf16_t* ob; const PG8_LAS float* rs_lds; float* ssq_out; int ldc;
    __device__ __forceinline__ void operator()(const f32x4 (&acc)[2][2][4][2], const Unit& u, int wr, int wc, int fr, int fq) const {
        const int rl0 = wr * 64 + fr, row0 = u.pm * BM + rl0, col0 = u.pn * BM + wc * 32 + 4 * fq;
#pragma unroll
        for (int ai = 0; ai < 2; ++ai)
#pragma unroll
            for (int m = 0; m < 4; ++m) { const int row = row0 + ai * HALF + m * 16; const float s = rs_lds ? rs_lds[u.ord * BM + rl0 + ai * HALF + m * 16] : 1.0f;
                const size_t off = (size_t)row * ldc + col0; float q = 0.f;
#pragma unroll
                for (int bj = 0; bj < 2; ++bj)
#pragma unroll
                    for (int n = 0; n < 2; ++n) { const size_t o2 = off + bj * HALF + n * 16; const f32x4 b = *(const f32x4*)(base + o2); const f32x4 o = b + acc[ai][bj][m][n] * s;
                        *(f32x4*)(out + o2) = o; q += (o[0] * o[0] + o[1] * o[1]) + (o[2] * o[2] + o[3] * o[3]);
                        if (ob) { u32x2 w; w.x = cvt_pk_bf16(o[0], o[1]); w.y = cvt_pk_bf16(o[2], o[3]); *(u32x2*)(ob + o2) = w; } }
                if (ssq_out) { q += __shfl_xor(q, 16); q += __shfl_xor(q, 32); if (fq == 0) ssq_out[(size_t)row * 32 + u.pn * 4 + wc] = q; }
                if (m & 1) asm volatile("" ::: "memory"); }
    }
};
struct EpiResB {
    static constexpr bool PERM = true, AFTER_DRAIN = false;
    bf16_t* xio; const PG8_LAS float* rs_lds; float* ssq_out; int ldc;
    __device__ __forceinline__ void operator()(const f32x4 (&acc)[2][2][4][2], const Unit& u, int wr, int wc, int fr, int fq) const {
        const int rl0 = wr * 64 + fr, row0 = u.pm * BM + rl0, col0 = u.pn * BM + wc * 32 + 8 * fq;
#pragma unroll
        for (int ai = 0; ai < 2; ++ai)
#pragma unroll
            for (int m = 0; m < 4; ++m) { const int row = row0 + ai * HALF + m * 16; const float s = rs_lds[u.ord * BM + rl0 + ai * HALF + m * 16];
                const size_t off = (size_t)row * ldc + col0; float q = 0.f;
#pragma unroll
                for (int bj = 0; bj < 2; ++bj) { const size_t o2 = off + bj * HALF; const u32x4 bw = *(const u32x4*)(xio + o2);
                    f32x4 o0 = acc[ai][bj][m][0] * s, o1 = acc[ai][bj][m][1] * s;
                    o0[0] += bf_lo(bw.x); o0[1] += bf_hi(bw.x); o0[2] += bf_lo(bw.y); o0[3] += bf_hi(bw.y); o1[0] += bf_lo(bw.z); o1[1] += bf_hi(bw.z); o1[2] += bf_lo(bw.w); o1[3] += bf_hi(bw.w);
                    q += ((o0[0] * o0[0] + o0[1] * o0[1]) + (o0[2] * o0[2] + o0[3] * o0[3])) + ((o1[0] * o1[0] + o1[1] * o1[1]) + (o1[2] * o1[2] + o1[3] * o1[3]));
                    u32x4 w; w.x = cvt_pk_bf16(o0[0], o0[1]); w.y = cvt_pk_bf16(o0[2], o0[3]); w.z = cvt_pk_bf16(o1[0], o1[1]); w.w = cvt_pk_bf16(o1[2], o1[3]); *(u32x4*)(xio + o2) = w; }
                q += __shfl_xor(q, 16); q += __shfl_xor(q, 32); if (fq == 0) ssq_out[(size_t)row * 32 + u.pn * 4 + wc] = q;
                if (m & 1) asm volatile("" ::: "memory"); }
    }
};
struct PanelOrder {
    int G, c;
    __host__ __device__ void init(int G_, int c_) { G = G_; c = c_; }
    __host__ __device__ bool next(int i, Unit& u) const { if (i >= 2) return false; const int xcd = c & 7, idx = c >> 3; u.pm = 32 * i + 4 * xcd + (idx >> 3); u.pn = idx & 7; return true; }
    __device__ __forceinline__ void a_ready(const Unit&) const {}
    __device__ __forceinline__ void done(const Unit&) const {}
};
struct EpiFinal {
    static constexpr bool PERM = false, AFTER_DRAIN = false;
    const bf16_t* base; float* out; const float* gain; float* xslots; unsigned* cnt; unsigned* tmo; PG8_LAS unsigned char* lds; int ldc;
    __device__ __forceinline__ void operator()(f32x4 (&acc)[2][2][4][2], const Unit& u, int wr, int wc, int fr, int fq) const {
        PG8_LAS float* Pt = (PG8_LAS float*)lds;
        PG8_LAS float* St = (PG8_LAS float*)(lds + 4096);
        const int tid = threadIdx.x, wid = __builtin_amdgcn_readfirstlane(tid >> 6), lane = tid & 63;
        const int rl0 = wr * 64 + fr, row0 = u.pm * BM + rl0, col0 = u.pn * BM + wc * 32 + 4 * fq;
#pragma unroll
        for (int ai = 0; ai < 2; ++ai)
#pragma unroll
            for (int m = 0; m < 4; ++m) { const size_t off = (size_t)(row0 + ai * HALF + m * 16) * ldc + col0; float q = 0.f;
#pragma unroll
                for (int bj = 0; bj < 2; ++bj)
#pragma unroll
                    for (int n = 0; n < 2; ++n) { const u32x2 bw = *(const u32x2*)(base + off + bj * HALF + n * 16);
                        f32x4 o = acc[ai][bj][m][n]; o[0] += bf_lo(bw.x); o[1] += bf_hi(bw.x); o[2] += bf_lo(bw.y); o[3] += bf_hi(bw.y); acc[ai][bj][m][n] = o;
                        q += (o[0] * o[0] + o[1] * o[1]) + (o[2] * o[2] + o[3] * o[3]); }
                q += __shfl_xor(q, 16); q += __shfl_xor(q, 32);
                if (fq == 0) Pt[(rl0 + ai * HALF + m * 16) * 4 + wc] = q; }
        asm volatile("s_waitcnt lgkmcnt(0)" ::: "memory"); __builtin_amdgcn_s_barrier(); asm volatile("" ::: "memory");
        if (tid < BM) { const f32x4 p4 = *(const PG8_LAS f32x4*)(Pt + tid * 4);
            __hip_atomic_store(xslots + (size_t)(u.pm * BM + tid) * 8 + u.pn, (p4[0] + p4[1]) + (p4[2] + p4[3]), __ATOMIC_RELAXED, __HIP_MEMORY_SCOPE_AGENT); }
        asm volatile("s_waitcnt vmcnt(0)" ::: "memory");
        if (tid < BM && lane == 0) __hip_atomic_fetch_add(cnt + 64 * u.pm, 1u, __ATOMIC_RELAXED, __HIP_MEMORY_SCOPE_AGENT);
        if (wid == 0) {
            unsigned sp = 0;
            while ((unsigned)__builtin_amdgcn_readfirstlane(__hip_atomic_load(cnt + 64 * u.pm, __ATOMIC_RELAXED, __HIP_MEMORY_SCOPE_AGENT)) < 32u) {
                __builtin_amdgcn_s_sleep(2);
                if (++sp > (1u << 22)) { if (lane == 0) __hip_atomic_store(tmo, 1u, __ATOMIC_RELAXED, __HIP_MEMORY_SCOPE_AGENT); break; } }
            __builtin_amdgcn_fence(__ATOMIC_ACQUIRE, "agent");
        }
        asm volatile("s_waitcnt vmcnt(0) lgkmcnt(0)" ::: "memory"); __builtin_amdgcn_s_barrier(); asm volatile("" ::: "memory");
        if (tid < BM) { const float* sl = xslots + (size_t)(u.pm * BM + tid) * 8; float t = 0.f;
#pragma unroll
            for (int j = 0; j < 8; ++j) t += __hip_atomic_load(sl + j, __ATOMIC_RELAXED, __HIP_MEMORY_SCOPE_AGENT);
            St[tid] = rsqrtf(t * (1.0f / 2048.0f) + RMS_EPS); }
        asm volatile("s_waitcnt vmcnt(0) lgkmcnt(0)" ::: "memory"); __builtin_amdgcn_s_barrier(); asm volatile("" ::: "memory");
        f32x4 gv[2][2];
#pragma unroll
        for (int bj = 0; bj < 2; ++bj)
#pragma unroll
            for (int n = 0; n < 2; ++n) gv[bj][n] = *(const f32x4*)(gain + col0 + bj * HALF + n * 16);
#pragma unroll
        for (int ai = 0; ai < 2; ++ai)
#pragma unroll
            for (int m = 0; m < 4; ++m) { const int rl = rl0 + ai * HALF + m * 16; const float s = St[rl]; float* rowp = out + (size_t)(u.pm * BM + rl) * ldc + col0;
#pragma unroll
                for (int bj = 0; bj < 2; ++bj)
#pragma unroll
                    for (int n = 0; n < 2; ++n) *(f32x4*)(rowp + bj * HALF + n * 16) = acc[ai][bj][m][n] * s * gv[bj][n]; }
        asm volatile("s_waitcnt lgkmcnt(0)" ::: "memory"); __builtin_amdgcn_s_barrier(); asm volatile("" ::: "memory");
    }
};
struct EpiGate {
    static constexpr bool PERM = true, AFTER_DRAIN = false;
    bf16_t* O; const bf16_t* gate; const float* scale; int ldc;
    __device__ __forceinline__ void operator()(const f32x4 (&acc)[2][2][4][2], const Unit& u, int wr, int wc, int fr, int fq) const {
        const int row0 = u.pm * BM + wr * 64 + fr, col0 = u.pn * BM + wc * 32 + 8 * fq;
        f32x4 sc[2][2];
#pragma unroll
        for (int bj = 0; bj < 2; ++bj)
#pragma unroll
            for (int n = 0; n < 2; ++n) sc[bj][n] = *(const f32x4*)(scale + col0 + bj * HALF + 4 * n);
#pragma unroll
        for (int ai = 0; ai < 2; ++ai)
#pragma unroll
            for (int m = 0; m < 4; ++m) { const size_t off = (size_t)(row0 + ai * HALF + m * 16) * ldc + col0;
#pragma unroll
                for (int bj = 0; bj < 2; ++bj) { const u32x4 gw = *(const u32x4*)(gate + off + bj * HALF);
                    const float g0 = bf_lo(gw.x), g1 = bf_hi(gw.x), g2 = bf_lo(gw.y), g3 = bf_hi(gw.y), g4 = bf_lo(gw.z), g5 = bf_hi(gw.z), g6 = bf_lo(gw.w), g7 = bf_hi(gw.w);
                    const f32x4 v0 = acc[ai][bj][m][0] * sc[bj][0], v1 = acc[ai][bj][m][1] * sc[bj][1];
                    u32x4 w; w.x = cvt_pk_bf16(v0[0] * g0 * sigmoid_f(g0), v0[1] * g1 * sigmoid_f(g1)); w.y = cvt_pk_bf16(v0[2] * g2 * sigmoid_f(g2), v0[3] * g3 * sigmoid_f(g3));
                    w.z = cvt_pk_bf16(v1[0] * g4 * sigmoid_f(g4), v1[1] * g5 * sigmoid_f(g5)); w.w = cvt_pk_bf16(v1[2] * g6 * sigmoid_f(g6), v1[3] * g7 * sigmoid_f(g7));
                    *(u32x4*)(O + off + bj * HALF) = w; } }
    }
};

template <class Epi, class Sched, bool ALIGN_EPI = false, bool SP2 = false>
__device__ __forceinline__ void gemm_phase(PG8_LAS unsigned char* lds, const Gemm g, const Sched& S, const Epi& E) {
    const int tid = threadIdx.x, wid = __builtin_amdgcn_readfirstlane(tid >> 6), lane = tid & 63, wr = wid >> 2, wc = wid & 3, fr = lane & 15, fq = lane >> 4;
    const int K = g.K, nt = K / BK;
    unsigned voffA[2], voffB[2];
#pragma unroll
    for (int i = 0; i < 2; ++i) { int R, C; stage_rc(tid * 16 + i * 8192, R, C); const int Rb = Epi::PERM ? ((R & ~31) + perm32(R & 31)) : R;
        voffA[i] = (unsigned)(R * g.lda + C) * 2u; voffB[i] = (unsigned)(Rb * g.ldb + C) * 2u; }
    const size_t kstep = (size_t)(BK * 2);
    const size_t hstepA = (size_t)HALF * g.lda * 2, hstepB = (size_t)HALF * g.ldb * 2;
    const size_t tstepA = 2 * hstepA, tstepB = 2 * hstepB, gstepA = (size_t)K * 2;
    const unsigned ldsw = (unsigned)wid * 1024u;
    const int aoffk[2] = {lds_byte(wr * 64 + fr, fq * 8), lds_byte(wr * 64 + fr, 32 + fq * 8)}, boffk[2] = {lds_byte(wc * 32 + fr, fq * 8), lds_byte(wc * 32 + fr, 32 + fq * 8)};
#define PG8_SA(b, h) (((b) * 2 + (h)) * HTB)
#define PG8_SB(b, h) ((4 + (b) * 2 + (h)) * HTB)
#define PG8_STAGE(bufoff, gbase, voff) do { _Pragma("unroll") for (int _i = 0; _i < 2; ++_i) \
        __builtin_amdgcn_global_load_lds((const unsigned*)((const char*)(gbase) + (voff)[_i]), (PG8_LAS unsigned*)(lds + (bufoff) + ldsw + _i * 8192), 16, 0, 0); } while (0)
#define PG8_LDA(dst, b, h) do { _Pragma("unroll") for (int m = 0; m < 4; ++m) _Pragma("unroll") for (int k = 0; k < 2; ++k) dst[m][k] = *(const PG8_LAS bf16x8*)(lds + PG8_SA(b, h) + aoffk[k] + m * 2048); } while (0)
#define PG8_LDB(dst, b, h) do { _Pragma("unroll") for (int n = 0; n < 2; ++n) _Pragma("unroll") for (int k = 0; k < 2; ++k) dst[n][k] = *(const PG8_LAS bf16x8*)(lds + PG8_SB(b, h) + boffk[k] + n * 2048); } while (0)
#define PG8_MMA(ai, bj, At, Bt) do { __builtin_amdgcn_s_setprio(1); _Pragma("unroll") for (int m = 0; m < 4; ++m) _Pragma("unroll") for (int n = 0; n < 2; ++n) _Pragma("unroll") for (int k = 0; k < 2; ++k) \
        acc[ai][bj][m][n] = __builtin_amdgcn_mfma_f32_16x16x32_bf16(Bt[n][k], At[m][k], acc[ai][bj][m][n], 0, 0, 0); __builtin_amdgcn_s_setprio(0); } while (0)
#define PG8_WAIT_V(n) asm volatile("s_waitcnt vmcnt(" #n ")" ::: "memory")
#define PG8_WAIT_L(n) asm volatile("s_waitcnt lgkmcnt(" #n ")" ::: "memory")
#define PG8_BAR __builtin_amdgcn_s_barrier()
#define PG8_SCHED __builtin_amdgcn_sched_barrier(0)
    Unit cur, nxt; int ui = 0;
    if (!S.next(0, cur)) return;
    cur.ord = 0;
    f32x4 acc[2][2][4][2];
#pragma unroll
    for (int a = 0; a < 2; ++a)
#pragma unroll
        for (int b = 0; b < 2; ++b)
#pragma unroll
            for (int m = 0; m < 4; ++m)
#pragma unroll
                for (int n = 0; n < 2; ++n) acc[a][b][m][n] = (f32x4){0.f, 0.f, 0.f, 0.f};
    bf16x8 At[4][2], B0[2][2], B1[2][2];
    const char* cA = (const char*)g.A + (size_t)cur.pm * tstepA + (size_t)(cur.pn >> g.gsh) * gstepA; const char* cB = (const char*)g.Bt + (size_t)cur.pn * tstepB + (size_t)(cur.pm >> g.bgsh) * gstepA;
    S.a_ready(cur);
    if constexpr (SP2) {
        PG8_STAGE(PG8_SB(0, 0), cB, voffB); PG8_STAGE(PG8_SB(0, 1), cB + hstepB, voffB); PG8_STAGE(PG8_SA(0, 0), cA, voffA); PG8_STAGE(PG8_SA(0, 1), cA + hstepA, voffA);
        if (wr == 1) PG8_BAR;
        PG8_WAIT_V(2); PG8_BAR;
        PG8_STAGE(PG8_SB(1, 0), cB + kstep, voffB); PG8_STAGE(PG8_SA(1, 0), cA + kstep, voffA); PG8_STAGE(PG8_SB(1, 1), cB + hstepB + kstep, voffB);
        PG8_WAIT_V(6); PG8_BAR;
    } else {
        PG8_STAGE(PG8_SB(0, 0), cB, voffB); PG8_STAGE(PG8_SA(0, 0), cA, voffA); PG8_STAGE(PG8_SB(0, 1), cB + hstepB, voffB); PG8_STAGE(PG8_SA(0, 1), cA + hstepA, voffA);
        if (wr == 1) PG8_BAR;
        PG8_WAIT_V(4); PG8_BAR;
        PG8_STAGE(PG8_SB(1, 0), cB + kstep, voffB); PG8_STAGE(PG8_SA(1, 0), cA + kstep, voffA); PG8_STAGE(PG8_SB(1, 1), cB + hstepB + kstep, voffB);
        PG8_WAIT_V(6); PG8_BAR;
    }
    for (;;) {
        const bool has_next = S.next(ui + 1, nxt); nxt.ord = ui + 1;
        const char* nA = has_next ? (const char*)g.A + (size_t)nxt.pm * tstepA + (size_t)(nxt.pn >> g.gsh) * gstepA : cA; const char* nB = has_next ? (const char*)g.Bt + (size_t)nxt.pn * tstepB + (size_t)(nxt.pm >> g.bgsh) * gstepA : cB;
        for (int t = 0; t < nt; t += 2) {
            const bool last = (t == nt - 2);
            const char* a1 = cA + (size_t)(t + 1) * kstep;
            const char* a2 = last ? nA : cA + (size_t)(t + 2) * kstep; const char* b2 = last ? nB : cB + (size_t)(t + 2) * kstep;
            const char* a3 = a2 + kstep; const char* b3 = b2 + kstep;
            if (last && has_next) S.a_ready(nxt);
            if constexpr (SP2) {
            PG8_LDB(B0, 0, 0); PG8_LDB(B1, 0, 1); PG8_SCHED; PG8_LDA(At, 0, 0); PG8_STAGE(PG8_SA(1, 1), a1 + hstepA, voffA);
            PG8_WAIT_V(8); PG8_WAIT_L(0); PG8_BAR; PG8_MMA(0, 0, At, B0); PG8_MMA(0, 1, At, B1); PG8_BAR; PG8_SCHED;
            PG8_LDA(At, 0, 1); PG8_STAGE(PG8_SB(0, 0), b2, voffB); PG8_STAGE(PG8_SB(0, 1), b2 + hstepB, voffB); PG8_STAGE(PG8_SA(0, 0), a2, voffA);
            PG8_WAIT_V(8); PG8_WAIT_L(0); PG8_BAR; PG8_MMA(1, 0, At, B0); PG8_MMA(1, 1, At, B1); PG8_BAR; PG8_SCHED;
            PG8_LDB(B0, 1, 0); PG8_LDB(B1, 1, 1); PG8_SCHED; PG8_LDA(At, 1, 0); PG8_STAGE(PG8_SA(0, 1), a2 + hstepA, voffA);
            PG8_WAIT_V(8); PG8_WAIT_L(0); PG8_BAR; PG8_MMA(0, 0, At, B0); PG8_MMA(0, 1, At, B1); PG8_BAR; PG8_SCHED;
            PG8_LDA(At, 1, 1); PG8_STAGE(PG8_SB(1, 0), b3, voffB); PG8_STAGE(PG8_SB(1, 1), b3 + hstepB, voffB); PG8_STAGE(PG8_SA(1, 0), a3, voffA);
            PG8_WAIT_V(8); PG8_WAIT_L(0); PG8_BAR; PG8_MMA(1, 0, At, B0); PG8_MMA(1, 1, At, B1); PG8_BAR; PG8_SCHED;
            } else {
            PG8_LDB(B0, 0, 0); PG8_SCHED; PG8_LDA(At, 0, 0); PG8_STAGE(PG8_SA(1, 1), a1 + hstepA, voffA);
            PG8_WAIT_L(8); PG8_BAR; PG8_WAIT_L(0); PG8_MMA(0, 0, At, B0); PG8_BAR; PG8_SCHED;
            PG8_LDB(B1, 0, 1); PG8_STAGE(PG8_SB(0, 0), b2, voffB);
            PG8_BAR; PG8_WAIT_L(0); PG8_MMA(0, 1, At, B1); PG8_BAR;
            PG8_LDA(At, 0, 1); PG8_STAGE(PG8_SA(0, 0), a2, voffA);
            PG8_BAR; PG8_WAIT_L(0); PG8_MMA(1, 0, At, B0); PG8_BAR; PG8_SCHED;
            PG8_STAGE(PG8_SB(0, 1), b2 + hstepB, voffB);
            PG8_WAIT_V(6); PG8_BAR; PG8_MMA(1, 1, At, B1); PG8_BAR;
            PG8_LDB(B0, 1, 0); PG8_SCHED; PG8_LDA(At, 1, 0); PG8_STAGE(PG8_SA(0, 1), a2 + hstepA, voffA);
            PG8_WAIT_L(8); PG8_BAR; PG8_WAIT_L(0); PG8_MMA(0, 0, At, B0); PG8_BAR; PG8_SCHED;
            PG8_LDB(B1, 1, 1); PG8_STAGE(PG8_SB(1, 0), b3, voffB);
            PG8_BAR; PG8_WAIT_L(0); PG8_MMA(0, 1, At, B1); PG8_BAR;
            PG8_LDA(At, 1, 1); PG8_STAGE(PG8_SA(1, 0), a3, voffA);
            PG8_BAR; PG8_WAIT_L(0); PG8_MMA(1, 0, At, B0); PG8_BAR; PG8_SCHED;
            PG8_STAGE(PG8_SB(1, 1), b3 + hstepB, voffB);
            PG8_WAIT_V(6); PG8_BAR; PG8_MMA(1, 1, At, B1); PG8_BAR;
            }
        }
        if constexpr (ALIGN_EPI) { if (wr == 0) PG8_BAR; }
        if constexpr (!Epi::AFTER_DRAIN) { E(acc, cur, wr, wc, fr, fq); S.done(cur); }
        if (!has_next) break;
#pragma unroll
        for (int a = 0; a < 2; ++a)
#pragma unroll
            for (int b = 0; b < 2; ++b)
#pragma unroll
                for (int m = 0; m < 4; ++m)
#pragma unroll
                    for (int n = 0; n < 2; ++n) acc[a][b][m][n] = (f32x4){0.f, 0.f, 0.f, 0.f};
        cur = nxt; cA = nA; cB = nB; ++ui;
        if constexpr (ALIGN_EPI) { if (wr == 1) PG8_BAR; }
    }
    PG8_WAIT_V(0);
    if constexpr (!ALIGN_EPI) { if (wr == 0) PG8_BAR; }
    PG8_BAR;
    if constexpr (Epi::AFTER_DRAIN) { E.fused(acc, cur, wr, wc, fr, fq, lds, wid, lane); S.done(cur); }
#undef PG8_SA
#undef PG8_SB
#undef PG8_STAGE
#undef PG8_LDA
#undef PG8_LDB
#undef PG8_MMA
#undef PG8_WAIT_V
#undef PG8_WAIT_L
#undef PG8_BAR
#undef PG8_SCHED
}

}

constexpr int NWAVES = 8;
constexpr int BATCH = 4, SEQ = 4096, DM = 2048, M = BATCH * SEQ;
constexpr int DI = 4096, HD = 64, NH = 64, NG = 8, HPG = 8, NS = 128, CONVK = 4;
constexpr int CONV_DIM = DI + 2 * NG * NS;
constexpr int SSM_IN = DI + CONV_DIM + NH;
constexpr int N1 = DI + CONV_DIM;
constexpr int BCW = 2 * NG * NS;
constexpr int DP = 4096, PG = 4, PGD = 1024;
constexpr float EPS = 1e-6f;

constexpr size_t MiB = 1u << 20;
constexpr size_t WS_CTL = 0, CTL_ZERO_BYTES = 64 * 1024;
constexpr size_t WS_DT  = 1 * MiB;
constexpr size_t WS_W1T = 5 * MiB;
constexpr size_t WS_W2T = 46 * MiB;
constexpr size_t WS_W3T = 62 * MiB;
constexpr size_t WS_W4T = 94 * MiB;
constexpr size_t WS_W5T = 102 * MiB;
constexpr size_t WS_RA  = 120 * MiB;
constexpr size_t WS_RB  = 248 * MiB;
constexpr size_t WS_RC  = 440 * MiB;
constexpr size_t WS_SSQP = 504 * MiB;
constexpr size_t WS_END = 512 * MiB;
static_assert(WS_W1T + (size_t)SSM_IN * DM * 2 <= WS_W2T && WS_W2T + (size_t)DM * DI * 2 <= WS_W3T && WS_W3T + (size_t)2 * DP * DM * 2 <= WS_W4T && WS_W4T + (size_t)DP * PGD * 2 <= WS_W5T && WS_W5T + (size_t)DM * DP * 2 <= WS_RA, "weights map");
static_assert(WS_RA + (size_t)M * DI * 2 <= WS_RB && WS_RB + (size_t)M * CONV_DIM * 2 <= WS_RC && WS_RC + (size_t)M * DM * 2 <= WS_END && WS_RB + 128 * MiB + (size_t)M * DP * 2 <= WS_END, "activation map");
constexpr int CW_TMO = 64, CW_FIN = 8192;
constexpr int CW_BAR = 4096;
constexpr int CW_SSQ1 = 16384, CW_SSQ2 = CW_SSQ1 + M, CW_SSQ3 = CW_SSQ2 + M;
static_assert((CW_SSQ3 + M) * 4 <= (int)(1 * MiB) && CW_SSQ1 * 4 >= (int)CTL_ZERO_BYTES && (CW_FIN + 64 * 64) * 4 <= (int)CTL_ZERO_BYTES && (CW_BAR + 3456) * 4 <= (int)CTL_ZERO_BYTES, "CTL map: counters inside the memset region, statistics inside the 1 MiB control area");

constexpr int RING_OFF = 0, RING_BYTES = 161792;
constexpr int LDSCTL_OFF = RING_BYTES, MISC_OFF = LDSCTL_OFF + 320;
constexpr int LDS_BYTES = 163840;
static_assert(MISC_OFF + 128 <= LDS_BYTES, "LDS map");

#define LAS __attribute__((address_space(3)))
typedef unsigned short bf16;
typedef unsigned v4u __attribute__((ext_vector_type(4)));
typedef unsigned v2u __attribute__((ext_vector_type(2)));
typedef float f32x4 __attribute__((ext_vector_type(4)));
typedef short bf16x8 __attribute__((ext_vector_type(8)));
#define LDS_WAIT() asm volatile("s_waitcnt lgkmcnt(0)" ::: "memory")
#define VM_WAIT() asm volatile("s_waitcnt vmcnt(0)" ::: "memory")
__device__ __forceinline__ unsigned f2bf(float f) { unsigned u = __builtin_bit_cast(unsigned, f); return (u + 0x7fffu + ((u >> 16) & 1u)) >> 16; }
__device__ __forceinline__ unsigned pk2(float lo, float hi) { return f2bf(lo) | (f2bf(hi) << 16); }
__device__ __forceinline__ float bflo(unsigned w) { return __uint_as_float(w << 16); }
__device__ __forceinline__ float bfhi(unsigned w) { return __uint_as_float(w & 0xffff0000u); }
__device__ __forceinline__ float bf1(bf16 v) { return __uint_as_float(((unsigned)v) << 16); }
__device__ __forceinline__ float sigm(float v) { return __builtin_amdgcn_rcpf(1.0f + __builtin_amdgcn_exp2f(-1.4426950408889634f * v)); }
__device__ __forceinline__ float wave_sum(float v) {
#pragma unroll
    for (int o = 1; o < 64; o <<= 1) v += __shfl_xor(v, o);
    return v;
}

#define XB_TMO      128
#define XB_XCNT(j)  (256  + 64 * (j))
#define XB_XSUB(j)  (1280 + 64 * (j))
#define XB_XGEN(j)  (2304 + 64 * (j))
#define XB_TOP      3328
#define XB_TOPGEN   3392
#define XCD_BAR_WORDS 3456
#define XB_SPIN_CAP (1u << 18)

__device__ __forceinline__ unsigned xb_ld(unsigned* p)              { return __hip_atomic_load(p, __ATOMIC_RELAXED, __HIP_MEMORY_SCOPE_AGENT); }
__device__ __forceinline__ unsigned xb_add(unsigned* p, unsigned v) { return __hip_atomic_fetch_add(p, v, __ATOMIC_RELAXED, __HIP_MEMORY_SCOPE_AGENT); }
__device__ __forceinline__ unsigned xb_xcc_id() { return (unsigned)__builtin_amdgcn_s_getreg((3 << 11) | 20) & 0xFu; }
#define XB_SPIN(cond, bar) do { unsigned _sp = 0; while (cond) { __builtin_amdgcn_s_sleep(1); \
    if ((++_sp & 255u) == 0u) { if (xb_ld(&(bar)[XB_TMO])) break; if (_sp > XB_SPIN_CAP) { atomicAdd(&(bar)[XB_TMO], 1u); break; } } } } while (0)

struct XcdBarrier {
    unsigned* bar; unsigned x;
    volatile LAS unsigned* st;
};

__device__ __forceinline__ XcdBarrier xcd_barrier_post(unsigned* bar, volatile LAS unsigned* st) {
    XcdBarrier b; b.bar = bar; b.x = xb_xcc_id(); b.st = st;
    if (threadIdx.x == 0) (void)xb_add(&bar[XB_XCNT(b.x)], 1u);
    return b;
}
__device__ __forceinline__ void xcd_barrier_complete(unsigned* bar, unsigned x, unsigned& nloc, unsigned& nx) {
    const unsigned G = gridDim.x * gridDim.y * gridDim.z;
    unsigned sum, cnt, mine, sp = 0u;
    for (;;) {
        sum = 0u; cnt = 0u; mine = 0u;
#pragma unroll
        for (unsigned j = 0; j < 16; ++j) { const unsigned c = xb_ld(&bar[XB_XCNT(j)]); sum += c; cnt += (c > 0u) ? 1u : 0u; mine = (j == x) ? c : mine; }
        if (sum == G) break;
        __builtin_amdgcn_s_sleep(1);
        if ((++sp & 255u) == 0u) { if (xb_ld(&bar[XB_TMO])) break; if (sp > XB_SPIN_CAP) { atomicAdd(&bar[XB_TMO], 1u); break; } }
    }
    nloc = mine > 0u ? mine : 1u; nx = cnt > 0u ? cnt : 1u;
}

__device__ __forceinline__ void xcd_barrier(const XcdBarrier& b) {
    asm volatile("s_waitcnt vmcnt(0)" ::: "memory");
    __syncthreads();
    if (threadIdx.x == 0) {
        unsigned* bar = b.bar;
        __builtin_amdgcn_s_waitcnt(0);
        unsigned nloc = b.st[0], nx = b.st[1];
        if (nloc == 0u) { xcd_barrier_complete(bar, b.x, nloc, nx); b.st[0] = nloc; b.st[1] = nx; }
        const unsigned old = xb_add(&bar[XB_XSUB(b.x)], 1u);
        const unsigned gen = old / nloc;
        if (old + 1u == (gen + 1u) * nloc) {
            __builtin_amdgcn_fence(__ATOMIC_RELEASE, "agent");
            asm volatile("s_waitcnt vmcnt(0)" ::: "memory");
            const unsigned og = xb_add(&bar[XB_TOP], 1u);
            const unsigned tg = og / nx;
            if (og + 1u == (tg + 1u) * nx) xb_add(&bar[XB_TOPGEN], 1u);
            else XB_SPIN(xb_ld(&bar[XB_TOPGEN]) == tg, bar);
            __builtin_amdgcn_fence(__ATOMIC_ACQUIRE, "agent");
            xb_add(&bar[XB_XGEN(b.x)], 1u);
            asm volatile("s_waitcnt vmcnt(0)" ::: "memory");
        } else {
            XB_SPIN(xb_ld(&bar[XB_XGEN(b.x)]) == gen, bar);
            __builtin_amdgcn_fence(__ATOMIC_ACQUIRE, "agent");
            asm volatile("s_waitcnt vmcnt(0)" ::: "memory");
        }
    }
    __syncthreads();
}

struct Ctx { LAS unsigned char* lds; int tid, lane, wave, G, vcu; };

struct Ptrs {
    const float *x, *ln_g, *final_g, *ssm_w_in, *conv_w, *conv_b, *dt_bias, *a_log, *ssm_d, *norm_g, *ssm_w_out, *pool_w_in, *pool_w_group, *pool_scale, *pool_w_out;
    float* out; unsigned char* ws;
};

__device__ __forceinline__ void t_decode(const Ptrs& P, int it, const float*& src, const float*& gain, int& hasg, bf16*& dst, int& ldw, int& K) {
    constexpr int I1 = (DM / 64) * (SSM_IN / 32), I2 = (DI / 64) * (DM / 32), I3 = (DM / 64) * (DP / 32), I4G = (PGD / 64) * (PGD / 32), I4 = PG * I4G;
    const float* W; const float* g; bf16* WT; int N, row_off = 0, r = it;
    if (r < I1) { W = P.ssm_w_in; g = P.ln_g; K = DM; N = SSM_IN; ldw = SSM_IN; WT = (bf16*)(P.ws + WS_W1T); }
    else if ((r -= I1) < I2) { W = P.ssm_w_out; g = P.norm_g; K = DI; N = DM; ldw = DM; WT = (bf16*)(P.ws + WS_W2T); }
    else if ((r -= I2) < I3) { W = P.pool_w_in + DP; g = P.ln_g + DM; K = DM; N = DP; ldw = 2 * DP; WT = (bf16*)(P.ws + WS_W3T); row_off = DP; }
    else if ((r -= I3) < I4) { const int gi = r / I4G; r -= gi * I4G; W = P.pool_w_group + (size_t)gi * PGD * PGD; g = nullptr; K = PGD; N = PGD; ldw = PGD; WT = (bf16*)(P.ws + WS_W4T); row_off = gi * PGD; }
    else { r -= I4; W = P.pool_w_out; g = nullptr; K = DP; N = DM; ldw = DM; WT = (bf16*)(P.ws + WS_W5T); }
    const int nblk = N / 32, kb = r / nblk, nb = r - kb * nblk, k0 = 64 * kb, n0 = 32 * nb;
    src = W + (size_t)k0 * ldw + n0; hasg = g != nullptr; gain = (g ? g : P.ln_g) + k0;     dst = WT + (size_t)(row_off + n0) * K + k0;
}
__device__ __forceinline__ void t_load(const float* src, const float* gain, int ldw, int lane, f32x4 (&v)[8], f32x4 (&gv)[2]) {
#pragma unroll
    for (int i = 0; i < 8; ++i) { const int kk = 8 * i + (lane >> 3); v[i] = __builtin_nontemporal_load((const f32x4*)(src + (size_t)kk * ldw + 4 * (lane & 7))); }
    gv[0] = *(const f32x4*)(gain + 8 * (lane & 7)); gv[1] = *(const f32x4*)(gain + 8 * (lane & 7) + 4);
}
__device__ __forceinline__ void t_process(bf16* dst, int K, int lane, LAS float* scr, const f32x4 (&v)[8], const f32x4 (&gv)[2], int hasg) {
#pragma unroll
    for (int i = 0; i < 8; ++i) *(LAS f32x4*)(scr + (8 * i + (lane >> 3)) * 32 + (((lane & 7) ^ i) << 2)) = v[i];
    LDS_WAIT(); asm volatile("" ::: "memory");
    const f32x4 one = {1.f, 1.f, 1.f, 1.f}; const f32x4 g0 = hasg ? gv[0] : one, g1 = hasg ? gv[1] : one;
    const int c = lane & 7, nn = lane >> 3;
#pragma unroll
    for (int j = 0; j < 4; ++j) { const int n = nn + 8 * j; const LAS float* s = scr + (8 * c) * 32 + (((n >> 2) ^ c) << 2) + (n & 3);
        v4u o; o.x = pk2(s[0 * 32] * g0.x, s[1 * 32] * g0.y); o.y = pk2(s[2 * 32] * g0.z, s[3 * 32] * g0.w); o.z = pk2(s[4 * 32] * g1.x, s[5 * 32] * g1.y); o.w = pk2(s[6 * 32] * g1.z, s[7 * 32] * g1.w);
        *(v4u*)(dst + (size_t)n * K + 8 * c) = o; }
    LDS_WAIT(); asm volatile("" ::: "memory");
}
__device__ __forceinline__ void r_decode(const Ptrs& P, int r, const float*& src, bf16*& dst, float& scale, float*& ssq) {
    if (r < M) { src = P.x + (size_t)r * DM; dst = (bf16*)(P.ws + WS_RC) + (size_t)r * DM; scale = 1.0f; ssq = (float*)(P.ws + WS_CTL) + CW_SSQ1 + r; }
    else { const int rr = r - M, m = rr >> 1, hf = rr & 1; src = P.pool_w_in + (size_t)m * 2 * DP + hf * DM; dst = (bf16*)P.out + (size_t)m * DP + hf * DM; scale = P.ln_g[DM + m]; ssq = nullptr; }
}
__device__ __forceinline__ void r_load(const float* src, int lane, f32x4 (&v)[8]) {
#pragma unroll
    for (int j = 0; j < 8; ++j) v[j] = __builtin_nontemporal_load((const f32x4*)src + lane + 64 * j);
}
__device__ __forceinline__ void r_process(bf16* dst, float scale, float* ssq, int lane, const f32x4 (&v)[8]) {
    if (ssq) { float s = 0.f;
#pragma unroll
        for (int j = 0; j < 8; ++j) s += (v[j].x * v[j].x + v[j].y * v[j].y) + (v[j].z * v[j].z + v[j].w * v[j].w);
        s = wave_sum(s); if (lane == 0) *ssq = s; }
#pragma unroll
    for (int j = 0; j < 8; ++j) { v2u w; w.x = pk2(v[j].x * scale, v[j].y * scale); w.y = pk2(v[j].z * scale, v[j].w * scale); ((v2u*)dst)[lane + 64 * j] = w; }
}
__device__ __forceinline__ int t_map(int li, int mode) {
    constexpr int I1 = (DM / 64) * (SSM_IN / 32), I2 = (DI / 64) * (DM / 32), I3 = (DM / 64) * (DP / 32), I4 = PG * (PGD / 64) * (PGD / 32);
    return mode == 0 ? (li < I1 ? li : li + I2 + I3) : (li < I2 + I3 ? I1 + li : I1 + I4 + li);
}
__device__ __forceinline__ void prep_transposes(const Ctx& F, const Ptrs& P, int mode, int gw, int NGW) {
    LAS float* scr = (LAS float*)(F.lds + RING_OFF + F.wave * 16384);
    const int lane = F.lane;
    constexpr int I1 = (DM / 64) * (SSM_IN / 32), I2 = (DI / 64) * (DM / 32), I3 = (DM / 64) * (DP / 32), I4 = PG * (PGD / 64) * (PGD / 32), I5 = (DP / 64) * (DM / 32);
    const int NT = mode == 0 ? I1 + I4 : I2 + I3 + I5;
    if (gw >= NT) return;
    const int cnt = (NT - gw + NGW - 1) / NGW;
    const float *sA, *gA, *sB, *gB; bf16 *dA, *dB; int lA, kA, lB, kB, hA, hB; f32x4 vA[8], vB[8]; f32x4 fA[2], fB[2];
    t_decode(P, t_map(gw, mode), sA, gA, hA, dA, lA, kA); t_load(sA, gA, lA, lane, vA, fA);
    for (int j = 0; j < cnt; j += 2) {
        { const int jn = (j + 1 < cnt) ? j + 1 : cnt - 1; t_decode(P, t_map(gw + jn * NGW, mode), sB, gB, hB, dB, lB, kB); t_load(sB, gB, lB, lane, vB, fB); }
        t_process(dA, kA, lane, scr, vA, fA, hA);
        { const int jn = (j + 2 < cnt) ? j + 2 : cnt - 1; t_decode(P, t_map(gw + jn * NGW, mode), sA, gA, hA, dA, lA, kA); t_load(sA, gA, lA, lane, vA, fA); }
        if (j + 1 < cnt) t_process(dB, kB, lane, scr, vB, fB, hB);
    }
}
__device__ __forceinline__ void phase_prep(const Ctx& F, const Ptrs& P) {
    const int gw = F.vcu * NWAVES + F.wave, NGW = F.G * NWAVES, lane = F.lane;
    prep_transposes(F, P, 0, gw, NGW);
    {
        constexpr int NR = M + 2 * DM;
        const int cnt = (NR - gw + NGW - 1) / NGW;
        const float *sA, *sB; bf16 *dA, *dB; float cA, cB; float *qA, *qB; f32x4 vA[8], vB[8];
        r_decode(P, gw, sA, dA, cA, qA); r_load(sA, lane, vA);
        for (int j = 0; j < cnt; j += 2) {
            { const int jn = (j + 1 < cnt) ? j + 1 : cnt - 1; r_decode(P, gw + jn * NGW, sB, dB, cB, qB); r_load(sB, lane, vB); }
            r_process(dA, cA, qA, lane, vA);
            { const int jn = (j + 2 < cnt) ? j + 2 : cnt - 1; r_decode(P, gw + jn * NGW, sA, dA, cA, qA); r_load(sA, lane, vA); }
            if (j + 1 < cnt) r_process(dB, cB, qB, lane, vB);
        }
    }
}

__device__ __forceinline__ float softplus_f(float v) { return fmaxf(v, 0.f) + log1pf(expf(-fabsf(v))); }

__device__ __forceinline__ void phase_dt(const Ctx& F, const Ptrs& P) {
    const bf16* XB = (const bf16*)(P.ws + WS_RC); const bf16* WDT = (const bf16*)(P.ws + WS_W1T) + (size_t)N1 * DM;
    const float* ssq1 = (const float*)(P.ws + WS_CTL) + CW_SSQ1; float* DT = (float*)(P.ws + WS_DT);
    LAS float* part = (LAS float*)F.lds;
    const int w = F.wave, lane = F.lane, fr = lane & 15, fq = lane >> 4;
    for (int item = F.vcu; item < M / 64; item += F.G) {
        const int r0 = item * 64;
        f32x4 acc[4][4];
#pragma unroll
        for (int i = 0; i < 4; ++i)
#pragma unroll
            for (int j = 0; j < 4; ++j) acc[i][j] = (f32x4){0.f, 0.f, 0.f, 0.f};
        const bf16* ap = XB + (size_t)(r0 + fr) * DM + w * 256 + 8 * fq;
        const bf16* bp = WDT + (size_t)fr * DM + w * 256 + 8 * fq;
#pragma unroll
        for (int hf = 0; hf < 2; ++hf) {
            bf16x8 a[4][4], b[4][4];
#pragma unroll
            for (int ks = 0; ks < 4; ++ks)
#pragma unroll
                for (int t = 0; t < 4; ++t) { a[ks][t] = *(const bf16x8*)(ap + (size_t)(16 * t) * DM + 32 * (4 * hf + ks)); b[ks][t] = *(const bf16x8*)(bp + (size_t)(16 * t) * DM + 32 * (4 * hf + ks)); }
#pragma unroll
            for (int ks = 0; ks < 4; ++ks)
#pragma unroll
                for (int rt = 0; rt < 4; ++rt)
#pragma unroll
                    for (int ct = 0; ct < 4; ++ct) acc[rt][ct] = __builtin_amdgcn_mfma_f32_16x16x32_bf16(a[ks][rt], b[ks][ct], acc[rt][ct], 0, 0, 0);
        }
#pragma unroll
        for (int rt = 0; rt < 4; ++rt)
#pragma unroll
            for (int ct = 0; ct < 4; ++ct) *(LAS f32x4*)(part + (size_t)w * 4096 + (16 * ct + fr) * 64 + 16 * rt + 4 * fq) = acc[rt][ct];
        __syncthreads();
        {
            const int hd = F.tid & 63, rb = 8 * (F.tid >> 6);
            f32x4 s0 = (f32x4){0.f, 0.f, 0.f, 0.f}, s1 = s0;
#pragma unroll
            for (int pw = 0; pw < 8; ++pw) { s0 = s0 + *(const LAS f32x4*)(part + (size_t)pw * 4096 + hd * 64 + rb); s1 = s1 + *(const LAS f32x4*)(part + (size_t)pw * 4096 + hd * 64 + rb + 4); }
            const float bias = P.dt_bias[hd];
            const f32x4 q0 = *(const f32x4*)(ssq1 + r0 + rb), q1 = *(const f32x4*)(ssq1 + r0 + rb + 4);
            const float qq[8] = {q0.x, q0.y, q0.z, q0.w, q1.x, q1.y, q1.z, q1.w};
#pragma unroll
            for (int i = 0; i < 8; ++i) { const int row = r0 + rb + i; const float sc = rsqrtf(qq[i] * (1.0f / DM) + EPS); const float v = (i < 4 ? s0[i & 3] : s1[i & 3]) * sc + bias;
                DT[(size_t)row * NH + hd] = softplus_f(v); }
        }
        __syncthreads();
    }
}

constexpr int IMG_C = 0, IMG_B = 16384, IMG_BT = 32768, IMG_BYTES = 49152;
constexpr int SC_BYTES = 1024, CBT_BYTES = 10 * 512, BL_C = 0, BL_BT = 16384, BL_CBT = 32768, BL_SC = BL_CBT + CBT_BYTES, BLOB_BYTES = BL_SC + 8 * SC_BYTES;
constexpr int MAIN_BYTES = 32768 + SC_BYTES, HEAD_BYTES = CBT_BYTES + SC_BYTES;
constexpr int SL_MAIN = 0, SL_HEAD = 2 * MAIN_BYTES, SL_XT = SL_HEAD + 2 * HEAD_BYTES, SL_XWT = SL_XT + 2 * 8192, SL_P = SL_XWT + 2 * 8192, SL_YT = SL_P + 2 * 8192, SL_END = SL_YT + 2 * 16384;
static_assert(SL_END <= RING_BYTES, "SSD LDS map");
__device__ __forceinline__ int img256(int r, int c) { return r * 256 + ((c ^ (r & 15)) << 4); }
__device__ __forceinline__ int img128(int r, int c) { return r * 128 + ((c ^ ((r >> 1) & 7)) << 4); }
typedef __bf16 bf16x2_t __attribute__((ext_vector_type(2)));
typedef float f32x2_t __attribute__((ext_vector_type(2)));
__device__ __forceinline__ unsigned cvtpk(float lo, float hi) { f32x2_t v = {lo, hi}; bf16x2_t b = __builtin_convertvector(v, bf16x2_t); return __builtin_bit_cast(unsigned, b); }
#define RAW_BARRIER() do { asm volatile("s_waitcnt lgkmcnt(0)" ::: "memory"); __builtin_amdgcn_s_barrier(); asm volatile("" ::: "memory"); } while (0)

__device__ __forceinline__ void bc_load(const bf16* XBC, const float* DT, int unit, int isC, int n0, int tg, int wave, int lane, v4u (&raw)[7], float& dtv) {
    const int g = unit % NG, bc = unit / NG, c = bc % (SEQ / 64);
    const int ch = DI + isC * (NG * NS) + g * NS + n0;
    const size_t T0 = (size_t)bc * 64 + 4 * tg;
    const bool nohalo = (c == 0 && tg == 0);
#pragma unroll
    for (int k = 0; k < 7; ++k) { const size_t row = (k < 3 && nohalo) ? T0 : (T0 + k - 3); raw[k] = *(const v4u*)(XBC + row * CONV_DIM + ch); }
    dtv = DT[((size_t)bc * 64 + lane) * NH + g * HPG + wave];
}
__device__ __forceinline__ void bc_process(const Ctx& F, const Ptrs& P, unsigned char* IMGS, int unit, int isC, int n0, int tg, const float (&w)[4][8], const float (&bias)[8], const v4u (&rawv)[7], float dtv) {
    LAS unsigned char* L = F.lds;
    const int g = unit % NG, bc = unit / NG, c = bc % (SEQ / 64);
    const bool nohalo = (c == 0 && tg == 0);
    float raw[7][8];
#pragma unroll
    for (int k = 0; k < 7; ++k) { v4u rr = rawv[k];
        if (k < 3 && nohalo) { rr.x = 0u; rr.y = 0u; rr.z = 0u; rr.w = 0u; }
        raw[k][0] = bflo(rr.x); raw[k][1] = bfhi(rr.x); raw[k][2] = bflo(rr.y); raw[k][3] = bfhi(rr.y); raw[k][4] = bflo(rr.z); raw[k][5] = bfhi(rr.z); raw[k][6] = bflo(rr.w); raw[k][7] = bfhi(rr.w); }
    float o[4][8];
#pragma unroll
    for (int i = 0; i < 4; ++i)
#pragma unroll
        for (int j = 0; j < 8; ++j) { const float v = bias[j] + w[0][j] * raw[i][j] + w[1][j] * raw[i + 1][j] + w[2][j] * raw[i + 2][j] + w[3][j] * raw[i + 3][j]; o[i][j] = v * sigm(v); }
    const int ks = n0 >> 5, hi = (n0 >> 4) & 1, q0 = 2 * ((n0 >> 3) & 1);
    const int ibase = isC ? IMG_C : IMG_B;
#pragma unroll
    for (int i = 0; i < 4; ++i) { const int l = 4 * tg + i;
        v2u lo, hi2; lo.x = cvtpk(o[i][0], o[i][1]); lo.y = cvtpk(o[i][2], o[i][3]); hi2.x = cvtpk(o[i][4], o[i][5]); hi2.y = cvtpk(o[i][6], o[i][7]);
        *(LAS v2u*)(L + ibase + img256(l, 4 * ks + q0) + 8 * hi) = lo;
        *(LAS v2u*)(L + ibase + img256(l, 4 * ks + q0 + 1) + 8 * hi) = hi2; }
    if (!isC) {
#pragma unroll
        for (int e = 0; e < 8; ++e) { v2u t; t.x = cvtpk(o[0][e], o[1][e]); t.y = cvtpk(o[2][e], o[3][e]);
            *(LAS v2u*)(L + IMG_BT + img128(n0 + e, tg >> 1) + 8 * (tg & 1)) = t; }
    }
    RAW_BARRIER();
    unsigned char* blob = IMGS + (size_t)unit * BLOB_BYTES;
#pragma unroll
    for (int k = 0; k < 2; ++k) { const v4u vc = *(const LAS v4u*)(L + IMG_C + F.tid * 16 + k * 8192), vt = *(const LAS v4u*)(L + IMG_BT + F.tid * 16 + k * 8192);
        *(v4u*)(blob + BL_C + F.tid * 16 + k * 8192) = vc; *(v4u*)(blob + BL_BT + F.tid * 16 + k * 8192) = vt; }
    {
        const int w = F.wave, r = F.lane & 15, q = F.lane >> 4;
        const int lt0 = (w < 4) ? w : (w == 4) ? 1 : (w == 5) ? 2 : 3, st0 = (w < 4) ? w : (w == 4) ? 0 : (w == 7) ? 2 : 1;
#pragma unroll
        for (int tt = 0; tt < 2; ++tt) { if (tt == 1 && (w < 4 || w > 5)) break;
            const int lt = tt ? lt0 + 1 : lt0, st = tt ? 0 : st0;
            f32x4 cb = {0.f, 0.f, 0.f, 0.f};
#pragma unroll
            for (int ks = 0; ks < 4; ++ks) { const bf16x8 av = *(const LAS bf16x8*)(L + IMG_C + img256(16 * lt + r, 4 * ks + q)), bv = *(const LAS bf16x8*)(L + IMG_B + img256(16 * st + r, 4 * ks + q));
                cb = __builtin_amdgcn_mfma_f32_16x16x32_bf16(av, bv, cb, 0, 0, 0); }
            v2u cw2; cw2.x = cvtpk(cb[0], cb[1]); cw2.y = cvtpk(cb[2], cb[3]); *(v2u*)(blob + BL_CBT + (tt ? 8 + (w - 4) : w) * 512 + F.lane * 8) = cw2; }
    }
    {
        const int hh = g * HPG + F.wave; const float a = -expf(P.a_log[hh]);
        float cs = a * dtv;
        cs += __int_as_float(__builtin_amdgcn_update_dpp(0, __float_as_int(cs), 0x111, 0xF, 0xF, true));
        cs += __int_as_float(__builtin_amdgcn_update_dpp(0, __float_as_int(cs), 0x112, 0xF, 0xF, true));
        cs += __int_as_float(__builtin_amdgcn_update_dpp(0, __float_as_int(cs), 0x114, 0xF, 0xF, true));
        cs += __int_as_float(__builtin_amdgcn_update_dpp(0, __float_as_int(cs), 0x118, 0xF, 0xF, true));
        { const int ci = __float_as_int(cs); const float t0 = __int_as_float(__builtin_amdgcn_readlane(ci, 15)), t1 = __int_as_float(__builtin_amdgcn_readlane(ci, 31)), t2 = __int_as_float(__builtin_amdgcn_readlane(ci, 47));
          const int row = F.lane >> 4; cs += (row >= 1 ? t0 : 0.f) + (row >= 2 ? t1 : 0.f) + (row >= 3 ? t2 : 0.f); }
        const float last = __int_as_float(__builtin_amdgcn_readlane(__float_as_int(cs), 63));
        float* sc = (float*)(blob + BL_SC + F.wave * SC_BYTES);
        sc[F.lane] = dtv; sc[64 + F.lane] = cs; sc[128 + F.lane] = __expf(cs); sc[192 + F.lane] = dtv * __expf(last - cs);
    }
    RAW_BARRIER();
}
__device__ __forceinline__ void phase_bcprep(const Ctx& F, const Ptrs& P) {
    const bf16* XBC = (const bf16*)(P.ws + WS_RB); unsigned char* IMGS = (unsigned char*)P.out; const float* DT = (const float*)(P.ws + WS_DT);
    const int cg = F.tid & 31, tg = F.tid >> 5, isC = cg >> 4, n0 = 8 * (cg & 15);
    constexpr int NU = BATCH * (SEQ / 64) * NG;
    if (F.G % NG != 0 || F.vcu >= NU) return;
    const int g = F.vcu % NG, ch = DI + isC * (NG * NS) + g * NS + n0, cnt = (NU - F.vcu + F.G - 1) / F.G;
    float w[4][8], bias[8];
#pragma unroll
    for (int k = 0; k < 4; ++k) { const f32x4 a = *(const f32x4*)(P.conv_w + (size_t)k * CONV_DIM + ch), b = *(const f32x4*)(P.conv_w + (size_t)k * CONV_DIM + ch + 4);
        w[k][0] = a.x; w[k][1] = a.y; w[k][2] = a.z; w[k][3] = a.w; w[k][4] = b.x; w[k][5] = b.y; w[k][6] = b.z; w[k][7] = b.w; }
    { const f32x4 a = *(const f32x4*)(P.conv_b + ch), b = *(const f32x4*)(P.conv_b + ch + 4); bias[0] = a.x; bias[1] = a.y; bias[2] = a.z; bias[3] = a.w; bias[4] = b.x; bias[5] = b.y; bias[6] = b.z; bias[7] = b.w; }
    v4u rA[7], rB[7]; float dA, dB;
    bc_load(XBC, DT, F.vcu, isC, n0, tg, F.wave, F.lane, rA, dA);
    for (int j = 0; j < cnt; j += 2) {
        { const int jn = (j + 1 < cnt) ? j + 1 : cnt - 1; bc_load(XBC, DT, F.vcu + jn * F.G, isC, n0, tg, F.wave, F.lane, rB, dB); }
        bc_process(F, P, IMGS, F.vcu + j * F.G, isC, n0, tg, w, bias, rA, dA);
        { const int jn = (j + 2 < cnt) ? j + 2 : cnt - 1; bc_load(XBC, DT, F.vcu + jn * F.G, isC, n0, tg, F.wave, F.lane, rA, dA); }
        { const int jp = (j + 1 < cnt) ? j + 1 : cnt - 1; bc_process(F, P, IMGS, F.vcu + jp * F.G, isC, n0, tg, w, bias, rB, dB); }
    }
}

__device__ __forceinline__ int dpp_i(int v, const int ctrl_sel) { return ctrl_sel == 0 ? __builtin_amdgcn_update_dpp(0, v, 0xB1, 0xF, 0xF, false) : ctrl_sel == 1 ? __builtin_amdgcn_update_dpp(0, v, 0x4E, 0xF, 0xF, false) : __builtin_amdgcn_update_dpp(0, v, 0x141, 0xF, 0xF, false); }
__device__ __forceinline__ float dpp_add(float v, const int sel) { return v + __int_as_float(dpp_i(__float_as_int(v), sel)); }
struct ConvW { float a[4], b[4], ba, bb; };
struct PTile { v2u cbw; f32x4 csl; float cs_s, dt_s; };
__device__ __forceinline__ void ssd_p_load(PTile& t, const LAS unsigned char* CBT, const LAS float* SC, int slot, int lane, int lt, int st, int r, int q) {
    t.cbw = *(const LAS v2u*)(CBT + slot * 512 + lane * 8); t.csl = *(const LAS f32x4*)(SC + 64 + 16 * lt + 4 * q);
    const int s = 16 * st + r; t.cs_s = SC[64 + s]; t.dt_s = SC[s];
}
template <bool DIAG> __device__ __forceinline__ void ssd_p_make(LAS unsigned char* Pbuf, const PTile& t, int lt, int st, int r, int q, float Dh) {
    const float cb[4] = {bflo(t.cbw.x), bfhi(t.cbw.x), bflo(t.cbw.y), bfhi(t.cbw.y)};
    const int s = 16 * st + r;
#pragma unroll
    for (int rg = 0; rg < 4; ++rg) { const int l = 16 * lt + 4 * q + rg; float v;
        if (DIAG) { v = cb[rg] * __expf(fminf(t.csl[rg] - t.cs_s, 0.f)) * t.dt_s; v = (s <= l) ? v : 0.f; if (s == l) v += Dh; }
        else v = cb[rg] * __expf(t.csl[rg] - t.cs_s) * t.dt_s;
        *(LAS unsigned short*)(Pbuf + img128(l, s >> 3) + (s & 7) * 2) = (unsigned short)(cvtpk(v, 0.f) & 0xffffu); }
}
__device__ __forceinline__ void ssd_head(LAS unsigned char* L, int par, int hpar, bool first_chunk, const unsigned (&xr)[7], int w, int lane, int r, int q, const ConvW& cw, float Dh) {
    const LAS unsigned char* HD = L + SL_HEAD + hpar * HEAD_BYTES; const LAS float* SC = (const LAS float*)(HD + CBT_BYTES);
    const int cp = lane & 31, hf = lane >> 5;
    const f32x4 wv4 = *(const LAS f32x4*)(SC + 192 + 8 * w + 4 * hf);
    const int lt1 = (w < 4) ? w : (w == 4) ? 1 : (w == 5) ? 2 : 3, st1 = (w < 4) ? w : (w == 4) ? 0 : (w == 7) ? 2 : 1;
    PTile t1, t2;
    ssd_p_load(t1, HD, SC, w, lane, lt1, st1, r, q);
    ssd_p_load(t2, HD, SC, (w == 4 || w == 5) ? 8 + (w - 4) : w, lane, (w == 4 || w == 5) ? lt1 + 1 : lt1, (w == 4 || w == 5) ? 0 : st1, r, q);
    __builtin_amdgcn_sched_barrier(0);
    {
        float xa[7], xc[7];
#pragma unroll
        for (int k = 0; k < 7; ++k) { const bool zpad = first_chunk && w == 0 && hf == 0 && k < 3; xa[k] = zpad ? 0.f : bflo(xr[k]); xc[k] = zpad ? 0.f : bfhi(xr[k]); }
        float oa[4], oc[4], wa[4], wc[4];
#pragma unroll
        for (int i = 0; i < 4; ++i) { const float va = cw.ba + cw.a[0] * xa[i] + cw.a[1] * xa[i + 1] + cw.a[2] * xa[i + 2] + cw.a[3] * xa[i + 3], vc = cw.bb + cw.b[0] * xc[i] + cw.b[1] * xc[i + 1] + cw.b[2] * xc[i + 2] + cw.b[3] * xc[i + 3];
            oa[i] = va * sigm(va); oc[i] = vc * sigm(vc); wa[i] = oa[i] * wv4[i]; wc[i] = oc[i] * wv4[i]; }
        v2u t; LAS unsigned char* XTb = L + SL_XT + par * 8192; LAS unsigned char* XWb = L + SL_XWT + par * 8192;
        const int o0 = img128(2 * cp, w) + 8 * hf, o1 = img128(2 * cp + 1, w) + 8 * hf;
        t.x = cvtpk(oa[0], oa[1]); t.y = cvtpk(oa[2], oa[3]); *(LAS v2u*)(XTb + o0) = t;
        t.x = cvtpk(oc[0], oc[1]); t.y = cvtpk(oc[2], oc[3]); *(LAS v2u*)(XTb + o1) = t;
        t.x = cvtpk(wa[0], wa[1]); t.y = cvtpk(wa[2], wa[3]); *(LAS v2u*)(XWb + o0) = t;
        t.x = cvtpk(wc[0], wc[1]); t.y = cvtpk(wc[2], wc[3]); *(LAS v2u*)(XWb + o1) = t;
    }
    LAS unsigned char* Pb = L + SL_P + par * 8192;
    if (w < 4) ssd_p_make<true>(Pb, t1, w, w, r, q, Dh);
    else { ssd_p_make<false>(Pb, t1, lt1, st1, r, q, Dh);
        if (w < 6) ssd_p_make<false>(Pb, t2, lt1 + 1, 0, r, q, Dh); }
}
__device__ __forceinline__ void ssd_mfma(LAS unsigned char* L, int par, f32x4 (&st)[4], int lane, int r, int q, int pt, int nh, const int (&ay)[2], int ap, const int (&a128)[2]) {
    const LAS unsigned char* IC = L + SL_MAIN + par * MAIN_BYTES; const LAS unsigned char* IBT = IC + 16384 + 8192 * nh; const LAS float* SC = (const LAS float*)(IC + 32768);
    const LAS unsigned char* XTb = L + SL_XT + par * 8192; const LAS unsigned char* XWb = L + SL_XWT + par * 8192; const LAS unsigned char* Pb = L + SL_P + par * 8192;
    bf16x8 yav[2][4], xwb[2], bav[2][4], pa[4]; f32x4 ev4[4];
#pragma unroll
    for (int ks = 0; ks < 2; ++ks)
#pragma unroll
        for (int lt = 0; lt < 4; ++lt) yav[ks][lt] = *(const LAS bf16x8*)(IC + 4096 * lt + ay[ks]);
    const float elast = SC[128 + 63];
#pragma unroll
    for (int lt = 0; lt < 4; ++lt) ev4[lt] = *(const LAS f32x4*)(SC + 128 + 16 * lt + 4 * q);
    const bf16x8 xb = *(const LAS bf16x8*)(XTb + 2048 * pt + ap);
#pragma unroll
    for (int lt = 0; lt < 4; ++lt) pa[lt] = *(const LAS bf16x8*)(Pb + 2048 * lt + ap);
    __builtin_amdgcn_sched_barrier(0);
    f32x4 acc[4];
    {
        bf16x8 sb[2];
#pragma unroll
        for (int ks = 0; ks < 2; ++ks) { v4u sbw; sbw.x = cvtpk(st[2 * ks][0], st[2 * ks][1]); sbw.y = cvtpk(st[2 * ks][2], st[2 * ks][3]); sbw.z = cvtpk(st[2 * ks + 1][0], st[2 * ks + 1][1]); sbw.w = cvtpk(st[2 * ks + 1][2], st[2 * ks + 1][3]);
            sb[ks] = __builtin_bit_cast(bf16x8, sbw); }
#pragma unroll
        for (int lt = 0; lt < 4; ++lt) { acc[lt] = (f32x4){0.f, 0.f, 0.f, 0.f};
#pragma unroll
            for (int ks = 0; ks < 2; ++ks) acc[lt] = __builtin_amdgcn_mfma_f32_16x16x32_bf16(yav[ks][lt], sb[ks], acc[lt], 0, 0, 0); }
    }
#pragma unroll
    for (int ks = 0; ks < 2; ++ks) { xwb[ks] = *(const LAS bf16x8*)(XWb + 2048 * pt + a128[ks]);
#pragma unroll
        for (int j = 0; j < 4; ++j) bav[ks][j] = *(const LAS bf16x8*)(IBT + 2048 * j + a128[ks]); }
    __builtin_amdgcn_sched_barrier(0);
#pragma unroll
    for (int lt = 0; lt < 4; ++lt) acc[lt] = acc[lt] * ev4[lt];
#pragma unroll
    for (int j = 0; j < 4; ++j) st[j] = st[j] * elast;
#pragma unroll
    for (int lt = 0; lt < 4; ++lt) acc[lt] = __builtin_amdgcn_mfma_f32_16x16x32_bf16(pa[lt], xb, acc[lt], 0, 0, 0);
#pragma unroll
    for (int ks = 0; ks < 2; ++ks)
#pragma unroll
        for (int j = 0; j < 4; ++j) st[j] = __builtin_amdgcn_mfma_f32_16x16x32_bf16(bav[ks][j], xwb[ks], st[j], 0, 0, 0);
#pragma unroll
    for (int lt = 0; lt < 4; ++lt) { const int p = 16 * pt + r; v2u yw; yw.x = cvtpk(acc[lt][0], acc[lt][1]); yw.y = cvtpk(acc[lt][2], acc[lt][3]);
        *(LAS v2u*)(L + SL_YT + par * 16384 + nh * 8192 + img128(p, 2 * lt + (q >> 1)) + 8 * (q & 1)) = yw; }
}
__device__ __forceinline__ void ssd_epi(const LAS unsigned char* L, int par, const unsigned (&zr)[4], int w, int lane, unsigned (&ob)[4], float& s1) {
    const int cp = lane & 31, hf = lane >> 5;
    const LAS unsigned char* Y0 = L + SL_YT + par * 16384; const int oa = img128(2 * cp, w) + 8 * hf, oc = img128(2 * cp + 1, w) + 8 * hf;
    const v2u ya = *(const LAS v2u*)(Y0 + oa), yc = *(const LAS v2u*)(Y0 + oc), yb = *(const LAS v2u*)(Y0 + 8192 + oa), yd = *(const LAS v2u*)(Y0 + 8192 + oc);
    const float y0[4] = {bflo(ya.x) + bflo(yb.x), bfhi(ya.x) + bfhi(yb.x), bflo(ya.y) + bflo(yb.y), bfhi(ya.y) + bfhi(yb.y)}, y1[4] = {bflo(yc.x) + bflo(yd.x), bfhi(yc.x) + bfhi(yd.x), bflo(yc.y) + bflo(yd.y), bfhi(yc.y) + bfhi(yd.y)};
    float sq[4];
#pragma unroll
    for (int i = 0; i < 4; ++i) { const float za = bflo(zr[i]), zc = bfhi(zr[i]); const float ga = y0[i] * (za * sigm(za)), gc = y1[i] * (zc * sigm(zc)); sq[i] = ga * ga + gc * gc; ob[i] = cvtpk(ga, gc); }
    float s2[2];
#pragma unroll
    for (int k2 = 0; k2 < 2; ++k2) { const auto sw = __builtin_amdgcn_permlane16_swap(__float_as_uint(sq[k2]), __float_as_uint(sq[2 + k2]), false, false);
        s2[k2] = __uint_as_float(sw[0]) + __uint_as_float(sw[1]); }
    { const bool hi = (lane & 8) != 0; const float send = hi ? s2[0] : s2[1], keep = hi ? s2[1] : s2[0]; s1 = keep + __int_as_float(__builtin_amdgcn_update_dpp(0, __float_as_int(send), 0x128  , 0xF, 0xF, false)); }
    s1 = dpp_add(s1, 0); s1 = dpp_add(s1, 1); s1 = dpp_add(s1, 2);
}
__device__ __forceinline__ void ssd_dma_main(const Ctx& F, const unsigned char* blob_c, int hsub, int w, int lane, int par) {
    LAS unsigned char* dst = F.lds + SL_MAIN + par * MAIN_BYTES;
#pragma unroll
    for (int k = 0; k < 4; ++k) { const int piece = k * 8 + w; __builtin_amdgcn_global_load_lds((const unsigned*)(blob_c + BL_C + piece * 1024) + lane * 4, (LAS unsigned*)(dst + piece * 1024), 16, 0, 0); }
    if (w == 0) __builtin_amdgcn_global_load_lds((const unsigned*)(blob_c + BL_SC + hsub * SC_BYTES) + lane * 4, (LAS unsigned*)(dst + 32768), 16, 0, 0);
}
__device__ __forceinline__ void ssd_dma_head(const Ctx& F, const unsigned char* blob_c, int hsub, int w, int lane, int par) {
    LAS unsigned char* dst = F.lds + SL_HEAD + par * HEAD_BYTES;
    if (w < 5) __builtin_amdgcn_global_load_lds((const unsigned*)(blob_c + BL_CBT + w * 1024) + lane * 4, (LAS unsigned*)(dst + w * 1024), 16, 0, 0);
    if (w == 5) __builtin_amdgcn_global_load_lds((const unsigned*)(blob_c + BL_SC + hsub * SC_BYTES) + lane * 4, (LAS unsigned*)(dst + CBT_BYTES), 16, 0, 0);
}
template <bool DRY> __device__ __forceinline__ void phase_ssd(const Ctx& F, const Ptrs& P) {
    const bf16* XBC = (const bf16*)(P.ws + WS_RB); bf16* Z = (bf16*)(P.ws + WS_RA);
    float* ssqp = (float*)(P.ws + WS_SSQP); const unsigned char* IMGS = (const unsigned char*)P.out;
    LAS unsigned char* L = F.lds;
    const int w = F.wave, lane = F.lane, r = lane & 15, q = lane >> 4, pt = w & 3, nh = w >> 2;
    constexpr int NC = SEQ / 64;
    for (int unit = F.vcu; unit < BATCH * NH; unit += F.G) {
        const int b = unit / NH, h = unit % NH, g = h / HPG, hsub = h % HPG, cp = lane & 31, hf = lane >> 5, ch = h * HD + 2 * cp;
        const float Dh = P.ssm_d[h];
        ConvW cw;
#pragma unroll
        for (int t = 0; t < 4; ++t) { cw.a[t] = P.conv_w[t * CONV_DIM + ch]; cw.b[t] = P.conv_w[t * CONV_DIM + ch + 1]; }
        cw.ba = P.conv_b[ch]; cw.bb = P.conv_b[ch + 1];
        const unsigned char* blob0 = IMGS + ((size_t)b * NC * NG + g) * BLOB_BYTES;
        const bf16* x0 = XBC + ((size_t)b * SEQ + 8 * w + 4 * hf) * CONV_DIM + h * HD + 2 * cp;
        bf16* z0 = Z + ((size_t)b * SEQ + 8 * w + 4 * hf) * DI + h * HD + 2 * cp;
        const __amdgpu_buffer_rsrc_t rx = __builtin_amdgcn_make_buffer_rsrc((void*)XBC, 0, (int)((size_t)M * CONV_DIM * 2), 0x00020000), rz = __builtin_amdgcn_make_buffer_rsrc((void*)Z, 0, (int)((size_t)M * DI * 2), 0x00020000);
        const unsigned xs0 = (unsigned)((((size_t)b * SEQ + 8 * w) * CONV_DIM + h * HD) * 2), zs0 = (unsigned)((((size_t)b * SEQ + 8 * w) * DI + h * HD) * 2);
        const int xvo = cp * 4 + hf * (4 * CONV_DIM * 2), zvo = cp * 4 + hf * (4 * DI * 2);
        f32x4 st[4];
#pragma unroll
        for (int j = 0; j < 4; ++j) st[j] = (f32x4){0.f, 0.f, 0.f, 0.f};
        int a256[4], a128[2];
#pragma unroll
        for (int ks = 0; ks < 4; ++ks) a256[ks] = img256(r, 4 * ks + q);
#pragma unroll
        for (int ks = 0; ks < 2; ++ks) a128[ks] = img128(r, 4 * ks + q);
        const int ay[2] = {nh ? a256[2] : a256[0], nh ? a256[3] : a256[1]}; const int ap = nh ? a128[1] : a128[0];
        {
          const int l = F.tid >> 3, cch = F.tid & 7; unsigned zz = 0u; asm volatile("" : "+v"(zz));
          if ((cch >> 1) > (l >> 4)) { *(LAS v4u*)(L + SL_P + img128(l, cch)) = (v4u){zz, zz, zz, zz}; *(LAS v4u*)(L + SL_P + 8192 + img128(l, cch)) = (v4u){zz, zz, zz, zz}; } }
        unsigned xr[7], zr[4];
        {
            unsigned x0r[7], x1r[7];
            ssd_dma_main(F, blob0, hsub, w, lane, 0); ssd_dma_head(F, blob0, hsub, w, lane, 0); ssd_dma_head(F, blob0 + (size_t)NG * BLOB_BYTES, hsub, w, lane, 1);
#pragma unroll
            for (int k = 0; k < 7; ++k) { x0r[k] = *(const unsigned*)(x0 + (long)(k - 3) * CONV_DIM); x1r[k] = *(const unsigned*)(x0 + (long)(64 + k - 3) * CONV_DIM); }
            asm volatile("s_waitcnt vmcnt(0)" ::: "memory");
#pragma unroll
            for (int k = 0; k < 7; ++k) { asm volatile("v_mov_b32 %0, %1" : "=v"(xr[k]) : "v"(x1r[k])); asm volatile("" : "+v"(x0r[k])); }
#pragma unroll
            for (int i = 0; i < 4; ++i) zr[i] = 0u;
            RAW_BARRIER();
            ssd_head(L, 0, 0, true, x0r, w, lane, r, q, cw, Dh);
            RAW_BARRIER();
        }
        for (int j = 0; j < NC; ++j) {
            unsigned nxr[7], nzr[4];
#define SSD_ISSUE()             { \
                const int c1 = (j + 1 < NC) ? j + 1 : j, c2 = (j + 2 < NC) ? j + 2 : NC - 1; \
                ssd_dma_main(F, blob0 + (size_t)c1 * NG * BLOB_BYTES, hsub, w, lane, (j + 1) & 1); \
                if (j + 2 < NC) ssd_dma_head(F, blob0 + (size_t)c2 * NG * BLOB_BYTES, hsub, w, lane, j & 1); \
                const unsigned xso = xs0 + (unsigned)(c2 * 64 - 3) * (CONV_DIM * 2), zso = zs0 + (unsigned)(j * 64) * (DI * 2); \
_Pragma("unroll") \
                for (int k = 0; k < 7; ++k) nxr[k] = __builtin_amdgcn_raw_buffer_load_b32(rx, xvo, xso + k * (CONV_DIM * 2), 0); \
_Pragma("unroll") \
                for (int i = 0; i < 4; ++i) nzr[i] = __builtin_amdgcn_raw_buffer_load_b32(rz, zvo, zso + i * (DI * 2), 0); \
            }
            const int igrp = w % 3;
            if (igrp == 0) SSD_ISSUE()
            unsigned eob[4]; float es1;
            ssd_epi(L, (j + 1) & 1, zr, w, lane, eob, es1);
            if (igrp == 1) SSD_ISSUE()
            __builtin_amdgcn_s_setprio(2); ssd_mfma(L, j & 1, st, lane, r, q, pt, nh, ay, ap, a128); __builtin_amdgcn_s_setprio(0);
            if (igrp == 2) SSD_ISSUE()
            { const int d = (j + 1 < NC) ? j + 1 : j; ssd_head(L, (j + 1) & 1, d & 1, false, xr, w, lane, r, q, cw, Dh); }
            asm volatile("s_waitcnt vmcnt(0)" ::: "memory");
#pragma unroll
            for (int k2 = 0; k2 < 7; ++k2) asm volatile("v_mov_b32 %0, %1" : "=v"(xr[k2]) : "v"(nxr[k2]));
#pragma unroll
            for (int k2 = 0; k2 < 4; ++k2) asm volatile("v_mov_b32 %0, %1" : "=v"(zr[k2]) : "v"(nzr[k2]));
            if (j > 0) {
                const unsigned zso = zs0 + (unsigned)((j - 1) * 64) * (DI * 2);
#pragma unroll
                for (int i = 0; i < 4; ++i) if (!DRY || es1 == 1.2345e30f) __builtin_amdgcn_raw_buffer_store_b32(eob[i], rz, zvo, zso + i * (DI * 2), 0);
                if ((lane & 7) == 0 && (!DRY || es1 == 1.2345e30f)) { const int i = 4 * (lane >> 5) + 2 * ((lane >> 4) & 1) + ((lane >> 3) & 1); ssqp[((size_t)b * SEQ + (j - 1) * 64 + 8 * w + i) * NH + h] = es1; }
            }
            RAW_BARRIER();
        }
        {
            unsigned ob[4]; float s1;
            ssd_epi(L, (NC - 1) & 1, zr, w, lane, ob, s1);
            bf16* zc = z0 + (size_t)(NC - 1) * 64 * DI;
#pragma unroll
            for (int i = 0; i < 4; ++i) if (!DRY || s1 == 1.2345e30f) *(unsigned*)(zc + (long)i * DI) = ob[i];
            if ((lane & 7) == 0 && (!DRY || s1 == 1.2345e30f)) { const int i = 4 * (lane >> 5) + 2 * ((lane >> 4) & 1) + ((lane >> 3) & 1); ssqp[((size_t)b * SEQ + (NC - 1) * 64 + 8 * w + i) * NH + h] = s1; }
        }
        asm volatile("s_waitcnt vmcnt(0)" ::: "memory"); RAW_BARRIER();
    }
}

template <int N> __device__ __forceinline__ void pool_prefill(const bf16* vrow, float (&s)[8]) {
    v4u r[N];
#pragma unroll
    for (int d = 0; d < N; ++d) r[d] = *(const v4u*)(vrow - (size_t)(d + 1) * DP);
#pragma unroll
    for (int d = 0; d < N; ++d) { s[0] += bflo(r[d].x); s[1] += bfhi(r[d].x); s[2] += bflo(r[d].y); s[3] += bfhi(r[d].y); s[4] += bflo(r[d].z); s[5] += bfhi(r[d].z); s[6] += bflo(r[d].w); s[7] += bfhi(r[d].w); }
}
__device__ __forceinline__ void phase_pool(const Ctx& F, const Ptrs& P) {
    const bf16* V = (const bf16*)(P.ws + WS_RA); const bf16* GT = (const bf16*)(P.ws + WS_RB); bf16* Y2 = (bf16*)(P.ws + WS_RB);
    const int NCG = DP / 8;
    const int nitems = (M / 32) * NCG;
    for (int it = F.vcu * 512 + F.tid; it < nitems; it += F.G * 512) {
        const int cg = it % NCG, tb = it / NCG, c0 = cg * 8, t0 = tb * 32, win = 2 << (c0 / PGD);
        const int pos0 = t0 % SEQ;
        float sc[8]; { const f32x4 a = *(const f32x4*)(P.pool_scale + c0), b = *(const f32x4*)(P.pool_scale + c0 + 4); sc[0] = a.x; sc[1] = a.y; sc[2] = a.z; sc[3] = a.w; sc[4] = b.x; sc[5] = b.y; sc[6] = b.z; sc[7] = b.w; }
        float s[8];
#pragma unroll
        for (int j = 0; j < 8; ++j) s[j] = 0.f;
        if (pos0 > 0) {
            if (win == 2) pool_prefill<1>(V + (size_t)t0 * DP + c0, s);
            else if (win == 4) pool_prefill<3>(V + (size_t)t0 * DP + c0, s);
            else if (win == 8) pool_prefill<7>(V + (size_t)t0 * DP + c0, s);
            else pool_prefill<15>(V + (size_t)t0 * DP + c0, s);
        }
        for (int tt = 0; tt < 32; tt += 8) {
            v4u rv[8], gv[8], qv[8];
#pragma unroll
            for (int u = 0; u < 8; ++u) { const int t = tt + u; rv[u] = *(const v4u*)(V + (size_t)(t0 + t) * DP + c0); gv[u] = *(const v4u*)(GT + (size_t)(t0 + t) * DP + c0);
                const int pd = pos0 + t - (win - 1); qv[u] = *(const v4u*)(V + (size_t)(t0 + t - (pd >= 0 ? win - 1 : 0)) * DP + c0); }
#pragma unroll
            for (int u = 0; u < 8; ++u) { const int t = tt + u, pos = pos0 + t; const v4u r = rv[u], gr = gv[u], q = qv[u];
                const float cur[8] = {bflo(r.x), bfhi(r.x), bflo(r.y), bfhi(r.y), bflo(r.z), bfhi(r.z), bflo(r.w), bfhi(r.w)};
                const float gt[8] = {bflo(gr.x), bfhi(gr.x), bflo(gr.y), bfhi(gr.y), bflo(gr.z), bfhi(gr.z), bflo(gr.w), bfhi(gr.w)};
#pragma unroll
                for (int j = 0; j < 8; ++j) s[j] += cur[j];
                const int cnt = (pos + 1 < win) ? (pos + 1) : win; const float inv = 1.0f / (float)cnt;
                float o[8];
#pragma unroll
                for (int j = 0; j < 8; ++j) o[j] = (s[j] * inv - cur[j]) * sc[j] * (gt[j] * sigm(gt[j]));
                v4u ow; ow.x = pk2(o[0], o[1]); ow.y = pk2(o[2], o[3]); ow.z = pk2(o[4], o[5]); ow.w = pk2(o[6], o[7]);
                *(v4u*)(Y2 + (size_t)(t0 + t) * DP + c0) = ow;
                if (pos - (win - 1) >= 0) {
                    s[0] -= bflo(q.x); s[1] -= bfhi(q.x); s[2] -= bflo(q.y); s[3] -= bfhi(q.y); s[4] -= bflo(q.z); s[5] -= bfhi(q.z); s[6] -= bflo(q.w); s[7] -= bfhi(q.w); } }
        }
    }
}

__device__ __forceinline__ void fin_load(const float* row, int lane, f32x4 (&v)[8]) {
#pragma unroll
    for (int j = 0; j < 8; ++j) v[j] = ((const f32x4*)row)[lane + 64 * j];
}
__device__ __forceinline__ void fin_process(float* row, int lane, const f32x4 (&v)[8], const f32x4 (&gv)[8]) {
    float s = 0.f;
#pragma unroll
    for (int j = 0; j < 8; ++j) s += (v[j].x * v[j].x + v[j].y * v[j].y) + (v[j].z * v[j].z + v[j].w * v[j].w);
    s = wave_sum(s);
    const float rs = rsqrtf(s * (1.0f / DM) + EPS);
#pragma unroll
    for (int j = 0; j < 8; ++j) ((f32x4*)row)[lane + 64 * j] = v[j] * rs * gv[j];
}
__device__ __forceinline__ void phase_final(const Ctx& F, const Ptrs& P) {
    const int gw = F.vcu * NWAVES + F.wave, NGW = F.G * NWAVES, lane = F.lane;
    f32x4 gv[8];
#pragma unroll
    for (int j = 0; j < 8; ++j) gv[j] = ((const f32x4*)P.final_g)[lane + 64 * j];
    const int cnt = (M - gw + NGW - 1) / NGW;
    f32x4 vA[8], vB[8];
    fin_load(P.out + (size_t)gw * DM, lane, vA);
    for (int j = 0; j < cnt; j += 2) {
        { const int jn = (j + 1 < cnt) ? j + 1 : j; fin_load(P.out + (size_t)(gw + jn * NGW) * DM, lane, vB); }
        fin_process(P.out + (size_t)(gw + j * NGW) * DM, lane, vA, gv);
        if (j + 1 < cnt) {
            { const int jn = (j + 2 < cnt) ? j + 2 : j + 1; fin_load(P.out + (size_t)(gw + jn * NGW) * DM, lane, vA); }
            fin_process(P.out + (size_t)(gw + (j + 1) * NGW) * DM, lane, vB, gv);
        }
    }
}

constexpr int N_PHASES = 10;
struct Args { Ptrs p; int ph_lo, ph_hi, li, pad; };
typedef __attribute__((address_space(4))) const Args* KArgsPtr;
__device__ __forceinline__ Ptrs load_ptrs() {
    Ptrs r{};
#if defined(__HIP_DEVICE_COMPILE__)
    KArgsPtr ka = (KArgsPtr)__builtin_amdgcn_kernarg_segment_ptr(); asm volatile("" : "+s"(ka));
    r.x = ka->p.x; r.ln_g = ka->p.ln_g; r.final_g = ka->p.final_g; r.ssm_w_in = ka->p.ssm_w_in; r.conv_w = ka->p.conv_w; r.conv_b = ka->p.conv_b; r.dt_bias = ka->p.dt_bias; r.a_log = ka->p.a_log; r.ssm_d = ka->p.ssm_d;
    r.norm_g = ka->p.norm_g; r.ssm_w_out = ka->p.ssm_w_out; r.pool_w_in = ka->p.pool_w_in; r.pool_w_group = ka->p.pool_w_group; r.pool_scale = ka->p.pool_scale; r.pool_w_out = ka->p.pool_w_out; r.out = ka->p.out; r.ws = ka->p.ws;
#endif
    return r;
}
__global__ void __launch_bounds__(NWAVES * 64, 2) trunk_fwd(Args args) {
    extern __shared__ __attribute__((aligned(16))) unsigned char lds[];
    Ctx F;
    F.lds = (LAS unsigned char*)lds;
    F.tid = threadIdx.x; F.lane = F.tid & 63; F.wave = __builtin_amdgcn_readfirstlane(F.tid >> 6);
    F.G = gridDim.x; { const int bx = blockIdx.x; F.vcu = (F.G % 8 == 0) ? (bx % 8) * (F.G / 8) + bx / 8 : bx; }
    unsigned* ctl0; { const Ptrs P0 = load_ptrs(); ctl0 = (unsigned*)(P0.ws + WS_CTL); }
    for (int u = F.tid; u < (LDS_BYTES - LDSCTL_OFF) / 4; u += NWAVES * 64) ((LAS unsigned*)(F.lds + LDSCTL_OFF))[u] = 0u;
    __syncthreads();
#if MK_ONE_LAUNCH
    XcdBarrier bar = xcd_barrier_post(ctl0 + CW_BAR, (volatile LAS unsigned*)(F.lds + MISC_OFF) + 8);
#define GRID_BAR() xcd_barrier(bar)
#else
#define GRID_BAR() do {} while (0)
#endif
    const int lo = args.ph_lo, hi = args.ph_hi;
#define IN(k) (lo <= (k) && (k) < hi)
#define BOTH(k) (IN(k) && IN((k) + 1))
#define PHASE_VARS const Ptrs P = load_ptrs(); unsigned* ctl = (unsigned*)(P.ws + WS_CTL); \
    float* ssq1 = (float*)ctl + CW_SSQ1; float* ssq3p = (float*)(P.ws + WS_SSQP + 4 * MiB); const float* ssqp = (const float*)(P.ws + WS_SSQP);   \
    bf16* W1T = (bf16*)(P.ws + WS_W1T); bf16* W2T = (bf16*)(P.ws + WS_W2T); bf16* W3T = (bf16*)(P.ws + WS_W3T); bf16* W4T = (bf16*)(P.ws + WS_W4T); bf16* W5T = (bf16*)(P.ws + WS_W5T); \
    bf16* RA = (bf16*)(P.ws + WS_RA); bf16* RB = (bf16*)(P.ws + WS_RB); bf16* RC = (bf16*)(P.ws + WS_RC); \
    (void)ctl; (void)ssq1; (void)ssq3p; (void)ssqp; (void)W1T; (void)W2T; (void)W3T; (void)W4T; (void)W5T; (void)RA; (void)RB; (void)RC;

#define REP(k) (1 + ((REPEAT_MASK >> (k)) & 1))
    unsigned long long ts_a = 0, ts_b = 0;
#define TS_A(k) do { if (STAMP_PHASE == (k)) ts_a = __builtin_amdgcn_s_memrealtime(); } while (0)
#define TS_B(k) do { if (STAMP_PHASE == (k)) ts_b = __builtin_amdgcn_s_memrealtime(); } while (0)
    TS_A(0);
    if (IN(0)) { PHASE_VARS for (int rep = 0; rep < REP(0); ++rep) phase_prep(F, P); if (BOTH(0)) GRID_BAR(); }
    TS_B(0);
    TS_A(1);
    if (IN(1)) {
        PHASE_VARS
        {
          pg8::Gemm g{W4T, (const bf16*)P.out, DP, DM, PGD, PGD, DP, 30, 2}; pg8::StaticOrder S; S.init(DP, DM, F.G, (int)blockIdx.x);
          pg8::EpiPlain E{W3T, DM};
          TS_A(10); pg8::gemm_phase<pg8::EpiPlain, pg8::StaticOrder, true, true>(F.lds + RING_OFF, g, S, E);
          { constexpr int NWC = (DP / 256) * (DM / 256); if ((int)blockIdx.x >= NWC && F.G > NWC) prep_transposes(F, P, 1, ((int)blockIdx.x - NWC) * NWAVES + F.wave, (F.G - NWC) * NWAVES); else if (F.G <= NWC) prep_transposes(F, P, 1, F.vcu * NWAVES + F.wave, F.G * NWAVES); }
          __syncthreads(); TS_B(10); }
        TS_A(11); for (int rep = 0; rep < REP(10); ++rep) phase_dt(F, P); TS_B(11);
        for (int rep = 0; rep < REP(1); ++rep) {
        pg8::Gemm g{RC, W1T, M, N1, DM, DM, DM, 30, 30}; pg8::StaticOrder S; S.init(M, N1, F.G, (int)blockIdx.x);
        pg8::EpiProj E{RA, DI, RB, CONV_DIM, DI / 256, ssq1, 1.0f / DM, nullptr};
        pg8::gemm_phase<pg8::EpiProj, pg8::StaticOrder, true, true>(F.lds + RING_OFF, g, S, E);
        }
        if (BOTH(1)) GRID_BAR();
    }
    TS_B(1);
    TS_A(2);
    if (IN(2)) { PHASE_VARS for (int rep = 0; rep < REP(2); ++rep) phase_bcprep(F, P); if (BOTH(2)) GRID_BAR(); }
    TS_B(2);
    TS_A(3);
    if (IN(3)) { PHASE_VARS if (REP(3) > 1) phase_ssd<true>(F, P); phase_ssd<false>(F, P); if (BOTH(3)) GRID_BAR(); }
    TS_B(3);
    TS_A(4);
    if (IN(4)) {
        PHASE_VARS
        for (int rep = 0; rep < REP(4); ++rep) {
        pg8::Gemm g{RA, W2T, M, DM, DI, DI, DI, 30, 30}; pg8::StaticOrder S; S.init(M, DM, F.G, (int)blockIdx.x);
        LAS float* rs_tab = (LAS float*)(F.lds + pg8::STAGE_BYTES);
        {
          pg8::Unit uu; const int o = F.tid >> 8, rr = F.tid & 255;
          if (S.next(o, uu)) { const f32x4* pp = (const f32x4*)(ssqp + (size_t)(uu.pm * 256 + rr) * NH); f32x4 a = pp[0];
#pragma unroll
              for (int j = 1; j < 16; ++j) a = a + pp[j];
              rs_tab[o * 256 + rr] = rsqrtf(((a[0] + a[1]) + (a[2] + a[3])) * (1.0f / DI) + EPS); }
          __syncthreads(); }
        pg8::EpiResB E{RC, rs_tab, ssq3p, DM};
        pg8::gemm_phase<pg8::EpiResB, pg8::StaticOrder, true, true>(F.lds + RING_OFF, g, S, E);
        }
        if (BOTH(4)) GRID_BAR();
    }
    TS_B(4);
    TS_A(5);
    if (IN(5)) {
        PHASE_VARS
        for (int rep = 0; rep < REP(5); ++rep) {
        pg8::Gemm g{RC, W3T, M, 2 * DP, DM, DM, DM, 30, 30}; pg8::StaticOrder S; S.init(M, 2 * DP, F.G, (int)blockIdx.x);
        LAS float* rs_tab = (LAS float*)(F.lds + pg8::STAGE_BYTES);
        {
          for (int o = F.tid >> 8; o < 8; o += 2) { pg8::Unit uu; const int rr = F.tid & 255;
            if (S.next(o, uu)) { const f32x4* pp = (const f32x4*)(ssq3p + (size_t)(uu.pm * 256 + rr) * 32); f32x4 a = pp[0];
#pragma unroll
              for (int j = 1; j < 8; ++j) a = a + pp[j];
              rs_tab[o * 256 + rr] = rsqrtf(((a[0] + a[1]) + (a[2] + a[3])) * (1.0f / DM) + EPS); } }
          __syncthreads(); }
        pg8::EpiProj E{RA, DP, RB, DP, DP / 256, nullptr, 0.f, rs_tab};
        pg8::gemm_phase<pg8::EpiProj, pg8::StaticOrder, true, true>(F.lds + RING_OFF, g, S, E);
        }
        if (BOTH(5)) GRID_BAR();
    }
    TS_B(5);
    TS_A(6);
    if (IN(6)) { PHASE_VARS for (int rep = 0; rep < REP(6); ++rep) phase_pool(F, P); if (BOTH(6)) GRID_BAR(); }
    TS_B(6);
    TS_A(8);
    if (IN(8)) {
        PHASE_VARS
        pg8::Gemm g{RB, W5T, M, DM, DP, DP, DP, 30, 30}; pg8::PanelOrder S; S.init(F.G, (int)blockIdx.x);
        pg8::EpiFinal E{RC, P.out, P.final_g, (float*)(P.ws + WS_SSQP + 6 * MiB), ctl + CW_FIN, ctl + CW_TMO, F.lds + pg8::STAGE_BYTES, DM};
        pg8::gemm_phase<pg8::EpiFinal, pg8::PanelOrder, true, true>(F.lds + RING_OFF, g, S, E);
    }
    TS_B(8);
    if (STAMP_PHASE >= 0) { const unsigned long long t0 = __builtin_amdgcn_s_memrealtime(); while (__builtin_amdgcn_s_memrealtime() - t0 < ts_b - ts_a) __builtin_amdgcn_s_sleep(8); }
#undef IN
#undef BOTH
}

extern "C" void kernel_launch(void* const* d_in, const int* in_sizes, int n_in, void* d_out, int out_size, void* d_ws, size_t ws_size, hipStream_t stream) {
    static int grid = 0;
    if (grid == 0) {
        if (n_in != 15 || in_sizes[0] != M * DM || out_size != M * DM || ws_size < WS_END) { fprintf(stderr, "kernel_launch: unexpected shapes: n_in %d in0 %d out %d ws %zu (need %zu); nothing launched\n", n_in, n_in > 0 ? in_sizes[0] : -1, out_size, ws_size, (size_t)WS_END); grid = -1; return; }
        int dev = 0, cus = 0, per_cu = 0;
        if (hipGetDevice(&dev) != hipSuccess || hipDeviceGetAttribute(&cus, hipDeviceAttributeMultiprocessorCount, dev) != hipSuccess) { fprintf(stderr, "kernel_launch: device query failed\n"); grid = -1; return; }
        if (hipFuncSetAttribute((const void*)trunk_fwd, hipFuncAttributeMaxDynamicSharedMemorySize, LDS_BYTES) != hipSuccess) { fprintf(stderr, "kernel_launch: hipFuncSetAttribute failed\n"); grid = -1; return; }
        if (hipOccupancyMaxActiveBlocksPerMultiprocessor(&per_cu, (const void*)trunk_fwd, NWAVES * 64, LDS_BYTES) != hipSuccess || per_cu < 1) { fprintf(stderr, "kernel_launch: occupancy query says %d blocks per CU\n", per_cu); }
        (void)hipGetLastError();
        grid = cus;
        if (cus != 256) { fprintf(stderr, "kernel_launch: this kernel's unit orders are built for a 256-CU device (got %d CUs); nothing launched\n", cus); grid = -1; return; }
    }
    if (grid < 0) return;
    if (hipMemsetAsync((char*)d_ws + WS_CTL, 0, CTL_ZERO_BYTES, stream) != hipSuccess) { fprintf(stderr, "kernel_launch: memset failed\n"); return; }
    Args a{};
    a.p.x = (const float*)d_in[0]; a.p.ln_g = (const float*)d_in[1]; a.p.final_g = (const float*)d_in[2]; a.p.ssm_w_in = (const float*)d_in[3]; a.p.conv_w = (const float*)d_in[4];
    a.p.conv_b = (const float*)d_in[5]; a.p.dt_bias = (const float*)d_in[6]; a.p.a_log = (const float*)d_in[7]; a.p.ssm_d = (const float*)d_in[8]; a.p.norm_g = (const float*)d_in[9];
    a.p.ssm_w_out = (const float*)d_in[10]; a.p.pool_w_in = (const float*)d_in[11]; a.p.pool_w_group = (const float*)d_in[12]; a.p.pool_scale = (const float*)d_in[13]; a.p.pool_w_out = (const float*)d_in[14];
    a.p.out = (float*)d_out; a.p.ws = (unsigned char*)d_ws;
#if MK_ONE_LAUNCH
    a.ph_lo = 0; a.ph_hi = N_PHASES; a.li = 0;
    hipLaunchKernelGGL(trunk_fwd, dim3(grid), dim3(NWAVES * 64), LDS_BYTES, stream, a);
#else
    for (int li = 0; li < N_PHASES; ++li) { a.ph_lo = li; a.ph_hi = li + 1; a.li = li;
        hipLaunchKernelGGL(trunk_fwd, dim3(grid), dim3(NWAVES * 64), LDS_BYTES, stream, a); }
#endif
    const hipError_t le = hipPeekAtLastError();
    if (le != hipSuccess) fprintf(stderr, "kernel_launch: launch failed: %s\n", hipGetErrorName(le));
}
```
